# Optimizing an MI355X kernel written in HIP

```python
import jax, jax.numpy as jnp
from jax import lax
import numpy as np

D_MODEL = 1024
BATCH = 8
SEQ = 2048
DEPTH = 4

GLA_HEADS = 4
GLA_DK = 64
GLA_DV = 128
GLA_KEY = GLA_HEADS * GLA_DK
GLA_VAL = GLA_HEADS * GLA_DV
GLA_RANK = 16
GLA_TAU = 16.0
GLA_CHUNK = 64
SGU_HEADS = 4
SGU_CHUNK = 128
SGU_W = 512
SGU_DH = SGU_W // SGU_HEADS
CONV_GROUPS = 4
CONV_W = 512
CONV_K = 3
N_BRANCH = 3
D_FF = 2816
FFN_CONV_K = 3
EPS = 1e-6

IN_SPLITS = (GLA_KEY, GLA_KEY, GLA_VAL, GLA_VAL, GLA_RANK, SGU_W, SGU_W, CONV_W, CONV_W, CONV_W, N_BRANCH * D_MODEL)
IN_COLS = 2 * GLA_KEY + 2 * GLA_VAL + GLA_RANK + 2 * SGU_W + 3 * CONV_W + N_BRANCH * D_MODEL

kernel_name = 'hybrid_gla_sgu_shortconv_convffn'


def rms_norm(x, g):
    xf = x.astype(jnp.float32)
    y = xf * lax.rsqrt(jnp.mean(xf * xf, axis=-1, keepdims=True) + EPS)
    return (y * g.astype(jnp.float32)).astype(x.dtype)


def layer_norm(x, g, b):
    xf = x.astype(jnp.float32)
    mu = jnp.mean(xf, axis=-1, keepdims=True)
    xc = xf - mu
    y = xc * lax.rsqrt(jnp.mean(xc * xc, axis=-1, keepdims=True) + EPS)
    return (y * g.astype(jnp.float32) + b.astype(jnp.float32)).astype(x.dtype)


def causal_dwconv(x, w):
    K = w.shape[0]
    S = x.shape[1]
    xp = jnp.pad(x, ((0, 0), (K - 1, 0), (0, 0)))
    y = xp[:, 0:S] * w[0]
    for kk in range(1, K):
        y = y + xp[:, kk:kk + S] * w[kk]
    return y


def gla_chunked(q, k, v, log_a):
    Bsz, S, H, dk = q.shape
    dv = v.shape[-1]
    C = GLA_CHUNK
    n = S // C
    f32 = jnp.float32
    q, k, v, log_a = (t.astype(f32).reshape(Bsz, n, C, H, t.shape[-1]) for t in (q, k, v, log_a))
    b = jnp.cumsum(log_a, axis=2)
    b_last = b[:, :, -1:]
    q_t = q * jnp.exp(b)
    k_t = k * jnp.exp(-b)
    k_end = k * jnp.exp(b_last - b)
    causal = jnp.tril(jnp.ones((C, C), dtype=bool))
    scores = jnp.einsum('bnihk,bnjhk->bnhij', q_t, k_t)
    scores = jnp.where(causal, scores, 0.0)
    o_intra = jnp.einsum('bnhij,bnjhv->bnihv', scores, v)
    chunk_state = jnp.einsum('bnjhk,bnjhv->bnhkv', k_end, v)
    decay = jnp.exp(b_last[:, :, 0])

    def step(s_prev, inp):
        dec, cs = inp
        return dec[..., None] * s_prev + cs, s_prev

    s0 = jnp.zeros((Bsz, H, dk, dv), f32)
    _, s_prevs = lax.scan(step, s0, (jnp.moveaxis(decay, 1, 0), jnp.moveaxis(chunk_state, 1, 0)))
    s_prevs = jnp.moveaxis(s_prevs, 0, 1)
    o_inter = jnp.einsum('bnihk,bnhkv->bnihv', q_t, s_prevs)
    return (o_intra + o_inter).reshape(Bsz, S, H, dv)


def sgu_chunked(u, v, ln_g, ln_b, ws, bs):
    Bsz, S, _ = v.shape
    n = S // SGU_CHUNK
    v = layer_norm(v, ln_g, ln_b)
    v = v.reshape(Bsz, n, SGU_CHUNK, SGU_HEADS, SGU_DH)
    ws_causal = jnp.where(jnp.tril(jnp.ones((SGU_CHUNK, SGU_CHUNK), dtype=bool)), ws, 0.0)
    mixed = jnp.einsum('hts,bnshd->bnthd', ws_causal, v) + jnp.transpose(bs)[None, None, :, :, None]
    return u * mixed.reshape(Bsz, S, SGU_W)


def setup_inputs(seed: int = 0) -> dict:
    key = jax.random.key(seed)
    ks = jax.random.split(key, 24)
    f32 = jnp.float32

    def nrm(k, shape, scale):
        return jax.random.normal(k, shape, f32) * scale

    L = DEPTH
    return {
        'x': nrm(ks[0], (BATCH, SEQ, D_MODEL), 1.0),
        'norm_mix': 1.0 + nrm(ks[1], (L, D_MODEL), 0.02),
        'w_in': nrm(ks[2], (L, D_MODEL, IN_COLS), D_MODEL ** -0.5),
        'gla_w_alpha': nrm(ks[3], (L, GLA_RANK, GLA_KEY), GLA_RANK ** -0.5),
        'gla_b_alpha': nrm(ks[4], (L, GLA_KEY), 0.1),
        'gla_norm': 1.0 + nrm(ks[5], (L, GLA_VAL), 0.02),
        'gla_w_out': nrm(ks[6], (L, GLA_VAL, D_MODEL), GLA_VAL ** -0.5),
        'sgu_ln_g': 1.0 + nrm(ks[7], (L, SGU_W), 0.02),
        'sgu_ln_b': nrm(ks[8], (L, SGU_W), 0.02),
        'sgu_ws': nrm(ks[9], (L, SGU_HEADS, SGU_CHUNK, SGU_CHUNK), SGU_CHUNK ** -0.5),
        'sgu_bs': 1.0 + nrm(ks[10], (L, SGU_HEADS, SGU_CHUNK), 0.02),
        'sgu_w_out': nrm(ks[11], (L, SGU_W, D_MODEL), SGU_W ** -0.5),
        'conv_w': nrm(ks[12], (L, CONV_K, CONV_W), CONV_K ** -0.5),
        'conv_w_out': nrm(ks[13], (L, CONV_W, D_MODEL), CONV_W ** -0.5),
        'w_o': nrm(ks[14], (L, D_MODEL, D_MODEL), D_MODEL ** -0.5),
        'norm_ffn': 1.0 + nrm(ks[15], (L, D_MODEL), 0.02),
        'ffn_w_up': nrm(ks[16], (L, D_MODEL, 2 * D_FF), D_MODEL ** -0.5),
        'ffn_conv_w': nrm(ks[17], (L, FFN_CONV_K, 2 * D_FF), FFN_CONV_K ** -0.5),
        'ffn_conv_b': nrm(ks[18], (L, 2 * D_FF), 0.01),
        'ffn_w_down': nrm(ks[19], (L, D_FF, D_MODEL), D_FF ** -0.5),
        'norm_final': 1.0 + nrm(ks[20], (D_MODEL,), 0.02),
    }


def reference(x, norm_mix, w_in, gla_w_alpha, gla_b_alpha, gla_norm, gla_w_out,
              sgu_ln_g, sgu_ln_b, sgu_ws, sgu_bs, sgu_w_out, conv_w, conv_w_out,
              w_o, norm_ffn, ffn_w_up, ffn_conv_w, ffn_conv_b, ffn_w_down, norm_final):
    Bsz, S, D = x.shape
    split_points = np.cumsum(IN_SPLITS)[:-1].tolist()
    for l in range(DEPTH):
        h = rms_norm(x, norm_mix[l])
        proj = h @ w_in[l]
        (q, k, v, g_out, a_lr, su, sv, cb, cc, cx, gate_logits) = jnp.split(proj, split_points, axis=-1)

        log_a = jax.nn.log_sigmoid((a_lr @ gla_w_alpha[l] + gla_b_alpha[l]).astype(jnp.float32)) / GLA_TAU
        o = gla_chunked(q.reshape(Bsz, S, GLA_HEADS, GLA_DK) * (GLA_DK ** -0.5),
                        k.reshape(Bsz, S, GLA_HEADS, GLA_DK),
                        v.reshape(Bsz, S, GLA_HEADS, GLA_DV),
                        log_a.reshape(Bsz, S, GLA_HEADS, GLA_DK))
        o = rms_norm(o, gla_norm[l].reshape(GLA_HEADS, GLA_DV)).astype(x.dtype).reshape(Bsz, S, GLA_VAL)
        y_a = (o * jax.nn.silu(g_out)) @ gla_w_out[l]

        y_b = sgu_chunked(jax.nn.gelu(su), jax.nn.gelu(sv), sgu_ln_g[l], sgu_ln_b[l],
                          sgu_ws[l], sgu_bs[l]) @ sgu_w_out[l]

        y_c = (cb * causal_dwconv(cc * cx, conv_w[l])) @ conv_w_out[l]

        gt = jax.nn.sigmoid(gate_logits).reshape(Bsz, S, N_BRANCH, D)
        merged = gt[:, :, 0] * y_a + gt[:, :, 1] * y_b + gt[:, :, 2] * y_c
        x = x + merged @ w_o[l]

        h = rms_norm(x, norm_ffn[l])
        a = causal_dwconv(h @ ffn_w_up[l], ffn_conv_w[l]) + ffn_conv_b[l]
        gate, val = jnp.split(a, 2, axis=-1)
        x = x + (jax.nn.silu(gate) * val) @ ffn_w_down[l]
    return rms_norm(x, norm_final)
```

```cpp
#include <hip/hip_runtime.h>
#include <hip/hip_cooperative_groups.h>
#include <cstdio>
#include <cstdint>
#include <cmath>
namespace cg = cooperative_groups;

#ifndef MK_ONE_LAUNCH
#define MK_ONE_LAUNCH 1
#endif

namespace cfg {
constexpr int D = 1024, BATCH = 8, SEQ = 2048, DEPTH = 4, M = BATCH * SEQ;
constexpr int GH = 4, GDK = 64, GDV = 128, GKEY = 256, GVAL = 512, GRANK = 16;
constexpr int SGW = 512, SGC = 128, CW = 512, DFF = 2816, DFF2 = 5632;
constexpr int INC = 7184, NIN = 7424;
constexpr int O_Q = 0, O_K = 256, O_V = 512, O_G = 1024, O_A = 1536, O_SU = 1552, O_SV = 2064, O_CB = 2576, O_CC = 3088, O_CX = 3600, O_GT = 4112;
constexpr float EPS = 1e-6f;
}
using namespace cfg;

namespace pg8 {
#define PG8_LAS __attribute__((address_space(3)))
typedef unsigned short bf16_t;
typedef short bf16x8 __attribute__((ext_vector_type(8)));
typedef float f32x4 __attribute__((ext_vector_type(4)));
typedef unsigned u32x4 __attribute__((ext_vector_type(4)));
constexpr int BM = 256, BK = 64, HALF = 128, HTB = HALF * BK * 2  , STAGE_BYTES = 8 * HTB, NXCD = 8, WGM = 8;

__host__ __device__ __forceinline__ int lds_byte(int r, int c) { const int st = (r >> 4) * 2 + (c >> 5), rr = r & 15, cc = c & 31, ob = rr * 64 + cc * 2; return st * 1024 + (ob ^ (((ob >> 9) & 1) << 5)); }
__host__ __device__ __forceinline__ void stage_rc(int b, int& R, int& C) { const int st = b / 1024, sb = b % 1024, swz = sb ^ (((sb >> 9) & 1) << 5); R = (st >> 1) * 16 + swz / 64; C = (st & 1) * 32 + (swz % 64) / 2; }
__host__ __device__ __forceinline__ int perm32(int rho) { const int n = rho >> 4, i = rho & 15; return 8 * (i >> 2) + 4 * n + (i & 3); }

struct Unit { int pm, pn; };
struct Gemm { const bf16_t* A; const bf16_t* Bt; int M, N, K; };

struct StaticOrder {
    int nM, nN, nwg, G, c;
    __host__ __device__ void init(int M, int N, int G_, int c_) { nM = M / BM; nN = N / BM; nwg = nM * nN; G = G_; c = c_; }
    __host__ __device__ bool next(int i, Unit& u) const {
        const long L = (long)i * G + c; if (L >= nwg) return false;
        int wgid = (int)L; { const int q = nwg / NXCD, r = nwg % NXCD, xcd = wgid % NXCD, off = wgid / NXCD; wgid = (xcd < r ? xcd * (q + 1) : r * (q + 1) + (xcd - r) * q) + off; }
        const int nig = WGM * nN, gid = wgid / nig, fm = gid * WGM, gsz = (nM - fm) < WGM ? (nM - fm) : WGM;
        u.pm = fm + ((wgid % nig) % gsz); u.pn = (wgid % nig) / gsz; return true;
    }
    __device__ __forceinline__ void a_ready(const Unit&) const {}
    __device__ __forceinline__ void done(const Unit&) const {}
};

__device__ __forceinline__ unsigned cvt_pk_bf16(float lo, float hi) { unsigned r; asm volatile("v_cvt_pk_bf16_f32 %0, %1, %2" : "=v"(r) : "v"(lo), "v"(hi)); return r; }
typedef float f32x2 __attribute__((ext_vector_type(2)));
template <class Epi, class Sched, bool ALIGN_EPI = false, bool SP2 = false>
__device__ __forceinline__ void gemm_phase(PG8_LAS unsigned char* lds, const Gemm g, const Sched& S, const Epi& E) {
    int tid_ = threadIdx.x; asm volatile("" : "+v"(tid_));
    const int tid = tid_, wid = __builtin_amdgcn_readfirstlane(tid >> 6), lane = tid & 63, wr = wid >> 2, wc = wid & 3, fr = lane & 15, fq = lane >> 4;
    const int K = g.K, nt = K / BK;
    unsigned voffA[2], voffB[2];
#pragma unroll
    for (int i = 0; i < 2; ++i) { int R, C; stage_rc(tid * 16 + i * 8192, R, C); const int Rb = Epi::PERM ? ((R & ~31) + perm32(R & 31)) : R;
        voffA[i] = (unsigned)(R * K + C) * 2u; voffB[i] = (unsigned)(Rb * K + C) * 2u; }
    const size_t kstep = (size_t)(BK * 2);
    const size_t hstep = (size_t)HALF * K * 2;
    const size_t tstep = 2 * hstep;
    const unsigned ldsw = (unsigned)wid * 1024u;
    const int aoff = lds_byte(wr * 64 + fr, fq * 8), boff = lds_byte(wc * 32 + fr, fq * 8);
#define PG8_SA(b, h) (((b) * 2 + (h)) * HTB)
#define PG8_SB(b, h) ((4 + (b) * 2 + (h)) * HTB)
#define PG8_STAGE(bufoff, gbase, voff) do { _Pragma("unroll") for (int _i = 0; _i < 2; ++_i) \
        __builtin_amdgcn_global_load_lds((const unsigned*)((const char*)(gbase) + (voff)[_i]), (PG8_LAS unsigned*)(lds + (bufoff) + ldsw + _i * 8192), 16, 0, 0); } while (0)
#define PG8_LDA(dst, b, h) do { _Pragma("unroll") for (int m = 0; m < 4; ++m) _Pragma("unroll") for (int k = 0; k < 2; ++k) dst[m][k] = *(const PG8_LAS bf16x8*)(lds + PG8_SA(b, h) + aoff + m * 2048 + k * 1024); } while (0)
#define PG8_LDB(dst, b, h) do { _Pragma("unroll") for (int n = 0; n < 2; ++n) _Pragma("unroll") for (int k = 0; k < 2; ++k) dst[n][k] = *(const PG8_LAS bf16x8*)(lds + PG8_SB(b, h) + boff + n * 2048 + k * 1024); } while (0)
#define PG8_MMA(ai, bj, At, Bt) do { __builtin_amdgcn_s_setprio(1); _Pragma("unroll") for (int m = 0; m < 4; ++m) _Pragma("unroll") for (int n = 0; n < 2; ++n) _Pragma("unroll") for (int k = 0; k < 2; ++k) \
        acc[ai][bj][m][n] = __builtin_amdgcn_mfma_f32_16x16x32_bf16(Bt[n][k], At[m][k], acc[ai][bj][m][n], 0, 0, 0); __builtin_amdgcn_s_setprio(0); } while (0)
#define PG8_WAIT_V(n) asm volatile("s_waitcnt vmcnt(" #n ")" ::: "memory")
#define PG8_WAIT_L(n) asm volatile("s_waitcnt lgkmcnt(" #n ")" ::: "memory")
#define PG8_BAR __builtin_amdgcn_s_barrier()
#define PG8_SCHED __builtin_amdgcn_sched_barrier(0)
    Unit cur, nxt; int ui = 0;
    if (!S.next(0, cur)) return;
    f32x4 acc[2][2][4][2];
#pragma unroll
    for (int a = 0; a < 2; ++a)
#pragma unroll
        for (int b = 0; b < 2; ++b)
#pragma unroll
            for (int m = 0; m < 4; ++m)
#pragma unroll
                for (int n = 0; n < 2; ++n) acc[a][b][m][n] = (f32x4){0.f, 0.f, 0.f, 0.f};
    bf16x8 At[4][2], B0[2][2], B1[2][2];
    const char* cA = (const char*)g.A + (size_t)cur.pm * tstep; const char* cB = (const char*)g.Bt + (size_t)cur.pn * tstep;
    S.a_ready(cur);
    if constexpr (SP2) {
        PG8_STAGE(PG8_SB(0, 0), cB, voffB); PG8_STAGE(PG8_SB(0, 1), cB + hstep, voffB); PG8_STAGE(PG8_SA(0, 0), cA, voffA); PG8_STAGE(PG8_SA(0, 1), cA + hstep, voffA);
        if (wr == 1) PG8_BAR;
        PG8_WAIT_V(2); PG8_BAR;
        PG8_STAGE(PG8_SB(1, 0), cB + kstep, voffB); PG8_STAGE(PG8_SA(1, 0), cA + kstep, voffA); PG8_STAGE(PG8_SB(1, 1), cB + hstep + kstep, voffB);
        PG8_WAIT_V(6); PG8_BAR;
    } else {
        PG8_STAGE(PG8_SB(0, 0), cB, voffB); PG8_STAGE(PG8_SA(0, 0), cA, voffA); PG8_STAGE(PG8_SB(0, 1), cB + hstep, voffB); PG8_STAGE(PG8_SA(0, 1), cA + hstep, voffA);
        if (wr == 1) PG8_BAR;
        PG8_WAIT_V(4); PG8_BAR;
        PG8_STAGE(PG8_SB(1, 0), cB + kstep, voffB); PG8_STAGE(PG8_SA(1, 0), cA + kstep, voffA); PG8_STAGE(PG8_SB(1, 1), cB + hstep + kstep, voffB);
        PG8_WAIT_V(6); PG8_BAR;
    }
    for (;;) {
        const bool has_next = S.next(ui + 1, nxt);
        const char* nA = has_next ? (const char*)g.A + (size_t)nxt.pm * tstep : cA; const char* nB = has_next ? (const char*)g.Bt + (size_t)nxt.pn * tstep : cB;
        for (int t = 0; t < nt; t += 2) {
            const bool last = (t == nt - 2);
            const char* a1 = cA + (size_t)(t + 1) * kstep;
            const char* a2 = last ? nA : cA + (size_t)(t + 2) * kstep; const char* b2 = last ? nB : cB + (size_t)(t + 2) * kstep;
            const char* a3 = a2 + kstep; const char* b3 = b2 + kstep;
            if (last && has_next) S.a_ready(nxt);
            if constexpr (SP2) {
            PG8_LDB(B0, 0, 0); PG8_LDB(B1, 0, 1); PG8_SCHED; PG8_LDA(At, 0, 0); PG8_STAGE(PG8_SA(1, 1), a1 + hstep, voffA);
            PG8_WAIT_V(8); PG8_WAIT_L(0); PG8_BAR; PG8_MMA(0, 0, At, B0); PG8_MMA(0, 1, At, B1); PG8_BAR; PG8_SCHED;
            PG8_LDA(At, 0, 1); PG8_STAGE(PG8_SB(0, 0), b2, voffB); PG8_STAGE(PG8_SB(0, 1), b2 + hstep, voffB); PG8_STAGE(PG8_SA(0, 0), a2, voffA);
            PG8_WAIT_V(8); PG8_WAIT_L(0); PG8_BAR; PG8_MMA(1, 0, At, B0); PG8_MMA(1, 1, At, B1); PG8_BAR; PG8_SCHED;
            PG8_LDB(B0, 1, 0); PG8_LDB(B1, 1, 1); PG8_SCHED; PG8_LDA(At, 1, 0); PG8_STAGE(PG8_SA(0, 1), a2 + hstep, voffA);
            PG8_WAIT_V(8); PG8_WAIT_L(0); PG8_BAR; PG8_MMA(0, 0, At, B0); PG8_MMA(0, 1, At, B1); PG8_BAR; PG8_SCHED;
            PG8_LDA(At, 1, 1); PG8_STAGE(PG8_SB(1, 0), b3, voffB); PG8_STAGE(PG8_SB(1, 1), b3 + hstep, voffB); PG8_STAGE(PG8_SA(1, 0), a3, voffA);
            PG8_WAIT_V(8); PG8_WAIT_L(0); PG8_BAR; PG8_MMA(1, 0, At, B0); PG8_MMA(1, 1, At, B1); PG8_BAR; PG8_SCHED;
            } else {
            PG8_LDB(B0, 0, 0); PG8_SCHED; PG8_LDA(At, 0, 0); PG8_STAGE(PG8_SA(1, 1), a1 + hstep, voffA);
            PG8_WAIT_L(8); PG8_BAR; PG8_WAIT_L(0); PG8_MMA(0, 0, At, B0); PG8_BAR; PG8_SCHED;
            PG8_LDB(B1, 0, 1); PG8_STAGE(PG8_SB(0, 0), b2, voffB);
            PG8_BAR; PG8_WAIT_L(0); PG8_MMA(0, 1, At, B1); PG8_BAR;
            PG8_LDA(At, 0, 1); PG8_STAGE(PG8_SA(0, 0), a2, voffA);
            PG8_BAR; PG8_WAIT_L(0); PG8_MMA(1, 0, At, B0); PG8_BAR; PG8_SCHED;
            PG8_STAGE(PG8_SB(0, 1), b2 + hstep, voffB);
            PG8_WAIT_V(6); PG8_BAR; PG8_MMA(1, 1, At, B1); PG8_BAR;
            PG8_LDB(B0, 1, 0); PG8_SCHED; PG8_LDA(At, 1, 0); PG8_STAGE(PG8_SA(0, 1), a2 + hstep, voffA);
            PG8_WAIT_L(8); PG8_BAR; PG8_WAIT_L(0); PG8_MMA(0, 0, At, B0); PG8_BAR; PG8_SCHED;
            PG8_LDB(B1, 1, 1); PG8_STAGE(PG8_SB(1, 0), b3, voffB);
            PG8_BAR; PG8_WAIT_L(0); PG8_MMA(0, 1, At, B1); PG8_BAR;
            PG8_LDA(At, 1, 1); PG8_STAGE(PG8_SA(1, 0), a3, voffA);
            PG8_BAR; PG8_WAIT_L(0); PG8_MMA(1, 0, At, B0); PG8_BAR; PG8_SCHED;
            PG8_STAGE(PG8_SB(1, 1), b3 + hstep, voffB);
            PG8_WAIT_V(6); PG8_BAR; PG8_MMA(1, 1, At, B1); PG8_BAR;
            }
        }
        if constexpr (ALIGN_EPI) { if (wr == 0) PG8_BAR; }
        if constexpr (!Epi::AFTER_DRAIN) { E(acc, cur, wr, wc, fr, fq); S.done(cur); }
        if (!has_next) break;
#pragma unroll
        for (int a = 0; a < 2; ++a)
#pragma unroll
            for (int b = 0; b < 2; ++b)
#pragma unroll
                for (int m = 0; m < 4; ++m)
#pragma unroll
                    for (int n = 0; n < 2; ++n) acc[a][b][m][n] = (f32x4){0.f, 0.f, 0.f, 0.f};
        cur = nxt; cA = nA; cB = nB; ++ui;
        if constexpr (ALIGN_EPI) { if (wr == 1) PG8_BAR; }
    }
    PG8_WAIT_V(0);
    if constexpr (!ALIGN_EPI) { if (wr == 0) PG8_BAR; }
    PG8_BAR;
    if constexpr (Epi::AFTER_DRAIN) { E.fused(acc, cur, wr, wc, fr, fq, lds, wid, lane); S.done(cur); }
#undef PG8_SA
#undef PG8_SB
#undef PG8_STAGE
#undef PG8_LDA
#undef PG8_LDB
#undef PG8_MMA
#undef PG8_WAIT_V
#undef PG8_WAIT_L
#undef PG8_BAR
#undef PG8_SCHED
}
}

#define GAS __attribute__((address_space(1)))
#define LAS __attribute__((address_space(3)))
typedef unsigned short bf16;
typedef unsigned v4u __attribute__((ext_vector_type(4)));
typedef unsigned v2u __attribute__((ext_vector_type(2)));
typedef float f32x4 __attribute__((ext_vector_type(4)));
typedef float f32x2 __attribute__((ext_vector_type(2)));
typedef short bf16x8 __attribute__((ext_vector_type(8)));
constexpr int NWAVES = 8, NTHREADS = 512;
constexpr int RING_BYTES = 131072, LDS_BYTES = 147456;

constexpr size_t MiB = 1u << 20;
constexpr size_t SL_WIN = 0, SL_WBR = SL_WIN + (size_t)NIN * D * 2, SL_WO = SL_WBR + (size_t)3 * D * 512 * 2, SL_WUP = SL_WO + (size_t)D * D * 2,
                 SL_WDN = SL_WUP + (size_t)DFF2 * D * 2, SL_SGW = SL_WDN + (size_t)D * DFF * 2, SL_END = SL_SGW + (size_t)4 * 128 * 128 * 2, SL_BYTES = 38 * MiB;
static_assert(SL_END <= SL_BYTES, "weight slot");
constexpr size_t WS_CTL = 0, WS_SLOT0 = 1 * MiB, WS_XB = WS_SLOT0 + 2 * SL_BYTES, WS_SSQ = WS_XB + 32 * MiB, WS_SVST = WS_SSQ + 1 * MiB, WS_ACT0 = WS_SVST + 1 * MiB;
constexpr size_t A_Q = 0, A_K = 8 * MiB, A_V = 16 * MiB, A_Z = 32 * MiB, A_SV = 80 * MiB, A_CC = 96 * MiB, A_CX = 112 * MiB, A_LOGA = 128 * MiB, A_G = 144 * MiB,
                 A_CST = 240 * MiB, A_DEC = 272 * MiB, A_END = 273 * MiB;
constexpr size_t A_MERGED = A_Q, A_HUP = 0, A_ACT = 176 * MiB;
static_assert(A_ACT + (size_t)M * DFF * 2 <= A_END, "overlay");
constexpr size_t WS_END = WS_ACT0 + A_END;

__device__ __forceinline__ float bf2f(unsigned h) { return __uint_as_float(h << 16); }
__device__ __forceinline__ unsigned pk2(float lo, float hi) { return pg8::cvt_pk_bf16(lo, hi); }
__device__ __forceinline__ float fsigmoid(float z) { return __builtin_amdgcn_rcpf(1.f + __expf(-z)); }
__device__ __forceinline__ float fsilu(float z) { return z * fsigmoid(z); }
__device__ __forceinline__ float fgelu(float z) { return z * fsigmoid(1.5957691216057308f * (z + 0.044715f * z * z * z)); }
__device__ __forceinline__ float flogsig(float z) { return fminf(z, 0.f) - __logf(1.f + __expf(-fabsf(z))); }
__device__ __forceinline__ float wave_sum(float v) {
#pragma unroll
    for (int o = 1; o < 64; o <<= 1) v += __shfl_xor(v, o);
    return v;
}
#define LDS_WAIT() asm volatile("s_waitcnt lgkmcnt(0)" ::: "memory")
__device__ __forceinline__ f32x4 mfma16(bf16x8 a, bf16x8 b, f32x4 c) { return __builtin_amdgcn_mfma_f32_16x16x32_bf16(a, b, c, 0, 0, 0); }

__device__ __forceinline__ void tr_write(bf16* WT, int K, int k0, LAS float* scr, int lane) {
    LDS_WAIT(); asm volatile("" ::: "memory");
    const int c = lane & 7;
#pragma unroll
    for (int j = 0; j < 4; ++j) { const int n = (lane >> 3) + 8 * j; const LAS float* s = scr + (8 * c) * 33 + n;
        v4u o; o.x = pk2(s[0 * 33], s[1 * 33]); o.y = pk2(s[2 * 33], s[3 * 33]); o.z = pk2(s[4 * 33], s[5 * 33]); o.w = pk2(s[6 * 33], s[7 * 33]);
        *(GAS v4u*)(WT + (size_t)n * K + k0 + 8 * c) = o; }
    LDS_WAIT(); asm volatile("" ::: "memory");
}
__device__ __forceinline__ void tr_item(const float* W, int ldw, int col0, const float* ksc, float sc, bf16* WT, int K, int k0, LAS float* scr, int lane) {
#pragma unroll 8
    for (int i = 0; i < 32; ++i) { const int kk = 2 * i + (lane >> 5); float v = W[(size_t)(k0 + kk) * ldw + col0 + (lane & 31)]; v *= ksc ? ksc[k0 + kk] * sc : sc; scr[kk * 33 + (lane & 31)] = v; }
    tr_write(WT, K, k0, scr, lane);
}
__device__ __forceinline__ void alpha_item(const float* win, const float* wal, const float* g, bf16* WT, int k0, int j0, LAS float* scr, int lane) {
    const int jj = lane & 31, half = lane >> 5; float wa[16];
#pragma unroll
    for (int r = 0; r < 16; ++r) wa[r] = wal[r * GKEY + j0 + jj];
    for (int i = 0; i < 32; ++i) { const int kk = 2 * i + half, k = k0 + kk; const float* wr = win + (size_t)k * INC + O_A; float s = 0.f;
#pragma unroll
        for (int r = 0; r < 16; ++r) s += wr[r] * wa[r];
        scr[kk * 33 + jj] = s * g[k]; }
    tr_write(WT + (size_t)j0 * D, D, k0, scr, lane);
}
struct Inputs { const float* p[21]; };
constexpr int CV_J0 = 16 * 224, CV_J1 = 16 * 8, CV_J2 = 3 * 8 * 32, CV_J3 = 16 * 32, CV_J4 = 16 * 176, CV_J5 = 44 * 32, CV_J6 = 128, CV_ITEMS = CV_J0 + CV_J1 + CV_J2 + CV_J3 + CV_J4 + CV_J5 + CV_J6;
__device__ __forceinline__ void convert_layer(const Inputs& I, int l, unsigned char* slot, LAS unsigned char* lds, int gw, int ngw, int wave, int lane) {
    LAS float* scr = (LAS float*)(lds + wave * 8448);
    bf16* WIN = (bf16*)(slot + SL_WIN); bf16* WBR = (bf16*)(slot + SL_WBR); bf16* WO = (bf16*)(slot + SL_WO); bf16* WUP = (bf16*)(slot + SL_WUP); bf16* WDN = (bf16*)(slot + SL_WDN); bf16* SGWS = (bf16*)(slot + SL_SGW);
    const float* win = I.p[2] + (size_t)l * D * INC;
    for (int it = gw; it < CV_ITEMS; it += ngw) {
        int r = it;
        if (r < CV_J0) { const int kb = r / 224, nb = r % 224; const int drow = nb < 48 ? 32 * nb : 1792 + 32 * (nb - 48), scol = nb < 48 ? 32 * nb : O_SU + 32 * (nb - 48);
            tr_item(win, INC, scol, I.p[1] + (size_t)l * D, drow < 256 ? 0.125f : 1.f, WIN + (size_t)drow * D, D, 64 * kb, scr, lane); continue; }
        r -= CV_J0;
        if (r < CV_J1) { const int kb = r / 8, jb = r % 8; alpha_item(win, I.p[3] + (size_t)l * GRANK * GKEY, I.p[1] + (size_t)l * D, WIN + (size_t)1536 * D, 64 * kb, 32 * jb, scr, lane); continue; }
        r -= CV_J1;
        if (r < CV_J2) { const int br = r / 256, rr = r % 256, kb = rr / 32, nb = rr % 32;
            const float* W = (br == 0 ? I.p[6] : br == 1 ? I.p[11] : I.p[13]) + (size_t)l * 512 * D;
            tr_item(W, D, 32 * nb, br == 0 ? I.p[5] + (size_t)l * GVAL : nullptr, 1.f, WBR + ((size_t)br * D + 32 * nb) * 512, 512, 64 * kb, scr, lane); continue; }
        r -= CV_J2;
        if (r < CV_J3) { const int kb = r / 32, nb = r % 32; tr_item(I.p[14] + (size_t)l * D * D, D, 32 * nb, nullptr, 1.f, WO + (size_t)32 * nb * D, D, 64 * kb, scr, lane); continue; }
        r -= CV_J3;
        if (r < CV_J4) { const int kb = r / 176, nb = r % 176, pn = nb / 8, jb = nb % 8; const int scol = jb < 4 ? 128 * pn + 32 * jb : DFF + 128 * pn + 32 * (jb - 4);
            tr_item(I.p[16] + (size_t)l * D * DFF2, DFF2, scol, I.p[15] + (size_t)l * D, 1.f, WUP + (size_t)32 * nb * D, D, 64 * kb, scr, lane); continue; }
        r -= CV_J4;
        if (r < CV_J5) { const int kb = r / 32, nb = r % 32; tr_item(I.p[19] + (size_t)l * DFF * D, D, 32 * nb, nullptr, 1.f, WDN + (size_t)32 * nb * DFF, DFF, 64 * kb, scr, lane); continue; }
        r -= CV_J5;
        { const int e0 = r * 512 + lane * 8, t = (e0 >> 7) & 127, s0 = e0 & 127; const float* src = I.p[9] + (size_t)l * 4 * 128 * 128 + e0;
          const f32x4 a = *(const f32x4*)src, b = *(const f32x4*)(src + 4); float v[8] = {a[0], a[1], a[2], a[3], b[0], b[1], b[2], b[3]};
#pragma unroll
          for (int e = 0; e < 8; ++e) if (s0 + e > t) v[e] = 0.f;
          v4u o; o.x = pk2(v[0], v[1]); o.y = pk2(v[2], v[3]); o.z = pk2(v[4], v[5]); o.w = pk2(v[6], v[7]); *(GAS v4u*)(SGWS + e0) = o; }
    }
}
__device__ __forceinline__ void x_prep(const float* xin, float* xout, bf16* xb, float* ssq, int gw, int ngw, int lane) {
    for (int row = gw; row < M; row += ngw) {
        const GAS f32x4* xr = (const GAS f32x4*)(xin + (size_t)row * D) + lane; f32x4 v[4]; float s = 0.f;
#pragma unroll
        for (int j = 0; j < 4; ++j) { v[j] = xr[64 * j]; s += (v[j][0] * v[j][0] + v[j][1] * v[j][1]) + (v[j][2] * v[j][2] + v[j][3] * v[j][3]); }
        s = wave_sum(s);
#pragma unroll
        for (int j = 0; j < 4; ++j) { ((GAS f32x4*)(xout + (size_t)row * D))[lane + 64 * j] = v[j]; v2u w; w.x = pk2(v[j][0], v[j][1]); w.y = pk2(v[j][2], v[j][3]); ((GAS v2u*)(xb + (size_t)row * D))[lane + 64 * j] = w; }
        if (lane < 16) ssq[(size_t)row * 16 + lane] = lane == 0 ? s : 0.f;
    }
}
__device__ __forceinline__ void final_norm(float* x, const float* ssq, const float* g, int gw, int ngw, int lane) {
    for (int row = gw; row < M; row += ngw) {
        const float pv = lane < 16 ? ssq[(size_t)row * 16 + lane] : 0.f; const float rs = rsqrtf(wave_sum(pv) * (1.f / D) + EPS);
        GAS f32x4* xr = (GAS f32x4*)(x + (size_t)row * D) + lane;
#pragma unroll
        for (int j = 0; j < 4; ++j) { const f32x4 gv = ((const GAS f32x4*)g)[lane + 64 * j]; xr[64 * j] = xr[64 * j] * rs * gv; }
    }
}

constexpr int GP = 72;
constexpr int L_QT = 0, L_KT = 9216, L_KENDT = 18432, L_VT = 27648, L_ST = 46080, L_SEG = 64512, L_DECS = 66560, L_RED = 66816, L_GLA_END = 67328;
constexpr int VP = 136;

__device__ __forceinline__ void sgu_item(int item, LAS unsigned char* lds, bf16* ZB, const bf16* SV, const float* SVST, const float* lng, const float* lnb, const bf16* wsb, const float* bs, int wave, int lane) {
    const int h = item & 3, r0 = (item >> 2) * 128; LAS bf16* vnT = (LAS bf16*)lds;
    { const int d0 = 16 * wave, s0 = 2 * lane; float mean[2], rstd[2]; v4u xv[2][2];
#pragma unroll
      for (int rr = 0; rr < 2; ++rr) { const size_t row = (size_t)r0 + s0 + rr; const f32x4* p = (const f32x4*)(SVST + row * 16); const f32x4 a = p[0], b = p[1], c = p[2], d = p[3];
          const float sm = (a[0] + a[2]) + (b[0] + b[2]) + (c[0] + c[2]) + (d[0] + d[2]), sq = (a[1] + a[3]) + (b[1] + b[3]) + (c[1] + c[3]) + (d[1] + d[3]);
          mean[rr] = sm * (1.f / 512.f); rstd[rr] = rsqrtf(fmaxf(sq * (1.f / 512.f) - mean[rr] * mean[rr], 0.f) + EPS);
          const v4u* q = (const v4u*)(SV + row * 512 + h * 128 + d0); xv[rr][0] = q[0]; xv[rr][1] = q[1]; }
#pragma unroll
      for (int j = 0; j < 16; ++j) { const float g = lng[h * 128 + d0 + j], b = lnb[h * 128 + d0 + j]; const unsigned w0 = xv[0][j >> 3][(j >> 1) & 3], w1 = xv[1][j >> 3][(j >> 1) & 3];
          const float x0 = (j & 1) ? bf2f(w0 >> 16) : bf2f(w0 & 0xffffu), x1 = (j & 1) ? bf2f(w1 >> 16) : bf2f(w1 & 0xffffu);
          *(LAS unsigned*)(vnT + (d0 + j) * VP + s0) = pk2((x0 - mean[0]) * rstd[0] * g + b, (x1 - mean[1]) * rstd[1] * g + b); } }
    __syncthreads();
    { const int fr = lane & 15, fq = lane >> 4, t = 16 * wave + fr, nks = (wave >> 1) + 1; bf16x8 bfr[4];
#pragma unroll
      for (int ks = 0; ks < 4; ++ks) bfr[ks] = (ks < nks) ? *(const bf16x8*)(wsb + ((size_t)h * 128 + t) * 128 + 32 * ks + 8 * fq) : (bf16x8){0, 0, 0, 0, 0, 0, 0, 0};
      f32x4 acc[8];
#pragma unroll
      for (int m = 0; m < 8; ++m) { acc[m] = (f32x4){0.f, 0.f, 0.f, 0.f};
#pragma unroll
          for (int ks = 0; ks < 4; ++ks) if (ks < nks) { const bf16x8 a = *(const LAS bf16x8*)(vnT + (16 * m + fr) * VP + 32 * ks + 8 * fq); acc[m] = mfma16(a, bfr[ks], acc[m]); } }
      const size_t row = (size_t)r0 + t; const float bias = bs[h * 128 + t];
#pragma unroll
      for (int m = 0; m < 8; ++m) { bf16* p = ZB + row * 512 + h * 128 + 16 * m + 4 * fq; const v2u su = *(const v2u*)p; v2u o;
          o.x = pk2(bf2f(su.x & 0xffffu) * (acc[m][0] + bias), bf2f(su.x >> 16) * (acc[m][1] + bias)); o.y = pk2(bf2f(su.y & 0xffffu) * (acc[m][2] + bias), bf2f(su.y >> 16) * (acc[m][3] + bias)); *(v2u*)p = o; } }
    __syncthreads();
}
__device__ __forceinline__ void convbr_item(int idx, bf16* ZC, const bf16* CC, const bf16* CX, const float* cw) {
    const int c0 = (idx & 63) * 8, r0 = (idx >> 6) * 8; float w[3][8];
#pragma unroll
    for (int k = 0; k < 3; ++k) { const f32x4 a = *(const f32x4*)(cw + k * CW + c0), b = *(const f32x4*)(cw + k * CW + c0 + 4);
#pragma unroll
        for (int e = 0; e < 4; ++e) { w[k][e] = a[e]; w[k][4 + e] = b[e]; } }
    float u2[8], u1[8];
    auto loadu = [&](int row, float (&u)[8]) { const v4u a = *(const v4u*)(CC + (size_t)row * CW + c0), b = *(const v4u*)(CX + (size_t)row * CW + c0);
#pragma unroll
        for (int e = 0; e < 4; ++e) { u[2 * e] = bf2f(a[e] & 0xffffu) * bf2f(b[e] & 0xffffu); u[2 * e + 1] = bf2f(a[e] >> 16) * bf2f(b[e] >> 16); } };
    if ((r0 & (SEQ - 1)) == 0) {
#pragma unroll
        for (int e = 0; e < 8; ++e) { u2[e] = 0.f; u1[e] = 0.f; } }
    else { loadu(r0 - 2, u2); loadu(r0 - 1, u1); }
#pragma unroll
    for (int i = 0; i < 8; ++i) { float u0[8]; loadu(r0 + i, u0); bf16* p = ZC + (size_t)(r0 + i) * CW + c0; const v4u cb = *(const v4u*)p; float z[8];
#pragma unroll
        for (int e = 0; e < 8; ++e) { const float y = w[0][e] * u2[e] + w[1][e] * u1[e] + w[2][e] * u0[e]; const float c = (e & 1) ? bf2f(cb[e >> 1] >> 16) : bf2f(cb[e >> 1] & 0xffffu); z[e] = c * y; u2[e] = u1[e]; u1[e] = u0[e]; }
        v4u o; o.x = pk2(z[0], z[1]); o.y = pk2(z[2], z[3]); o.z = pk2(z[4], z[5]); o.w = pk2(z[6], z[7]); *(v4u*)p = o; }
}
template <bool FULL> __device__ __forceinline__ float gla_stage(LAS unsigned char* lds, size_t r0, int h, const bf16* Q, const bf16* KK, const bf16* V, const float* LOGA, int tid) {
    const int kcol = tid & 63, seg = tid >> 6; LAS float* SEG = (LAS float*)(lds + L_SEG);
    float p[8]; unsigned kq[8], qq[8];
#pragma unroll
    for (int j = 0; j < 8; ++j) { const size_t row = r0 + 8 * seg + j; p[j] = LOGA[row * GKEY + h * 64 + kcol]; kq[j] = KK[row * GKEY + h * 64 + kcol]; if (FULL) qq[j] = Q[row * GKEY + h * 64 + kcol]; }
#pragma unroll
    for (int j = 1; j < 8; ++j) p[j] += p[j - 1];
    SEG[seg * 64 + kcol] = p[7];
    { const int tp = tid & 31, vg = tid >> 5; LAS bf16* VT = (LAS bf16*)(lds + L_VT);
      const v4u a = *(const v4u*)(V + (r0 + 2 * tp) * GVAL + h * 128 + 8 * vg), b = *(const v4u*)(V + (r0 + 2 * tp + 1) * GVAL + h * 128 + 8 * vg);
#pragma unroll
      for (int e = 0; e < 4; ++e) { *(LAS unsigned*)(VT + (8 * vg + 2 * e) * GP + 2 * tp) = (a[e] & 0xffffu) | (b[e] << 16); *(LAS unsigned*)(VT + (8 * vg + 2 * e + 1) * GP + 2 * tp) = (a[e] >> 16) | (b[e] & 0xffff0000u); } }
    __syncthreads();
    float off = 0.f, tot = 0.f;
#pragma unroll
    for (int s = 0; s < 8; ++s) { const float v = SEG[s * 64 + kcol]; tot += v; if (s < seg) off += v; }
    float ke[8];
#pragma unroll
    for (int j = 0; j < 8; ++j) { const float b = off + p[j], kf = bf2f(kq[j]); ke[j] = kf * __expf(tot - b);
        if (FULL) { const int t = 8 * seg + j; ((LAS bf16*)(lds + L_QT))[t * GP + kcol] = (bf16)(pk2(bf2f(qq[j]) * __expf(b), 0.f) & 0xffffu); ((LAS bf16*)(lds + L_KT))[t * GP + kcol] = (bf16)(pk2(kf * __expf(-b), 0.f) & 0xffffu); } }
    v4u o; o.x = pk2(ke[0], ke[1]); o.y = pk2(ke[2], ke[3]); o.z = pk2(ke[4], ke[5]); o.w = pk2(ke[6], ke[7]);
    *(LAS v4u*)((LAS bf16*)(lds + L_KENDT) + kcol * GP + 8 * seg) = o;
    return __expf(tot);
}
__device__ __forceinline__ void gla_b1_item(int item, LAS unsigned char* lds, const bf16* KK, const bf16* V, const float* LOGA, float* CST, float* DEC, int tid, int wave, int lane) {
    const int h = item & 3; const size_t r0 = (size_t)(item >> 2) * 64;
    const float dec = gla_stage<false>(lds, r0, h, nullptr, KK, V, LOGA, tid);
    if (tid < 64) DEC[(size_t)item * 64 + tid] = dec;
    __syncthreads();
    const int fr = lane & 15, fq = lane >> 4; const LAS bf16* VT = (const LAS bf16*)(lds + L_VT); const LAS bf16* KE = (const LAS bf16*)(lds + L_KENDT);
    bf16x8 bv[2];
#pragma unroll
    for (int ks = 0; ks < 2; ++ks) bv[ks] = *(const LAS bf16x8*)(VT + (16 * wave + fr) * GP + 32 * ks + 8 * fq);
#pragma unroll
    for (int m = 0; m < 4; ++m) { f32x4 acc = (f32x4){0.f, 0.f, 0.f, 0.f};
#pragma unroll
        for (int ks = 0; ks < 2; ++ks) acc = mfma16(*(const LAS bf16x8*)(KE + (16 * m + fr) * GP + 32 * ks + 8 * fq), bv[ks], acc);
        *(f32x4*)(CST + (size_t)item * 8192 + (16 * wave + fr) * 64 + 16 * m + 4 * fq) = acc; }
    __syncthreads();
}
__device__ __forceinline__ void gla_b2_unit(int unit, LAS unsigned char* lds, const bf16* Q, const bf16* KK, const bf16* V, const float* LOGA, const float* CST, const float* DEC, bf16* ZA, int tid, int wave, int lane) {
    const int g = unit & 7, h = (unit >> 3) & 3, b = unit >> 5, fr = lane & 15, fq = lane >> 4;
    f32x4 S[4];
#pragma unroll
    for (int m = 0; m < 4; ++m) S[m] = (f32x4){0.f, 0.f, 0.f, 0.f};
    for (int j = 0; j < 4 * g; ++j) { const size_t it = ((size_t)(b * 32 + j) * 4 + h); const float* cp = CST + it * 8192 + (16 * wave + fr) * 64 + 4 * fq; const float* dp = DEC + it * 64 + 4 * fq;
#pragma unroll
        for (int m = 0; m < 4; ++m) { const f32x4 c = *(const f32x4*)(cp + 16 * m), d = *(const f32x4*)(dp + 16 * m); S[m] = d * S[m] + c; } }
    const LAS bf16* QT = (const LAS bf16*)(lds + L_QT); const LAS bf16* KT = (const LAS bf16*)(lds + L_KT); const LAS bf16* KE = (const LAS bf16*)(lds + L_KENDT);
    const LAS bf16* VT = (const LAS bf16*)(lds + L_VT); LAS bf16* ST = (LAS bf16*)(lds + L_ST); LAS float* DECS = (LAS float*)(lds + L_DECS); LAS float* RED = (LAS float*)(lds + L_RED);
    const int ih = wave & 3, vh = wave >> 2;
    for (int c = 0; c < 4; ++c) {
        const size_t r0 = (size_t)b * SEQ + (size_t)(4 * g + c) * 64;
#pragma unroll
        for (int m = 0; m < 4; ++m) { v2u w; w.x = pk2(S[m][0], S[m][1]); w.y = pk2(S[m][2], S[m][3]); *(LAS v2u*)(ST + (16 * wave + fr) * GP + 16 * m + 4 * fq) = w; }
        const float dec = gla_stage<true>(lds, r0, h, Q, KK, V, LOGA, tid);
        if (tid < 64) DECS[tid] = dec;
        __syncthreads();
        bf16x8 bq[2];
#pragma unroll
        for (int ks = 0; ks < 2; ++ks) bq[ks] = *(const LAS bf16x8*)(QT + (16 * ih + fr) * GP + 32 * ks + 8 * fq);
        f32x4 X[4];
#pragma unroll
        for (int jt = 0; jt < 4; ++jt) { X[jt] = (f32x4){0.f, 0.f, 0.f, 0.f};
            if (jt <= ih) {
#pragma unroll
                for (int ks = 0; ks < 2; ++ks) X[jt] = mfma16(*(const LAS bf16x8*)(KT + (16 * jt + fr) * GP + 32 * ks + 8 * fq), bq[ks], X[jt]);
#pragma unroll
                for (int r = 0; r < 4; ++r) if (16 * jt + 4 * fq + r > 16 * ih + fr) X[jt][r] = 0.f; } }
        bf16x8 xb[2];
#pragma unroll
        for (int k2 = 0; k2 < 2; ++k2) { v4u w; w.x = pk2(X[2 * k2][0], X[2 * k2][1]); w.y = pk2(X[2 * k2][2], X[2 * k2][3]); w.z = pk2(X[2 * k2 + 1][0], X[2 * k2 + 1][1]); w.w = pk2(X[2 * k2 + 1][2], X[2 * k2 + 1][3]); xb[k2] = __builtin_bit_cast(bf16x8, w); }
        f32x4 O[4]; float ss = 0.f;
#pragma unroll
        for (int mt = 0; mt < 4; ++mt) { const int v = 64 * vh + 16 * mt + fr; f32x4 o = (f32x4){0.f, 0.f, 0.f, 0.f};
#pragma unroll
            for (int k2 = 0; k2 < 2; ++k2) { const v2u lo = *(const LAS v2u*)(VT + v * GP + 32 * k2 + 4 * fq), hi = *(const LAS v2u*)(VT + v * GP + 32 * k2 + 16 + 4 * fq); v4u a; a.x = lo.x; a.y = lo.y; a.z = hi.x; a.w = hi.y;
                o = mfma16(__builtin_bit_cast(bf16x8, a), xb[k2], o); }
#pragma unroll
            for (int ks = 0; ks < 2; ++ks) o = mfma16(*(const LAS bf16x8*)(ST + v * GP + 32 * ks + 8 * fq), bq[ks], o);
            O[mt] = o; ss += (o[0] * o[0] + o[1] * o[1]) + (o[2] * o[2] + o[3] * o[3]); }
        ss += __shfl_xor(ss, 16); ss += __shfl_xor(ss, 32);
        if (fq == 0) RED[(vh * 4 + ih) * 16 + fr] = ss;
        __syncthreads();
        const float rs = rsqrtf((RED[ih * 16 + fr] + RED[(4 + ih) * 16 + fr]) * (1.f / 128.f) + EPS);
        { const size_t row = r0 + 16 * ih + fr;
#pragma unroll
          for (int mt = 0; mt < 4; ++mt) { bf16* p = ZA + row * GVAL + h * 128 + 64 * vh + 16 * mt + 4 * fq; const v2u gt = *(const v2u*)p; v2u o;
              o.x = pk2(O[mt][0] * rs * bf2f(gt.x & 0xffffu), O[mt][1] * rs * bf2f(gt.x >> 16)); o.y = pk2(O[mt][2] * rs * bf2f(gt.y & 0xffffu), O[mt][3] * rs * bf2f(gt.y >> 16)); *(v2u*)p = o; } }
        bf16x8 bv[2];
#pragma unroll
        for (int ks = 0; ks < 2; ++ks) bv[ks] = *(const LAS bf16x8*)(VT + (16 * wave + fr) * GP + 32 * ks + 8 * fq);
#pragma unroll
        for (int m = 0; m < 4; ++m) { const f32x4 d = *(const LAS f32x4*)(DECS + 16 * m + 4 * fq); S[m] = S[m] * d;
#pragma unroll
            for (int ks = 0; ks < 2; ++ks) S[m] = mfma16(*(const LAS bf16x8*)(KE + (16 * m + fr) * GP + 32 * ks + 8 * fq), bv[ks], S[m]); }
        __syncthreads();
    }
}
__device__ __forceinline__ void ffn_act_item(int idx, const bf16* HUP, bf16* ACT, const float* cw, const float* cb) {
    const int cgp = idx % 352, rb = idx / 352, pn = cgp >> 4, c8 = (cgp & 15) * 8, j0 = 128 * pn + c8, r0 = rb * 16;
    float wg[3][8], wv[3][8], bg[8], bv[8];
#pragma unroll
    for (int e = 0; e < 8; ++e) { bg[e] = cb[j0 + e]; bv[e] = cb[DFF + j0 + e];
#pragma unroll
        for (int k = 0; k < 3; ++k) { wg[k][e] = cw[k * DFF2 + j0 + e]; wv[k][e] = cw[k * DFF2 + DFF + j0 + e]; } }
    float g2[8], g1[8], v2[8], v1[8];
    auto ld = [&](int row, float (&g)[8], float (&v)[8]) { const bf16* p = HUP + (size_t)row * DFF2 + 256 * pn + c8; const v4u a = *(const v4u*)p, b = *(const v4u*)(p + 128);
#pragma unroll
        for (int e = 0; e < 4; ++e) { g[2 * e] = bf2f(a[e] & 0xffffu); g[2 * e + 1] = bf2f(a[e] >> 16); v[2 * e] = bf2f(b[e] & 0xffffu); v[2 * e + 1] = bf2f(b[e] >> 16); } };
    if ((r0 & (SEQ - 1)) == 0) {
#pragma unroll
        for (int e = 0; e < 8; ++e) { g2[e] = 0.f; g1[e] = 0.f; v2[e] = 0.f; v1[e] = 0.f; } }
    else { ld(r0 - 2, g2, v2); ld(r0 - 1, g1, v1); }
    for (int i = 0; i < 16; ++i) { float g0[8], v0[8]; ld(r0 + i, g0, v0); float z[8];
#pragma unroll
        for (int e = 0; e < 8; ++e) { const float ga = wg[0][e] * g2[e] + wg[1][e] * g1[e] + wg[2][e] * g0[e] + bg[e], va = wv[0][e] * v2[e] + wv[1][e] * v1[e] + wv[2][e] * v0[e] + bv[e];
            z[e] = fsilu(ga) * va; g2[e] = g1[e]; g1[e] = g0[e]; v2[e] = v1[e]; v1[e] = v0[e]; }
        v4u o; o.x = pk2(z[0], z[1]); o.y = pk2(z[2], z[3]); o.z = pk2(z[4], z[5]); o.w = pk2(z[6], z[7]); *(v4u*)(ACT + (size_t)(r0 + i) * DFF + j0) = o; }
}

using pg8::Unit;
__device__ __forceinline__ void row_rstd(const float* SSQ, int pm, int wr, int fr, int fq, float (&rsd)[2][4]) {
    const int lane = fr + 16 * fq;
#pragma unroll
    for (int ai = 0; ai < 2; ++ai) { const size_t row = (size_t)pm * 256 + ai * 128 + wr * 64 + lane; const f32x4* p = (const f32x4*)(SSQ + row * 16); const f32x4 a = p[0], b = p[1], c = p[2], d = p[3];
        const float s = ((a[0] + a[1]) + (a[2] + a[3])) + ((b[0] + b[1]) + (b[2] + b[3])) + ((c[0] + c[1]) + (c[2] + c[3])) + ((d[0] + d[1]) + (d[2] + d[3]));
        const float rs = rsqrtf(s * (1.f / D) + EPS);
#pragma unroll
        for (int m = 0; m < 4; ++m) rsd[ai][m] = __shfl(rs, 16 * m + fr); }
}
struct EpiA {
    static constexpr bool PERM = true, AFTER_DRAIN = false;
    unsigned char* act0; const float* SSQ; float* SVST; const float* bal;
    __device__ __forceinline__ void operator()(const f32x4 (&acc)[2][2][4][2], const Unit& u, int wr, int wc, int fr_, int fq_) const {
        int fr = fr_, fq = fq_; asm volatile("" : "+v"(fr), "+v"(fq));
        float rsd[2][4]; row_rstd(SSQ, u.pm, wr, fr, fq, rsd);
        const int pn = u.pn; int mode, ldc, colt; size_t boff;
        if (pn < 1) { mode = 0; boff = A_Q; ldc = 256; colt = 0; } else if (pn < 2) { mode = 0; boff = A_K; ldc = 256; colt = 0; } else if (pn < 4) { mode = 0; boff = A_V; ldc = 512; colt = (pn - 2) * 256; }
        else if (pn < 6) { mode = 1; boff = A_Z; ldc = 512; colt = (pn - 4) * 256; } else if (pn < 7) { mode = 4; boff = A_LOGA; ldc = 256; colt = 0; }
        else if (pn < 9) { mode = 2; boff = A_Z + (size_t)M * 512 * 2; ldc = 512; colt = (pn - 7) * 256; } else if (pn < 11) { mode = 3; boff = A_SV; ldc = 512; colt = (pn - 9) * 256; }
        else if (pn < 13) { mode = 0; boff = A_Z + (size_t)2 * M * 512 * 2; ldc = 512; colt = (pn - 11) * 256; } else if (pn < 15) { mode = 0; boff = A_CC; ldc = 512; colt = (pn - 13) * 256; }
        else if (pn < 17) { mode = 0; boff = A_CX; ldc = 512; colt = (pn - 15) * 256; } else { mode = 5; boff = A_G; ldc = 3072; colt = (pn - 17) * 256; }
        const int col0 = colt + wc * 32 + 8 * fq;
#pragma unroll
        for (int ai = 0; ai < 2; ++ai)
#pragma unroll
            for (int m = 0; m < 4; ++m) { const size_t row = (size_t)u.pm * 256 + ai * 128 + wr * 64 + m * 16 + fr; const float rs = rsd[ai][m]; float s1 = 0.f, s2 = 0.f;
#pragma unroll
                for (int bj = 0; bj < 2; ++bj) { const f32x4 a0 = acc[ai][bj][m][0] * rs, a1 = acc[ai][bj][m][1] * rs; float v[8] = {a0[0], a0[1], a0[2], a0[3], a1[0], a1[1], a1[2], a1[3]};
                    if (mode == 4) { const f32x4 b0 = *(const f32x4*)(bal + col0 + bj * 128), b1 = *(const f32x4*)(bal + col0 + bj * 128 + 4); f32x4 o0, o1;
#pragma unroll
                        for (int e = 0; e < 4; ++e) { o0[e] = flogsig(v[e] + b0[e]) * 0.0625f; o1[e] = flogsig(v[4 + e] + b1[e]) * 0.0625f; }
                        float* p = (float*)(act0 + boff) + row * 256 + col0 + bj * 128; *(f32x4*)p = o0; *(f32x4*)(p + 4) = o1; }
                    else {
                        if (mode == 1) {
#pragma unroll
                            for (int e = 0; e < 8; ++e) v[e] = fsilu(v[e]); }
                        else if (mode == 2 || mode == 3) {
#pragma unroll
                            for (int e = 0; e < 8; ++e) v[e] = fgelu(v[e]); }
                        else if (mode == 5) {
#pragma unroll
                            for (int e = 0; e < 8; ++e) v[e] = fsigmoid(v[e]); }
                        if (mode == 3) {
#pragma unroll
                            for (int e = 0; e < 8; ++e) { s1 += v[e]; s2 += v[e] * v[e]; } }
                        v4u o; o.x = pk2(v[0], v[1]); o.y = pk2(v[2], v[3]); o.z = pk2(v[4], v[5]); o.w = pk2(v[6], v[7]);
                        *(v4u*)((bf16*)(act0 + boff) + row * ldc + col0 + bj * 128) = o; } }
                if (mode == 3) { s1 += __shfl_xor(s1, 16); s1 += __shfl_xor(s1, 32); s2 += __shfl_xor(s2, 16); s2 += __shfl_xor(s2, 32);
                    if (fq == 0) *(f32x2*)(SVST + row * 16 + ((pn - 9) * 4 + wc) * 2) = (f32x2){s1, s2}; } }
    }
};
struct EpiC {
    static constexpr bool PERM = true, AFTER_DRAIN = false;
    const bf16* G; bf16* MG;
    __device__ __forceinline__ void operator()(const f32x4 (&acc)[2][2][4][2], const Unit& u, int wr, int wc, int fr_, int fq_) const {
        int fr = fr_, fq = fq_; asm volatile("" : "+v"(fr), "+v"(fq));
        const int br = u.pm >> 6, pm = u.pm & 63, pn = u.pn & 3; const int col0 = pn * 256 + wc * 32 + 8 * fq;
#pragma unroll
        for (int ai = 0; ai < 2; ++ai)
#pragma unroll
            for (int m = 0; m < 4; ++m) { const size_t row = (size_t)pm * 256 + ai * 128 + wr * 64 + m * 16 + fr;
#pragma unroll
                for (int bj = 0; bj < 2; ++bj) { const f32x4 a0 = acc[ai][bj][m][0], a1 = acc[ai][bj][m][1]; float v[8] = {a0[0], a0[1], a0[2], a0[3], a1[0], a1[1], a1[2], a1[3]};
                    const v4u gt = *(const v4u*)(G + row * 3072 + br * 1024 + col0 + bj * 128); bf16* mp = MG + row * 1024 + col0 + bj * 128;
#pragma unroll
                    for (int e = 0; e < 4; ++e) { v[2 * e] *= bf2f(gt[e] & 0xffffu); v[2 * e + 1] *= bf2f(gt[e] >> 16); }
                    if (br != 0) { const v4u old = *(const v4u*)mp;
#pragma unroll
                        for (int e = 0; e < 4; ++e) { v[2 * e] += bf2f(old[e] & 0xffffu); v[2 * e + 1] += bf2f(old[e] >> 16); } }
                    v4u o; o.x = pk2(v[0], v[1]); o.y = pk2(v[2], v[3]); o.z = pk2(v[4], v[5]); o.w = pk2(v[6], v[7]); *(v4u*)mp = o; } }
    }
};
struct BranchOrder {
    int G, c;
    __device__ bool next(int i, Unit& u) const { const int j = i / 3, br = i - 3 * j, T = c + G * j; if (T >= 256) return false;
        const int w = (T & 7) * 32 + (T >> 3), pm = (w >> 5) * 8 + (w & 7), pn = (w & 31) >> 3; u.pm = br * 64 + pm; u.pn = br * 4 + pn; return true; }
    __device__ __forceinline__ void a_ready(const Unit&) const {}
    __device__ __forceinline__ void done(const Unit&) const {}
};
struct EpiRes {
    static constexpr bool PERM = false, AFTER_DRAIN = false;
    float* X; bf16* XB; float* SSQ;
    __device__ __forceinline__ void operator()(const f32x4 (&acc)[2][2][4][2], const Unit& u, int wr, int wc, int fr_, int fq_) const {
        int fr = fr_, fq = fq_; asm volatile("" : "+v"(fr), "+v"(fq));
        const int col0 = u.pn * 256 + wc * 32 + 4 * fq;
#pragma unroll
        for (int ai = 0; ai < 2; ++ai)
#pragma unroll
            for (int m = 0; m < 4; ++m) { const size_t row = (size_t)u.pm * 256 + ai * 128 + wr * 64 + m * 16 + fr; float ss = 0.f;
#pragma unroll
                for (int bj = 0; bj < 2; ++bj)
#pragma unroll
                    for (int n = 0; n < 2; ++n) { const size_t off = row * D + col0 + bj * 128 + n * 16; const f32x4 xn = *(const f32x4*)(X + off) + acc[ai][bj][m][n]; *(f32x4*)(X + off) = xn;
                        v2u w; w.x = pk2(xn[0], xn[1]); w.y = pk2(xn[2], xn[3]); *(v2u*)(XB + off) = w; ss += (xn[0] * xn[0] + xn[1] * xn[1]) + (xn[2] * xn[2] + xn[3] * xn[3]); }
                ss += __shfl_xor(ss, 16); ss += __shfl_xor(ss, 32);
                if (fq == 0) SSQ[row * 16 + u.pn * 4 + wc] = ss; }
    }
};
struct EpiUp {
    static constexpr bool PERM = true, AFTER_DRAIN = false;
    bf16* HUP; const float* SSQ;
    __device__ __forceinline__ void operator()(const f32x4 (&acc)[2][2][4][2], const Unit& u, int wr, int wc, int fr_, int fq_) const {
        int fr = fr_, fq = fq_; asm volatile("" : "+v"(fr), "+v"(fq));
        float rsd[2][4]; row_rstd(SSQ, u.pm, wr, fr, fq, rsd);
        const int col0 = u.pn * 256 + wc * 32 + 8 * fq;
#pragma unroll
        for (int ai = 0; ai < 2; ++ai)
#pragma unroll
            for (int m = 0; m < 4; ++m) { const size_t row = (size_t)u.pm * 256 + ai * 128 + wr * 64 + m * 16 + fr; const float rs = rsd[ai][m];
#pragma unroll
                for (int bj = 0; bj < 2; ++bj) { const f32x4 a0 = acc[ai][bj][m][0] * rs, a1 = acc[ai][bj][m][1] * rs;
                    v4u o; o.x = pk2(a0[0], a0[1]); o.y = pk2(a0[2], a0[3]); o.z = pk2(a1[0], a1[1]); o.w = pk2(a1[2], a1[3]); *(v4u*)(HUP + row * DFF2 + col0 + bj * 128) = o; } }
    }
};

struct Args { Inputs in; float* out; unsigned char* ws; int ph_lo, ph_hi; };
constexpr int NPHASE = 2 + 8 * DEPTH;
#define LAUNDER_S(p) asm volatile("" : "+s"(p))
#define LAUNDER_V(p) asm volatile("" : "+v"(p))
struct Ctx { unsigned char* ws; unsigned char* act0; float* X; int tid, lane, wave, G, bx, gw, ngw; };
__device__ __forceinline__ Ctx make_ctx(const Args& a) {
    Ctx c; size_t z = 0; LAUNDER_S(z); c.ws = a.ws + z; c.X = (float*)((unsigned char*)a.out + z); c.act0 = c.ws + WS_ACT0;
    int t = threadIdx.x; LAUNDER_V(t); c.tid = t; c.lane = t & 63; c.wave = __builtin_amdgcn_readfirstlane(t >> 6);
    c.G = gridDim.x; c.bx = blockIdx.x; c.gw = c.bx * NWAVES + c.wave; c.ngw = c.G * NWAVES; return c;
}
__device__ __forceinline__ unsigned char* slot_of(const Ctx& c, int l) { return c.ws + WS_SLOT0 + (size_t)(l & 1) * SL_BYTES; }
__device__ __forceinline__ void ph_p0(const Args& a, LAS unsigned char* lds) { const Ctx c = make_ctx(a);
    convert_layer(a.in, 0, c.ws + WS_SLOT0, lds, c.gw, c.ngw, c.wave, c.lane); x_prep(a.in.p[0], c.X, (bf16*)(c.ws + WS_XB), (float*)(c.ws + WS_SSQ), c.gw, c.ngw, c.lane); }
__device__ __forceinline__ void ph_a(const Args& a, int l, LAS unsigned char* lds) { const Ctx c = make_ctx(a);
    pg8::Gemm g{(const bf16*)(c.ws + WS_XB), (const bf16*)(slot_of(c, l) + SL_WIN), M, NIN, D}; pg8::StaticOrder S; S.init(M, NIN, c.G, c.bx);
    EpiA E{c.act0, (const float*)(c.ws + WS_SSQ), (float*)(c.ws + WS_SVST), a.in.p[4] + (size_t)l * GKEY};
    pg8::gemm_phase<EpiA, pg8::StaticOrder, true, true>(lds, g, S, E); }
__device__ __forceinline__ void ph_b1(const Args& a, int l, LAS unsigned char* lds) { const Ctx c = make_ctx(a); const Inputs& I = a.in;
    bf16* Zb = (bf16*)(c.act0 + A_Z);
    for (int it = c.bx; it < 1024; it += c.G) gla_b1_item(it, lds, (const bf16*)(c.act0 + A_K), (const bf16*)(c.act0 + A_V), (const float*)(c.act0 + A_LOGA), (float*)(c.act0 + A_CST), (float*)(c.act0 + A_DEC), c.tid, c.wave, c.lane);
    for (int it = c.bx; it < 512; it += c.G) sgu_item(it, lds, Zb + (size_t)M * 512, (const bf16*)(c.act0 + A_SV), (const float*)(c.ws + WS_SVST), I.p[7] + (size_t)l * SGW, I.p[8] + (size_t)l * SGW, (const bf16*)(slot_of(c, l) + SL_SGW), I.p[10] + (size_t)l * 512, c.wave, c.lane);
    for (int it = c.bx * NTHREADS + c.tid; it < 131072; it += c.G * NTHREADS) convbr_item(it, Zb + (size_t)2 * M * 512, (const bf16*)(c.act0 + A_CC), (const bf16*)(c.act0 + A_CX), I.p[12] + (size_t)l * 3 * CW);
    if (l + 1 < DEPTH) convert_layer(I, l + 1, slot_of(c, l + 1), lds, c.gw, c.ngw, c.wave, c.lane); }
__device__ __forceinline__ void ph_b2(const Args& a, int l, LAS unsigned char* lds) { const Ctx c = make_ctx(a);
    for (int it = c.bx; it < 256; it += c.G) gla_b2_unit(it, lds, (const bf16*)(c.act0 + A_Q), (const bf16*)(c.act0 + A_K), (const bf16*)(c.act0 + A_V), (const float*)(c.act0 + A_LOGA), (const float*)(c.act0 + A_CST), (const float*)(c.act0 + A_DEC), (bf16*)(c.act0 + A_Z), c.tid, c.wave, c.lane); }
__device__ __forceinline__ void ph_c(const Args& a, int l, LAS unsigned char* lds) { const Ctx c = make_ctx(a);
    pg8::Gemm g{(const bf16*)(c.act0 + A_Z), (const bf16*)(slot_of(c, l) + SL_WBR), 3 * M, 3 * D, 512}; BranchOrder S{c.G, c.bx}; EpiC E{(const bf16*)(c.act0 + A_G), (bf16*)(c.act0 + A_MERGED)};
    pg8::gemm_phase<EpiC, BranchOrder, true, true>(lds, g, S, E); }
__device__ __forceinline__ void ph_res(const Args& a, const bf16* A, const bf16* Bt, int K, LAS unsigned char* lds) { const Ctx c = make_ctx(a);
    pg8::Gemm g{A, Bt, M, D, K}; pg8::StaticOrder S; S.init(M, D, c.G, c.bx); EpiRes E{c.X, (bf16*)(c.ws + WS_XB), (float*)(c.ws + WS_SSQ)};
    pg8::gemm_phase<EpiRes, pg8::StaticOrder, true, true>(lds, g, S, E); }
__device__ __forceinline__ void ph_e(const Args& a, int l, LAS unsigned char* lds) { const Ctx c = make_ctx(a);
    pg8::Gemm g{(const bf16*)(c.ws + WS_XB), (const bf16*)(slot_of(c, l) + SL_WUP), M, DFF2, D}; pg8::StaticOrder S; S.init(M, DFF2, c.G, c.bx); EpiUp E{(bf16*)(c.act0 + A_HUP), (const float*)(c.ws + WS_SSQ)};
    pg8::gemm_phase<EpiUp, pg8::StaticOrder, true, true>(lds, g, S, E); }
__device__ __forceinline__ void ph_e2(const Args& a, int l) { const Ctx c = make_ctx(a);
    for (int it = c.bx * NTHREADS + c.tid; it < 1024 * 352; it += c.G * NTHREADS) ffn_act_item(it, (const bf16*)(c.act0 + A_HUP), (bf16*)(c.act0 + A_ACT), a.in.p[17] + (size_t)l * 3 * DFF2, a.in.p[18] + (size_t)l * DFF2); }
__device__ __forceinline__ void ph_fin(const Args& a) { const Ctx c = make_ctx(a); final_norm(c.X, (const float*)(c.ws + WS_SSQ), a.in.p[20], c.gw, c.ngw, c.lane); }

#ifndef PHMASK
#define PHMASK 0xFFFF
#endif
#define EN(b) ((PHMASK >> (b)) & 1)
__global__ void __launch_bounds__(NTHREADS, 2) mk_fwd(Args args) {
    extern __shared__ __attribute__((aligned(16))) unsigned char lds_raw[];
    LAS unsigned char* lds = (LAS unsigned char*)lds_raw;
    const int lo = args.ph_lo, hi = args.ph_hi;
#define IN(k) (lo <= (k) && (k) < hi)
#if MK_ONE_LAUNCH
#define SEAM(k) do { if (IN(k) && IN((k) + 1)) { cg::this_grid().sync(); } } while (0)
#else
#define SEAM(k) do { } while (0)
#endif
    int ph = 0;
    if (EN(0) && IN(ph)) ph_p0(args, lds);
    SEAM(ph); ++ph;
    for (int l = 0; l < DEPTH; ++l) {
        if (EN(1) && IN(ph)) ph_a(args, l, lds);
        SEAM(ph); ++ph;
        if (EN(2) && IN(ph)) ph_b1(args, l, lds);
        SEAM(ph); ++ph;
        if (EN(3) && IN(ph)) ph_b2(args, l, lds);
        SEAM(ph); ++ph;
        if (EN(4) && IN(ph)) ph_c(args, l, lds);
        SEAM(ph); ++ph;
        if (EN(5) && IN(ph)) { size_t z = 0; LAUNDER_S(z); unsigned char* ws = args.ws + z; ph_res(args, (const bf16*)(ws + WS_ACT0 + A_MERGED), (const bf16*)(ws + WS_SLOT0 + (size_t)(l & 1) * SL_BYTES + SL_WO), D, lds); }
        SEAM(ph); ++ph;
        if (EN(6) && IN(ph)) ph_e(args, l, lds);
        SEAM(ph); ++ph;
        if (EN(7) && IN(ph)) ph_e2(args, l);
        SEAM(ph); ++ph;
        if (EN(8) && IN(ph)) { size_t z = 0; LAUNDER_S(z); unsigned char* ws = args.ws + z; ph_res(args, (const bf16*)(ws + WS_ACT0 + A_ACT), (const bf16*)(ws + WS_SLOT0 + (size_t)(l & 1) * SL_BYTES + SL_WDN), DFF, lds); }
        SEAM(ph); ++ph;
    }
    if (EN(9) && IN(ph)) ph_fin(args);
#undef IN
#undef SEAM
}

extern "C" void kernel_launch(void* const* d_in, const int* in_sizes, int n_in, void* d_out, int out_size, void* d_ws, size_t ws_size, hipStream_t stream) {
    static int grid = 0;
    if (grid == 0) {
        if (n_in != 21 || out_size != M * D || ws_size < WS_END) { fprintf(stderr, "kernel_launch: unexpected shapes / workspace (%zu < %zu)\n", ws_size, (size_t)WS_END); grid = -1; return; }
        int dev = 0, cus = 0, per_cu = 0;
        if (hipGetDevice(&dev) != hipSuccess || hipDeviceGetAttribute(&cus, hipDeviceAttributeMultiprocessorCount, dev) != hipSuccess) { grid = -1; return; }
        if (hipFuncSetAttribute((const void*)mk_fwd, hipFuncAttributeMaxDynamicSharedMemorySize, LDS_BYTES) != hipSuccess) { fprintf(stderr, "kernel_launch: hipFuncSetAttribute failed\n"); grid = -1; return; }
        if (hipOccupancyMaxActiveBlocksPerMultiprocessor(&per_cu, (const void*)mk_fwd, NTHREADS, LDS_BYTES) != hipSuccess || per_cu < 1) { fprintf(stderr, "kernel_launch: occupancy query says %d\n", per_cu); per_cu = 1; }
        (void)hipGetLastError();
        grid = cus * 1;
    }
    if (grid < 0) return;
    Args a{};
    for (int i = 0; i < 21; ++i) a.in.p[i] = (const float*)d_in[i];
    a.out = (float*)d_out; a.ws = (unsigned char*)d_ws;
#if MK_ONE_LAUNCH
    a.ph_lo = 0; a.ph_hi = NPHASE;
    void* kargs[] = {&a};
    hipError_t e = hipLaunchCooperativeKernel((const void*)mk_fwd, dim3(grid), dim3(NTHREADS), kargs, LDS_BYTES, stream);
    if (e != hipSuccess) fprintf(stderr, "kernel_launch: cooperative launch failed: %s (grid %d)\n", hipGetErrorString(e), grid);
#else
    for (int p = 0; p < NPHASE; ++p) { a.ph_lo = p; a.ph_hi = p + 1; hipLaunchKernelGGL(mk_fwd, dim3(grid), dim3(NTHREADS), LDS_BYTES, stream, a); }
#endif
}
```

```cpp
#include <hip/hip_runtime.h>
#include <hip/hip_cooperative_groups.h>
#include <cstdio>
#include <cstdint>
#include <cmath>
namespace cg = cooperative_groups;

#ifndef MK_ONE_LAUNCH
#define MK_ONE_LAUNCH 1
#endif

namespace cfg {
constexpr int D = 1024, BATCH = 8, SEQ = 2048, DEPTH = 4, M = BATCH * SEQ;
constexpr int GH = 4, GDK = 64, GDV = 128, GKEY = 256, GVAL = 512, GRANK = 16;
constexpr int SGW = 512, SGC = 128, CW = 512, DFF = 2816, DFF2 = 5632;
constexpr int INC = 7184, NIN = 7424;
constexpr int O_Q = 0, O_K = 256, O_V = 512, O_G = 1024, O_A = 1536, O_SU = 1552, O_SV = 2064, O_CB = 2576, O_CC = 3088, O_CX = 3600, O_GT = 4112;
constexpr float EPS = 1e-6f;
}
using namespace cfg;

namespace pg8 {
#define PG8_LAS __attribute__((address_space(3)))
typedef unsigned short bf16_t;
typedef short bf16x8 __attribute__((ext_vector_type(8)));
typedef float f32x4 __attribute__((ext_vector_type(4)));
typedef unsigned u32x4 __attribute__((ext_vector_type(4)));
constexpr int BM = 256, BK = 64, HALF = 128, HTB = HALF * BK * 2  , STAGE_BYTES = 8 * HTB, NXCD = 8, WGM = 8;

__host__ __device__ __forceinline__ int lds_byte(int r, int c) { const int st = (r >> 4) * 2 + (c >> 5), rr = r & 15, cc = c & 31, ob = rr * 64 + cc * 2; return st * 1024 + (ob ^ (((ob >> 9) & 1) << 5)); }
__host__ __device__ __forceinline__ void stage_rc(int b, int& R, int& C) { const int st = b / 1024, sb = b % 1024, swz = sb ^ (((sb >> 9) & 1) << 5); R = (st >> 1) * 16 + swz / 64; C = (st & 1) * 32 + (swz % 64) / 2; }
__host__ __device__ __forceinline__ int perm32(int rho) { const int n = rho >> 4, i = rho & 15; return 8 * (i >> 2) + 4 * n + (i & 3); }

struct Unit { int pm, pn; };
struct Gemm { const bf16_t* A; const bf16_t* Bt; int M, N, K; };

struct StaticOrder {
    int nM, nN, nwg, G, c;
    __host__ __device__ void init(int M, int N, int G_, int c_) { nM = M / BM; nN = N / BM; nwg = nM * nN; G = G_; c = c_; }
    __host__ __device__ bool next(int i, Unit& u) const {
        const long L = (long)i * G + c; if (L >= nwg) return false;
        int wgid = (int)L; { const int q = nwg / NXCD, r = nwg % NXCD, xcd = wgid % NXCD, off = wgid / NXCD; wgid = (xcd < r ? xcd * (q + 1) : r * (q + 1) + (xcd - r) * q) + off; }
        const int nig = WGM * nN, gid = wgid / nig, fm = gid * WGM, gsz = (nM - fm) < WGM ? (nM - fm) : WGM;
        u.pm = fm + ((wgid % nig) % gsz); u.pn = (wgid % nig) / gsz; return true;
    }
    __device__ __forceinline__ void a_ready(const Unit&) const {}
    __device__ __forceinline__ void done(const Unit&) const {}
};

__device__ __forceinline__ unsigned cvt_pk_bf16(float lo, float hi) { unsigned r; asm volatile("v_cvt_pk_bf16_f32 %0, %1, %2" : "=v"(r) : "v"(lo), "v"(hi)); return r; }
typedef float f32x2 __attribute__((ext_vector_type(2)));
template <class Epi, class Sched, bool ALIGN_EPI = false, bool SP2 = false>
__device__ __forceinline__ void gemm_phase(PG8_LAS unsigned char* lds, const Gemm g, const Sched& S, const Epi& E) {
    int tid_ = threadIdx.x; asm volatile("" : "+v"(tid_));
    const int tid = tid_, wid = __builtin_amdgcn_readfirstlane(tid >> 6), lane = tid & 63, wr = wid >> 2, wc = wid & 3, fr = lane & 15, fq = lane >> 4;
    const int K = g.K, nt = K / BK;
    unsigned voffA[2], voffB[2];
#pragma unroll
    for (int i = 0; i < 2; ++i) { int R, C; stage_rc(tid * 16 + i * 8192, R, C); const int Rb = Epi::PERM ? ((R & ~31) + perm32(R & 31)) : R;
        voffA[i] = (unsigned)(R * K + C) * 2u; voffB[i] = (unsigned)(Rb * K + C) * 2u; }
    const size_t kstep = (size_t)(BK * 2);
    const size_t hstep = (size_t)HALF * K * 2;
    const size_t tstep = 2 * hstep;
    const unsigned ldsw = (unsigned)wid * 1024u;
    const int aoff = lds_byte(wr * 64 + fr, fq * 8), boff = lds_byte(wc * 32 + fr, fq * 8);
#define PG8_SA(b, h) (((b) * 2 + (h)) * HTB)
#define PG8_SB(b, h) ((4 + (b) * 2 + (h)) * HTB)
#define PG8_STAGE(bufoff, gbase, voff) do { _Pragma("unroll") for (int _i = 0; _i < 2; ++_i) \
        __builtin_amdgcn_global_load_lds((const unsigned*)((const char*)(gbase) + (voff)[_i]), (PG8_LAS unsigned*)(lds + (bufoff) + ldsw + _i * 8192), 16, 0, 0); } while (0)
#define PG8_LDA(dst, b, h) do { _Pragma("unroll") for (int m = 0; m < 4; ++m) _Pragma("unroll") for (int k = 0; k < 2; ++k) dst[m][k] = *(const PG8_LAS bf16x8*)(lds + PG8_SA(b, h) + aoff + m * 2048 + k * 1024); } while (0)
#define PG8_LDB(dst, b, h) do { _Pragma("unroll") for (int n = 0; n < 2; ++n) _Pragma("unroll") for (int k = 0; k < 2; ++k) dst[n][k] = *(const PG8_LAS bf16x8*)(lds + PG8_SB(b, h) + boff + n * 2048 + k * 1024); } while (0)
#define PG8_MMA(ai, bj, At, Bt) do { __builtin_amdgcn_s_setprio(1); _Pragma("unroll") for (int m = 0; m < 4; ++m) _Pragma("unroll") for (int n = 0; n < 2; ++n) _Pragma("unroll") for (int k = 0; k < 2; ++k) \
        acc[ai][bj][m][n] = __builtin_amdgcn_mfma_f32_16x16x32_bf16(Bt[n][k], At[m][k], acc[ai][bj][m][n], 0, 0, 0); __builtin_amdgcn_s_setprio(0); } while (0)
#define PG8_WAIT_V(n) asm volatile("s_waitcnt vmcnt(" #n ")" ::: "memory")
#define PG8_WAIT_L(n) asm volatile("s_waitcnt lgkmcnt(" #n ")" ::: "memory")
#define PG8_BAR __builtin_amdgcn_s_barrier()
#define PG8_SCHED __builtin_amdgcn_sched_barrier(0)
    Unit cur, nxt; int ui = 0;
    if (!S.next(0, cur)) return;
    f32x4 acc[2][2][4][2];
#pragma unroll
    for (int a = 0; a < 2; ++a)
#pragma unroll
        for (int b = 0; b < 2; ++b)
#pragma unroll
            for (int m = 0; m < 4; ++m)
#pragma unroll
                for (int n = 0; n < 2; ++n) acc[a][b][m][n] = (f32x4){0.f, 0.f, 0.f, 0.f};
    bf16x8 At[4][2], B0[2][2], B1[2][2];
    const char* cA = (const char*)g.A + (size_t)cur.pm * tstep; const char* cB = (const char*)g.Bt + (size_t)cur.pn * tstep;
    S.a_ready(cur);
    if constexpr (SP2) {
        PG8_STAGE(PG8_SB(0, 0), cB, voffB); PG8_STAGE(PG8_SB(0, 1), cB + hstep, voffB); PG8_STAGE(PG8_SA(0, 0), cA, voffA); PG8_STAGE(PG8_SA(0, 1), cA + hstep, voffA);
        if (wr == 1) PG8_BAR;
        PG8_WAIT_V(2); PG8_BAR;
        PG8_STAGE(PG8_SB(1, 0), cB + kstep, voffB); PG8_STAGE(PG8_SA(1, 0), cA + kstep, voffA); PG8_STAGE(PG8_SB(1, 1), cB + hstep + kstep, voffB);
        PG8_WAIT_V(6); PG8_BAR;
    } else {
        PG8_STAGE(PG8_SB(0, 0), cB, voffB); PG8_STAGE(PG8_SA(0, 0), cA, voffA); PG8_STAGE(PG8_SB(0, 1), cB + hstep, voffB); PG8_STAGE(PG8_SA(0, 1), cA + hstep, voffA);
        if (wr == 1) PG8_BAR;
        PG8_WAIT_V(4); PG8_BAR;
        PG8_STAGE(PG8_SB(1, 0), cB + kstep, voffB); PG8_STAGE(PG8_SA(1, 0), cA + kstep, voffA); PG8_STAGE(PG8_SB(1, 1), cB + hstep + kstep, voffB);
        PG8_WAIT_V(6); PG8_BAR;
    }
    for (;;) {
        const bool has_next = S.next(ui + 1, nxt);
        const char* nA = has_next ? (const char*)g.A + (size_t)nxt.pm * tstep : cA; const char* nB = has_next ? (const char*)g.Bt + (size_t)nxt.pn * tstep : cB;
        for (int t = 0; t < nt; t += 2) {
            const bool last = (t == nt - 2);
            const char* a1 = cA + (size_t)(t + 1) * kstep;
            const char* a2 = last ? nA : cA + (size_t)(t + 2) * kstep; const char* b2 = last ? nB : cB + (size_t)(t + 2) * kstep;
            const char* a3 = a2 + kstep; const char* b3 = b2 + kstep;
            if (last && has_next) S.a_ready(nxt);
            if constexpr (SP2) {
            PG8_LDB(B0, 0, 0); PG8_LDB(B1, 0, 1); PG8_SCHED; PG8_LDA(At, 0, 0); PG8_STAGE(PG8_SA(1, 1), a1 + hstep, voffA);
            PG8_WAIT_V(8); PG8_WAIT_L(0); PG8_BAR; PG8_MMA(0, 0, At, B0); PG8_MMA(0, 1, At, B1); PG8_BAR; PG8_SCHED;
            PG8_LDA(At, 0, 1); PG8_STAGE(PG8_SB(0, 0), b2, voffB); PG8_STAGE(PG8_SB(0, 1), b2 + hstep, voffB); PG8_STAGE(PG8_SA(0, 0), a2, voffA);
            PG8_WAIT_V(8); PG8_WAIT_L(0); PG8_BAR; PG8_MMA(1, 0, At, B0); PG8_MMA(1, 1, At, B1); PG8_BAR; PG8_SCHED;
            PG8_LDB(B0, 1, 0); PG8_LDB(B1, 1, 1); PG8_SCHED; PG8_LDA(At, 1, 0); PG8_STAGE(PG8_SA(0, 1), a2 + hstep, voffA);
            PG8_WAIT_V(8); PG8_WAIT_L(0); PG8_BAR; PG8_MMA(0, 0, At, B0); PG8_MMA(0, 1, At, B1); PG8_BAR; PG8_SCHED;
            PG8_LDA(At, 1, 1); PG8_STAGE(PG8_SB(1, 0), b3, voffB); PG8_STAGE(PG8_SB(1, 1), b3 + hstep, voffB); PG8_STAGE(PG8_SA(1, 0), a3, voffA);
            PG8_WAIT_V(8); PG8_WAIT_L(0); PG8_BAR; PG8_MMA(1, 0, At, B0); PG8_MMA(1, 1, At, B1); PG8_BAR; PG8_SCHED;
            } else {
            PG8_LDB(B0, 0, 0); PG8_SCHED; PG8_LDA(At, 0, 0); PG8_STAGE(PG8_SA(1, 1), a1 + hstep, voffA);
            PG8_WAIT_L(8); PG8_BAR; PG8_WAIT_L(0); PG8_MMA(0, 0, At, B0); PG8_BAR; PG8_SCHED;
            PG8_LDB(B1, 0, 1); PG8_STAGE(PG8_SB(0, 0), b2, voffB);
            PG8_BAR; PG8_WAIT_L(0); PG8_MMA(0, 1, At, B1); PG8_BAR;
            PG8_LDA(At, 0, 1); PG8_STAGE(PG8_SA(0, 0), a2, voffA);
            PG8_BAR; PG8_WAIT_L(0); PG8_MMA(1, 0, At, B0); PG8_BAR; PG8_SCHED;
            PG8_STAGE(PG8_SB(0, 1), b2 + hstep, voffB);
            PG8_WAIT_V(6); PG8_BAR; PG8_MMA(1, 1, At, B1); PG8_BAR;
            PG8_LDB(B0, 1, 0); PG8_SCHED; PG8_LDA(At, 1, 0); PG8_STAGE(PG8_SA(0, 1), a2 + hstep, voffA);
            PG8_WAIT_L(8); PG8_BAR; PG8_WAIT_L(0); PG8_MMA(0, 0, At, B0); PG8_BAR; PG8_SCHED;
            PG8_LDB(B1, 1, 1); PG8_STAGE(PG8_SB(1, 0), b3, voffB);
            PG8_BAR; PG8_WAIT_L(0); PG8_MMA(0, 1, At, B1); PG8_BAR;
            PG8_LDA(At, 1, 1); PG8_STAGE(PG8_SA(1, 0), a3, voffA);
            PG8_BAR; PG8_WAIT_L(0); PG8_MMA(1, 0, At, B0); PG8_BAR; PG8_SCHED;
            PG8_STAGE(PG8_SB(1, 1), b3 + hstep, voffB);
            PG8_WAIT_V(6); PG8_BAR; PG8_MMA(1, 1, At, B1); PG8_BAR;
            }
        }
        if constexpr (ALIGN_EPI) { if (wr == 0) PG8_BAR; }
        if constexpr (!Epi::AFTER_DRAIN) { E(acc, cur, wr, wc, fr, fq); S.done(cur); }
        if (!has_next) break;
#pragma unroll
        for (int a = 0; a < 2; ++a)
#pragma unroll
            for (int b = 0; b < 2; ++b)
#pragma unroll
                for (int m = 0; m < 4; ++m)
#pragma unroll
                    for (int n = 0; n < 2; ++n) acc[a][b][m][n] = (f32x4){0.f, 0.f, 0.f, 0.f};
        cur = nxt; cA = nA; cB = nB; ++ui;
        if constexpr (ALIGN_EPI) { if (wr == 1) PG8_BAR; }
    }
    PG8_WAIT_V(0);
    if constexpr (!ALIGN_EPI) { if (wr == 0) PG8_BAR; }
    PG8_BAR;
    if constexpr (Epi::AFTER_DRAIN) { E.fused(acc, cur, wr, wc, fr, fq, lds, wid, lane); S.done(cur); }
#undef PG8_SA
#undef PG8_SB
#undef PG8_STAGE
#undef PG8_LDA
#undef PG8_LDB
#undef PG8_MMA
#undef PG8_WAIT_V
#undef PG8_WAIT_L
#undef PG8_BAR
#undef PG8_SCHED
}
}

#define GAS __attribute__((address_space(1)))
#define LAS __attribute__((address_space(3)))
typedef unsigned short bf16;
typedef unsigned v4u __attribute__((ext_vector_type(4)));
typedef unsigned v2u __attribute__((ext_vector_type(2)));
typedef float f32x4 __attribute__((ext_vector_type(4)));
typedef float f32x2 __attribute__((ext_vector_type(2)));
typedef short bf16x8 __attribute__((ext_vector_type(8)));
constexpr int NWAVES = 8, NTHREADS = 512;
constexpr int RING_BYTES = 131072, LDS_BYTES = 147456;

constexpr size_t MiB = 1u << 20;
constexpr size_t SL_WIN = 0, SL_WBR = SL_WIN + (size_t)NIN * D * 2, SL_WO = SL_WBR + (size_t)3 * D * 512 * 2, SL_WUP = SL_WO + (size_t)D * D * 2,
                 SL_WDN = SL_WUP + (size_t)DFF2 * D * 2, SL_SGW = SL_WDN + (size_t)D * DFF * 2, SL_END = SL_SGW + (size_t)4 * 128 * 128 * 2, SL_BYTES = 38 * MiB;
static_assert(SL_END <= SL_BYTES, "weight slot");
constexpr size_t WS_CTL = 0, WS_SLOT0 = 1 * MiB, WS_XB = WS_SLOT0 + 2 * SL_BYTES, WS_SSQ = WS_XB + 32 * MiB, WS_SVST = WS_SSQ + 1 * MiB, WS_ACT0 = WS_SVST + 1 * MiB;
constexpr size_t A_Q = 0, A_K = 8 * MiB, A_V = 16 * MiB, A_Z = 32 * MiB, A_SV = 80 * MiB, A_CC = 96 * MiB, A_CX = 112 * MiB, A_LOGA = 128 * MiB, A_G = 144 * MiB,
                 A_CST = 240 * MiB, A_DEC = 272 * MiB, A_END = 273 * MiB;
constexpr size_t A_MERGED = A_Q, A_HUP = 0, A_ACT = 176 * MiB;
static_assert(A_ACT + (size_t)M * DFF * 2 <= A_END, "overlay");
constexpr size_t WS_END = WS_ACT0 + A_END;

__device__ __forceinline__ float bf2f(unsigned h) { return __uint_as_float(h << 16); }
__device__ __forceinline__ unsigned pk2(float lo, float hi) { return pg8::cvt_pk_bf16(lo, hi); }
__device__ __forceinline__ float fsigmoid(float z) { return __builtin_amdgcn_rcpf(1.f + __expf(-z)); }
__device__ __forceinline__ float fsilu(float z) { return z * fsigmoid(z); }
__device__ __forceinline__ float fgelu(float z) { return z * fsigmoid(1.5957691216057308f * (z + 0.044715f * z * z * z)); }
__device__ __forceinline__ float flogsig(float z) { return fminf(z, 0.f) - __logf(1.f + __expf(-fabsf(z))); }
__device__ __forceinline__ float wave_sum(float v) {
#pragma unroll
    for (int o = 1; o < 64; o <<= 1) v += __shfl_xor(v, o);
    return v;
}
#define LDS_WAIT() asm volatile("s_waitcnt lgkmcnt(0)" ::: "memory")
__device__ __forceinline__ f32x4 mfma16(bf16x8 a, bf16x8 b, f32x4 c) { return __builtin_amdgcn_mfma_f32_16x16x32_bf16(a, b, c, 0, 0, 0); }

__device__ __forceinline__ void tr_write(bf16* WT, int K, int k0, LAS float* scr, int lane) {
    LDS_WAIT(); asm volatile("" ::: "memory");
    const int c = lane & 7;
#pragma unroll
    for (int j = 0; j < 4; ++j) { const int n = (lane >> 3) + 8 * j; const LAS float* s = scr + (8 * c) * 33 + n;
        v4u o; o.x = pk2(s[0 * 33], s[1 * 33]); o.y = pk2(s[2 * 33], s[3 * 33]); o.z = pk2(s[4 * 33], s[5 * 33]); o.w = pk2(s[6 * 33], s[7 * 33]);
        *(GAS v4u*)(WT + (size_t)n * K + k0 + 8 * c) = o; }
    LDS_WAIT(); asm volatile("" ::: "memory");
}
__device__ __forceinline__ void tr_item(const float* W, int ldw, int col0, const float* ksc, float sc, bf16* WT, int K, int k0, LAS float* scr, int lane) {
#pragma unroll 8
    for (int i = 0; i < 32; ++i) { const int kk = 2 * i + (lane >> 5); float v = W[(size_t)(k0 + kk) * ldw + col0 + (lane & 31)]; v *= ksc ? ksc[k0 + kk] * sc : sc; scr[kk * 33 + (lane & 31)] = v; }
    tr_write(WT, K, k0, scr, lane);
}
__device__ __forceinline__ void alpha_item(const float* win, const float* wal, const float* g, bf16* WT, int k0, int j0, LAS float* scr, int lane) {
    const int jj = lane & 31, half = lane >> 5; float wa[16];
#pragma unroll
    for (int r = 0; r < 16; ++r) wa[r] = wal[r * GKEY + j0 + jj];
    for (int i = 0; i < 32; ++i) { const int kk = 2 * i + half, k = k0 + kk; const float* wr = win + (size_t)k * INC + O_A; float s = 0.f;
#pragma unroll
        for (int r = 0; r < 16; ++r) s += wr[r] * wa[r];
        scr[kk * 33 + jj] = s * g[k]; }
    tr_write(WT + (size_t)j0 * D, D, k0, scr, lane);
}
struct Inputs { const float* p[21]; };
constexpr int CV_J0 = 16 * 224, CV_J1 = 16 * 8, CV_J2 = 3 * 8 * 32, CV_J3 = 16 * 32, CV_J4 = 16 * 176, CV_J5 = 44 * 32, CV_J6 = 128, CV_ITEMS = CV_J0 + CV_J1 + CV_J2 + CV_J3 + CV_J4 + CV_J5 + CV_J6;
__device__ __forceinline__ void convert_layer(const Inputs& I, int l, unsigned char* slot, LAS unsigned char* lds, int gw, int ngw, int wave, int lane) {
    LAS float* scr = (LAS float*)(lds + wave * 8448);
    bf16* WIN = (bf16*)(slot + SL_WIN); bf16* WBR = (bf16*)(slot + SL_WBR); bf16* WO = (bf16*)(slot + SL_WO); bf16* WUP = (bf16*)(slot + SL_WUP); bf16* WDN = (bf16*)(slot + SL_WDN); bf16* SGWS = (bf16*)(slot + SL_SGW);
    const float* win = I.p[2] + (size_t)l * D * INC;
    for (int it = gw; it < CV_ITEMS; it += ngw) {
        int r = it;
        if (r < CV_J0) { const int kb = r / 224, nb = r % 224; const int drow = nb < 48 ? 32 * nb : 1792 + 32 * (nb - 48), scol = nb < 48 ? 32 * nb : O_SU + 32 * (nb - 48);
            tr_item(win, INC, scol, I.p[1] + (size_t)l * D, drow < 256 ? 0.125f : 1.f, WIN + (size_t)drow * D, D, 64 * kb, scr, lane); continue; }
        r -= CV_J0;
        if (r < CV_J1) { const int kb = r / 8, jb = r % 8; alpha_item(win, I.p[3] + (size_t)l * GRANK * GKEY, I.p[1] + (size_t)l * D, WIN + (size_t)1536 * D, 64 * kb, 32 * jb, scr, lane); continue; }
        r -= CV_J1;
        if (r < CV_J2) { const int br = r / 256, rr = r % 256, kb = rr / 32, nb = rr % 32;
            const float* W = (br == 0 ? I.p[6] : br == 1 ? I.p[11] : I.p[13]) + (size_t)l * 512 * D;
            tr_item(W, D, 32 * nb, br == 0 ? I.p[5] + (size_t)l * GVAL : nullptr, 1.f, WBR + ((size_t)br * D + 32 * nb) * 512, 512, 64 * kb, scr, lane); continue; }
        r -= CV_J2;
        if (r < CV_J3) { const int kb = r / 32, nb = r % 32; tr_item(I.p[14] + (size_t)l * D * D, D, 32 * nb, nullptr, 1.f, WO + (size_t)32 * nb * D, D, 64 * kb, scr, lane); continue; }
        r -= CV_J3;
        if (r < CV_J4) { const int kb = r / 176, nb = r % 176, pn = nb / 8, jb = nb % 8; const int scol = jb < 4 ? 128 * pn + 32 * jb : DFF + 128 * pn + 32 * (jb - 4);
            tr_item(I.p[16] + (size_t)l * D * DFF2, DFF2, scol, I.p[15] + (size_t)l * D, 1.f, WUP + (size_t)32 * nb * D, D, 64 * kb, scr, lane); continue; }
        r -= CV_J4;
        if (r < CV_J5) { const int kb = r / 32, nb = r % 32; tr_item(I.p[19] + (size_t)l * DFF * D, D, 32 * nb, nullptr, 1.f, WDN + (size_t)32 * nb * DFF, DFF, 64 * kb, scr, lane); continue; }
        r -= CV_J5;
        { const int e0 = r * 512 + lane * 8, t = (e0 >> 7) & 127, s0 = e0 & 127; const float* src = I.p[9] + (size_t)l * 4 * 128 * 128 + e0;
          const f32x4 a = *(const f32x4*)src, b = *(const f32x4*)(src + 4); float v[8] = {a[0], a[1], a[2], a[3], b[0], b[1], b[2], b[3]};
#pragma unroll
          for (int e = 0; e < 8; ++e) if (s0 + e > t) v[e] = 0.f;
          v4u o; o.x = pk2(v[0], v[1]); o.y = pk2(v[2], v[3]); o.z = pk2(v[4], v[5]); o.w = pk2(v[6], v[7]); *(GAS v4u*)(SGWS + e0) = o; }
    }
}
__device__ __forceinline__ void x_prep(const float* xin, float* xout, bf16* xb, float* ssq, int gw, int ngw, int lane) {
    for (int row = gw; row < M; row += ngw) {
        const GAS f32x4* xr = (const GAS f32x4*)(xin + (size_t)row * D) + lane; f32x4 v[4]; float s = 0.f;
#pragma unroll
        for (int j = 0; j < 4; ++j) { v[j] = xr[64 * j]; s += (v[j][0] * v[j][0] + v[j][1] * v[j][1]) + (v[j][2] * v[j][2] + v[j][3] * v[j][3]); }
        s = wave_sum(s);
#pragma unroll
        for (int j = 0; j < 4; ++j) { ((GAS f32x4*)(xout + (size_t)row * D))[lane + 64 * j] = v[j]; v2u w; w.x = pk2(v[j][0], v[j][1]); w.y = pk2(v[j][2], v[j][3]); ((GAS v2u*)(xb + (size_t)row * D))[lane + 64 * j] = w; }
        if (lane < 16) ssq[(size_t)row * 16 + lane] = lane == 0 ? s : 0.f;
    }
}
__device__ __forceinline__ void final_norm(float* x, const float* ssq, const float* g, int gw, int ngw, int lane) {
    for (int row = gw; row < M; row += ngw) {
        const float pv = lane < 16 ? ssq[(size_t)row * 16 + lane] : 0.f; const float rs = rsqrtf(wave_sum(pv) * (1.f / D) + EPS);
        GAS f32x4* xr = (GAS f32x4*)(x + (size_t)row * D) + lane;
#pragma unroll
        for (int j = 0; j < 4; ++j) { const f32x4 gv = ((const GAS f32x4*)g)[lane + 64 * j]; xr[64 * j] = xr[64 * j] * rs * gv; }
    }
}

constexpr int GP = 72;
constexpr int L_QT = 0, L_KT = 9216, L_KENDT = 18432, L_VT = 27648, L_ST = 46080, L_SEG = 64512, L_DECS = 66560, L_RED = 66816, L_GLA_END = 67328;
constexpr int VP = 136;

__device__ __forceinline__ void sgu_item(int item, LAS unsigned char* lds, bf16* ZB, const bf16* SV, const float* SVST, const float* lng, const float* lnb, const bf16* wsb, const float* bs, int wave, int lane) {
    const int h = item & 3, r0 = (item >> 2) * 128; LAS bf16* vnT = (LAS bf16*)lds;
    { const int d0 = 16 * wave, s0 = 2 * lane; float mean[2], rstd[2]; v4u xv[2][2];
#pragma unroll
      for (int rr = 0; rr < 2; ++rr) { const size_t row = (size_t)r0 + s0 + rr; const f32x4* p = (const f32x4*)(SVST + row * 16); const f32x4 a = p[0], b = p[1], c = p[2], d = p[3];
          const float sm = (a[0] + a[2]) + (b[0] + b[2]) + (c[0] + c[2]) + (d[0] + d[2]), sq = (a[1] + a[3]) + (b[1] + b[3]) + (c[1] + c[3]) + (d[1] + d[3]);
          mean[rr] = sm * (1.f / 512.f); rstd[rr] = rsqrtf(fmaxf(sq * (1.f / 512.f) - mean[rr] * mean[rr], 0.f) + EPS);
          const v4u* q = (const v4u*)(SV + row * 512 + h * 128 + d0); xv[rr][0] = q[0]; xv[rr][1] = q[1]; }
#pragma unroll
      for (int j = 0; j < 16; ++j) { const float g = lng[h * 128 + d0 + j], b = lnb[h * 128 + d0 + j]; const unsigned w0 = xv[0][j >> 3][(j >> 1) & 3], w1 = xv[1][j >> 3][(j >> 1) & 3];
          const float x0 = (j & 1) ? bf2f(w0 >> 16) : bf2f(w0 & 0xffffu), x1 = (j & 1) ? bf2f(w1 >> 16) : bf2f(w1 & 0xffffu);
          *(LAS unsigned*)(vnT + (d0 + j) * VP + s0) = pk2((x0 - mean[0]) * rstd[0] * g + b, (x1 - mean[1]) * rstd[1] * g + b); } }
    __syncthreads();
    { const int fr = lane & 15, fq = lane >> 4, t = 16 * wave + fr, nks = (wave >> 1) + 1; bf16x8 bfr[4];
#pragma unroll
      for (int ks = 0; ks < 4; ++ks) bfr[ks] = (ks < nks) ? *(const bf16x8*)(wsb + ((size_t)h * 128 + t) * 128 + 32 * ks + 8 * fq) : (bf16x8){0, 0, 0, 0, 0, 0, 0, 0};
      f32x4 acc[8];
#pragma unroll
      for (int m = 0; m < 8; ++m) { acc[m] = (f32x4){0.f, 0.f, 0.f, 0.f};
#pragma unroll
          for (int ks = 0; ks < 4; ++ks) if (ks < nks) { const bf16x8 a = *(const LAS bf16x8*)(vnT + (16 * m + fr) * VP + 32 * ks + 8 * fq); acc[m] = mfma16(a, bfr[ks], acc[m]); } }
      const size_t row = (size_t)r0 + t; const float bias = bs[h * 128 + t];
#pragma unroll
      for (int m = 0; m < 8; ++m) { bf16* p = ZB + row * 512 + h * 128 + 16 * m + 4 * fq; const v2u su = *(const v2u*)p; v2u o;
          o.x = pk2(bf2f(su.x & 0xffffu) * (acc[m][0] + bias), bf2f(su.x >> 16) * (acc[m][1] + bias)); o.y = pk2(bf2f(su.y & 0xffffu) * (acc[m][2] + bias), bf2f(su.y >> 16) * (acc[m][3] + bias)); *(v2u*)p = o; } }
    __syncthreads();
}
__device__ __forceinline__ void convbr_item(int idx, bf16* ZC, const bf16* CC, const bf16* CX, const float* cw) {
    const int c0 = (idx & 63) * 8, r0 = (idx >> 6) * 8; float w[3][8];
#pragma unroll
    for (int k = 0; k < 3; ++k) { const f32x4 a = *(const f32x4*)(cw + k * CW + c0), b = *(const f32x4*)(cw + k * CW + c0 + 4);
#pragma unroll
        for (int e = 0; e < 4; ++e) { w[k][e] = a[e]; w[k][4 + e] = b[e]; } }
    float u2[8], u1[8];
    auto loadu = [&](int row, float (&u)[8]) { const v4u a = *(const v4u*)(CC + (size_t)row * CW + c0), b = *(const v4u*)(CX + (size_t)row * CW + c0);
#pragma unroll
        for (int e = 0; e < 4; ++e) { u[2 * e] = bf2f(a[e] & 0xffffu) * bf2f(b[e] & 0xffffu); u[2 * e + 1] = bf2f(a[e] >> 16) * bf2f(b[e] >> 16); } };
    if ((r0 & (SEQ - 1)) == 0) {
#pragma unroll
        for (int e = 0; e < 8; ++e) { u2[e] = 0.f; u1[e] = 0.f; } }
    else { loadu(r0 - 2, u2); loadu(r0 - 1, u1); }
#pragma unroll
    for (int i = 0; i < 8; ++i) { float u0[8]; loadu(r0 + i, u0); bf16* p = ZC + (size_t)(r0 + i) * CW + c0; const v4u cb = *(const v4u*)p; float z[8];
#pragma unroll
        for (int e = 0; e < 8; ++e) { const float y = w[0][e] * u2[e] + w[1][e] * u1[e] + w[2][e] * u0[e]; const float c = (e & 1) ? bf2f(cb[e >> 1] >> 16) : bf2f(cb[e >> 1] & 0xffffu); z[e] = c * y; u2[e] = u1[e]; u1[e] = u0[e]; }
        v4u o; o.x = pk2(z[0], z[1]); o.y = pk2(z[2], z[3]); o.z = pk2(z[4], z[5]); o.w = pk2(z[6], z[7]); *(v4u*)p = o; }
}
template <bool FULL> __device__ __forceinline__ float gla_stage(LAS unsigned char* lds, size_t r0, int h, const bf16* Q, const bf16* KK, const bf16* V, const float* LOGA, int tid) {
    const int kcol = tid & 63, seg = tid >> 6; LAS float* SEG = (LAS float*)(lds + L_SEG);
    float p[8]; unsigned kq[8], qq[8];
#pragma unroll
    for (int j = 0; j < 8; ++j) { const size_t row = r0 + 8 * seg + j; p[j] = LOGA[row * GKEY + h * 64 + kcol]; kq[j] = KK[row * GKEY + h * 64 + kcol]; if (FULL) qq[j] = Q[row * GKEY + h * 64 + kcol]; }
#pragma unroll
    for (int j = 1; j < 8; ++j) p[j] += p[j - 1];
    SEG[seg * 64 + kcol] = p[7];
    { const int tp = tid & 31, vg = tid >> 5; LAS bf16* VT = (LAS bf16*)(lds + L_VT);
      const v4u a = *(const v4u*)(V + (r0 + 2 * tp) * GVAL + h * 128 + 8 * vg), b = *(const v4u*)(V + (r0 + 2 * tp + 1) * GVAL + h * 128 + 8 * vg);
#pragma unroll
      for (int e = 0; e < 4; ++e) { *(LAS unsigned*)(VT + (8 * vg + 2 * e) * GP + 2 * tp) = (a[e] & 0xffffu) | (b[e] << 16); *(LAS unsigned*)(VT + (8 * vg + 2 * e + 1) * GP + 2 * tp) = (a[e] >> 16) | (b[e] & 0xffff0000u); } }
    __syncthreads();
    float off = 0.f, tot = 0.f;
#pragma unroll
    for (int s = 0; s < 8; ++s) { const float v = SEG[s * 64 + kcol]; tot += v; if (s < seg) off += v; }
    float ke[8];
#pragma unroll
    for (int j = 0; j < 8; ++j) { const float b = off + p[j], kf = bf2f(kq[j]); ke[j] = kf * __expf(tot - b);
        if (FULL) { const int t = 8 * seg + j; ((LAS bf16*)(lds + L_QT))[t * GP + kcol] = (bf16)(pk2(bf2f(qq[j]) * __expf(b), 0.f) & 0xffffu); ((LAS bf16*)(lds + L_KT))[t * GP + kcol] = (bf16)(pk2(kf * __expf(-b), 0.f) & 0xffffu); } }
    v4u o; o.x = pk2(ke[0], ke[1]); o.y = pk2(ke[2], ke[3]); o.z = pk2(ke[4], ke[5]); o.w = pk2(ke[6], ke[7]);
    *(LAS v4u*)((LAS bf16*)(lds + L_KENDT) + kcol * GP + 8 * seg) = o;
    return __expf(tot);
}
__device__ __forceinline__ void gla_b1_item(int item, LAS unsigned char* lds, const bf16* KK, const bf16* V, const float* LOGA, float* CST, float* DEC, int tid, int wave, int lane) {
    const int h = item & 3; const size_t r0 = (size_t)(item >> 2) * 64;
    const float dec = gla_stage<false>(lds, r0, h, nullptr, KK, V, LOGA, tid);
    if (tid < 64) DEC[(size_t)item * 64 + tid] = dec;
    __syncthreads();
    const int fr = lane & 15, fq = lane >> 4; const LAS bf16* VT = (const LAS bf16*)(lds + L_VT); const LAS bf16* KE = (const LAS bf16*)(lds + L_KENDT);
    bf16x8 bv[2];
#pragma unroll
    for (int ks = 0; ks < 2; ++ks) bv[ks] = *(const LAS bf16x8*)(VT + (16 * wave + fr) * GP + 32 * ks + 8 * fq);
#pragma unroll
    for (int m = 0; m < 4; ++m) { f32x4 acc = (f32x4){0.f, 0.f, 0.f, 0.f};
#pragma unroll
        for (int ks = 0; ks < 2; ++ks) acc = mfma16(*(const LAS bf16x8*)(KE + (16 * m + fr) * GP + 32 * ks + 8 * fq), bv[ks], acc);
        *(f32x4*)(CST + (size_t)item * 8192 + (16 * wave + fr) * 64 + 16 * m + 4 * fq) = acc; }
    __syncthreads();
}
__device__ __forceinline__ void gla_b2_unit(int unit, LAS unsigned char* lds, const bf16* Q, const bf16* KK, const bf16* V, const float* LOGA, const float* CST, const float* DEC, bf16* ZA, int tid, int wave, int lane) {
    const int g = unit & 7, h = (unit >> 3) & 3, b = unit >> 5, fr = lane & 15, fq = lane >> 4;
    f32x4 S[4];
#pragma unroll
    for (int m = 0; m < 4; ++m) S[m] = (f32x4){0.f, 0.f, 0.f, 0.f};
    for (int j = 0; j < 4 * g; ++j) { const size_t it = ((size_t)(b * 32 + j) * 4 + h); const float* cp = CST + it * 8192 + (16 * wave + fr) * 64 + 4 * fq; const float* dp = DEC + it * 64 + 4 * fq;
#pragma unroll
        for (int m = 0; m < 4; ++m) { const f32x4 c = *(const f32x4*)(cp + 16 * m), d = *(const f32x4*)(dp + 16 * m); S[m] = d * S[m] + c; } }
    const LAS bf16* QT = (const LAS bf16*)(lds + L_QT); const LAS bf16* KT = (const LAS bf16*)(lds + L_KT); const LAS bf16* KE = (const LAS bf16*)(lds + L_KENDT);
    const LAS bf16* VT = (const LAS bf16*)(lds + L_VT); LAS bf16* ST = (LAS bf16*)(lds + L_ST); LAS float* DECS = (LAS float*)(lds + L_DECS); LAS float* RED = (LAS float*)(lds + L_RED);
    const int ih = wave & 3, vh = wave >> 2;
    for (int c = 0; c < 4; ++c) {
        const size_t r0 = (size_t)b * SEQ + (size_t)(4 * g + c) * 64;
#pragma unroll
        for (int m = 0; m < 4; ++m) { v2u w; w.x = pk2(S[m][0], S[m][1]); w.y = pk2(S[m][2], S[m][3]); *(LAS v2u*)(ST + (16 * wave + fr) * GP + 16 * m + 4 * fq) = w; }
        const float dec = gla_stage<true>(lds, r0, h, Q, KK, V, LOGA, tid);
        if (tid < 64) DECS[tid] = dec;
        __syncthreads();
        bf16x8 bq[2];
#pragma unroll
        for (int ks = 0; ks < 2; ++ks) bq[ks] = *(const LAS bf16x8*)(QT + (16 * ih + fr) * GP + 32 * ks + 8 * fq);
        f32x4 X[4];
#pragma unroll
        for (int jt = 0; jt < 4; ++jt) { X[jt] = (f32x4){0.f, 0.f, 0.f, 0.f};
            if (jt <= ih) {
#pragma unroll
                for (int ks = 0; ks < 2; ++ks) X[jt] = mfma16(*(const LAS bf16x8*)(KT + (16 * jt + fr) * GP + 32 * ks + 8 * fq), bq[ks], X[jt]);
#pragma unroll
                for (int r = 0; r < 4; ++r) if (16 * jt + 4 * fq + r > 16 * ih + fr) X[jt][r] = 0.f; } }
        bf16x8 xb[2];
#pragma unroll
        for (int k2 = 0; k2 < 2; ++k2) { v4u w; w.x = pk2(X[2 * k2][0], X[2 * k2][1]); w.y = pk2(X[2 * k2][2], X[2 * k2][3]); w.z = pk2(X[2 * k2 + 1][0], X[2 * k2 + 1][1]); w.w = pk2(X[2 * k2 + 1][2], X[2 * k2 + 1][3]); xb[k2] = __builtin_bit_cast(bf16x8, w); }
        f32x4 O[4]; float ss = 0.f;
#pragma unroll
        for (int mt = 0; mt < 4; ++mt) { const int v = 64 * vh + 16 * mt + fr; f32x4 o = (f32x4){0.f, 0.f, 0.f, 0.f};
#pragma unroll
            for (int k2 = 0; k2 < 2; ++k2) { const v2u lo = *(const LAS v2u*)(VT + v * GP + 32 * k2 + 4 * fq), hi = *(const LAS v2u*)(VT + v * GP + 32 * k2 + 16 + 4 * fq); v4u a; a.x = lo.x; a.y = lo.y; a.z = hi.x; a.w = hi.y;
                o = mfma16(__builtin_bit_cast(bf16x8, a), xb[k2], o); }
#pragma unroll
            for (int ks = 0; ks < 2; ++ks) o = mfma16(*(const LAS bf16x8*)(ST + v * GP + 32 * ks + 8 * fq), bq[ks], o);
            O[mt] = o; ss += (o[0] * o[0] + o[1] * o[1]) + (o[2] * o[2] + o[3] * o[3]); }
        ss += __shfl_xor(ss, 16); ss += __shfl_xor(ss, 32);
        if (fq == 0) RED[(vh * 4 + ih) * 16 + fr] = ss;
        __syncthreads();
        const float rs = rsqrtf((RED[ih * 16 + fr] + RED[(4 + ih) * 16 + fr]) * (1.f / 128.f) + EPS);
        { const size_t row = r0 + 16 * ih + fr;
#pragma unroll
          for (int mt = 0; mt < 4; ++mt) { bf16* p = ZA + row * GVAL + h * 128 + 64 * vh + 16 * mt + 4 * fq; const v2u gt = *(const v2u*)p; v2u o;
              o.x = pk2(O[mt][0] * rs * bf2f(gt.x & 0xffffu), O[mt][1] * rs * bf2f(gt.x >> 16)); o.y = pk2(O[mt][2] * rs * bf2f(gt.y & 0xffffu), O[mt][3] * rs * bf2f(gt.y >> 16)); *(v2u*)p = o; } }
        bf16x8 bv[2];
#pragma unroll
        for (int ks = 0; ks < 2; ++ks) bv[ks] = *(const LAS bf16x8*)(VT + (16 * wave + fr) * GP + 32 * ks + 8 * fq);
#pragma unroll
        for (int m = 0; m < 4; ++m) { const f32x4 d = *(const LAS f32x4*)(DECS + 16 * m + 4 * fq); S[m] = S[m] * d;
#pragma unroll
            for (int ks = 0; ks < 2; ++ks) S[m] = mfma16(*(const LAS bf16x8*)(KE + (16 * m + fr) * GP + 32 * ks + 8 * fq), bv[ks], S[m]); }
        __syncthreads();
    }
}
__device__ __forceinline__ void ffn_act_item(int idx, const bf16* HUP, bf16* ACT, const float* cw, const float* cb) {
    const int cgp = idx % 352, rb = idx / 352, pn = cgp >> 4, c8 = (cgp & 15) * 8, j0 = 128 * pn + c8, r0 = rb * 16;
    float wg[3][8], wv[3][8], bg[8], bv[8];
#pragma unroll
    for (int e = 0; e < 8; ++e) { bg[e] = cb[j0 + e]; bv[e] = cb[DFF + j0 + e];
#pragma unroll
        for (int k = 0; k < 3; ++k) { wg[k][e] = cw[k * DFF2 + j0 + e]; wv[k][e] = cw[k * DFF2 + DFF + j0 + e]; } }
    float g2[8], g1[8], v2[8], v1[8];
    auto ld = [&](int row, float (&g)[8], float (&v)[8]) { const bf16* p = HUP + (size_t)row * DFF2 + 256 * pn + c8; const v4u a = *(const v4u*)p, b = *(const v4u*)(p + 128);
#pragma unroll
        for (int e = 0; e < 4; ++e) { g[2 * e] = bf2f(a[e] & 0xffffu); g[2 * e + 1] = bf2f(a[e] >> 16); v[2 * e] = bf2f(b[e] & 0xffffu); v[2 * e + 1] = bf2f(b[e] >> 16); } };
    if ((r0 & (SEQ - 1)) == 0) {
#pragma unroll
        for (int e = 0; e < 8; ++e) { g2[e] = 0.f; g1[e] = 0.f; v2[e] = 0.f; v1[e] = 0.f; } }
    else { ld(r0 - 2, g2, v2); ld(r0 - 1, g1, v1); }
    for (int i = 0; i < 16; ++i) { float g0[8], v0[8]; ld(r0 + i, g0, v0); float z[8];
#pragma unroll
        for (int e = 0; e < 8; ++e) { const float ga = wg[0][e] * g2[e] + wg[1][e] * g1[e] + wg[2][e] * g0[e] + bg[e], va = wv[0][e] * v2[e] + wv[1][e] * v1[e] + wv[2][e] * v0[e] + bv[e];
            z[e] = fsilu(ga) * va; g2[e] = g1[e]; g1[e] = g0[e]; v2[e] = v1[e]; v1[e] = v0[e]; }
        v4u o; o.x = pk2(z[0], z[1]); o.y = pk2(z[2], z[3]); o.z = pk2(z[4], z[5]); o.w = pk2(z[6], z[7]); *(v4u*)(ACT + (size_t)(r0 + i) * DFF + j0) = o; }
}

using pg8::Unit;
__device__ __forceinline__ void row_rstd(const float* SSQ, int pm, int wr, int fr, int fq, float (&rsd)[2][4]) {
    const int lane = fr + 16 * fq;
#pragma unroll
    for (int ai = 0; ai < 2; ++ai) { const size_t row = (size_t)pm * 256 + ai * 128 + wr * 64 + lane; const f32x4* p = (const f32x4*)(SSQ + row * 16); const f32x4 a = p[0], b = p[1], c = p[2], d = p[3];
        const float s = ((a[0] + a[1]) + (a[2] + a[3])) + ((b[0] + b[1]) + (b[2] + b[3])) + ((c[0] + c[1]) + (c[2] + c[3])) + ((d[0] + d[1]) + (d[2] + d[3]));
        const float rs = rsqrtf(s * (1.f / D) + EPS);
#pragma unroll
        for (int m = 0; m < 4; ++m) rsd[ai][m] = __shfl(rs, 16 * m + fr); }
}
struct EpiA {
    static constexpr bool PERM = true, AFTER_DRAIN = false;
    unsigned char* act0; const float* SSQ; float* SVST; const float* bal;
    __device__ __forceinline__ void operator()(const f32x4 (&acc)[2][2][4][2], const Unit& u, int wr, int wc, int fr_, int fq_) const {
        int fr = fr_, fq = fq_; asm volatile("" : "+v"(fr), "+v"(fq));
        float rsd[2][4]; row_rstd(SSQ, u.pm, wr, fr, fq, rsd);
        const int pn = u.pn; int mode, ldc, colt; size_t boff;
        if (pn < 1) { mode = 0; boff = A_Q; ldc = 256; colt = 0; } else if (pn < 2) { mode = 0; boff = A_K; ldc = 256; colt = 0; } else if (pn < 4) { mode = 0; boff = A_V; ldc = 512; colt = (pn - 2) * 256; }
        else if (pn < 6) { mode = 1; boff = A_Z; ldc = 512; colt = (pn - 4) * 256; } else if (pn < 7) { mode = 4; boff = A_LOGA; ldc = 256; colt = 0; }
        else if (pn < 9) { mode = 2; boff = A_Z + (size_t)M * 512 * 2; ldc = 512; colt = (pn - 7) * 256; } else if (pn < 11) { mode = 3; boff = A_SV; ldc = 512; colt = (pn - 9) * 256; }
        else if (pn < 13) { mode = 0; boff = A_Z + (size_t)2 * M * 512 * 2; ldc = 512; colt = (pn - 11) * 256; } else if (pn < 15) { mode = 0; boff = A_CC; ldc = 512; colt = (pn - 13) * 256; }
        else if (pn < 17) { mode = 0; boff = A_CX; ldc = 512; colt = (pn - 15) * 256; } else { mode = 5; boff = A_G; ldc = 3072; colt = (pn - 17) * 256; }
        const int col0 = colt + wc * 32 + 8 * fq;
#pragma unroll
        for (int ai = 0; ai < 2; ++ai)
#pragma unroll
            for (int m = 0; m < 4; ++m) { const size_t row = (size_t)u.pm * 256 + ai * 128 + wr * 64 + m * 16 + fr; const float rs = rsd[ai][m]; float s1 = 0.f, s2 = 0.f;
#pragma unroll
                for (int bj = 0; bj < 2; ++bj) { const f32x4 a0 = acc[ai][bj][m][0] * rs, a1 = acc[ai][bj][m][1] * rs; float v[8] = {a0[0], a0[1], a0[2], a0[3], a1[0], a1[1], a1[2], a1[3]};
                    if (mode == 4) { const f32x4 b0 = *(const f32x4*)(bal + col0 + bj * 128), b1 = *(const f32x4*)(bal + col0 + bj * 128 + 4); f32x4 o0, o1;
#pragma unroll
                        for (int e = 0; e < 4; ++e) { o0[e] = flogsig(v[e] + b0[e]) * 0.0625f; o1[e] = flogsig(v[4 + e] + b1[e]) * 0.0625f; }
                        float* p = (float*)(act0 + boff) + row * 256 + col0 + bj * 128; *(f32x4*)p = o0; *(f32x4*)(p + 4) = o1; }
                    else {
                        if (mode == 1) {
#pragma unroll
                            for (int e = 0; e < 8; ++e) v[e] = fsilu(v[e]); }
                        else if (mode == 2 || mode == 3) {
#pragma unroll
                            for (int e = 0; e < 8; ++e) v[e] = fgelu(v[e]); }
                        else if (mode == 5) {
#pragma unroll
                            for (int e = 0; e < 8; ++e) v[e] = fsigmoid(v[e]); }
                        if (mode == 3) {
#pragma unroll
                            for (int e = 0; e < 8; ++e) { s1 += v[e]; s2 += v[e] * v[e]; } }
                        v4u o; o.x = pk2(v[0], v[1]); o.y = pk2(v[2], v[3]); o.z = pk2(v[4], v[5]); o.w = pk2(v[6], v[7]);
                        *(v4u*)((bf16*)(act0 + boff) + row * ldc + col0 + bj * 128) = o; } }
                if (mode == 3) { s1 += __shfl_xor(s1, 16); s1 += __shfl_xor(s1, 32); s2 += __shfl_xor(s2, 16); s2 += __shfl_xor(s2, 32);
                    if (fq == 0) *(f32x2*)(SVST + row * 16 + ((pn - 9) * 4 + wc) * 2) = (f32x2){s1, s2}; } }
    }
};
struct EpiC {
    static constexpr bool PERM = true, AFTER_DRAIN = false;
    const bf16* G; bf16* MG;
    __device__ __forceinline__ void operator()(const f32x4 (&acc)[2][2][4][2], const Unit& u, int wr, int wc, int fr_, int fq_) const {
        int fr = fr_, fq = fq_; asm volatile("" : "+v"(fr), "+v"(fq));
        const int br = u.pm >> 6, pm = u.pm & 63, pn = u.pn & 3; const int col0 = pn * 256 + wc * 32 + 8 * fq;
#pragma unroll
        for (int ai = 0; ai < 2; ++ai)
#pragma unroll
            for (int m = 0; m < 4; ++m) { const size_t row = (size_t)pm * 256 + ai * 128 + wr * 64 + m * 16 + fr;
#pragma unroll
                for (int bj = 0; bj < 2; ++bj) { const f32x4 a0 = acc[ai][bj][m][0], a1 = acc[ai][bj][m][1]; float v[8] = {a0[0], a0[1], a0[2], a0[3], a1[0], a1[1], a1[2], a1[3]};
                    const v4u gt = *(const v4u*)(G + row * 3072 + br * 1024 + col0 + bj * 128); bf16* mp = MG + row * 1024 + col0 + bj * 128;
#pragma unroll
                    for (int e = 0; e < 4; ++e) { v[2 * e] *= bf2f(gt[e] & 0xffffu); v[2 * e + 1] *= bf2f(gt[e] >> 16); }
                    if (br != 0) { const v4u old = *(const v4u*)mp;
#pragma unroll
                        for (int e = 0; e < 4; ++e) { v[2 * e] += bf2f(old[e] & 0xffffu); v[2 * e + 1] += bf2f(old[e] >> 16); } }
                    v4u o; o.x = pk2(v[0], v[1]); o.y = pk2(v[2], v[3]); o.z = pk2(v[4], v[5]); o.w = pk2(v[6], v[7]); *(v4u*)mp = o; } }
    }
};
struct BranchOrder {
    int G, c;
    __device__ bool next(int i, Unit& u) const { const int j = i / 3, br = i - 3 * j, T = c + G * j; if (T >= 256) return false;
        const int w = (T & 7) * 32 + (T >> 3), pm = (w >> 5) * 8 + (w & 7), pn = (w & 31) >> 3; u.pm = br * 64 + pm; u.pn = br * 4 + pn; return true; }
    __device__ __forceinline__ void a_ready(const Unit&) const {}
    __device__ __forceinline__ void done(const Unit&) const {}
};
struct EpiRes {
    static constexpr bool PERM = false, AFTER_DRAIN = false;
    float* X; bf16* XB; float* SSQ;
    __device__ __forceinline__ void operator()(const f32x4 (&acc)[2][2][4][2], const Unit& u, int wr, int wc, int fr_, int fq_) const {
        int fr = fr_, fq = fq_; asm volatile("" : "+v"(fr), "+v"(fq));
        const int col0 = u.pn * 256 + wc * 32 + 4 * fq;
#pragma unroll
        for (int ai = 0; ai < 2; ++ai)
#pragma unroll
            for (int m = 0; m < 4; ++m) { const size_t row = (size_t)u.pm * 256 + ai * 128 + wr * 64 + m * 16 + fr; float ss = 0.f;
#pragma unroll
                for (int bj = 0; bj < 2; ++bj)
#pragma unroll
                    for (int n = 0; n < 2; ++n) { const size_t off = row * D + col0 + bj * 128 + n * 16; const f32x4 xn = *(const f32x4*)(X + off) + acc[ai][bj][m][n]; *(f32x4*)(X + off) = xn;
                        v2u w; w.x = pk2(xn[0], xn[1]); w.y = pk2(xn[2], xn[3]); *(v2u*)(XB + off) = w; ss += (xn[0] * xn[0] + xn[1] * xn[1]) + (xn[2] * xn[2] + xn[3] * xn[3]); }
                ss += __shfl_xor(ss, 16); ss += __shfl_xor(ss, 32);
                if (fq == 0) SSQ[row * 16 + u.pn * 4 + wc] = ss; }
    }
};
struct EpiUp {
    static constexpr bool PERM = true, AFTER_DRAIN = false;
    bf16* HUP; const float* SSQ;
    __device__ __forceinline__ void operator()(const f32x4 (&acc)[2][2][4][2], const Unit& u, int wr, int wc, int fr_, int fq_) const {
        int fr = fr_, fq = fq_; asm volatile("" : "+v"(fr), "+v"(fq));
        float rsd[2][4]; row_rstd(SSQ, u.pm, wr, fr, fq, rsd);
        const int col0 = u.pn * 256 + wc * 32 + 8 * fq;
#pragma unroll
        for (int ai = 0; ai < 2; ++ai)
#pragma unroll
            for (int m = 0; m < 4; ++m) { const size_t row = (size_t)u.pm * 256 + ai * 128 + wr * 64 + m * 16 + fr; const float rs = rsd[ai][m];
#pragma unroll
                for (int bj = 0; bj < 2; ++bj) { const f32x4 a0 = acc[ai][bj][m][0] * rs, a1 = acc[ai][bj][m][1] * rs;
                    v4u o; o.x = pk2(a0[0], a0[1]); o.y = pk2(a0[2], a0[3]); o.z = pk2(a1[0], a1[1]); o.w = pk2(a1[2], a1[3]); *(v4u*)(HUP + row * DFF2 + col0 + bj * 128) = o; } }
    }
};

#define XB_TMO      128
#define XB_XCNT(j)  (256  + 64 * (j))
#define XB_XSUB(j)  (1280 + 64 * (j))
#define XB_XGEN(j)  (2304 + 64 * (j))
#define XB_TOP      3328
#define XB_TOPGEN   3392
#define XCD_BAR_WORDS 3456
#define XB_SPIN_CAP (1u << 18)

__device__ __forceinline__ unsigned xb_ld(unsigned* p)              { return __hip_atomic_load(p, __ATOMIC_RELAXED, __HIP_MEMORY_SCOPE_AGENT); }
__device__ __forceinline__ unsigned xb_add(unsigned* p, unsigned v) { return __hip_atomic_fetch_add(p, v, __ATOMIC_RELAXED, __HIP_MEMORY_SCOPE_AGENT); }
__device__ __forceinline__ unsigned xb_xcc_id() { return (unsigned)__builtin_amdgcn_s_getreg((3 << 11) | 20) & 0xFu; }
#define XB_SPIN(cond, bar) do { unsigned _sp = 0; while (cond) { __builtin_amdgcn_s_sleep(1); \
    if ((++_sp & 255u) == 0u) { if (xb_ld(&(bar)[XB_TMO])) break; if (_sp > XB_SPIN_CAP) { atomicAdd(&(bar)[XB_TMO], 1u); break; } } } } while (0)

struct XcdBarrier {
    unsigned* bar; unsigned x;
    volatile LAS unsigned* st;
};

__device__ __forceinline__ XcdBarrier xcd_barrier_post(unsigned* bar, volatile LAS unsigned* st) {
    XcdBarrier b; b.bar = bar; b.x = xb_xcc_id(); b.st = st;
    if (threadIdx.x == 0) (void)xb_add(&bar[XB_XCNT(b.x)], 1u);
    return b;
}
__device__ __forceinline__ void xcd_barrier_complete(unsigned* bar, unsigned x, unsigned& nloc, unsigned& nx) {
    const unsigned G = gridDim.x * gridDim.y * gridDim.z;
    unsigned sum, cnt, mine, sp = 0u;
    for (;;) {
        sum = 0u; cnt = 0u; mine = 0u;
#pragma unroll
        for (unsigned j = 0; j < 16; ++j) { const unsigned c = xb_ld(&bar[XB_XCNT(j)]); sum += c; cnt += (c > 0u) ? 1u : 0u; mine = (j == x) ? c : mine; }
        if (sum == G) break;
        __builtin_amdgcn_s_sleep(1);
        if ((++sp & 255u) == 0u) { if (xb_ld(&bar[XB_TMO])) break; if (sp > XB_SPIN_CAP) { atomicAdd(&bar[XB_TMO], 1u); break; } }
    }
    nloc = mine > 0u ? mine : 1u; nx = cnt > 0u ? cnt : 1u;
}

__device__ __forceinline__ void xcd_barrier(const XcdBarrier& b) {
    asm volatile("s_waitcnt vmcnt(0)" ::: "memory");
    __syncthreads();
    if (threadIdx.x == 0) {
        unsigned* bar = b.bar;
        __builtin_amdgcn_s_waitcnt(0);
        unsigned nloc = b.st[0], nx = b.st[1];
        if (nloc == 0u) { xcd_barrier_complete(bar, b.x, nloc, nx); b.st[0] = nloc; b.st[1] = nx; }
        const unsigned old = xb_add(&bar[XB_XSUB(b.x)], 1u);
        const unsigned gen = old / nloc;
        if (old + 1u == (gen + 1u) * nloc) {
            __builtin_amdgcn_fence(__ATOMIC_RELEASE, "agent");
            asm volatile("s_waitcnt vmcnt(0)" ::: "memory");
            const unsigned og = xb_add(&bar[XB_TOP], 1u);
            const unsigned tg = og / nx;
            if (og + 1u == (tg + 1u) * nx) xb_add(&bar[XB_TOPGEN], 1u);
            else XB_SPIN(xb_ld(&bar[XB_TOPGEN]) == tg, bar);
            __builtin_amdgcn_fence(__ATOMIC_ACQUIRE, "agent");
            xb_add(&bar[XB_XGEN(b.x)], 1u);
            asm volatile("s_waitcnt vmcnt(0)" ::: "memory");
        } else {
            XB_SPIN(xb_ld(&bar[XB_XGEN(b.x)]) == gen, bar);
            __builtin_amdgcn_fence(__ATOMIC_ACQUIRE, "agent");
            asm volatile("s_waitcnt vmcnt(0)" ::: "memory");
        }
    }
    __syncthreads();
}

struct Args { Inputs in; float* out; unsigned char* ws; int ph_lo, ph_hi; };
constexpr int NPHASE = 2 + 8 * DEPTH;
#define LAUNDER_S(p) asm volatile("" : "+s"(p))
#define LAUNDER_V(p) asm volatile("" : "+v"(p))
struct Ctx { unsigned char* ws; unsigned char* act0; float* X; int tid, lane, wave, G, bx, gw, ngw; };
__device__ __forceinline__ Ctx make_ctx(const Args& a) {
    Ctx c; size_t z = 0; LAUNDER_S(z); c.ws = a.ws + z; c.X = (float*)((unsigned char*)a.out + z); c.act0 = c.ws + WS_ACT0;
    int t = threadIdx.x; LAUNDER_V(t); c.tid = t; c.lane = t & 63; c.wave = __builtin_amdgcn_readfirstlane(t >> 6);
    c.G = gridDim.x; c.bx = blockIdx.x; c.gw = c.bx * NWAVES + c.wave; c.ngw = c.G * NWAVES; return c;
}
__device__ __forceinline__ unsigned char* slot_of(const Ctx& c, int l) { return c.ws + WS_SLOT0 + (size_t)(l & 1) * SL_BYTES; }
__device__ __forceinline__ void ph_p0(const Args& a, LAS unsigned char* lds) { const Ctx c = make_ctx(a);
    convert_layer(a.in, 0, c.ws + WS_SLOT0, lds, c.gw, c.ngw, c.wave, c.lane); x_prep(a.in.p[0], c.X, (bf16*)(c.ws + WS_XB), (float*)(c.ws + WS_SSQ), c.gw, c.ngw, c.lane); }
__device__ __forceinline__ void ph_a(const Args& a, int l, LAS unsigned char* lds) { const Ctx c = make_ctx(a);
    pg8::Gemm g{(const bf16*)(c.ws + WS_XB), (const bf16*)(slot_of(c, l) + SL_WIN), M, NIN, D}; pg8::StaticOrder S; S.init(M, NIN, c.G, c.bx);
    EpiA E{c.act0, (const float*)(c.ws + WS_SSQ), (float*)(c.ws + WS_SVST), a.in.p[4] + (size_t)l * GKEY};
    pg8::gemm_phase<EpiA, pg8::StaticOrder, true, true>(lds, g, S, E); }
__device__ __forceinline__ void ph_b1(const Args& a, int l, LAS unsigned char* lds) { const Ctx c = make_ctx(a); const Inputs& I = a.in;
    bf16* Zb = (bf16*)(c.act0 + A_Z);
    for (int it = c.bx; it < 1024; it += c.G) gla_b1_item(it, lds, (const bf16*)(c.act0 + A_K), (const bf16*)(c.act0 + A_V), (const float*)(c.act0 + A_LOGA), (float*)(c.act0 + A_CST), (float*)(c.act0 + A_DEC), c.tid, c.wave, c.lane);
    for (int it = c.bx; it < 512; it += c.G) sgu_item(it, lds, Zb + (size_t)M * 512, (const bf16*)(c.act0 + A_SV), (const float*)(c.ws + WS_SVST), I.p[7] + (size_t)l * SGW, I.p[8] + (size_t)l * SGW, (const bf16*)(slot_of(c, l) + SL_SGW), I.p[10] + (size_t)l * 512, c.wave, c.lane);
    for (int it = c.bx * NTHREADS + c.tid; it < 131072; it += c.G * NTHREADS) convbr_item(it, Zb + (size_t)2 * M * 512, (const bf16*)(c.act0 + A_CC), (const bf16*)(c.act0 + A_CX), I.p[12] + (size_t)l * 3 * CW);
    if (l + 1 < DEPTH) convert_layer(I, l + 1, slot_of(c, l + 1), lds, c.gw, c.ngw, c.wave, c.lane); }
__device__ __forceinline__ void ph_b2(const Args& a, int l, LAS unsigned char* lds) { const Ctx c = make_ctx(a);
    for (int it = c.bx; it < 256; it += c.G) gla_b2_unit(it, lds, (const bf16*)(c.act0 + A_Q), (const bf16*)(c.act0 + A_K), (const bf16*)(c.act0 + A_V), (const float*)(c.act0 + A_LOGA), (const float*)(c.act0 + A_CST), (const float*)(c.act0 + A_DEC), (bf16*)(c.act0 + A_Z), c.tid, c.wave, c.lane); }
__device__ __forceinline__ void ph_c(const Args& a, int l, LAS unsigned char* lds) { const Ctx c = make_ctx(a);
    pg8::Gemm g{(const bf16*)(c.act0 + A_Z), (const bf16*)(slot_of(c, l) + SL_WBR), 3 * M, 3 * D, 512}; BranchOrder S{c.G, c.bx}; EpiC E{(const bf16*)(c.act0 + A_G), (bf16*)(c.act0 + A_MERGED)};
    pg8::gemm_phase<EpiC, BranchOrder, true, true>(lds, g, S, E); }
__device__ __forceinline__ void ph_res(const Args& a, const bf16* A, const bf16* Bt, int K, LAS unsigned char* lds) { const Ctx c = make_ctx(a);
    pg8::Gemm g{A, Bt, M, D, K}; pg8::StaticOrder S; S.init(M, D, c.G, c.bx); EpiRes E{c.X, (bf16*)(c.ws + WS_XB), (float*)(c.ws + WS_SSQ)};
    pg8::gemm_phase<EpiRes, pg8::StaticOrder, true, true>(lds, g, S, E); }
__device__ __forceinline__ void ph_e(const Args& a, int l, LAS unsigned char* lds) { const Ctx c = make_ctx(a);
    pg8::Gemm g{(const bf16*)(c.ws + WS_XB), (const bf16*)(slot_of(c, l) + SL_WUP), M, DFF2, D}; pg8::StaticOrder S; S.init(M, DFF2, c.G, c.bx); EpiUp E{(bf16*)(c.act0 + A_HUP), (const float*)(c.ws + WS_SSQ)};
    pg8::gemm_phase<EpiUp, pg8::StaticOrder, true, true>(lds, g, S, E); }
__device__ __forceinline__ void ph_e2(const Args& a, int l) { const Ctx c = make_ctx(a);
    for (int it = c.bx * NTHREADS + c.tid; it < 1024 * 352; it += c.G * NTHREADS) ffn_act_item(it, (const bf16*)(c.act0 + A_HUP), (bf16*)(c.act0 + A_ACT), a.in.p[17] + (size_t)l * 3 * DFF2, a.in.p[18] + (size_t)l * DFF2); }
__device__ __forceinline__ void ph_fin(const Args& a) { const Ctx c = make_ctx(a); final_norm(c.X, (const float*)(c.ws + WS_SSQ), a.in.p[20], c.gw, c.ngw, c.lane); }

#ifndef PHMASK
#define PHMASK 0xFFFF
#endif
#define EN(b) ((PHMASK >> (b)) & 1)
__global__ void __launch_bounds__(NTHREADS, 2) mk_fwd(Args args) {
    extern __shared__ __attribute__((aligned(16))) unsigned char lds_raw[];
    LAS unsigned char* lds = (LAS unsigned char*)lds_raw;
    const int lo = args.ph_lo, hi = args.ph_hi;
#define IN(k) (lo <= (k) && (k) < hi)
#if MK_ONE_LAUNCH
    volatile LAS unsigned* bst = (volatile LAS unsigned*)(lds + RING_BYTES + 512);
    if (threadIdx.x < 2) bst[threadIdx.x] = 0u;
    __syncthreads();
    const XcdBarrier bar = xcd_barrier_post((unsigned*)(args.ws + WS_CTL) + 1024, bst);
#define SEAM(k) do { if (IN(k) && IN((k) + 1)) { if ((k) == 0) cg::this_grid().sync(); else xcd_barrier(bar); } } while (0)
#else
#define SEAM(k) do { } while (0)
#endif
    int ph = 0;
    if (EN(0) && IN(ph)) ph_p0(args, lds);
    SEAM(ph); ++ph;
    for (int l = 0; l < DEPTH; ++l) {
        if (EN(1) && IN(ph)) ph_a(args, l, lds);
        SEAM(ph); ++ph;
        if (EN(2) && IN(ph)) ph_b1(args, l, lds);
        SEAM(ph); ++ph;
        if (EN(3) && IN(ph)) ph_b2(args, l, lds);
        SEAM(ph); ++ph;
        if (EN(4) && IN(ph)) ph_c(args, l, lds);
        SEAM(ph); ++ph;
        if (EN(5) && IN(ph)) { size_t z = 0; LAUNDER_S(z); unsigned char* ws = args.ws + z; ph_res(args, (const bf16*)(ws + WS_ACT0 + A_MERGED), (const bf16*)(ws + WS_SLOT0 + (size_t)(l & 1) * SL_BYTES + SL_WO), D, lds); }
        SEAM(ph); ++ph;
        if (EN(6) && IN(ph)) ph_e(args, l, lds);
        SEAM(ph); ++ph;
        if (EN(7) && IN(ph)) ph_e2(args, l);
        SEAM(ph); ++ph;
        if (EN(8) && IN(ph)) { size_t z = 0; LAUNDER_S(z); unsigned char* ws = args.ws + z; ph_res(args, (const bf16*)(ws + WS_ACT0 + A_ACT), (const bf16*)(ws + WS_SLOT0 + (size_t)(l & 1) * SL_BYTES + SL_WDN), DFF, lds); }
        SEAM(ph); ++ph;
    }
    if (EN(9) && IN(ph)) ph_fin(args);
#undef IN
#undef SEAM
}

extern "C" void kernel_launch(void* const* d_in, const int* in_sizes, int n_in, void* d_out, int out_size, void* d_ws, size_t ws_size, hipStream_t stream) {
    static int grid = 0;
    if (grid == 0) {
        if (n_in != 21 || out_size != M * D || ws_size < WS_END) { fprintf(stderr, "kernel_launch: unexpected shapes / workspace (%zu < %zu)\n", ws_size, (size_t)WS_END); grid = -1; return; }
        int dev = 0, cus = 0, per_cu = 0;
        if (hipGetDevice(&dev) != hipSuccess || hipDeviceGetAttribute(&cus, hipDeviceAttributeMultiprocessorCount, dev) != hipSuccess) { grid = -1; return; }
        if (hipFuncSetAttribute((const void*)mk_fwd, hipFuncAttributeMaxDynamicSharedMemorySize, LDS_BYTES) != hipSuccess) { fprintf(stderr, "kernel_launch: hipFuncSetAttribute failed\n"); grid = -1; return; }
        if (hipOccupancyMaxActiveBlocksPerMultiprocessor(&per_cu, (const void*)mk_fwd, NTHREADS, LDS_BYTES) != hipSuccess || per_cu < 1) { fprintf(stderr, "kernel_launch: occupancy query says %d\n", per_cu); per_cu = 1; }
        (void)hipGetLastError();
        grid = cus * 1;
    }
    if (grid < 0) return;
#if MK_ONE_LAUNCH
    if (hipMemsetAsync((char*)d_ws + WS_CTL, 0, 65536, stream) != hipSuccess) { fprintf(stderr, "kernel_launch: memset failed\n"); return; }
#endif
    Args a{};
    for (int i = 0; i < 21; ++i) a.in.p[i] = (const float*)d_in[i];
    a.out = (float*)d_out; a.ws = (unsigned char*)d_ws;
#if MK_ONE_LAUNCH
    a.ph_lo = 0; a.ph_hi = NPHASE;
    void* kargs[] = {&a};
    hipError_t e = hipLaunchCooperativeKernel((const void*)mk_fwd, dim3(grid), dim3(NTHREADS), kargs, LDS_BYTES, stream);
    if (e != hipSuccess) fprintf(stderr, "kernel_launch: cooperative launch failed: %s (grid %d)\n", hipGetErrorString(e), grid);
#else
    for (int p = 0; p < NPHASE; ++p) { a.ph_lo = p; a.ph_hi = p + 1; hipLaunchKernelGGL(mk_fwd, dim3(grid), dim3(NTHREADS), LDS_BYTES, stream, a); }
#endif
}
```

```cpp
#include <hip/hip_runtime.h>
#include <hip/hip_cooperative_groups.h>
#include <cstdio>
#include <cstdint>
#include <cmath>
namespace cg = cooperative_groups;

#ifndef MK_ONE_LAUNCH
#define MK_ONE_LAUNCH 1
#endif

namespace cfg {
constexpr int D = 1024, BATCH = 8, SEQ = 2048, DEPTH = 4, M = BATCH * SEQ;
constexpr int GH = 4, GDK = 64, GDV = 128, GKEY = 256, GVAL = 512, GRANK = 16;
constexpr int SGW = 512, SGC = 128, CW = 512, DFF = 2816, DFF2 = 5632;
constexpr int INC = 7184, NIN = 7424;
constexpr int O_Q = 0, O_K = 256, O_V = 512, O_G = 1024, O_A = 1536, O_SU = 1552, O_SV = 2064, O_CB = 2576, O_CC = 3088, O_CX = 3600, O_GT = 4112;
constexpr float EPS = 1e-6f;
}
using namespace cfg;

namespace pg8 {
#define PG8_LAS __attribute__((address_space(3)))
typedef unsigned short bf16_t;
typedef short bf16x8 __attribute__((ext_vector_type(8)));
typedef float f32x4 __attribute__((ext_vector_type(4)));
typedef unsigned u32x4 __attribute__((ext_vector_type(4)));
constexpr int BM = 256, BK = 64, HALF = 128, HTB = HALF * BK * 2  , STAGE_BYTES = 8 * HTB, NXCD = 8, WGM = 8;

__host__ __device__ __forceinline__ int lds_byte(int r, int c) { const int st = (r >> 4) * 2 + (c >> 5), rr = r & 15, cc = c & 31, ob = rr * 64 + cc * 2; return st * 1024 + (ob ^ (((ob >> 9) & 1) << 5)); }
__host__ __device__ __forceinline__ void stage_rc(int b, int& R, int& C) { const int st = b / 1024, sb = b % 1024, swz = sb ^ (((sb >> 9) & 1) << 5); R = (st >> 1) * 16 + swz / 64; C = (st & 1) * 32 + (swz % 64) / 2; }
__host__ __device__ __forceinline__ int perm32(int rho) { const int n = rho >> 4, i = rho & 15; return 8 * (i >> 2) + 4 * n + (i & 3); }

struct Unit { int pm, pn; };
struct Gemm { const bf16_t* A; const bf16_t* Bt; int M, N, K; };

struct StaticOrder {
    int nM, nN, nwg, G, c;
    __host__ __device__ void init(int M, int N, int G_, int c_) { nM = M / BM; nN = N / BM; nwg = nM * nN; G = G_; c = c_; }
    __host__ __device__ bool next(int i, Unit& u) const {
        const long L = (long)i * G + c; if (L >= nwg) return false;
        int wgid = (int)L; { const int q = nwg / NXCD, r = nwg % NXCD, xcd = wgid % NXCD, off = wgid / NXCD; wgid = (xcd < r ? xcd * (q + 1) : r * (q + 1) + (xcd - r) * q) + off; }
        const int nig = WGM * nN, gid = wgid / nig, fm = gid * WGM, gsz = (nM - fm) < WGM ? (nM - fm) : WGM;
        u.pm = fm + ((wgid % nig) % gsz); u.pn = (wgid % nig) / gsz; return true;
    }
    __device__ __forceinline__ void a_ready(const Unit&) const {}
    __device__ __forceinline__ void done(const Unit&) const {}
};

__device__ __forceinline__ unsigned cvt_pk_bf16(float lo, float hi) { unsigned r; asm volatile("v_cvt_pk_bf16_f32 %0, %1, %2" : "=v"(r) : "v"(lo), "v"(hi)); return r; }
typedef float f32x2 __attribute__((ext_vector_type(2)));
template <class Epi, class Sched, bool ALIGN_EPI = false, bool SP2 = false>
__device__ __forceinline__ void gemm_phase(PG8_LAS unsigned char* lds, const Gemm g, const Sched& S, const Epi& E) {
    int tid_ = threadIdx.x; asm volatile("" : "+v"(tid_));
    const int tid = tid_, wid = __builtin_amdgcn_readfirstlane(tid >> 6), lane = tid & 63, wr = wid >> 2, wc = wid & 3, fr = lane & 15, fq = lane >> 4;
    const int K = g.K, nt = K / BK;
    unsigned voffA[2], voffB[2];
#pragma unroll
    for (int i = 0; i < 2; ++i) { int R, C; stage_rc(tid * 16 + i * 8192, R, C); const int Rb = Epi::PERM ? ((R & ~31) + perm32(R & 31)) : R;
        voffA[i] = (unsigned)(R * K + C) * 2u; voffB[i] = (unsigned)(Rb * K + C) * 2u; }
    const size_t kstep = (size_t)(BK * 2);
    const size_t hstep = (size_t)HALF * K * 2;
    const size_t tstep = 2 * hstep;
    const unsigned ldsw = (unsigned)wid * 1024u;
    const int aoff = lds_byte(wr * 64 + fr, fq * 8), boff = lds_byte(wc * 32 + fr, fq * 8);
#define PG8_SA(b, h) (((b) * 2 + (h)) * HTB)
#define PG8_SB(b, h) ((4 + (b) * 2 + (h)) * HTB)
#define PG8_STAGE(bufoff, gbase, voff) do { _Pragma("unroll") for (int _i = 0; _i < 2; ++_i) \
        __builtin_amdgcn_global_load_lds((const unsigned*)((const char*)(gbase) + (voff)[_i]), (PG8_LAS unsigned*)(lds + (bufoff) + ldsw + _i * 8192), 16, 0, 0); } while (0)
#define PG8_LDA(dst, b, h) do { _Pragma("unroll") for (int m = 0; m < 4; ++m) _Pragma("unroll") for (int k = 0; k < 2; ++k) dst[m][k] = *(const PG8_LAS bf16x8*)(lds + PG8_SA(b, h) + aoff + m * 2048 + k * 1024); } while (0)
#define PG8_LDB(dst, b, h) do { _Pragma("unroll") for (int n = 0; n < 2; ++n) _Pragma("unroll") for (int k = 0; k < 2; ++k) dst[n][k] = *(const PG8_LAS bf16x8*)(lds + PG8_SB(b, h) + boff + n * 2048 + k * 1024); } while (0)
#define PG8_MMA(ai, bj, At, Bt) do { __builtin_amdgcn_s_setprio(1); _Pragma("unroll") for (int m = 0; m < 4; ++m) _Pragma("unroll") for (int n = 0; n < 2; ++n) _Pragma("unroll") for (int k = 0; k < 2; ++k) \
        acc[ai][bj][m][n] = __builtin_amdgcn_mfma_f32_16x16x32_bf16(Bt[n][k], At[m][k], acc[ai][bj][m][n], 0, 0, 0); __builtin_amdgcn_s_setprio(0); } while (0)
#define PG8_WAIT_V(n) asm volatile("s_waitcnt vmcnt(" #n ")" ::: "memory")
#define PG8_WAIT_L(n) asm volatile("s_waitcnt lgkmcnt(" #n ")" ::: "memory")
#define PG8_BAR __builtin_amdgcn_s_barrier()
#define PG8_SCHED __builtin_amdgcn_sched_barrier(0)
    Unit cur, nxt; int ui = 0;
    if (!S.next(0, cur)) return;
    f32x4 acc[2][2][4][2];
#pragma unroll
    for (int a = 0; a < 2; ++a)
#pragma unroll
        for (int b = 0; b < 2; ++b)
#pragma unroll
            for (int m = 0; m < 4; ++m)
#pragma unroll
                for (int n = 0; n < 2; ++n) acc[a][b][m][n] = (f32x4){0.f, 0.f, 0.f, 0.f};
    bf16x8 At[4][2], B0[2][2], B1[2][2];
    const char* cA = (const char*)g.A + (size_t)cur.pm * tstep; const char* cB = (const char*)g.Bt + (size_t)cur.pn * tstep;
    S.a_ready(cur);
    if constexpr (SP2) {
        PG8_STAGE(PG8_SB(0, 0), cB, voffB); PG8_STAGE(PG8_SB(0, 1), cB + hstep, voffB); PG8_STAGE(PG8_SA(0, 0), cA, voffA); PG8_STAGE(PG8_SA(0, 1), cA + hstep, voffA);
        if (wr == 1) PG8_BAR;
        PG8_WAIT_V(2); PG8_BAR;
        PG8_STAGE(PG8_SB(1, 0), cB + kstep, voffB); PG8_STAGE(PG8_SA(1, 0), cA + kstep, voffA); PG8_STAGE(PG8_SB(1, 1), cB + hstep + kstep, voffB);
        PG8_WAIT_V(6); PG8_BAR;
    } else {
        PG8_STAGE(PG8_SB(0, 0), cB, voffB); PG8_STAGE(PG8_SA(0, 0), cA, voffA); PG8_STAGE(PG8_SB(0, 1), cB + hstep, voffB); PG8_STAGE(PG8_SA(0, 1), cA + hstep, voffA);
        if (wr == 1) PG8_BAR;
        PG8_WAIT_V(4); PG8_BAR;
        PG8_STAGE(PG8_SB(1, 0), cB + kstep, voffB); PG8_STAGE(PG8_SA(1, 0), cA + kstep, voffA); PG8_STAGE(PG8_SB(1, 1), cB + hstep + kstep, voffB);
        PG8_WAIT_V(6); PG8_BAR;
    }
    for (;;) {
        const bool has_next = S.next(ui + 1, nxt);
        const char* nA = has_next ? (const char*)g.A + (size_t)nxt.pm * tstep : cA; const char* nB = has_next ? (const char*)g.Bt + (size_t)nxt.pn * tstep : cB;
        for (int t = 0; t < nt; t += 2) {
            const bool last = (t == nt - 2);
            const char* a1 = cA + (size_t)(t + 1) * kstep;
            const char* a2 = last ? nA : cA + (size_t)(t + 2) * kstep; const char* b2 = last ? nB : cB + (size_t)(t + 2) * kstep;
            const char* a3 = a2 + kstep; const char* b3 = b2 + kstep;
            if (last && has_next) S.a_ready(nxt);
            if constexpr (SP2) {
            PG8_LDB(B0, 0, 0); PG8_LDB(B1, 0, 1); PG8_SCHED; PG8_LDA(At, 0, 0); PG8_STAGE(PG8_SA(1, 1), a1 + hstep, voffA);
            PG8_WAIT_V(8); PG8_WAIT_L(0); PG8_BAR; PG8_MMA(0, 0, At, B0); PG8_MMA(0, 1, At, B1); PG8_BAR; PG8_SCHED;
            PG8_LDA(At, 0, 1); PG8_STAGE(PG8_SB(0, 0), b2, voffB); PG8_STAGE(PG8_SB(0, 1), b2 + hstep, voffB); PG8_STAGE(PG8_SA(0, 0), a2, voffA);
            PG8_WAIT_V(8); PG8_WAIT_L(0); PG8_BAR; PG8_MMA(1, 0, At, B0); PG8_MMA(1, 1, At, B1); PG8_BAR; PG8_SCHED;
            PG8_LDB(B0, 1, 0); PG8_LDB(B1, 1, 1); PG8_SCHED; PG8_LDA(At, 1, 0); PG8_STAGE(PG8_SA(0, 1), a2 + hstep, voffA);
            PG8_WAIT_V(8); PG8_WAIT_L(0); PG8_BAR; PG8_MMA(0, 0, At, B0); PG8_MMA(0, 1, At, B1); PG8_BAR; PG8_SCHED;
            PG8_LDA(At, 1, 1); PG8_STAGE(PG8_SB(1, 0), b3, voffB); PG8_STAGE(PG8_SB(1, 1), b3 + hstep, voffB); PG8_STAGE(PG8_SA(1, 0), a3, voffA);
            PG8_WAIT_V(8); PG8_WAIT_L(0); PG8_BAR; PG8_MMA(1, 0, At, B0); PG8_MMA(1, 1, At, B1); PG8_BAR; PG8_SCHED;
            } else {
            PG8_LDB(B0, 0, 0); PG8_SCHED; PG8_LDA(At, 0, 0); PG8_STAGE(PG8_SA(1, 1), a1 + hstep, voffA);
            PG8_WAIT_L(8); PG8_BAR; PG8_WAIT_L(0); PG8_MMA(0, 0, At, B0); PG8_BAR; PG8_SCHED;
            PG8_LDB(B1, 0, 1); PG8_STAGE(PG8_SB(0, 0), b2, voffB);
            PG8_BAR; PG8_WAIT_L(0); PG8_MMA(0, 1, At, B1); PG8_BAR;
            PG8_LDA(At, 0, 1); PG8_STAGE(PG8_SA(0, 0), a2, voffA);
            PG8_BAR; PG8_WAIT_L(0); PG8_MMA(1, 0, At, B0); PG8_BAR; PG8_SCHED;
            PG8_STAGE(PG8_SB(0, 1), b2 + hstep, voffB);
            PG8_WAIT_V(6); PG8_BAR; PG8_MMA(1, 1, At, B1); PG8_BAR;
            PG8_LDB(B0, 1, 0); PG8_SCHED; PG8_LDA(At, 1, 0); PG8_STAGE(PG8_SA(0, 1), a2 + hstep, voffA);
            PG8_WAIT_L(8); PG8_BAR; PG8_WAIT_L(0); PG8_MMA(0, 0, At, B0); PG8_BAR; PG8_SCHED;
            PG8_LDB(B1, 1, 1); PG8_STAGE(PG8_SB(1, 0), b3, voffB);
            PG8_BAR; PG8_WAIT_L(0); PG8_MMA(0, 1, At, B1); PG8_BAR;
            PG8_LDA(At, 1, 1); PG8_STAGE(PG8_SA(1, 0), a3, voffA);
            PG8_BAR; PG8_WAIT_L(0); PG8_MMA(1, 0, At, B0); PG8_BAR; PG8_SCHED;
            PG8_STAGE(PG8_SB(1, 1), b3 + hstep, voffB);
            PG8_WAIT_V(6); PG8_BAR; PG8_MMA(1, 1, At, B1); PG8_BAR;
            }
        }
        if constexpr (ALIGN_EPI) { if (wr == 0) PG8_BAR; }
        if constexpr (!Epi::AFTER_DRAIN) { E(acc, cur, wr, wc, fr, fq); S.done(cur); }
        if (!has_next) break;
#pragma unroll
        for (int a = 0; a < 2; ++a)
#pragma unroll
            for (int b = 0; b < 2; ++b)
#pragma unroll
                for (int m = 0; m < 4; ++m)
#pragma unroll
                    for (int n = 0; n < 2; ++n) acc[a][b][m][n] = (f32x4){0.f, 0.f, 0.f, 0.f};
        cur = nxt; cA = nA; cB = nB; ++ui;
        if constexpr (ALIGN_EPI) { if (wr == 1) PG8_BAR; }
    }
    PG8_WAIT_V(0);
    if constexpr (!ALIGN_EPI) { if (wr == 0) PG8_BAR; }
    PG8_BAR;
    if constexpr (Epi::AFTER_DRAIN) { E.fused(acc, cur, wr, wc, fr, fq, lds, wid, lane); S.done(cur); }
#undef PG8_SA
#undef PG8_SB
#undef PG8_STAGE
#undef PG8_LDA
#undef PG8_LDB
#undef PG8_MMA
#undef PG8_WAIT_V
#undef PG8_WAIT_L
#undef PG8_BAR
#undef PG8_SCHED
}
}

#define GAS __attribute__((address_space(1)))
#define LAS __attribute__((address_space(3)))
typedef unsigned short bf16;
typedef unsigned v4u __attribute__((ext_vector_type(4)));
typedef unsigned v2u __attribute__((ext_vector_type(2)));
typedef float f32x4 __attribute__((ext_vector_type(4)));
typedef float f32x2 __attribute__((ext_vector_type(2)));
typedef short bf16x8 __attribute__((ext_vector_type(8)));
constexpr int NWAVES = 8, NTHREADS = 512;
constexpr int RING_BYTES = 131072, LDS_BYTES = 147456;

constexpr size_t MiB = 1u << 20;
constexpr size_t SL_WIN = 0, SL_WBR = SL_WIN + (size_t)NIN * D * 2, SL_WO = SL_WBR + (size_t)3 * D * 512 * 2, SL_WUP = SL_WO + (size_t)D * D * 2,
                 SL_WDN = SL_WUP + (size_t)DFF2 * D * 2, SL_SGW = SL_WDN + (size_t)D * DFF * 2, SL_END = SL_SGW + (size_t)4 * 128 * 128 * 2, SL_BYTES = 38 * MiB;
static_assert(SL_END <= SL_BYTES, "weight slot");
constexpr size_t WS_CTL = 0, WS_SLOT0 = 1 * MiB, WS_XB = WS_SLOT0 + 2 * SL_BYTES, WS_SSQ = WS_XB + 32 * MiB, WS_SVST = WS_SSQ + 1 * MiB, WS_ACT0 = WS_SVST + 1 * MiB;
constexpr size_t A_Q = 0, A_K = 8 * MiB, A_V = 16 * MiB, A_Z = 32 * MiB, A_SV = 80 * MiB, A_CC = 96 * MiB, A_CX = 112 * MiB, A_LOGA = 128 * MiB, A_G = 144 * MiB,
                 A_CST = 240 * MiB, A_DEC = 272 * MiB, A_END = 273 * MiB;
constexpr size_t A_MERGED = A_Q, A_HUP = 0, A_ACT = 176 * MiB;
static_assert(A_ACT + (size_t)M * DFF * 2 <= A_END, "overlay");
constexpr size_t WS_END = WS_ACT0 + A_END;
constexpr int CW_BAR = 1024, CW_QHEAD = 6144, CW_FIN = 8192;

__device__ __forceinline__ float bf2f(unsigned h) { return __uint_as_float(h << 16); }
__device__ __forceinline__ unsigned pk2(float lo, float hi) { return pg8::cvt_pk_bf16(lo, hi); }
__device__ __forceinline__ float fsigmoid(float z) { return __builtin_amdgcn_rcpf(1.f + __expf(-z)); }
__device__ __forceinline__ float fsilu(float z) { return z * fsigmoid(z); }
__device__ __forceinline__ float fgelu(float z) { return z * fsigmoid(1.5957691216057308f * (z + 0.044715f * z * z * z)); }
__device__ __forceinline__ float flogsig(float z) { return fminf(z, 0.f) - __logf(1.f + __expf(-fabsf(z))); }
__device__ __forceinline__ float wave_sum(float v) {
#pragma unroll
    for (int o = 1; o < 64; o <<= 1) v += __shfl_xor(v, o);
    return v;
}
#define LDS_WAIT() asm volatile("s_waitcnt lgkmcnt(0)" ::: "memory")
__device__ __forceinline__ f32x4 mfma16(bf16x8 a, bf16x8 b, f32x4 c) { return __builtin_amdgcn_mfma_f32_16x16x32_bf16(a, b, c, 0, 0, 0); }

__device__ __forceinline__ void tr_write(bf16* WT, int K, int k0, LAS float* scr, int lane) {
    LDS_WAIT(); asm volatile("" ::: "memory");
    const int c = lane & 7;
#pragma unroll
    for (int j = 0; j < 4; ++j) { const int n = (lane >> 3) + 8 * j; const LAS float* s = scr + (8 * c) * 33 + n;
        v4u o; o.x = pk2(s[0 * 33], s[1 * 33]); o.y = pk2(s[2 * 33], s[3 * 33]); o.z = pk2(s[4 * 33], s[5 * 33]); o.w = pk2(s[6 * 33], s[7 * 33]);
        *(GAS v4u*)(WT + (size_t)n * K + k0 + 8 * c) = o; }
    LDS_WAIT(); asm volatile("" ::: "memory");
}
__device__ __forceinline__ void tr_item(const float* W, int ldw, int col0, const float* ksc, float sc, bf16* WT, int K, int k0, LAS float* scr, int lane) {
#pragma unroll 8
    for (int i = 0; i < 32; ++i) { const int kk = 2 * i + (lane >> 5); float v = W[(size_t)(k0 + kk) * ldw + col0 + (lane & 31)]; v *= ksc ? ksc[k0 + kk] * sc : sc; scr[kk * 33 + (lane & 31)] = v; }
    tr_write(WT, K, k0, scr, lane);
}
__device__ __forceinline__ void alpha_item(const float* win, const float* wal, const float* g, bf16* WT, int k0, int j0, LAS float* scr, int lane) {
    const int jj = lane & 31, half = lane >> 5; float wa[16];
#pragma unroll
    for (int r = 0; r < 16; ++r) wa[r] = wal[r * GKEY + j0 + jj];
    for (int i = 0; i < 32; ++i) { const int kk = 2 * i + half, k = k0 + kk; const float* wr = win + (size_t)k * INC + O_A; float s = 0.f;
#pragma unroll
        for (int r = 0; r < 16; ++r) s += wr[r] * wa[r];
        scr[kk * 33 + jj] = s * g[k]; }
    tr_write(WT + (size_t)j0 * D, D, k0, scr, lane);
}
struct Inputs { const float* p[21]; };
constexpr int CV_J0 = 16 * 224, CV_J1 = 16 * 8, CV_J2 = 3 * 8 * 32, CV_J3 = 16 * 32, CV_J4 = 16 * 176, CV_J5 = 44 * 32, CV_J6 = 128, CV_ITEMS = CV_J0 + CV_J1 + CV_J2 + CV_J3 + CV_J4 + CV_J5 + CV_J6;
constexpr int CV_WIN_ITEMS = CV_J0 + CV_J1;
__device__ __forceinline__ void convert_item(const Inputs& I, int l, unsigned char* slot, LAS float* scr, int it, int lane) {
    bf16* WIN = (bf16*)(slot + SL_WIN); bf16* WBR = (bf16*)(slot + SL_WBR); bf16* WO = (bf16*)(slot + SL_WO); bf16* WUP = (bf16*)(slot + SL_WUP); bf16* WDN = (bf16*)(slot + SL_WDN); bf16* SGWS = (bf16*)(slot + SL_SGW);
    const float* win = I.p[2] + (size_t)l * D * INC;
        int r = it;
        if (r < CV_J0) { const int kb = r / 224, nb = r % 224; const int drow = nb < 48 ? 32 * nb : 1792 + 32 * (nb - 48), scol = nb < 48 ? 32 * nb : O_SU + 32 * (nb - 48);
            tr_item(win, INC, scol, I.p[1] + (size_t)l * D, drow < 256 ? 0.125f : 1.f, WIN + (size_t)drow * D, D, 64 * kb, scr, lane); return; }
        r -= CV_J0;
        if (r < CV_J1) { const int kb = r / 8, jb = r % 8; alpha_item(win, I.p[3] + (size_t)l * GRANK * GKEY, I.p[1] + (size_t)l * D, WIN + (size_t)1536 * D, 64 * kb, 32 * jb, scr, lane); return; }
        r -= CV_J1;
        if (r < CV_J2) { const int br = r / 256, rr = r % 256, kb = rr / 32, nb = rr % 32;
            const float* W = (br == 0 ? I.p[6] : br == 1 ? I.p[11] : I.p[13]) + (size_t)l * 512 * D;
            tr_item(W, D, 32 * nb, br == 0 ? I.p[5] + (size_t)l * GVAL : nullptr, 1.f, WBR + ((size_t)br * D + 32 * nb) * 512, 512, 64 * kb, scr, lane); return; }
        r -= CV_J2;
        if (r < CV_J3) { const int kb = r / 32, nb = r % 32; tr_item(I.p[14] + (size_t)l * D * D, D, 32 * nb, nullptr, 1.f, WO + (size_t)32 * nb * D, D, 64 * kb, scr, lane); return; }
        r -= CV_J3;
        if (r < CV_J4) { const int kb = r / 176, nb = r % 176, pn = nb / 8, jb = nb % 8; const int scol = jb < 4 ? 128 * pn + 32 * jb : DFF + 128 * pn + 32 * (jb - 4);
            tr_item(I.p[16] + (size_t)l * D * DFF2, DFF2, scol, I.p[15] + (size_t)l * D, 1.f, WUP + (size_t)32 * nb * D, D, 64 * kb, scr, lane); return; }
        r -= CV_J4;
        if (r < CV_J5) { const int kb = r / 32, nb = r % 32; tr_item(I.p[19] + (size_t)l * DFF * D, D, 32 * nb, nullptr, 1.f, WDN + (size_t)32 * nb * DFF, DFF, 64 * kb, scr, lane); return; }
        r -= CV_J5;
        { const int e0 = r * 512 + lane * 8, t = (e0 >> 7) & 127, s0 = e0 & 127; const float* src = I.p[9] + (size_t)l * 4 * 128 * 128 + e0;
          const f32x4 a = *(const f32x4*)src, b = *(const f32x4*)(src + 4); float v[8] = {a[0], a[1], a[2], a[3], b[0], b[1], b[2], b[3]};
#pragma unroll
          for (int e = 0; e < 8; ++e) if (s0 + e > t) v[e] = 0.f;
          v4u o; o.x = pk2(v[0], v[1]); o.y = pk2(v[2], v[3]); o.z = pk2(v[4], v[5]); o.w = pk2(v[6], v[7]); *(GAS v4u*)(SGWS + e0) = o; }
}
__device__ __forceinline__ void convert_static(const Inputs& I, int l, unsigned char* slot, LAS unsigned char* lds, int it_lo, int it_hi, int gw, int ngw, int wave, int lane) {
    LAS float* scr = (LAS float*)(lds + wave * 8448);
    for (int it = it_lo + gw; it < it_hi; it += ngw) convert_item(I, l, slot, scr, it, lane);
}
#define RLX_AGENT __ATOMIC_RELAXED, __HIP_MEMORY_SCOPE_AGENT
__device__ __forceinline__ void convert_queue(const Inputs& I, int l, unsigned char* slot, LAS unsigned char* lds, unsigned* head, int it_lo, int it_hi, unsigned* fin, int G, int tid, int wave, int lane) {
    LAS float* scr = (LAS float*)(lds + wave * 8448); volatile LAS unsigned* bc = (volatile LAS unsigned*)(lds + 8 * 8448);
    for (;;) {
        if (tid == 0) { unsigned v = 0xffffffffu; if (!fin || __hip_atomic_load(fin, RLX_AGENT) < (unsigned)G) v = __hip_atomic_fetch_add(head, 8u, RLX_AGENT); bc[0] = v; }
        __syncthreads();
        const unsigned base = bc[0];
        __syncthreads();
        if (base >= (unsigned)(it_hi - it_lo)) break;
        const int it = it_lo + (int)base + wave; if (it < it_hi) convert_item(I, l, slot, scr, it, lane);
    }
}
__device__ __forceinline__ void x_prep(const float* xin, bf16* xb, float* ssq, int gw, int ngw, int lane) {
    for (int row = gw; row < M; row += ngw) {
        const GAS f32x4* xr = (const GAS f32x4*)(xin + (size_t)row * D) + lane; f32x4 v[4]; float s = 0.f;
#pragma unroll
        for (int j = 0; j < 4; ++j) { v[j] = xr[64 * j]; s += (v[j][0] * v[j][0] + v[j][1] * v[j][1]) + (v[j][2] * v[j][2] + v[j][3] * v[j][3]); }
        s = wave_sum(s);
#pragma unroll
        for (int j = 0; j < 4; ++j) { v2u w; w.x = pk2(v[j][0], v[j][1]); w.y = pk2(v[j][2], v[j][3]); ((GAS v2u*)(xb + (size_t)row * D))[lane + 64 * j] = w; }
        if (lane < 16) ssq[(size_t)row * 16 + lane] = lane == 0 ? s : 0.f;
    }
}
__device__ __forceinline__ void final_norm(const bf16* xb, float* out, const float* ssq, const float* g, int gw, int ngw, int lane) {
    for (int row = gw; row < M; row += ngw) {
        const float pv = lane < 16 ? ssq[(size_t)row * 16 + lane] : 0.f; const float rs = rsqrtf(wave_sum(pv) * (1.f / D) + EPS);
        const GAS v2u* xr = (const GAS v2u*)(xb + (size_t)row * D) + lane; GAS f32x4* orow = (GAS f32x4*)(out + (size_t)row * D) + lane;
#pragma unroll
        for (int j = 0; j < 4; ++j) { const v2u w = xr[64 * j]; const f32x4 gv = ((const GAS f32x4*)g)[lane + 64 * j];
            orow[64 * j] = (f32x4){bf2f(w.x & 0xffffu) * rs * gv[0], bf2f(w.x >> 16) * rs * gv[1], bf2f(w.y & 0xffffu) * rs * gv[2], bf2f(w.y >> 16) * rs * gv[3]}; }
    }
}

constexpr int GP = 72;
constexpr int L_QT = 0, L_KT = 9216, L_KENDT = 18432, L_VT = 27648, L_ST = 46080, L_SEG = 64512, L_DECS = 66560, L_RED = 66816, L_GLA_END = 67328;
constexpr int VP = 136;

__device__ __forceinline__ void sgu_item(int item, LAS unsigned char* lds, const bf16* ZBI, bf16* ZBO, const bf16* SV, const float* SVST, const float* lng, const float* lnb, const bf16* wsb, const float* bs, int wave, int lane) {
    const int h = item & 3, r0 = (item >> 2) * 128; LAS bf16* vnT = (LAS bf16*)lds;
    { const int d0 = 16 * wave, s0 = 2 * lane; float mean[2], rstd[2]; v4u xv[2][2];
#pragma unroll
      for (int rr = 0; rr < 2; ++rr) { const size_t row = (size_t)r0 + s0 + rr; const f32x4* p = (const f32x4*)(SVST + row * 16); const f32x4 a = p[0], b = p[1], c = p[2], d = p[3];
          const float sm = (a[0] + a[2]) + (b[0] + b[2]) + (c[0] + c[2]) + (d[0] + d[2]), sq = (a[1] + a[3]) + (b[1] + b[3]) + (c[1] + c[3]) + (d[1] + d[3]);
          mean[rr] = sm * (1.f / 512.f); rstd[rr] = rsqrtf(fmaxf(sq * (1.f / 512.f) - mean[rr] * mean[rr], 0.f) + EPS);
          const v4u* q = (const v4u*)(SV + row * 512 + h * 128 + d0); xv[rr][0] = q[0]; xv[rr][1] = q[1]; }
#pragma unroll
      for (int j = 0; j < 16; ++j) { const float g = lng[h * 128 + d0 + j], b = lnb[h * 128 + d0 + j]; const unsigned w0 = xv[0][j >> 3][(j >> 1) & 3], w1 = xv[1][j >> 3][(j >> 1) & 3];
          const float x0 = (j & 1) ? bf2f(w0 >> 16) : bf2f(w0 & 0xffffu), x1 = (j & 1) ? bf2f(w1 >> 16) : bf2f(w1 & 0xffffu);
          *(LAS unsigned*)(vnT + (d0 + j) * VP + s0) = pk2((x0 - mean[0]) * rstd[0] * g + b, (x1 - mean[1]) * rstd[1] * g + b); } }
    __syncthreads();
    { const int fr = lane & 15, fq = lane >> 4, t = 16 * wave + fr, nks = (wave >> 1) + 1; bf16x8 bfr[4];
#pragma unroll
      for (int ks = 0; ks < 4; ++ks) bfr[ks] = (ks < nks) ? *(const bf16x8*)(wsb + ((size_t)h * 128 + t) * 128 + 32 * ks + 8 * fq) : (bf16x8){0, 0, 0, 0, 0, 0, 0, 0};
      f32x4 acc[8];
#pragma unroll
      for (int m = 0; m < 8; ++m) { acc[m] = (f32x4){0.f, 0.f, 0.f, 0.f};
#pragma unroll
          for (int ks = 0; ks < 4; ++ks) if (ks < nks) { const bf16x8 a = *(const LAS bf16x8*)(vnT + (16 * m + fr) * VP + 32 * ks + 8 * fq); acc[m] = mfma16(a, bfr[ks], acc[m]); } }
      const size_t row = (size_t)r0 + t; const float bias = bs[h * 128 + t];
#pragma unroll
      for (int m = 0; m < 8; ++m) { const size_t po = row * 512 + h * 128 + 16 * m + 4 * fq; bf16* p = ZBO + po; const v2u su = *(const v2u*)(ZBI + po); v2u o;
          o.x = pk2(bf2f(su.x & 0xffffu) * (acc[m][0] + bias), bf2f(su.x >> 16) * (acc[m][1] + bias)); o.y = pk2(bf2f(su.y & 0xffffu) * (acc[m][2] + bias), bf2f(su.y >> 16) * (acc[m][3] + bias)); *(v2u*)p = o; } }
    __syncthreads();
}
__device__ __forceinline__ void convbr_item(int idx, const bf16* ZCI, bf16* ZCO, const bf16* CC, const bf16* CX, const float* cw) {
    const int c0 = (idx & 63) * 8, r0 = (idx >> 6) * 8; float w[3][8];
#pragma unroll
    for (int k = 0; k < 3; ++k) { const f32x4 a = *(const f32x4*)(cw + k * CW + c0), b = *(const f32x4*)(cw + k * CW + c0 + 4);
#pragma unroll
        for (int e = 0; e < 4; ++e) { w[k][e] = a[e]; w[k][4 + e] = b[e]; } }
    float u2[8], u1[8];
    auto loadu = [&](int row, float (&u)[8]) { const v4u a = *(const v4u*)(CC + (size_t)row * CW + c0), b = *(const v4u*)(CX + (size_t)row * CW + c0);
#pragma unroll
        for (int e = 0; e < 4; ++e) { u[2 * e] = bf2f(a[e] & 0xffffu) * bf2f(b[e] & 0xffffu); u[2 * e + 1] = bf2f(a[e] >> 16) * bf2f(b[e] >> 16); } };
    if ((r0 & (SEQ - 1)) == 0) {
#pragma unroll
        for (int e = 0; e < 8; ++e) { u2[e] = 0.f; u1[e] = 0.f; } }
    else { loadu(r0 - 2, u2); loadu(r0 - 1, u1); }
#pragma unroll
    for (int i = 0; i < 8; ++i) { float u0[8]; loadu(r0 + i, u0); const size_t po = (size_t)(r0 + i) * CW + c0; bf16* p = ZCO + po; const v4u cb = *(const v4u*)(ZCI + po); float z[8];
#pragma unroll
        for (int e = 0; e < 8; ++e) { const float y = w[0][e] * u2[e] + w[1][e] * u1[e] + w[2][e] * u0[e]; const float c = (e & 1) ? bf2f(cb[e >> 1] >> 16) : bf2f(cb[e >> 1] & 0xffffu); z[e] = c * y; u2[e] = u1[e]; u1[e] = u0[e]; }
        v4u o; o.x = pk2(z[0], z[1]); o.y = pk2(z[2], z[3]); o.z = pk2(z[4], z[5]); o.w = pk2(z[6], z[7]); *(v4u*)p = o; }
}
template <bool FULL> __device__ __forceinline__ float gla_stage(LAS unsigned char* lds, size_t r0, int h, const bf16* Q, const bf16* KK, const bf16* V, const float* LOGA, int tid) {
    const int kcol = tid & 63, seg = tid >> 6; LAS float* SEG = (LAS float*)(lds + L_SEG);
    float p[8]; unsigned kq[8], qq[8];
#pragma unroll
    for (int j = 0; j < 8; ++j) { const size_t row = r0 + 8 * seg + j; p[j] = LOGA[row * GKEY + h * 64 + kcol]; kq[j] = KK[row * GKEY + h * 64 + kcol]; if (FULL) qq[j] = Q[row * GKEY + h * 64 + kcol]; }
#pragma unroll
    for (int j = 1; j < 8; ++j) p[j] += p[j - 1];
    SEG[seg * 64 + kcol] = p[7];
    { const int tp = tid & 31, vg = tid >> 5; LAS bf16* VT = (LAS bf16*)(lds + L_VT);
      const v4u a = *(const v4u*)(V + (r0 + 2 * tp) * GVAL + h * 128 + 8 * vg), b = *(const v4u*)(V + (r0 + 2 * tp + 1) * GVAL + h * 128 + 8 * vg);
#pragma unroll
      for (int e = 0; e < 4; ++e) { *(LAS unsigned*)(VT + (8 * vg + 2 * e) * GP + 2 * tp) = (a[e] & 0xffffu) | (b[e] << 16); *(LAS unsigned*)(VT + (8 * vg + 2 * e + 1) * GP + 2 * tp) = (a[e] >> 16) | (b[e] & 0xffff0000u); } }
    __syncthreads();
    float off = 0.f, tot = 0.f;
#pragma unroll
    for (int s = 0; s < 8; ++s) { const float v = SEG[s * 64 + kcol]; tot += v; if (s < seg) off += v; }
    float ke[8];
#pragma unroll
    for (int j = 0; j < 8; ++j) { const float b = off + p[j], kf = bf2f(kq[j]); ke[j] = kf * __expf(tot - b);
        if (FULL) { const int t = 8 * seg + j; ((LAS bf16*)(lds + L_QT))[t * GP + kcol] = (bf16)(pk2(bf2f(qq[j]) * __expf(b), 0.f) & 0xffffu); ((LAS bf16*)(lds + L_KT))[t * GP + kcol] = (bf16)(pk2(kf * __expf(-b), 0.f) & 0xffffu); } }
    v4u o; o.x = pk2(ke[0], ke[1]); o.y = pk2(ke[2], ke[3]); o.z = pk2(ke[4], ke[5]); o.w = pk2(ke[6], ke[7]);
    *(LAS v4u*)((LAS bf16*)(lds + L_KENDT) + kcol * GP + 8 * seg) = o;
    return __expf(tot);
}
__device__ __forceinline__ void gla_b1_item(int item, LAS unsigned char* lds, const bf16* KK, const bf16* V, const float* LOGA, float* CST, float* DEC, int tid, int wave, int lane) {
    const int h = item & 3; const size_t r0 = (size_t)(item >> 2) * 64;
    const float dec = gla_stage<false>(lds, r0, h, nullptr, KK, V, LOGA, tid);
    if (tid < 64) DEC[(size_t)item * 64 + tid] = dec;
    __syncthreads();
    const int fr = lane & 15, fq = lane >> 4; const LAS bf16* VT = (const LAS bf16*)(lds + L_VT); const LAS bf16* KE = (const LAS bf16*)(lds + L_KENDT);
    bf16x8 bv[2];
#pragma unroll
    for (int ks = 0; ks < 2; ++ks) bv[ks] = *(const LAS bf16x8*)(VT + (16 * wave + fr) * GP + 32 * ks + 8 * fq);
#pragma unroll
    for (int m = 0; m < 4; ++m) { f32x4 acc = (f32x4){0.f, 0.f, 0.f, 0.f};
#pragma unroll
        for (int ks = 0; ks < 2; ++ks) acc = mfma16(*(const LAS bf16x8*)(KE + (16 * m + fr) * GP + 32 * ks + 8 * fq), bv[ks], acc);
        *(f32x4*)(CST + (size_t)item * 8192 + (16 * wave + fr) * 64 + 16 * m + 4 * fq) = acc; }
    __syncthreads();
}
__device__ __forceinline__ void gla_b2_unit(int unit, LAS unsigned char* lds, const bf16* Q, const bf16* KK, const bf16* V, const float* LOGA, const float* CST, const float* DEC, const bf16* ZAI, bf16* ZAO, int tid, int wave, int lane) {
    const int g = unit & 7, h = (unit >> 3) & 3, b = unit >> 5, fr = lane & 15, fq = lane >> 4;
    f32x4 S[4];
#pragma unroll
    for (int m = 0; m < 4; ++m) S[m] = (f32x4){0.f, 0.f, 0.f, 0.f};
    for (int j = 0; j < 4 * g; ++j) { const size_t it = ((size_t)(b * 32 + j) * 4 + h); const float* cp = CST + it * 8192 + (16 * wave + fr) * 64 + 4 * fq; const float* dp = DEC + it * 64 + 4 * fq;
#pragma unroll
        for (int m = 0; m < 4; ++m) { const f32x4 c = *(const f32x4*)(cp + 16 * m), d = *(const f32x4*)(dp + 16 * m); S[m] = d * S[m] + c; } }
    const LAS bf16* QT = (const LAS bf16*)(lds + L_QT); const LAS bf16* KT = (const LAS bf16*)(lds + L_KT); const LAS bf16* KE = (const LAS bf16*)(lds + L_KENDT);
    const LAS bf16* VT = (const LAS bf16*)(lds + L_VT); LAS bf16* ST = (LAS bf16*)(lds + L_ST); LAS float* DECS = (LAS float*)(lds + L_DECS); LAS float* RED = (LAS float*)(lds + L_RED);
    const int ih = wave & 3, vh = wave >> 2;
    for (int c = 0; c < 4; ++c) {
        const size_t r0 = (size_t)b * SEQ + (size_t)(4 * g + c) * 64;
#pragma unroll
        for (int m = 0; m < 4; ++m) { v2u w; w.x = pk2(S[m][0], S[m][1]); w.y = pk2(S[m][2], S[m][3]); *(LAS v2u*)(ST + (16 * wave + fr) * GP + 16 * m + 4 * fq) = w; }
        const float dec = gla_stage<true>(lds, r0, h, Q, KK, V, LOGA, tid);
        if (tid < 64) DECS[tid] = dec;
        __syncthreads();
        bf16x8 bq[2];
#pragma unroll
        for (int ks = 0; ks < 2; ++ks) bq[ks] = *(const LAS bf16x8*)(QT + (16 * ih + fr) * GP + 32 * ks + 8 * fq);
        f32x4 X[4];
#pragma unroll
        for (int jt = 0; jt < 4; ++jt) { X[jt] = (f32x4){0.f, 0.f, 0.f, 0.f};
            if (jt <= ih) {
#pragma unroll
                for (int ks = 0; ks < 2; ++ks) X[jt] = mfma16(*(const LAS bf16x8*)(KT + (16 * jt + fr) * GP + 32 * ks + 8 * fq), bq[ks], X[jt]);
#pragma unroll
                for (int r = 0; r < 4; ++r) if (16 * jt + 4 * fq + r > 16 * ih + fr) X[jt][r] = 0.f; } }
        bf16x8 xb[2];
#pragma unroll
        for (int k2 = 0; k2 < 2; ++k2) { v4u w; w.x = pk2(X[2 * k2][0], X[2 * k2][1]); w.y = pk2(X[2 * k2][2], X[2 * k2][3]); w.z = pk2(X[2 * k2 + 1][0], X[2 * k2 + 1][1]); w.w = pk2(X[2 * k2 + 1][2], X[2 * k2 + 1][3]); xb[k2] = __builtin_bit_cast(bf16x8, w); }
        f32x4 O[4]; float ss = 0.f;
#pragma unroll
        for (int mt = 0; mt < 4; ++mt) { const int v = 64 * vh + 16 * mt + fr; f32x4 o = (f32x4){0.f, 0.f, 0.f, 0.f};
#pragma unroll
            for (int k2 = 0; k2 < 2; ++k2) { const v2u lo = *(const LAS v2u*)(VT + v * GP + 32 * k2 + 4 * fq), hi = *(const LAS v2u*)(VT + v * GP + 32 * k2 + 16 + 4 * fq); v4u a; a.x = lo.x; a.y = lo.y; a.z = hi.x; a.w = hi.y;
                o = mfma16(__builtin_bit_cast(bf16x8, a), xb[k2], o); }
#pragma unroll
            for (int ks = 0; ks < 2; ++ks) o = mfma16(*(const LAS bf16x8*)(ST + v * GP + 32 * ks + 8 * fq), bq[ks], o);
            O[mt] = o; ss += (o[0] * o[0] + o[1] * o[1]) + (o[2] * o[2] + o[3] * o[3]); }
        ss += __shfl_xor(ss, 16); ss += __shfl_xor(ss, 32);
        if (fq == 0) RED[(vh * 4 + ih) * 16 + fr] = ss;
        __syncthreads();
        const float rs = rsqrtf((RED[ih * 16 + fr] + RED[(4 + ih) * 16 + fr]) * (1.f / 128.f) + EPS);
        { const size_t row = r0 + 16 * ih + fr;
#pragma unroll
          for (int mt = 0; mt < 4; ++mt) { const size_t po = row * GVAL + h * 128 + 64 * vh + 16 * mt + 4 * fq; bf16* p = ZAO + po; const v2u gt = *(const v2u*)(ZAI + po); v2u o;
              o.x = pk2(O[mt][0] * rs * bf2f(gt.x & 0xffffu), O[mt][1] * rs * bf2f(gt.x >> 16)); o.y = pk2(O[mt][2] * rs * bf2f(gt.y & 0xffffu), O[mt][3] * rs * bf2f(gt.y >> 16)); *(v2u*)p = o; } }
        bf16x8 bv[2];
#pragma unroll
        for (int ks = 0; ks < 2; ++ks) bv[ks] = *(const LAS bf16x8*)(VT + (16 * wave + fr) * GP + 32 * ks + 8 * fq);
#pragma unroll
        for (int m = 0; m < 4; ++m) { const f32x4 d = *(const LAS f32x4*)(DECS + 16 * m + 4 * fq); S[m] = S[m] * d;
#pragma unroll
            for (int ks = 0; ks < 2; ++ks) S[m] = mfma16(*(const LAS bf16x8*)(KE + (16 * m + fr) * GP + 32 * ks + 8 * fq), bv[ks], S[m]); }
        __syncthreads();
    }
}
__device__ __forceinline__ void ffn_act_item(int idx, const bf16* HUP, bf16* ACT, const float* cw, const float* cb) {
    const int cgp = idx % 352, rb = idx / 352, pn = cgp >> 4, c8 = (cgp & 15) * 8, j0 = 128 * pn + c8, r0 = rb * 16;
    float wg[3][8], wv[3][8], bg[8], bv[8];
#pragma unroll
    for (int e = 0; e < 8; ++e) { bg[e] = cb[j0 + e]; bv[e] = cb[DFF + j0 + e];
#pragma unroll
        for (int k = 0; k < 3; ++k) { wg[k][e] = cw[k * DFF2 + j0 + e]; wv[k][e] = cw[k * DFF2 + DFF + j0 + e]; } }
    float g2[8], g1[8], v2[8], v1[8];
    auto ld = [&](int row, float (&g)[8], float (&v)[8]) { const bf16* p = HUP + (size_t)row * DFF2 + 256 * pn + c8; const v4u a = *(const v4u*)p, b = *(const v4u*)(p + 128);
#pragma unroll
        for (int e = 0; e < 4; ++e) { g[2 * e] = bf2f(a[e] & 0xffffu); g[2 * e + 1] = bf2f(a[e] >> 16); v[2 * e] = bf2f(b[e] & 0xffffu); v[2 * e + 1] = bf2f(b[e] >> 16); } };
    if ((r0 & (SEQ - 1)) == 0) {
#pragma unroll
        for (int e = 0; e < 8; ++e) { g2[e] = 0.f; g1[e] = 0.f; v2[e] = 0.f; v1[e] = 0.f; } }
    else { ld(r0 - 2, g2, v2); ld(r0 - 1, g1, v1); }
    for (int i = 0; i < 16; ++i) { float g0[8], v0[8]; ld(r0 + i, g0, v0); float z[8];
#pragma unroll
        for (int e = 0; e < 8; ++e) { const float ga = wg[0][e] * g2[e] + wg[1][e] * g1[e] + wg[2][e] * g0[e] + bg[e], va = wv[0][e] * v2[e] + wv[1][e] * v1[e] + wv[2][e] * v0[e] + bv[e];
            z[e] = fsilu(ga) * va; g2[e] = g1[e]; g1[e] = g0[e]; v2[e] = v1[e]; v1[e] = v0[e]; }
        v4u o; o.x = pk2(z[0], z[1]); o.y = pk2(z[2], z[3]); o.z = pk2(z[4], z[5]); o.w = pk2(z[6], z[7]); *(v4u*)(ACT + (size_t)(r0 + i) * DFF + j0) = o; }
}

using pg8::Unit;
__device__ __forceinline__ void row_rstd(const float* SSQ, int pm, int wr, int fr, int fq, float (&rsd)[2][4]) {
    const int lane = fr + 16 * fq;
#pragma unroll
    for (int ai = 0; ai < 2; ++ai) { const size_t row = (size_t)pm * 256 + ai * 128 + wr * 64 + lane; const f32x4* p = (const f32x4*)(SSQ + row * 16); const f32x4 a = p[0], b = p[1], c = p[2], d = p[3];
        const float s = ((a[0] + a[1]) + (a[2] + a[3])) + ((b[0] + b[1]) + (b[2] + b[3])) + ((c[0] + c[1]) + (c[2] + c[3])) + ((d[0] + d[1]) + (d[2] + d[3]));
        const float rs = rsqrtf(s * (1.f / D) + EPS);
#pragma unroll
        for (int m = 0; m < 4; ++m) rsd[ai][m] = __shfl(rs, 16 * m + fr); }
}
struct EpiA {
    static constexpr bool PERM = true, AFTER_DRAIN = false;
    unsigned char* act0; const float* SSQ; float* SVST; const float* bal;
    __device__ __forceinline__ void operator()(const f32x4 (&acc)[2][2][4][2], const Unit& u, int wr, int wc, int fr_, int fq_) const {
        int fr = fr_, fq = fq_; asm volatile("" : "+v"(fr), "+v"(fq));
        float rsd[2][4]; row_rstd(SSQ, u.pm, wr, fr, fq, rsd);
        const int pn = u.pn; int mode, ldc, colt; size_t boff;
        if (pn < 1) { mode = 0; boff = A_Q; ldc = 256; colt = 0; } else if (pn < 2) { mode = 0; boff = A_K; ldc = 256; colt = 0; } else if (pn < 4) { mode = 0; boff = A_V; ldc = 512; colt = (pn - 2) * 256; }
        else if (pn < 6) { mode = 1; boff = A_Z; ldc = 512; colt = (pn - 4) * 256; } else if (pn < 7) { mode = 4; boff = A_LOGA; ldc = 256; colt = 0; }
        else if (pn < 9) { mode = 2; boff = A_Z + (size_t)M * 512 * 2; ldc = 512; colt = (pn - 7) * 256; } else if (pn < 11) { mode = 3; boff = A_SV; ldc = 512; colt = (pn - 9) * 256; }
        else if (pn < 13) { mode = 0; boff = A_Z + (size_t)2 * M * 512 * 2; ldc = 512; colt = (pn - 11) * 256; } else if (pn < 15) { mode = 0; boff = A_CC; ldc = 512; colt = (pn - 13) * 256; }
        else if (pn < 17) { mode = 0; boff = A_CX; ldc = 512; colt = (pn - 15) * 256; } else { mode = 5; boff = A_G; ldc = 3072; colt = (pn - 17) * 256; }
        const int col0 = colt + wc * 32 + 8 * fq;
#pragma unroll
        for (int ai = 0; ai < 2; ++ai)
#pragma unroll
            for (int m = 0; m < 4; ++m) { const size_t row = (size_t)u.pm * 256 + ai * 128 + wr * 64 + m * 16 + fr; const float rs = rsd[ai][m]; float s1 = 0.f, s2 = 0.f;
#pragma unroll
                for (int bj = 0; bj < 2; ++bj) { const f32x4 a0 = acc[ai][bj][m][0] * rs, a1 = acc[ai][bj][m][1] * rs; float v[8] = {a0[0], a0[1], a0[2], a0[3], a1[0], a1[1], a1[2], a1[3]};
                    if (mode == 4) { const f32x4 b0 = *(const f32x4*)(bal + col0 + bj * 128), b1 = *(const f32x4*)(bal + col0 + bj * 128 + 4); f32x4 o0, o1;
#pragma unroll
                        for (int e = 0; e < 4; ++e) { o0[e] = flogsig(v[e] + b0[e]) * 0.0625f; o1[e] = flogsig(v[4 + e] + b1[e]) * 0.0625f; }
                        float* p = (float*)(act0 + boff) + row * 256 + col0 + bj * 128; *(f32x4*)p = o0; *(f32x4*)(p + 4) = o1; }
                    else {
                        if (mode == 1) {
#pragma unroll
                            for (int e = 0; e < 8; ++e) v[e] = fsilu(v[e]); }
                        else if (mode == 2 || mode == 3) {
#pragma unroll
                            for (int e = 0; e < 8; ++e) v[e] = fgelu(v[e]); }
                        else if (mode == 5) {
#pragma unroll
                            for (int e = 0; e < 8; ++e) v[e] = fsigmoid(v[e]); }
                        if (mode == 3) {
#pragma unroll
                            for (int e = 0; e < 8; ++e) { s1 += v[e]; s2 += v[e] * v[e]; } }
                        v4u o; o.x = pk2(v[0], v[1]); o.y = pk2(v[2], v[3]); o.z = pk2(v[4], v[5]); o.w = pk2(v[6], v[7]);
                        *(v4u*)((bf16*)(act0 + boff) + row * ldc + col0 + bj * 128) = o; } }
                if (mode == 3) { s1 += __shfl_xor(s1, 16); s1 += __shfl_xor(s1, 32); s2 += __shfl_xor(s2, 16); s2 += __shfl_xor(s2, 32);
                    if (fq == 0) *(f32x2*)(SVST + row * 16 + ((pn - 9) * 4 + wc) * 2) = (f32x2){s1, s2}; } }
    }
};
struct EpiC {
    static constexpr bool PERM = true, AFTER_DRAIN = false;
    const bf16* G; bf16* MG;
    __device__ __forceinline__ void operator()(const f32x4 (&acc)[2][2][4][2], const Unit& u, int wr, int wc, int fr_, int fq_) const {
        int fr = fr_, fq = fq_; asm volatile("" : "+v"(fr), "+v"(fq));
        const int br = u.pm >> 6, pm = u.pm & 63, pn = u.pn & 3; const int col0 = pn * 256 + wc * 32 + 8 * fq;
#pragma unroll
        for (int ai = 0; ai < 2; ++ai)
#pragma unroll
            for (int m = 0; m < 4; ++m) { const size_t row = (size_t)pm * 256 + ai * 128 + wr * 64 + m * 16 + fr;
#pragma unroll
                for (int bj = 0; bj < 2; ++bj) { const f32x4 a0 = acc[ai][bj][m][0], a1 = acc[ai][bj][m][1]; float v[8] = {a0[0], a0[1], a0[2], a0[3], a1[0], a1[1], a1[2], a1[3]};
                    const v4u gt = *(const v4u*)(G + row * 3072 + br * 1024 + col0 + bj * 128); bf16* mp = MG + row * 1024 + col0 + bj * 128;
#pragma unroll
                    for (int e = 0; e < 4; ++e) { v[2 * e] *= bf2f(gt[e] & 0xffffu); v[2 * e + 1] *= bf2f(gt[e] >> 16); }
                    if (br != 0) { const v4u old = *(const v4u*)mp;
#pragma unroll
                        for (int e = 0; e < 4; ++e) { v[2 * e] += bf2f(old[e] & 0xffffu); v[2 * e + 1] += bf2f(old[e] >> 16); } }
                    v4u o; o.x = pk2(v[0], v[1]); o.y = pk2(v[2], v[3]); o.z = pk2(v[4], v[5]); o.w = pk2(v[6], v[7]); *(v4u*)mp = o; } }
    }
};
struct BranchOrder {
    int G, c;
    __device__ bool next(int i, Unit& u) const { const int j = i / 3, br = i - 3 * j, T = c + G * j; if (T >= 256) return false;
        const int w = (T & 7) * 32 + (T >> 3), pm = (w >> 5) * 8 + (w & 7), pn = (w & 31) >> 3; u.pm = br * 64 + pm; u.pn = br * 4 + pn; return true; }
    __device__ __forceinline__ void a_ready(const Unit&) const {}
    __device__ __forceinline__ void done(const Unit&) const {}
};
struct EpiRes {
    static constexpr bool PERM = true, AFTER_DRAIN = false;
    const bf16* XI; bf16* XB; float* SSQ;
    __device__ __forceinline__ void operator()(const f32x4 (&acc)[2][2][4][2], const Unit& u, int wr, int wc, int fr_, int fq_) const {
        int fr = fr_, fq = fq_; asm volatile("" : "+v"(fr), "+v"(fq));
        const int col0 = u.pn * 256 + wc * 32 + 8 * fq;
#pragma unroll
        for (int ai = 0; ai < 2; ++ai)
#pragma unroll
            for (int m = 0; m < 4; ++m) { const size_t row = (size_t)u.pm * 256 + ai * 128 + wr * 64 + m * 16 + fr; float ss = 0.f;
#pragma unroll
                for (int bj = 0; bj < 2; ++bj) { const size_t off = row * D + col0 + bj * 128; const v4u xo = *(const v4u*)(XI + off); const f32x4 a0 = acc[ai][bj][m][0], a1 = acc[ai][bj][m][1];
                    float v[8] = {a0[0], a0[1], a0[2], a0[3], a1[0], a1[1], a1[2], a1[3]};
#pragma unroll
                    for (int e = 0; e < 4; ++e) { v[2 * e] += bf2f(xo[e] & 0xffffu); v[2 * e + 1] += bf2f(xo[e] >> 16); }
#pragma unroll
                    for (int e = 0; e < 8; ++e) ss += v[e] * v[e];
                    v4u o; o.x = pk2(v[0], v[1]); o.y = pk2(v[2], v[3]); o.z = pk2(v[4], v[5]); o.w = pk2(v[6], v[7]); *(v4u*)(XB + off) = o; }
                ss += __shfl_xor(ss, 16); ss += __shfl_xor(ss, 32);
                if (fq == 0) SSQ[row * 16 + u.pn * 4 + wc] = ss; }
    }
};
struct EpiUp {
    static constexpr bool PERM = true, AFTER_DRAIN = false;
    bf16* HUP; const float* SSQ;
    __device__ __forceinline__ void operator()(const f32x4 (&acc)[2][2][4][2], const Unit& u, int wr, int wc, int fr_, int fq_) const {
        int fr = fr_, fq = fq_; asm volatile("" : "+v"(fr), "+v"(fq));
        float rsd[2][4]; row_rstd(SSQ, u.pm, wr, fr, fq, rsd);
        const int col0 = u.pn * 256 + wc * 32 + 8 * fq;
#pragma unroll
        for (int ai = 0; ai < 2; ++ai)
#pragma unroll
            for (int m = 0; m < 4; ++m) { const size_t row = (size_t)u.pm * 256 + ai * 128 + wr * 64 + m * 16 + fr; const float rs = rsd[ai][m];
#pragma unroll
                for (int bj = 0; bj < 2; ++bj) { const f32x4 a0 = acc[ai][bj][m][0] * rs, a1 = acc[ai][bj][m][1] * rs;
                    v4u o; o.x = pk2(a0[0], a0[1]); o.y = pk2(a0[2], a0[3]); o.z = pk2(a1[0], a1[1]); o.w = pk2(a1[2], a1[3]); *(v4u*)(HUP + row * DFF2 + col0 + bj * 128) = o; } }
    }
};

#define XB_TMO      128
#define XB_XCNT(j)  (256  + 64 * (j))
#define XB_XSUB(j)  (1280 + 64 * (j))
#define XB_XGEN(j)  (2304 + 64 * (j))
#define XB_TOP      3328
#define XB_TOPGEN   3392
#define XCD_BAR_WORDS 3456
#define XB_SPIN_CAP (1u << 18)

__device__ __forceinline__ unsigned xb_ld(unsigned* p)              { return __hip_atomic_load(p, __ATOMIC_RELAXED, __HIP_MEMORY_SCOPE_AGENT); }
__device__ __forceinline__ unsigned xb_add(unsigned* p, unsigned v) { return __hip_atomic_fetch_add(p, v, __ATOMIC_RELAXED, __HIP_MEMORY_SCOPE_AGENT); }
__device__ __forceinline__ unsigned xb_xcc_id() { return (unsigned)__builtin_amdgcn_s_getreg((3 << 11) | 20) & 0xFu; }
#define XB_SPIN(cond, bar) do { unsigned _sp = 0; while (cond) { __builtin_amdgcn_s_sleep(1); \
    if ((++_sp & 255u) == 0u) { if (xb_ld(&(bar)[XB_TMO])) break; if (_sp > XB_SPIN_CAP) { atomicAdd(&(bar)[XB_TMO], 1u); break; } } } } while (0)

struct XcdBarrier {
    unsigned* bar; unsigned x;
    volatile LAS unsigned* st;
};

__device__ __forceinline__ XcdBarrier xcd_barrier_post(unsigned* bar, volatile LAS unsigned* st) {
    XcdBarrier b; b.bar = bar; b.x = xb_xcc_id(); b.st = st;
    if (threadIdx.x == 0) (void)xb_add(&bar[XB_XCNT(b.x)], 1u);
    return b;
}
__device__ __forceinline__ void xcd_barrier_complete(unsigned* bar, unsigned x, unsigned& nloc, unsigned& nx) {
    const unsigned G = gridDim.x * gridDim.y * gridDim.z;
    unsigned sum, cnt, mine, sp = 0u;
    for (;;) {
        sum = 0u; cnt = 0u; mine = 0u;
#pragma unroll
        for (unsigned j = 0; j < 16; ++j) { const unsigned c = xb_ld(&bar[XB_XCNT(j)]); sum += c; cnt += (c > 0u) ? 1u : 0u; mine = (j == x) ? c : mine; }
        if (sum == G) break;
        __builtin_amdgcn_s_sleep(1);
        if ((++sp & 255u) == 0u) { if (xb_ld(&bar[XB_TMO])) break; if (sp > XB_SPIN_CAP) { atomicAdd(&bar[XB_TMO], 1u); break; } }
    }
    nloc = mine > 0u ? mine : 1u; nx = cnt > 0u ? cnt : 1u;
}

__device__ __forceinline__ void xcd_barrier(const XcdBarrier& b) {
    asm volatile("s_waitcnt vmcnt(0)" ::: "memory");
    __syncthreads();
    if (threadIdx.x == 0) {
        unsigned* bar = b.bar;
        __builtin_amdgcn_s_waitcnt(0);
        unsigned nloc = b.st[0], nx = b.st[1];
        if (nloc == 0u) { xcd_barrier_complete(bar, b.x, nloc, nx); b.st[0] = nloc; b.st[1] = nx; }
        const unsigned old = xb_add(&bar[XB_XSUB(b.x)], 1u);
        const unsigned gen = old / nloc;
        if (old + 1u == (gen + 1u) * nloc) {
            __builtin_amdgcn_fence(__ATOMIC_RELEASE, "agent");
            asm volatile("s_waitcnt vmcnt(0)" ::: "memory");
            const unsigned og = xb_add(&bar[XB_TOP], 1u);
            const unsigned tg = og / nx;
            if (og + 1u == (tg + 1u) * nx) xb_add(&bar[XB_TOPGEN], 1u);
            else XB_SPIN(xb_ld(&bar[XB_TOPGEN]) == tg, bar);
            __builtin_amdgcn_fence(__ATOMIC_ACQUIRE, "agent");
            xb_add(&bar[XB_XGEN(b.x)], 1u);
            asm volatile("s_waitcnt vmcnt(0)" ::: "memory");
        } else {
            XB_SPIN(xb_ld(&bar[XB_XGEN(b.x)]) == gen, bar);
            __builtin_amdgcn_fence(__ATOMIC_ACQUIRE, "agent");
            asm volatile("s_waitcnt vmcnt(0)" ::: "memory");
        }
    }
    __syncthreads();
}

#ifndef PROBE
#define PROBE 0
#endif
struct Args { Inputs in; float* out; unsigned char* ws; int ph_lo, ph_hi; };
constexpr int NPHASE = 2 + 8 * DEPTH;
#define LAUNDER_S(p) asm volatile("" : "+s"(p))
#define LAUNDER_V(p) asm volatile("" : "+v"(p))
struct Ctx { unsigned char* ws; unsigned char* act0; float* X; int tid, lane, wave, G, bx, gw, ngw; };
__device__ __forceinline__ Ctx make_ctx(const Args& a) {
    Ctx c; size_t z = 0; LAUNDER_S(z); c.ws = a.ws + z; c.X = (float*)((unsigned char*)a.out + z); c.act0 = c.ws + WS_ACT0;
    int t = threadIdx.x; LAUNDER_V(t); c.tid = t; c.lane = t & 63; c.wave = __builtin_amdgcn_readfirstlane(t >> 6);
    c.G = gridDim.x; c.bx = blockIdx.x; c.gw = c.bx * NWAVES + c.wave; c.ngw = c.G * NWAVES; return c;
}
__device__ __forceinline__ unsigned char* slot_of(const Ctx& c, int l) { return c.ws + WS_SLOT0 + (size_t)(l & 1) * SL_BYTES; }
__device__ __forceinline__ unsigned* ctl_word(const Ctx& c, int w) { return (unsigned*)(c.ws + WS_CTL) + w; }
__device__ __forceinline__ void tail_convert(const Args& a, const Ctx& c, int l, int ph, bool drain, LAS unsigned char* lds) {
#if MK_ONE_LAUNCH
    unsigned* fin = ctl_word(c, CW_FIN + 64 * ph);
    if (c.tid == 0) __hip_atomic_fetch_add(fin, 1u, RLX_AGENT);
    if (l == 0 && ph == 1) convert_queue(a.in, 0, slot_of(c, 0), lds, ctl_word(c, CW_QHEAD), CV_WIN_ITEMS, CV_ITEMS, nullptr, c.G, c.tid, c.wave, c.lane);
    if (l + 1 < DEPTH) convert_queue(a.in, l + 1, slot_of(c, l + 1), lds, ctl_word(c, CW_QHEAD + 64 * (l + 1)), 0, CV_ITEMS, drain ? nullptr : fin, c.G, c.tid, c.wave, c.lane);
#else
    if (l == 0 && ph == 1) convert_static(a.in, 0, slot_of(c, 0), lds, CV_WIN_ITEMS, CV_ITEMS, c.gw, c.ngw, c.wave, c.lane);
    if (l + 1 < DEPTH && drain) convert_static(a.in, l + 1, slot_of(c, l + 1), lds, 0, CV_ITEMS, c.gw, c.ngw, c.wave, c.lane);
#endif
}
__device__ __forceinline__ void ph_p0(const Args& a, LAS unsigned char* lds) { const Ctx c = make_ctx(a);
    convert_static(a.in, 0, c.ws + WS_SLOT0, lds, 0, CV_WIN_ITEMS, c.gw, c.ngw, c.wave, c.lane); x_prep(a.in.p[0], (bf16*)(c.ws + WS_XB), (float*)(c.ws + WS_SSQ), c.gw, c.ngw, c.lane); }
__device__ __forceinline__ void ph_a(const Args& a, int l, int ph, LAS unsigned char* lds) { const Ctx c = make_ctx(a);
    pg8::Gemm g{(const bf16*)(c.ws + WS_XB), (const bf16*)(slot_of(c, l) + SL_WIN), M, NIN, D}; pg8::StaticOrder S; S.init(M, NIN, c.G, c.bx);
    EpiA E{c.act0, (const float*)(c.ws + WS_SSQ), (float*)(c.ws + WS_SVST), a.in.p[4] + (size_t)l * GKEY};
    for (int rep = 0; rep < 1 + (PROBE == 1); ++rep) pg8::gemm_phase<EpiA, pg8::StaticOrder, true, true>(lds, g, S, E);
    tail_convert(a, c, l, ph, false, lds); }
__device__ __forceinline__ void ph_b1(const Args& a, int l, LAS unsigned char* lds) { const Ctx c = make_ctx(a); const Inputs& I = a.in;
    bf16* Zb = (bf16*)(c.act0 + A_Z); bf16* DUM = (bf16*)(c.ws + WS_END);
    for (int rep = 0; rep < 1 + (PROBE == 2); ++rep)
    for (int it = c.bx; it < 1024; it += c.G) gla_b1_item(it, lds, (const bf16*)(c.act0 + A_K), (const bf16*)(c.act0 + A_V), (const float*)(c.act0 + A_LOGA), (float*)(c.act0 + A_CST), (float*)(c.act0 + A_DEC), c.tid, c.wave, c.lane);
    if (PROBE == 3) for (int it = c.bx; it < 512; it += c.G) sgu_item(it, lds, Zb + (size_t)M * 512, DUM, (const bf16*)(c.act0 + A_SV), (const float*)(c.ws + WS_SVST), I.p[7] + (size_t)l * SGW, I.p[8] + (size_t)l * SGW, (const bf16*)(slot_of(c, l) + SL_SGW), I.p[10] + (size_t)l * 512, c.wave, c.lane);
    for (int it = c.bx; it < 512; it += c.G) sgu_item(it, lds, Zb + (size_t)M * 512, Zb + (size_t)M * 512, (const bf16*)(c.act0 + A_SV), (const float*)(c.ws + WS_SVST), I.p[7] + (size_t)l * SGW, I.p[8] + (size_t)l * SGW, (const bf16*)(slot_of(c, l) + SL_SGW), I.p[10] + (size_t)l * 512, c.wave, c.lane);
    if (PROBE == 4) for (int it = c.bx * NTHREADS + c.tid; it < 131072; it += c.G * NTHREADS) convbr_item(it, Zb + (size_t)2 * M * 512, DUM, (const bf16*)(c.act0 + A_CC), (const bf16*)(c.act0 + A_CX), I.p[12] + (size_t)l * 3 * CW);
    for (int it = c.bx * NTHREADS + c.tid; it < 131072; it += c.G * NTHREADS) convbr_item(it, Zb + (size_t)2 * M * 512, Zb + (size_t)2 * M * 512, (const bf16*)(c.act0 + A_CC), (const bf16*)(c.act0 + A_CX), I.p[12] + (size_t)l * 3 * CW);
}
__device__ __forceinline__ void ph_b2(const Args& a, int l, int ph, LAS unsigned char* lds) { const Ctx c = make_ctx(a);
    if (PROBE == 6) for (int it = c.bx; it < 256; it += c.G) gla_b2_unit(it, lds, (const bf16*)(c.act0 + A_Q), (const bf16*)(c.act0 + A_K), (const bf16*)(c.act0 + A_V), (const float*)(c.act0 + A_LOGA), (const float*)(c.act0 + A_CST), (const float*)(c.act0 + A_DEC), (const bf16*)(c.act0 + A_Z), (bf16*)(c.ws + WS_END), c.tid, c.wave, c.lane);
    for (int it = c.bx; it < 256; it += c.G) gla_b2_unit(it, lds, (const bf16*)(c.act0 + A_Q), (const bf16*)(c.act0 + A_K), (const bf16*)(c.act0 + A_V), (const float*)(c.act0 + A_LOGA), (const float*)(c.act0 + A_CST), (const float*)(c.act0 + A_DEC), (const bf16*)(c.act0 + A_Z), (bf16*)(c.act0 + A_Z), c.tid, c.wave, c.lane);
    tail_convert(a, c, l, ph, false, lds); }
__device__ __forceinline__ void ph_c(const Args& a, int l, LAS unsigned char* lds) { const Ctx c = make_ctx(a);
    pg8::Gemm g{(const bf16*)(c.act0 + A_Z), (const bf16*)(slot_of(c, l) + SL_WBR), 3 * M, 3 * D, 512}; BranchOrder S{c.G, c.bx}; EpiC E{(const bf16*)(c.act0 + A_G), (bf16*)(c.act0 + A_MERGED)};
    for (int rep = 0; rep < 1 + (PROBE == 7); ++rep) pg8::gemm_phase<EpiC, BranchOrder, true, true>(lds, g, S, E); }
__device__ __forceinline__ void ph_res(const Args& a, const bf16* A, const bf16* Bt, int K, int dup, int l, int ph, bool drain, LAS unsigned char* lds) { const Ctx c = make_ctx(a);
    pg8::Gemm g{A, Bt, M, D, K}; pg8::StaticOrder S; S.init(M, D, c.G, c.bx);
    if (dup) { EpiRes E{(const bf16*)(c.ws + WS_XB), (bf16*)(c.ws + WS_END), (float*)(c.ws + WS_END + 32 * MiB)}; pg8::gemm_phase<EpiRes, pg8::StaticOrder, true, true>(lds, g, S, E); }
    EpiRes E{(const bf16*)(c.ws + WS_XB), (bf16*)(c.ws + WS_XB), (float*)(c.ws + WS_SSQ)};
    pg8::gemm_phase<EpiRes, pg8::StaticOrder, true, true>(lds, g, S, E);
    if (drain) tail_convert(a, c, l, ph, true, lds); }
__device__ __forceinline__ void ph_e(const Args& a, int l, int ph, LAS unsigned char* lds) { const Ctx c = make_ctx(a);
    pg8::Gemm g{(const bf16*)(c.ws + WS_XB), (const bf16*)(slot_of(c, l) + SL_WUP), M, DFF2, D}; pg8::StaticOrder S; S.init(M, DFF2, c.G, c.bx); EpiUp E{(bf16*)(c.act0 + A_HUP), (const float*)(c.ws + WS_SSQ)};
    for (int rep = 0; rep < 1 + (PROBE == 8); ++rep) pg8::gemm_phase<EpiUp, pg8::StaticOrder, true, true>(lds, g, S, E);
    tail_convert(a, c, l, ph, false, lds); }
__device__ __forceinline__ void ph_e2(const Args& a, int l) { const Ctx c = make_ctx(a);
    for (int rep = 0; rep < 1 + (PROBE == 9); ++rep)
    for (int it = c.bx * NTHREADS + c.tid; it < 1024 * 352; it += c.G * NTHREADS) ffn_act_item(it, (const bf16*)(c.act0 + A_HUP), (bf16*)(c.act0 + A_ACT), a.in.p[17] + (size_t)l * 3 * DFF2, a.in.p[18] + (size_t)l * DFF2); }
__device__ __forceinline__ void ph_fin(const Args& a) { const Ctx c = make_ctx(a); final_norm((const bf16*)(c.ws + WS_XB), c.X, (const float*)(c.ws + WS_SSQ), a.in.p[20], c.gw, c.ngw, c.lane); }

#ifndef PHMASK
#define PHMASK 0xFFFF
#endif
#define EN(b) ((PHMASK >> (b)) & 1)
__global__ void __launch_bounds__(NTHREADS, 2) mk_fwd(Args args) {
    extern __shared__ __attribute__((aligned(16))) unsigned char lds_raw[];
    LAS unsigned char* lds = (LAS unsigned char*)lds_raw;
    const int lo = args.ph_lo, hi = args.ph_hi;
#define IN(k) (lo <= (k) && (k) < hi)
#if MK_ONE_LAUNCH
    volatile LAS unsigned* bst = (volatile LAS unsigned*)(lds + RING_BYTES + 512);
    if (threadIdx.x < 2) bst[threadIdx.x] = 0u;
    __syncthreads();
    const XcdBarrier bar = xcd_barrier_post((unsigned*)(args.ws + WS_CTL) + CW_BAR, bst);
#define SEAM(k) do { if (IN(k) && IN((k) + 1)) { if ((k) == 0) cg::this_grid().sync(); else xcd_barrier(bar); } } while (0)
#else
#define SEAM(k) do { } while (0)
#endif
    int ph = 0;
    if (EN(0) && IN(ph)) ph_p0(args, lds);
    SEAM(ph); ++ph;
    for (int l = 0; l < DEPTH; ++l) {
        if (EN(1) && IN(ph)) ph_a(args, l, ph, lds);
        SEAM(ph); ++ph;
        if (EN(2) && IN(ph)) ph_b1(args, l, lds);
        SEAM(ph); ++ph;
        if (EN(3) && IN(ph)) ph_b2(args, l, ph, lds);
        SEAM(ph); ++ph;
        if (EN(4) && IN(ph)) ph_c(args, l, lds);
        SEAM(ph); ++ph;
        if (EN(5) && IN(ph)) { size_t z = 0; LAUNDER_S(z); unsigned char* ws = args.ws + z; ph_res(args, (const bf16*)(ws + WS_ACT0 + A_MERGED), (const bf16*)(ws + WS_SLOT0 + (size_t)(l & 1) * SL_BYTES + SL_WO), D, PROBE == 10, l, ph, false, lds); }
        SEAM(ph); ++ph;
        if (EN(6) && IN(ph)) ph_e(args, l, ph, lds);
        SEAM(ph); ++ph;
        if (EN(7) && IN(ph)) ph_e2(args, l);
        SEAM(ph); ++ph;
        if (EN(8) && IN(ph)) { size_t z = 0; LAUNDER_S(z); unsigned char* ws = args.ws + z; ph_res(args, (const bf16*)(ws + WS_ACT0 + A_ACT), (const bf16*)(ws + WS_SLOT0 + (size_t)(l & 1) * SL_BYTES + SL_WDN), DFF, PROBE == 11, l, ph, true, lds); }
        SEAM(ph); ++ph;
    }
    if (EN(9) && IN(ph)) ph_fin(args);
#undef IN
#undef SEAM
}

extern "C" void kernel_launch(void* const* d_in, const int* in_sizes, int n_in, void* d_out, int out_size, void* d_ws, size_t ws_size, hipStream_t stream) {
    static int grid = 0;
    if (grid == 0) {
        if (n_in != 21 || out_size != M * D || ws_size < WS_END + (PROBE ? 64 * MiB : 0)) { fprintf(stderr, "kernel_launch: unexpected shapes / workspace (%zu < %zu)\n", ws_size, (size_t)WS_END); grid = -1; return; }
        int dev = 0, cus = 0, per_cu = 0;
        if (hipGetDevice(&dev) != hipSuccess || hipDeviceGetAttribute(&cus, hipDeviceAttributeMultiprocessorCount, dev) != hipSuccess) { grid = -1; return; }
        if (hipFuncSetAttribute((const void*)mk_fwd, hipFuncAttributeMaxDynamicSharedMemorySize, LDS_BYTES) != hipSuccess) { fprintf(stderr, "kernel_launch: hipFuncSetAttribute failed\n"); grid = -1; return; }
        if (hipOccupancyMaxActiveBlocksPerMultiprocessor(&per_cu, (const void*)mk_fwd, NTHREADS, LDS_BYTES) != hipSuccess || per_cu < 1) { fprintf(stderr, "kernel_launch: occupancy query says %d\n", per_cu); per_cu = 1; }
        (void)hipGetLastError();
        grid = cus * 1;
    }
    if (grid < 0) return;
#if MK_ONE_LAUNCH
    if (hipMemsetAsync((char*)d_ws + WS_CTL, 0, 65536, stream) != hipSuccess) { fprintf(stderr, "kernel_launch: memset failed\n"); return; }
#endif
    Args a{};
    for (int i = 0; i < 21; ++i) a.in.p[i] = (const float*)d_in[i];
    a.out = (float*)d_out; a.ws = (unsigned char*)d_ws;
#if MK_ONE_LAUNCH
    a.ph_lo = 0; a.ph_hi = NPHASE;
    void* kargs[] = {&a};
    hipError_t e = hipLaunchCooperativeKernel((const void*)mk_fwd, dim3(grid), dim3(NTHREADS), kargs, LDS_BYTES, stream);
    if (e != hipSuccess) fprintf(stderr, "kernel_launch: cooperative launch failed: %s (grid %d)\n", hipGetErrorString(e), grid);
#else
    for (int p = 0; p < NPHASE; ++p) { a.ph_lo = p; a.ph_hi = p + 1; hipLaunchKernelGGL(mk_fwd, dim3(grid), dim3(NTHREADS), LDS_BYTES, stream, a); }
#endif
}
```

```cpp
#include <hip/hip_runtime.h>
#include <hip/hip_cooperative_groups.h>
#include <cstdio>
#include <cstdint>
#include <cmath>
namespace cg = cooperative_groups;

#ifndef MK_ONE_LAUNCH
#define MK_ONE_LAUNCH 1
#endif

namespace cfg {
constexpr int D = 1024, BATCH = 8, SEQ = 2048, DEPTH = 4, M = BATCH * SEQ;
constexpr int GH = 4, GDK = 64, GDV = 128, GKEY = 256, GVAL = 512, GRANK = 16;
constexpr int SGW = 512, SGC = 128, CW = 512, DFF = 2816, DFF2 = 5632;
constexpr int INC = 7184, NIN = 7424;
constexpr int O_Q = 0, O_K = 256, O_V = 512, O_G = 1024, O_A = 1536, O_SU = 1552, O_SV = 2064, O_CB = 2576, O_CC = 3088, O_CX = 3600, O_GT = 4112;
constexpr float EPS = 1e-6f;
}
using namespace cfg;

namespace pg8 {
#define PG8_LAS __attribute__((address_space(3)))
typedef unsigned short bf16_t;
typedef short bf16x8 __attribute__((ext_vector_type(8)));
typedef float f32x4 __attribute__((ext_vector_type(4)));
typedef unsigned u32x4 __attribute__((ext_vector_type(4)));
constexpr int BM = 256, BK = 64, HALF = 128, HTB = HALF * BK * 2  , STAGE_BYTES = 8 * HTB, NXCD = 8, WGM = 8;

__host__ __device__ __forceinline__ int lds_byte(int r, int c) { const int st = (r >> 4) * 2 + (c >> 5), rr = r & 15, cc = c & 31, ob = rr * 64 + cc * 2; return st * 1024 + (ob ^ (((ob >> 9) & 1) << 5)); }
__host__ __device__ __forceinline__ void stage_rc(int b, int& R, int& C) { const int st = b / 1024, sb = b % 1024, swz = sb ^ (((sb >> 9) & 1) << 5); R = (st >> 1) * 16 + swz / 64; C = (st & 1) * 32 + (swz % 64) / 2; }
__host__ __device__ __forceinline__ int perm32(int rho) { const int n = rho >> 4, i = rho & 15; return 8 * (i >> 2) + 4 * n + (i & 3); }

struct Unit { int pm, pn; };
struct Gemm { const bf16_t* A; const bf16_t* Bt; int M, N, K; };

struct StaticOrder {
    int nM, nN, nwg, G, c;
    __host__ __device__ void init(int M, int N, int G_, int c_) { nM = M / BM; nN = N / BM; nwg = nM * nN; G = G_; c = c_; }
    __host__ __device__ bool next(int i, Unit& u) const {
        const long L = (long)i * G + c; if (L >= nwg) return false;
        int wgid = (int)L; { const int q = nwg / NXCD, r = nwg % NXCD, xcd = wgid % NXCD, off = wgid / NXCD; wgid = (xcd < r ? xcd * (q + 1) : r * (q + 1) + (xcd - r) * q) + off; }
        const int nig = WGM * nN, gid = wgid / nig, fm = gid * WGM, gsz = (nM - fm) < WGM ? (nM - fm) : WGM;
        u.pm = fm + ((wgid % nig) % gsz); u.pn = (wgid % nig) / gsz; return true;
    }
    __device__ __forceinline__ void a_ready(const Unit&) const {}
    __device__ __forceinline__ void done(const Unit&) const {}
};

__device__ __forceinline__ unsigned cvt_pk_bf16(float lo, float hi) { unsigned r; asm volatile("v_cvt_pk_bf16_f32 %0, %1, %2" : "=v"(r) : "v"(lo), "v"(hi)); return r; }
typedef float f32x2 __attribute__((ext_vector_type(2)));
template <class Epi, class Sched, bool ALIGN_EPI = false, bool SP2 = false>
__device__ __forceinline__ void gemm_phase(PG8_LAS unsigned char* lds, const Gemm g, const Sched& S, const Epi& E, const int wave_id) {
    int ln__; asm volatile("v_mbcnt_lo_u32_b32 %0, -1, 0\n\tv_mbcnt_hi_u32_b32 %0, -1, %0" : "=v"(ln__));
    const int tid_ = ln__ + 64 * wave_id;
    const int tid = tid_, wid = __builtin_amdgcn_readfirstlane(tid >> 6), lane = tid & 63, wr = wid >> 2, wc = wid & 3, fr = lane & 15, fq = lane >> 4;
    const int K = g.K, nt = K / BK;
    unsigned voffA[2], voffB[2];
#pragma unroll
    for (int i = 0; i < 2; ++i) { int R, C; stage_rc(tid * 16 + i * 8192, R, C); const int Rb = Epi::PERM ? ((R & ~31) + perm32(R & 31)) : R;
        voffA[i] = (unsigned)(R * K + C) * 2u; voffB[i] = (unsigned)(Rb * K + C) * 2u; }
    const size_t kstep = (size_t)(BK * 2);
    const size_t hstep = (size_t)HALF * K * 2;
    const size_t tstep = 2 * hstep;
    const unsigned ldsw = (unsigned)wid * 1024u;
    const int aoff = lds_byte(wr * 64 + fr, fq * 8), boff = lds_byte(wc * 32 + fr, fq * 8);
#define PG8_SA(b, h) (((b) * 2 + (h)) * HTB)
#define PG8_SB(b, h) ((4 + (b) * 2 + (h)) * HTB)
#define PG8_STAGE(bufoff, gbase, voff) do { _Pragma("unroll") for (int _i = 0; _i < 2; ++_i) \
        __builtin_amdgcn_global_load_lds((const unsigned*)((const char*)(gbase) + (voff)[_i]), (PG8_LAS unsigned*)(lds + (bufoff) + ldsw + _i * 8192), 16, 0, 0); } while (0)
#define PG8_LDA(dst, b, h) do { _Pragma("unroll") for (int m = 0; m < 4; ++m) _Pragma("unroll") for (int k = 0; k < 2; ++k) dst[m][k] = *(const PG8_LAS bf16x8*)(lds + PG8_SA(b, h) + aoff + m * 2048 + k * 1024); } while (0)
#define PG8_LDB(dst, b, h) do { _Pragma("unroll") for (int n = 0; n < 2; ++n) _Pragma("unroll") for (int k = 0; k < 2; ++k) dst[n][k] = *(const PG8_LAS bf16x8*)(lds + PG8_SB(b, h) + boff + n * 2048 + k * 1024); } while (0)
#define PG8_MMA(ai, bj, At, Bt) do { __builtin_amdgcn_s_setprio(1); _Pragma("unroll") for (int m = 0; m < 4; ++m) _Pragma("unroll") for (int n = 0; n < 2; ++n) _Pragma("unroll") for (int k = 0; k < 2; ++k) \
        acc[ai][bj][m][n] = __builtin_amdgcn_mfma_f32_16x16x32_bf16(Bt[n][k], At[m][k], acc[ai][bj][m][n], 0, 0, 0); __builtin_amdgcn_s_setprio(0); } while (0)
#define PG8_WAIT_V(n) asm volatile("s_waitcnt vmcnt(" #n ")" ::: "memory")
#define PG8_WAIT_L(n) asm volatile("s_waitcnt lgkmcnt(" #n ")" ::: "memory")
#define PG8_BAR __builtin_amdgcn_s_barrier()
#define PG8_SCHED __builtin_amdgcn_sched_barrier(0)
    Unit cur, nxt; int ui = 0;
    if (!S.next(0, cur)) return;
    f32x4 acc[2][2][4][2];
#pragma unroll
    for (int a = 0; a < 2; ++a)
#pragma unroll
        for (int b = 0; b < 2; ++b)
#pragma unroll
            for (int m = 0; m < 4; ++m)
#pragma unroll
                for (int n = 0; n < 2; ++n) acc[a][b][m][n] = (f32x4){0.f, 0.f, 0.f, 0.f};
    bf16x8 At[4][2], B0[2][2], B1[2][2];
    const char* cA = (const char*)g.A + (size_t)cur.pm * tstep; const char* cB = (const char*)g.Bt + (size_t)cur.pn * tstep;
    S.a_ready(cur);
    if constexpr (SP2) {
        PG8_STAGE(PG8_SB(0, 0), cB, voffB); PG8_STAGE(PG8_SB(0, 1), cB + hstep, voffB); PG8_STAGE(PG8_SA(0, 0), cA, voffA); PG8_STAGE(PG8_SA(0, 1), cA + hstep, voffA);
        if (wr == 1) PG8_BAR;
        PG8_WAIT_V(2); PG8_BAR;
        PG8_STAGE(PG8_SB(1, 0), cB + kstep, voffB); PG8_STAGE(PG8_SA(1, 0), cA + kstep, voffA); PG8_STAGE(PG8_SB(1, 1), cB + hstep + kstep, voffB);
        PG8_WAIT_V(6); PG8_BAR;
    } else {
        PG8_STAGE(PG8_SB(0, 0), cB, voffB); PG8_STAGE(PG8_SA(0, 0), cA, voffA); PG8_STAGE(PG8_SB(0, 1), cB + hstep, voffB); PG8_STAGE(PG8_SA(0, 1), cA + hstep, voffA);
        if (wr == 1) PG8_BAR;
        PG8_WAIT_V(4); PG8_BAR;
        PG8_STAGE(PG8_SB(1, 0), cB + kstep, voffB); PG8_STAGE(PG8_SA(1, 0), cA + kstep, voffA); PG8_STAGE(PG8_SB(1, 1), cB + hstep + kstep, voffB);
        PG8_WAIT_V(6); PG8_BAR;
    }
    for (;;) {
        const bool has_next = S.next(ui + 1, nxt);
        const char* nA = has_next ? (const char*)g.A + (size_t)nxt.pm * tstep : cA; const char* nB = has_next ? (const char*)g.Bt + (size_t)nxt.pn * tstep : cB;
        for (int t = 0; t < nt; t += 2) {
            const bool last = (t == nt - 2);
            const char* a1 = cA + (size_t)(t + 1) * kstep;
            const char* a2 = last ? nA : cA + (size_t)(t + 2) * kstep; const char* b2 = last ? nB : cB + (size_t)(t + 2) * kstep;
            const char* a3 = a2 + kstep; const char* b3 = b2 + kstep;
            if (last && has_next) S.a_ready(nxt);
            if constexpr (SP2) {
            PG8_LDB(B0, 0, 0); PG8_LDB(B1, 0, 1); PG8_SCHED; PG8_LDA(At, 0, 0); PG8_STAGE(PG8_SA(1, 1), a1 + hstep, voffA);
            PG8_WAIT_V(8); PG8_WAIT_L(0); PG8_BAR; PG8_MMA(0, 0, At, B0); PG8_MMA(0, 1, At, B1); PG8_BAR; PG8_SCHED;
            PG8_LDA(At, 0, 1); PG8_STAGE(PG8_SB(0, 0), b2, voffB); PG8_STAGE(PG8_SB(0, 1), b2 + hstep, voffB); PG8_STAGE(PG8_SA(0, 0), a2, voffA);
            PG8_WAIT_V(8); PG8_WAIT_L(0); PG8_BAR; PG8_MMA(1, 0, At, B0); PG8_MMA(1, 1, At, B1); PG8_BAR; PG8_SCHED;
            PG8_LDB(B0, 1, 0); PG8_LDB(B1, 1, 1); PG8_SCHED; PG8_LDA(At, 1, 0); PG8_STAGE(PG8_SA(0, 1), a2 + hstep, voffA);
            PG8_WAIT_V(8); PG8_WAIT_L(0); PG8_BAR; PG8_MMA(0, 0, At, B0); PG8_MMA(0, 1, At, B1); PG8_BAR; PG8_SCHED;
            PG8_LDA(At, 1, 1); PG8_STAGE(PG8_SB(1, 0), b3, voffB); PG8_STAGE(PG8_SB(1, 1), b3 + hstep, voffB); PG8_STAGE(PG8_SA(1, 0), a3, voffA);
            PG8_WAIT_V(8); PG8_WAIT_L(0); PG8_BAR; PG8_MMA(1, 0, At, B0); PG8_MMA(1, 1, At, B1); PG8_BAR; PG8_SCHED;
            } else {
            PG8_LDB(B0, 0, 0); PG8_SCHED; PG8_LDA(At, 0, 0); PG8_STAGE(PG8_SA(1, 1), a1 + hstep, voffA);
            PG8_WAIT_L(8); PG8_BAR; PG8_WAIT_L(0); PG8_MMA(0, 0, At, B0); PG8_BAR; PG8_SCHED;
            PG8_LDB(B1, 0, 1); PG8_STAGE(PG8_SB(0, 0), b2, voffB);
            PG8_BAR; PG8_WAIT_L(0); PG8_MMA(0, 1, At, B1); PG8_BAR;
            PG8_LDA(At, 0, 1); PG8_STAGE(PG8_SA(0, 0), a2, voffA);
            PG8_BAR; PG8_WAIT_L(0); PG8_MMA(1, 0, At, B0); PG8_BAR; PG8_SCHED;
            PG8_STAGE(PG8_SB(0, 1), b2 + hstep, voffB);
            PG8_WAIT_V(6); PG8_BAR; PG8_MMA(1, 1, At, B1); PG8_BAR;
            PG8_LDB(B0, 1, 0); PG8_SCHED; PG8_LDA(At, 1, 0); PG8_STAGE(PG8_SA(0, 1), a2 + hstep, voffA);
            PG8_WAIT_L(8); PG8_BAR; PG8_WAIT_L(0); PG8_MMA(0, 0, At, B0); PG8_BAR; PG8_SCHED;
            PG8_LDB(B1, 1, 1); PG8_STAGE(PG8_SB(1, 0), b3, voffB);
            PG8_BAR; PG8_WAIT_L(0); PG8_MMA(0, 1, At, B1); PG8_BAR;
            PG8_LDA(At, 1, 1); PG8_STAGE(PG8_SA(1, 0), a3, voffA);
            PG8_BAR; PG8_WAIT_L(0); PG8_MMA(1, 0, At, B0); PG8_BAR; PG8_SCHED;
            PG8_STAGE(PG8_SB(1, 1), b3 + hstep, voffB);
            PG8_WAIT_V(6); PG8_BAR; PG8_MMA(1, 1, At, B1); PG8_BAR;
            }
        }
        if constexpr (ALIGN_EPI) { if (wr == 0) PG8_BAR; }
        if constexpr (!Epi::AFTER_DRAIN) { E(acc, cur, wr, wc, fr, fq); S.done(cur); }
        if (!has_next) break;
#pragma unroll
        for (int a = 0; a < 2; ++a)
#pragma unroll
            for (int b = 0; b < 2; ++b)
#pragma unroll
                for (int m = 0; m < 4; ++m)
#pragma unroll
                    for (int n = 0; n < 2; ++n) acc[a][b][m][n] = (f32x4){0.f, 0.f, 0.f, 0.f};
        cur = nxt; cA = nA; cB = nB; ++ui;
        if constexpr (ALIGN_EPI) { if (wr == 1) PG8_BAR; }
    }
    PG8_WAIT_V(0);
    if constexpr (!ALIGN_EPI) { if (wr == 0) PG8_BAR; }
    PG8_BAR;
    if constexpr (Epi::AFTER_DRAIN) { E.fused(acc, cur, wr, wc, fr, fq, lds, wid, lane); S.done(cur); }
#undef PG8_SA
#undef PG8_SB
#undef PG8_STAGE
#undef PG8_LDA
#undef PG8_LDB
#undef PG8_MMA
#undef PG8_WAIT_V
#undef PG8_WAIT_L
#undef PG8_BAR
#undef PG8_SCHED
}
}

#define GAS __attribute__((address_space(1)))
#define LAS __attribute__((address_space(3)))
typedef unsigned short bf16;
typedef unsigned v4u __attribute__((ext_vector_type(4)));
typedef unsigned v2u __attribute__((ext_vector_type(2)));
typedef float f32x4 __attribute__((ext_vector_type(4)));
typedef float f32x2 __attribute__((ext_vector_type(2)));
typedef short bf16x8 __attribute__((ext_vector_type(8)));
constexpr int NWAVES = 8, NTHREADS = 512;
constexpr int RING_BYTES = 131072, LDS_BYTES = 147456;

constexpr size_t MiB = 1u << 20;
constexpr size_t SL_WIN = 0, SL_WBR = SL_WIN + (size_t)NIN * D * 2, SL_WO = SL_WBR + (size_t)3 * D * 512 * 2, SL_WUP = SL_WO + (size_t)D * D * 2,
                 SL_WDN = SL_WUP + (size_t)DFF2 * D * 2, SL_SGW = SL_WDN + (size_t)D * DFF * 2, SL_END = SL_SGW + (size_t)4 * 128 * 128 * 2, SL_BYTES = 38 * MiB;
static_assert(SL_END <= SL_BYTES, "weight slot");
constexpr size_t WS_CTL = 0, WS_SLOT0 = 1 * MiB, WS_XB = WS_SLOT0 + 2 * SL_BYTES, WS_SSQ = WS_XB + 32 * MiB, WS_SVST = WS_SSQ + 1 * MiB, WS_ACT0 = WS_SVST + 1 * MiB;
constexpr size_t A_Q = 0, A_K = 8 * MiB, A_V = 16 * MiB, A_Z = 32 * MiB, A_SV = 80 * MiB, A_CC = 96 * MiB, A_CX = 112 * MiB, A_LOGA = 128 * MiB, A_G = 144 * MiB,
                 A_CST = 240 * MiB, A_DEC = 272 * MiB, A_END = 273 * MiB;
constexpr size_t A_MERGED = A_Q, A_HUP = 0, A_ACT = 176 * MiB, A_HT = 64 * MiB;
static_assert(A_ACT + (size_t)M * DFF * 2 <= A_END, "overlay");
constexpr size_t WS_END = WS_ACT0 + A_END;
constexpr int CW_BAR = 1024, CW_QHEAD = 6144, CW_FIN = 8192;

__device__ __forceinline__ float bf2f(unsigned h) { return __uint_as_float(h << 16); }
__device__ __forceinline__ unsigned pk2(float lo, float hi) { return pg8::cvt_pk_bf16(lo, hi); }
__device__ __forceinline__ float fsigmoid(float z) { return __builtin_amdgcn_rcpf(1.f + __expf(-z)); }
__device__ __forceinline__ float fsilu(float z) { return z * fsigmoid(z); }
__device__ __forceinline__ float fgelu(float z) { return z * fsigmoid(1.5957691216057308f * (z + 0.044715f * z * z * z)); }
__device__ __forceinline__ float flogsig(float z) { return fminf(z, 0.f) - __logf(1.f + __expf(-fabsf(z))); }
__device__ __forceinline__ float wave_sum(float v) {
#pragma unroll
    for (int o = 1; o < 64; o <<= 1) v += __shfl_xor(v, o);
    return v;
}
#define LDS_WAIT() asm volatile("s_waitcnt lgkmcnt(0)" ::: "memory")
__device__ __forceinline__ f32x4 mfma16(bf16x8 a, bf16x8 b, f32x4 c) { return __builtin_amdgcn_mfma_f32_16x16x32_bf16(a, b, c, 0, 0, 0); }

__device__ __forceinline__ void tr_write(bf16* WT, int K, int k0, LAS float* scr, int lane) {
    LDS_WAIT(); asm volatile("" ::: "memory");
    const int c = lane & 7;
#pragma unroll
    for (int j = 0; j < 4; ++j) { const int n = (lane >> 3) + 8 * j; const LAS float* s = scr + (8 * c) * 33 + n;
        v4u o; o.x = pk2(s[0 * 33], s[1 * 33]); o.y = pk2(s[2 * 33], s[3 * 33]); o.z = pk2(s[4 * 33], s[5 * 33]); o.w = pk2(s[6 * 33], s[7 * 33]);
        *(GAS v4u*)(WT + (size_t)n * K + k0 + 8 * c) = o; }
    LDS_WAIT(); asm volatile("" ::: "memory");
}
__device__ __forceinline__ void tr_item(const float* W, int ldw, int col0, const float* ksc, float sc, bf16* WT, int K, int k0, LAS float* scr, int lane) {
#pragma unroll 8
    for (int i = 0; i < 32; ++i) { const int kk = 2 * i + (lane >> 5); float v = W[(size_t)(k0 + kk) * ldw + col0 + (lane & 31)]; v *= ksc ? ksc[k0 + kk] * sc : sc; scr[kk * 33 + (lane & 31)] = v; }
    tr_write(WT, K, k0, scr, lane);
}
__device__ __forceinline__ void alpha_item(const float* win, const float* wal, const float* g, bf16* WT, int k0, int j0, LAS float* scr, int lane) {
    const int jj = lane & 31, half = lane >> 5; float wa[16];
#pragma unroll
    for (int r = 0; r < 16; ++r) wa[r] = wal[r * GKEY + j0 + jj];
    for (int i = 0; i < 32; ++i) { const int kk = 2 * i + half, k = k0 + kk; const float* wr = win + (size_t)k * INC + O_A; float s = 0.f;
#pragma unroll
        for (int r = 0; r < 16; ++r) s += wr[r] * wa[r];
        scr[kk * 33 + jj] = s * g[k]; }
    tr_write(WT + (size_t)j0 * D, D, k0, scr, lane);
}
struct Inputs { const float* p[21]; };
constexpr int CV_J0 = 16 * 224, CV_J1 = 16 * 8, CV_J2 = 3 * 8 * 32, CV_J3 = 16 * 32, CV_J4 = 16 * 176, CV_J5 = 44 * 32, CV_J6 = 128, CV_ITEMS = CV_J0 + CV_J1 + CV_J2 + CV_J3 + CV_J4 + CV_J5 + CV_J6;
constexpr int CV_WIN_ITEMS = CV_J0 + CV_J1;
__device__ __forceinline__ void convert_item(const Inputs& I, int l, unsigned char* slot, LAS float* scr, int it, int lane) {
    bf16* WIN = (bf16*)(slot + SL_WIN); bf16* WBR = (bf16*)(slot + SL_WBR); bf16* WO = (bf16*)(slot + SL_WO); bf16* WUP = (bf16*)(slot + SL_WUP); bf16* WDN = (bf16*)(slot + SL_WDN); bf16* SGWS = (bf16*)(slot + SL_SGW);
    const float* win = I.p[2] + (size_t)l * D * INC;
        int r = it;
        if (r < CV_J0) { const int kb = r / 224, nb = r % 224; const int drow = nb < 48 ? 32 * nb : 1792 + 32 * (nb - 48), scol = nb < 48 ? 32 * nb : O_SU + 32 * (nb - 48);
            tr_item(win, INC, scol, I.p[1] + (size_t)l * D, drow < 256 ? 0.125f : 1.f, WIN + (size_t)drow * D, D, 64 * kb, scr, lane); return; }
        r -= CV_J0;
        if (r < CV_J1) { const int kb = r / 8, jb = r % 8; alpha_item(win, I.p[3] + (size_t)l * GRANK * GKEY, I.p[1] + (size_t)l * D, WIN + (size_t)1536 * D, 64 * kb, 32 * jb, scr, lane); return; }
        r -= CV_J1;
        if (r < CV_J2) { const int br = r / 256, rr = r % 256, kb = rr / 32, nb = rr % 32;
            const float* W = (br == 0 ? I.p[6] : br == 1 ? I.p[11] : I.p[13]) + (size_t)l * 512 * D;
            tr_item(W, D, 32 * nb, br == 0 ? I.p[5] + (size_t)l * GVAL : nullptr, 1.f, WBR + ((size_t)br * D + 32 * nb) * 512, 512, 64 * kb, scr, lane); return; }
        r -= CV_J2;
        if (r < CV_J3) { const int kb = r / 32, nb = r % 32; tr_item(I.p[14] + (size_t)l * D * D, D, 32 * nb, nullptr, 1.f, WO + (size_t)32 * nb * D, D, 64 * kb, scr, lane); return; }
        r -= CV_J3;
        if (r < CV_J4) { const int kb = r / 176, nb = r % 176, pn = nb / 8, jb = nb % 8; const int scol = jb < 4 ? 128 * pn + 32 * jb : DFF + 128 * pn + 32 * (jb - 4);
            tr_item(I.p[16] + (size_t)l * D * DFF2, DFF2, scol, I.p[15] + (size_t)l * D, 1.f, WUP + (size_t)32 * nb * D, D, 64 * kb, scr, lane); return; }
        r -= CV_J4;
        if (r < CV_J5) { const int kb = r / 32, nb = r % 32; tr_item(I.p[19] + (size_t)l * DFF * D, D, 32 * nb, nullptr, 1.f, WDN + (size_t)32 * nb * DFF, DFF, 64 * kb, scr, lane); return; }
        r -= CV_J5;
        { const int e0 = r * 512 + lane * 8, t = (e0 >> 7) & 127, s0 = e0 & 127; const float* src = I.p[9] + (size_t)l * 4 * 128 * 128 + e0;
          const f32x4 a = *(const f32x4*)src, b = *(const f32x4*)(src + 4); float v[8] = {a[0], a[1], a[2], a[3], b[0], b[1], b[2], b[3]};
#pragma unroll
          for (int e = 0; e < 8; ++e) if (s0 + e > t) v[e] = 0.f;
          v4u o; o.x = pk2(v[0], v[1]); o.y = pk2(v[2], v[3]); o.z = pk2(v[4], v[5]); o.w = pk2(v[6], v[7]); *(GAS v4u*)(SGWS + e0) = o; }
}
__device__ __forceinline__ void convert_static(const Inputs& I, int l, unsigned char* slot, LAS unsigned char* lds, int it_lo, int it_hi, int gw, int ngw, int wave, int lane) {
    LAS float* scr = (LAS float*)(lds + wave * 8448);
    for (int it = it_lo + gw; it < it_hi; it += ngw) convert_item(I, l, slot, scr, it, lane);
}
#define RLX_AGENT __ATOMIC_RELAXED, __HIP_MEMORY_SCOPE_AGENT
__device__ __forceinline__ void convert_queue(const Inputs& I, int l, unsigned char* slot, LAS unsigned char* lds, unsigned* head, int it_lo, int it_hi, unsigned* fin, int G, int tid, int wave, int lane) {
    LAS float* scr = (LAS float*)(lds + wave * 8448); volatile LAS unsigned* bc = (volatile LAS unsigned*)(lds + 8 * 8448);
    for (;;) {
        if (tid == 0) { unsigned v = 0xffffffffu; if (!fin || __hip_atomic_load(fin, RLX_AGENT) < (unsigned)G) v = __hip_atomic_fetch_add(head, 8u, RLX_AGENT); bc[0] = v; }
        __syncthreads();
        const unsigned base = bc[0];
        __syncthreads();
        if (base >= (unsigned)(it_hi - it_lo)) break;
        const int it = it_lo + (int)base + wave; if (it < it_hi) convert_item(I, l, slot, scr, it, lane);
    }
}
__device__ __forceinline__ void x_prep(const float* xin, bf16* xb, float* ssq, int gw, int ngw, int lane) {
    for (int row = gw; row < M; row += ngw) {
        const GAS f32x4* xr = (const GAS f32x4*)(xin + (size_t)row * D) + lane; f32x4 v[4]; float s = 0.f;
#pragma unroll
        for (int j = 0; j < 4; ++j) { v[j] = xr[64 * j]; s += (v[j][0] * v[j][0] + v[j][1] * v[j][1]) + (v[j][2] * v[j][2] + v[j][3] * v[j][3]); }
        s = wave_sum(s);
#pragma unroll
        for (int j = 0; j < 4; ++j) { v2u w; w.x = pk2(v[j][0], v[j][1]); w.y = pk2(v[j][2], v[j][3]); ((GAS v2u*)(xb + (size_t)row * D))[lane + 64 * j] = w; }
        if (lane < 16) ssq[(size_t)row * 16 + lane] = lane == 0 ? s : 0.f;
    }
}
__device__ __forceinline__ void final_norm(const bf16* xb, float* out, const float* ssq, const float* g, int gw, int ngw, int lane) {
    for (int row = gw; row < M; row += ngw) {
        const float pv = lane < 16 ? ssq[(size_t)row * 16 + lane] : 0.f; const float rs = rsqrtf(wave_sum(pv) * (1.f / D) + EPS);
        const GAS v2u* xr = (const GAS v2u*)(xb + (size_t)row * D) + lane; GAS f32x4* orow = (GAS f32x4*)(out + (size_t)row * D) + lane;
#pragma unroll
        for (int j = 0; j < 4; ++j) { const v2u w = xr[64 * j]; const f32x4 gv = ((const GAS f32x4*)g)[lane + 64 * j];
            orow[64 * j] = (f32x4){bf2f(w.x & 0xffffu) * rs * gv[0], bf2f(w.x >> 16) * rs * gv[1], bf2f(w.y & 0xffffu) * rs * gv[2], bf2f(w.y >> 16) * rs * gv[3]}; }
    }
}

constexpr int GP = 72;
constexpr int L_QT = 0, L_KT = 9216, L_KENDT = 18432, L_VT = 27648, L_ST = 46080, L_SEG = 64512, L_DECS = 66560, L_RED = 66816, L_GLA_END = 67328;
constexpr int VP = 136;

__device__ __forceinline__ void sgu_item(int item, LAS unsigned char* lds, const bf16* ZBI, bf16* ZBO, const bf16* SV, const float* SVST, const float* lng, const float* lnb, const bf16* wsb, const float* bs, int wave, int lane) {
    const int h = item & 3, r0 = (item >> 2) * 128; LAS bf16* vnT = (LAS bf16*)lds;
    { const int d0 = 16 * wave, s0 = 2 * lane; float mean[2], rstd[2]; v4u xv[2][2];
#pragma unroll
      for (int rr = 0; rr < 2; ++rr) { const size_t row = (size_t)r0 + s0 + rr; const f32x4* p = (const f32x4*)(SVST + row * 16); const f32x4 a = p[0], b = p[1], c = p[2], d = p[3];
          const float sm = (a[0] + a[2]) + (b[0] + b[2]) + (c[0] + c[2]) + (d[0] + d[2]), sq = (a[1] + a[3]) + (b[1] + b[3]) + (c[1] + c[3]) + (d[1] + d[3]);
          mean[rr] = sm * (1.f / 512.f); rstd[rr] = rsqrtf(fmaxf(sq * (1.f / 512.f) - mean[rr] * mean[rr], 0.f) + EPS);
          const v4u* q = (const v4u*)(SV + row * 512 + h * 128 + d0); xv[rr][0] = q[0]; xv[rr][1] = q[1]; }
#pragma unroll
      for (int j = 0; j < 16; ++j) { const float g = lng[h * 128 + d0 + j], b = lnb[h * 128 + d0 + j]; const unsigned w0 = xv[0][j >> 3][(j >> 1) & 3], w1 = xv[1][j >> 3][(j >> 1) & 3];
          const float x0 = (j & 1) ? bf2f(w0 >> 16) : bf2f(w0 & 0xffffu), x1 = (j & 1) ? bf2f(w1 >> 16) : bf2f(w1 & 0xffffu);
          *(LAS unsigned*)(vnT + (d0 + j) * VP + s0) = pk2((x0 - mean[0]) * rstd[0] * g + b, (x1 - mean[1]) * rstd[1] * g + b); } }
    __syncthreads();
    { const int fr = lane & 15, fq = lane >> 4, t = 16 * wave + fr, nks = (wave >> 1) + 1; bf16x8 bfr[4];
#pragma unroll
      for (int ks = 0; ks < 4; ++ks) bfr[ks] = (ks < nks) ? *(const bf16x8*)(wsb + ((size_t)h * 128 + t) * 128 + 32 * ks + 8 * fq) : (bf16x8){0, 0, 0, 0, 0, 0, 0, 0};
      f32x4 acc[8];
#pragma unroll
      for (int m = 0; m < 8; ++m) { acc[m] = (f32x4){0.f, 0.f, 0.f, 0.f};
#pragma unroll
          for (int ks = 0; ks < 4; ++ks) if (ks < nks) { const bf16x8 a = *(const LAS bf16x8*)(vnT + (16 * m + fr) * VP + 32 * ks + 8 * fq); acc[m] = mfma16(a, bfr[ks], acc[m]); } }
      const size_t row = (size_t)r0 + t; const float bias = bs[h * 128 + t];
#pragma unroll
      for (int m = 0; m < 8; ++m) { const size_t po = row * 512 + h * 128 + 16 * m + 4 * fq; bf16* p = ZBO + po; const v2u su = *(const v2u*)(ZBI + po); v2u o;
          o.x = pk2(bf2f(su.x & 0xffffu) * (acc[m][0] + bias), bf2f(su.x >> 16) * (acc[m][1] + bias)); o.y = pk2(bf2f(su.y & 0xffffu) * (acc[m][2] + bias), bf2f(su.y >> 16) * (acc[m][3] + bias)); *(v2u*)p = o; } }
    __syncthreads();
}
__device__ __forceinline__ void convbr_item(int idx, const bf16* ZCI, bf16* ZCO, const bf16* CC, const bf16* CX, const float* cw) {
    const int c0 = (idx & 63) * 8, r0 = (idx >> 6) * 8; float w[3][8];
#pragma unroll
    for (int k = 0; k < 3; ++k) { const f32x4 a = *(const f32x4*)(cw + k * CW + c0), b = *(const f32x4*)(cw + k * CW + c0 + 4);
#pragma unroll
        for (int e = 0; e < 4; ++e) { w[k][e] = a[e]; w[k][4 + e] = b[e]; } }
    float u2[8], u1[8];
    auto loadu = [&](int row, float (&u)[8]) { const v4u a = *(const v4u*)(CC + (size_t)row * CW + c0), b = *(const v4u*)(CX + (size_t)row * CW + c0);
#pragma unroll
        for (int e = 0; e < 4; ++e) { u[2 * e] = bf2f(a[e] & 0xffffu) * bf2f(b[e] & 0xffffu); u[2 * e + 1] = bf2f(a[e] >> 16) * bf2f(b[e] >> 16); } };
    if ((r0 & (SEQ - 1)) == 0) {
#pragma unroll
        for (int e = 0; e < 8; ++e) { u2[e] = 0.f; u1[e] = 0.f; } }
    else { loadu(r0 - 2, u2); loadu(r0 - 1, u1); }
#pragma unroll
    for (int i = 0; i < 8; ++i) { float u0[8]; loadu(r0 + i, u0); const size_t po = (size_t)(r0 + i) * CW + c0; bf16* p = ZCO + po; const v4u cb = *(const v4u*)(ZCI + po); float z[8];
#pragma unroll
        for (int e = 0; e < 8; ++e) { const float y = w[0][e] * u2[e] + w[1][e] * u1[e] + w[2][e] * u0[e]; const float c = (e & 1) ? bf2f(cb[e >> 1] >> 16) : bf2f(cb[e >> 1] & 0xffffu); z[e] = c * y; u2[e] = u1[e]; u1[e] = u0[e]; }
        v4u o; o.x = pk2(z[0], z[1]); o.y = pk2(z[2], z[3]); o.z = pk2(z[4], z[5]); o.w = pk2(z[6], z[7]); *(v4u*)p = o; }
}
template <bool FULL> __device__ __forceinline__ float gla_stage(LAS unsigned char* lds, size_t r0, int h, const bf16* Q, const bf16* KK, const bf16* V, const float* LOGA, int tid) {
    const int kcol = tid & 63, seg = tid >> 6; LAS float* SEG = (LAS float*)(lds + L_SEG);
    float p[8]; unsigned kq[8], qq[8];
#pragma unroll
    for (int j = 0; j < 8; ++j) { const size_t row = r0 + 8 * seg + j; p[j] = LOGA[row * GKEY + h * 64 + kcol]; kq[j] = KK[row * GKEY + h * 64 + kcol]; if (FULL) qq[j] = Q[row * GKEY + h * 64 + kcol]; }
#pragma unroll
    for (int j = 1; j < 8; ++j) p[j] += p[j - 1];
    SEG[seg * 64 + kcol] = p[7];
    { const int tp = tid & 31, vg = tid >> 5; LAS bf16* VT = (LAS bf16*)(lds + L_VT);
      const v4u a = *(const v4u*)(V + (r0 + 2 * tp) * GVAL + h * 128 + 8 * vg), b = *(const v4u*)(V + (r0 + 2 * tp + 1) * GVAL + h * 128 + 8 * vg);
#pragma unroll
      for (int e = 0; e < 4; ++e) { *(LAS unsigned*)(VT + (8 * vg + 2 * e) * GP + 2 * tp) = (a[e] & 0xffffu) | (b[e] << 16); *(LAS unsigned*)(VT + (8 * vg + 2 * e + 1) * GP + 2 * tp) = (a[e] >> 16) | (b[e] & 0xffff0000u); } }
    __syncthreads();
    float off = 0.f, tot = 0.f;
#pragma unroll
    for (int s = 0; s < 8; ++s) { const float v = SEG[s * 64 + kcol]; tot += v; if (s < seg) off += v; }
    float ke[8];
#pragma unroll
    for (int j = 0; j < 8; ++j) { const float b = off + p[j], kf = bf2f(kq[j]); ke[j] = kf * __expf(tot - b);
        if (FULL) { const int t = 8 * seg + j; ((LAS bf16*)(lds + L_QT))[t * GP + kcol] = (bf16)(pk2(bf2f(qq[j]) * __expf(b), 0.f) & 0xffffu); ((LAS bf16*)(lds + L_KT))[t * GP + kcol] = (bf16)(pk2(kf * __expf(-b), 0.f) & 0xffffu); } }
    v4u o; o.x = pk2(ke[0], ke[1]); o.y = pk2(ke[2], ke[3]); o.z = pk2(ke[4], ke[5]); o.w = pk2(ke[6], ke[7]);
    *(LAS v4u*)((LAS bf16*)(lds + L_KENDT) + kcol * GP + 8 * seg) = o;
    return __expf(tot);
}
__device__ __forceinline__ void gla_b1_item(int item, LAS unsigned char* lds, const bf16* KK, const bf16* V, const float* LOGA, float* CST, float* DEC, int tid, int wave, int lane) {
    const int h = item & 3; const size_t r0 = (size_t)(item >> 2) * 64;
    const float dec = gla_stage<false>(lds, r0, h, nullptr, KK, V, LOGA, tid);
    if (tid < 64) DEC[(size_t)item * 64 + tid] = dec;
    __syncthreads();
    const int fr = lane & 15, fq = lane >> 4; const LAS bf16* VT = (const LAS bf16*)(lds + L_VT); const LAS bf16* KE = (const LAS bf16*)(lds + L_KENDT);
    bf16x8 bv[2];
#pragma unroll
    for (int ks = 0; ks < 2; ++ks) bv[ks] = *(const LAS bf16x8*)(VT + (16 * wave + fr) * GP + 32 * ks + 8 * fq);
#pragma unroll
    for (int m = 0; m < 4; ++m) { f32x4 acc = (f32x4){0.f, 0.f, 0.f, 0.f};
#pragma unroll
        for (int ks = 0; ks < 2; ++ks) acc = mfma16(*(const LAS bf16x8*)(KE + (16 * m + fr) * GP + 32 * ks + 8 * fq), bv[ks], acc);
        *(f32x4*)(CST + (size_t)item * 8192 + (16 * wave + fr) * 64 + 16 * m + 4 * fq) = acc; }
    __syncthreads();
}
__device__ __forceinline__ void gla_b2_unit(int unit, LAS unsigned char* lds, const bf16* Q, const bf16* KK, const bf16* V, const float* LOGA, const float* CST, const float* DEC, const bf16* ZAI, bf16* ZAO, int tid, int wave, int lane) {
    const int g = unit & 7, h = (unit >> 3) & 3, b = unit >> 5, fr = lane & 15, fq = lane >> 4;
    f32x4 S[4];
#pragma unroll
    for (int m = 0; m < 4; ++m) S[m] = (f32x4){0.f, 0.f, 0.f, 0.f};
    for (int j = 0; j < 4 * g; ++j) { const size_t it = ((size_t)(b * 32 + j) * 4 + h); const float* cp = CST + it * 8192 + (16 * wave + fr) * 64 + 4 * fq; const float* dp = DEC + it * 64 + 4 * fq;
#pragma unroll
        for (int m = 0; m < 4; ++m) { const f32x4 c = *(const f32x4*)(cp + 16 * m), d = *(const f32x4*)(dp + 16 * m); S[m] = d * S[m] + c; } }
    const LAS bf16* QT = (const LAS bf16*)(lds + L_QT); const LAS bf16* KT = (const LAS bf16*)(lds + L_KT); const LAS bf16* KE = (const LAS bf16*)(lds + L_KENDT);
    const LAS bf16* VT = (const LAS bf16*)(lds + L_VT); LAS bf16* ST = (LAS bf16*)(lds + L_ST); LAS float* DECS = (LAS float*)(lds + L_DECS); LAS float* RED = (LAS float*)(lds + L_RED);
    const int ih = wave & 3, vh = wave >> 2;
    for (int c = 0; c < 4; ++c) {
        const size_t r0 = (size_t)b * SEQ + (size_t)(4 * g + c) * 64;
#pragma unroll
        for (int m = 0; m < 4; ++m) { v2u w; w.x = pk2(S[m][0], S[m][1]); w.y = pk2(S[m][2], S[m][3]); *(LAS v2u*)(ST + (16 * wave + fr) * GP + 16 * m + 4 * fq) = w; }
        const float dec = gla_stage<true>(lds, r0, h, Q, KK, V, LOGA, tid);
        if (tid < 64) DECS[tid] = dec;
        __syncthreads();
        bf16x8 bq[2];
#pragma unroll
        for (int ks = 0; ks < 2; ++ks) bq[ks] = *(const LAS bf16x8*)(QT + (16 * ih + fr) * GP + 32 * ks + 8 * fq);
        f32x4 X[4];
#pragma unroll
        for (int jt = 0; jt < 4; ++jt) { X[jt] = (f32x4){0.f, 0.f, 0.f, 0.f};
            if (jt <= ih) {
#pragma unroll
                for (int ks = 0; ks < 2; ++ks) X[jt] = mfma16(*(const LAS bf16x8*)(KT + (16 * jt + fr) * GP + 32 * ks + 8 * fq), bq[ks], X[jt]);
#pragma unroll
                for (int r = 0; r < 4; ++r) if (16 * jt + 4 * fq + r > 16 * ih + fr) X[jt][r] = 0.f; } }
        bf16x8 xb[2];
#pragma unroll
        for (int k2 = 0; k2 < 2; ++k2) { v4u w; w.x = pk2(X[2 * k2][0], X[2 * k2][1]); w.y = pk2(X[2 * k2][2], X[2 * k2][3]); w.z = pk2(X[2 * k2 + 1][0], X[2 * k2 + 1][1]); w.w = pk2(X[2 * k2 + 1][2], X[2 * k2 + 1][3]); xb[k2] = __builtin_bit_cast(bf16x8, w); }
        f32x4 O[4]; float ss = 0.f;
#pragma unroll
        for (int mt = 0; mt < 4; ++mt) { const int v = 64 * vh + 16 * mt + fr; f32x4 o = (f32x4){0.f, 0.f, 0.f, 0.f};
#pragma unroll
            for (int k2 = 0; k2 < 2; ++k2) { const v2u lo = *(const LAS v2u*)(VT + v * GP + 32 * k2 + 4 * fq), hi = *(const LAS v2u*)(VT + v * GP + 32 * k2 + 16 + 4 * fq); v4u a; a.x = lo.x; a.y = lo.y; a.z = hi.x; a.w = hi.y;
                o = mfma16(__builtin_bit_cast(bf16x8, a), xb[k2], o); }
#pragma unroll
            for (int ks = 0; ks < 2; ++ks) o = mfma16(*(const LAS bf16x8*)(ST + v * GP + 32 * ks + 8 * fq), bq[ks], o);
            O[mt] = o; ss += (o[0] * o[0] + o[1] * o[1]) + (o[2] * o[2] + o[3] * o[3]); }
        ss += __shfl_xor(ss, 16); ss += __shfl_xor(ss, 32);
        if (fq == 0) RED[(vh * 4 + ih) * 16 + fr] = ss;
        __syncthreads();
        const float rs = rsqrtf((RED[ih * 16 + fr] + RED[(4 + ih) * 16 + fr]) * (1.f / 128.f) + EPS);
        { const size_t row = r0 + 16 * ih + fr;
#pragma unroll
          for (int mt = 0; mt < 4; ++mt) { const size_t po = row * GVAL + h * 128 + 64 * vh + 16 * mt + 4 * fq; bf16* p = ZAO + po; const v2u gt = *(const v2u*)(ZAI + po); v2u o;
              o.x = pk2(O[mt][0] * rs * bf2f(gt.x & 0xffffu), O[mt][1] * rs * bf2f(gt.x >> 16)); o.y = pk2(O[mt][2] * rs * bf2f(gt.y & 0xffffu), O[mt][3] * rs * bf2f(gt.y >> 16)); *(v2u*)p = o; } }
        bf16x8 bv[2];
#pragma unroll
        for (int ks = 0; ks < 2; ++ks) bv[ks] = *(const LAS bf16x8*)(VT + (16 * wave + fr) * GP + 32 * ks + 8 * fq);
#pragma unroll
        for (int m = 0; m < 4; ++m) { const f32x4 d = *(const LAS f32x4*)(DECS + 16 * m + 4 * fq); S[m] = S[m] * d;
#pragma unroll
            for (int ks = 0; ks < 2; ++ks) S[m] = mfma16(*(const LAS bf16x8*)(KE + (16 * m + fr) * GP + 32 * ks + 8 * fq), bv[ks], S[m]); }
        __syncthreads();
    }
}
__device__ __forceinline__ void ffn_act_item(int idx, const bf16* HUP, bf16* ACT, const float* cw, const float* cb) {
    const int cgp = idx % 352, rb = idx / 352, pn = cgp >> 4, c8 = (cgp & 15) * 8, j0 = 128 * pn + c8, r0 = rb * 16;
    float wg[3][8], wv[3][8], bg[8], bv[8];
#pragma unroll
    for (int e = 0; e < 8; ++e) { bg[e] = cb[j0 + e]; bv[e] = cb[DFF + j0 + e];
#pragma unroll
        for (int k = 0; k < 3; ++k) { wg[k][e] = cw[k * DFF2 + j0 + e]; wv[k][e] = cw[k * DFF2 + DFF + j0 + e]; } }
    float g2[8], g1[8], v2[8], v1[8];
    auto ld = [&](int row, float (&g)[8], float (&v)[8]) { const bf16* p = HUP + (size_t)row * DFF2 + 256 * pn + c8; const v4u a = *(const v4u*)p, b = *(const v4u*)(p + 128);
#pragma unroll
        for (int e = 0; e < 4; ++e) { g[2 * e] = bf2f(a[e] & 0xffffu); g[2 * e + 1] = bf2f(a[e] >> 16); v[2 * e] = bf2f(b[e] & 0xffffu); v[2 * e + 1] = bf2f(b[e] >> 16); } };
    if ((r0 & (SEQ - 1)) == 0) {
#pragma unroll
        for (int e = 0; e < 8; ++e) { g2[e] = 0.f; g1[e] = 0.f; v2[e] = 0.f; v1[e] = 0.f; } }
    else { ld(r0 - 2, g2, v2); ld(r0 - 1, g1, v1); }
    for (int i = 0; i < 16; ++i) { float g0[8], v0[8]; ld(r0 + i, g0, v0); float z[8];
#pragma unroll
        for (int e = 0; e < 8; ++e) { const float ga = wg[0][e] * g2[e] + wg[1][e] * g1[e] + wg[2][e] * g0[e] + bg[e], va = wv[0][e] * v2[e] + wv[1][e] * v1[e] + wv[2][e] * v0[e] + bv[e];
            z[e] = fsilu(ga) * va; g2[e] = g1[e]; g1[e] = g0[e]; v2[e] = v1[e]; v1[e] = v0[e]; }
        v4u o; o.x = pk2(z[0], z[1]); o.y = pk2(z[2], z[3]); o.z = pk2(z[4], z[5]); o.w = pk2(z[6], z[7]); *(v4u*)(ACT + (size_t)(r0 + i) * DFF + j0) = o; }
}

using pg8::Unit;
__device__ __forceinline__ void row_rstd(const float* SSQ, int pm, int wr, int fr, int fq, float (&rsd)[2][4]) {
    const int lane = fr + 16 * fq;
#pragma unroll
    for (int ai = 0; ai < 2; ++ai) { const size_t row = (size_t)pm * 256 + ai * 128 + wr * 64 + lane; const f32x4* p = (const f32x4*)(SSQ + row * 16); const f32x4 a = p[0], b = p[1], c = p[2], d = p[3];
        const float s = ((a[0] + a[1]) + (a[2] + a[3])) + ((b[0] + b[1]) + (b[2] + b[3])) + ((c[0] + c[1]) + (c[2] + c[3])) + ((d[0] + d[1]) + (d[2] + d[3]));
        const float rs = rsqrtf(s * (1.f / D) + EPS);
#pragma unroll
        for (int m = 0; m < 4; ++m) rsd[ai][m] = __shfl(rs, 16 * m + fr); }
}
struct EpiA {
    static constexpr bool PERM = true, AFTER_DRAIN = false;
    unsigned char* act0; const float* SSQ; float* SVST; const float* bal;
    __device__ __forceinline__ void operator()(const f32x4 (&acc)[2][2][4][2], const Unit& u, int wr, int wc, int fr_, int fq_) const {
        int ln_; asm volatile("v_mbcnt_lo_u32_b32 %0, -1, 0\n\tv_mbcnt_hi_u32_b32 %0, -1, %0" : "=v"(ln_)); const int fr = ln_ & 15, fq = ln_ >> 4; (void)fr_; (void)fq_;
        float rsd[2][4]; row_rstd(SSQ, u.pm, wr, fr, fq, rsd);
        const int pn = u.pn; int mode, ldc, colt; size_t boff;
        if (pn < 1) { mode = 0; boff = A_Q; ldc = 256; colt = 0; } else if (pn < 2) { mode = 0; boff = A_K; ldc = 256; colt = 0; } else if (pn < 4) { mode = 0; boff = A_V; ldc = 512; colt = (pn - 2) * 256; }
        else if (pn < 6) { mode = 1; boff = A_Z; ldc = 512; colt = (pn - 4) * 256; } else if (pn < 7) { mode = 4; boff = A_LOGA; ldc = 256; colt = 0; }
        else if (pn < 9) { mode = 2; boff = A_Z + (size_t)M * 512 * 2; ldc = 512; colt = (pn - 7) * 256; } else if (pn < 11) { mode = 3; boff = A_SV; ldc = 512; colt = (pn - 9) * 256; }
        else if (pn < 13) { mode = 0; boff = A_Z + (size_t)2 * M * 512 * 2; ldc = 512; colt = (pn - 11) * 256; } else if (pn < 15) { mode = 0; boff = A_CC; ldc = 512; colt = (pn - 13) * 256; }
        else if (pn < 17) { mode = 0; boff = A_CX; ldc = 512; colt = (pn - 15) * 256; } else { mode = 5; boff = A_G; ldc = 3072; colt = (pn - 17) * 256; }
        const int col0 = colt + wc * 32 + 8 * fq;
#pragma unroll
        for (int ai = 0; ai < 2; ++ai)
#pragma unroll
            for (int m = 0; m < 4; ++m) { const size_t row = (size_t)u.pm * 256 + ai * 128 + wr * 64 + m * 16 + fr; const float rs = rsd[ai][m]; float s1 = 0.f, s2 = 0.f;
#pragma unroll
                for (int bj = 0; bj < 2; ++bj) { const f32x4 a0 = acc[ai][bj][m][0] * rs, a1 = acc[ai][bj][m][1] * rs; float v[8] = {a0[0], a0[1], a0[2], a0[3], a1[0], a1[1], a1[2], a1[3]};
                    if (mode == 4) { const f32x4 b0 = *(const f32x4*)(bal + col0 + bj * 128), b1 = *(const f32x4*)(bal + col0 + bj * 128 + 4); f32x4 o0, o1;
#pragma unroll
                        for (int e = 0; e < 4; ++e) { o0[e] = flogsig(v[e] + b0[e]) * 0.0625f; o1[e] = flogsig(v[4 + e] + b1[e]) * 0.0625f; }
                        float* p = (float*)(act0 + boff) + row * 256 + col0 + bj * 128; *(f32x4*)p = o0; *(f32x4*)(p + 4) = o1; }
                    else {
                        if (mode == 1) {
#pragma unroll
                            for (int e = 0; e < 8; ++e) v[e] = fsilu(v[e]); }
                        else if (mode == 2 || mode == 3) {
#pragma unroll
                            for (int e = 0; e < 8; ++e) v[e] = fgelu(v[e]); }
                        else if (mode == 5) {
#pragma unroll
                            for (int e = 0; e < 8; ++e) v[e] = fsigmoid(v[e]); }
                        if (mode == 3) {
#pragma unroll
                            for (int e = 0; e < 8; ++e) { s1 += v[e]; s2 += v[e] * v[e]; } }
                        v4u o; o.x = pk2(v[0], v[1]); o.y = pk2(v[2], v[3]); o.z = pk2(v[4], v[5]); o.w = pk2(v[6], v[7]);
                        *(v4u*)((bf16*)(act0 + boff) + row * ldc + col0 + bj * 128) = o; } }
                if (mode == 3) { s1 += __shfl_xor(s1, 16); s1 += __shfl_xor(s1, 32); s2 += __shfl_xor(s2, 16); s2 += __shfl_xor(s2, 32);
                    if (fq == 0) *(f32x2*)(SVST + row * 16 + ((pn - 9) * 4 + wc) * 2) = (f32x2){s1, s2}; } }
    }
};
struct EpiC {
    static constexpr bool PERM = true, AFTER_DRAIN = false;
    const bf16* G; bf16* MG;
    __device__ __forceinline__ void operator()(const f32x4 (&acc)[2][2][4][2], const Unit& u, int wr, int wc, int fr_, int fq_) const {
        int ln_; asm volatile("v_mbcnt_lo_u32_b32 %0, -1, 0\n\tv_mbcnt_hi_u32_b32 %0, -1, %0" : "=v"(ln_)); const int fr = ln_ & 15, fq = ln_ >> 4; (void)fr_; (void)fq_;
        const int br = u.pm >> 6, pm = u.pm & 63, pn = u.pn & 3; const int col0 = pn * 256 + wc * 32 + 8 * fq;
#pragma unroll
        for (int ai = 0; ai < 2; ++ai)
#pragma unroll
            for (int m = 0; m < 4; ++m) { const size_t row = (size_t)pm * 256 + ai * 128 + wr * 64 + m * 16 + fr;
#pragma unroll
                for (int bj = 0; bj < 2; ++bj) { const f32x4 a0 = acc[ai][bj][m][0], a1 = acc[ai][bj][m][1]; float v[8] = {a0[0], a0[1], a0[2], a0[3], a1[0], a1[1], a1[2], a1[3]};
                    const v4u gt = *(const v4u*)(G + row * 3072 + br * 1024 + col0 + bj * 128); bf16* mp = MG + row * 1024 + col0 + bj * 128;
#pragma unroll
                    for (int e = 0; e < 4; ++e) { v[2 * e] *= bf2f(gt[e] & 0xffffu); v[2 * e + 1] *= bf2f(gt[e] >> 16); }
                    if (br != 0) { const v4u old = *(const v4u*)mp;
#pragma unroll
                        for (int e = 0; e < 4; ++e) { v[2 * e] += bf2f(old[e] & 0xffffu); v[2 * e + 1] += bf2f(old[e] >> 16); } }
                    v4u o; o.x = pk2(v[0], v[1]); o.y = pk2(v[2], v[3]); o.z = pk2(v[4], v[5]); o.w = pk2(v[6], v[7]); *(v4u*)mp = o; } }
    }
};
struct BranchOrder {
    int G, c;
    __device__ bool next(int i, Unit& u) const { const int j = i / 3, br = i - 3 * j, T = c + G * j; if (T >= 256) return false;
        const int w = (T & 7) * 32 + (T >> 3), pm = (w >> 5) * 8 + (w & 7), pn = (w & 31) >> 3; u.pm = br * 64 + pm; u.pn = br * 4 + pn; return true; }
    __device__ __forceinline__ void a_ready(const Unit&) const {}
    __device__ __forceinline__ void done(const Unit&) const {}
};
struct EpiRes {
    static constexpr bool PERM = true, AFTER_DRAIN = false;
    const bf16* XI; bf16* XB; float* SSQ;
    __device__ __forceinline__ void operator()(const f32x4 (&acc)[2][2][4][2], const Unit& u, int wr, int wc, int fr_, int fq_) const {
        int ln_; asm volatile("v_mbcnt_lo_u32_b32 %0, -1, 0\n\tv_mbcnt_hi_u32_b32 %0, -1, %0" : "=v"(ln_)); const int fr = ln_ & 15, fq = ln_ >> 4; (void)fr_; (void)fq_;
        const int col0 = u.pn * 256 + wc * 32 + 8 * fq;
#pragma unroll
        for (int ai = 0; ai < 2; ++ai)
#pragma unroll
            for (int m = 0; m < 4; ++m) { const size_t row = (size_t)u.pm * 256 + ai * 128 + wr * 64 + m * 16 + fr; float ss = 0.f;
#pragma unroll
                for (int bj = 0; bj < 2; ++bj) { const size_t off = row * D + col0 + bj * 128; const v4u xo = *(const v4u*)(XI + off); const f32x4 a0 = acc[ai][bj][m][0], a1 = acc[ai][bj][m][1];
                    float v[8] = {a0[0], a0[1], a0[2], a0[3], a1[0], a1[1], a1[2], a1[3]};
#pragma unroll
                    for (int e = 0; e < 4; ++e) { v[2 * e] += bf2f(xo[e] & 0xffffu); v[2 * e + 1] += bf2f(xo[e] >> 16); }
#pragma unroll
                    for (int e = 0; e < 8; ++e) ss += v[e] * v[e];
                    v4u o; o.x = pk2(v[0], v[1]); o.y = pk2(v[2], v[3]); o.z = pk2(v[4], v[5]); o.w = pk2(v[6], v[7]); *(v4u*)(XB + off) = o; }
                ss += __shfl_xor(ss, 16); ss += __shfl_xor(ss, 32);
                if (fq == 0) SSQ[row * 16 + u.pn * 4 + wc] = ss; }
    }
};
struct EpiUp {
    static constexpr bool PERM = true, AFTER_DRAIN = false;
    bf16* HUP; const float* SSQ;
    __device__ __forceinline__ void operator()(const f32x4 (&acc)[2][2][4][2], const Unit& u, int wr, int wc, int fr_, int fq_) const {
        int ln_; asm volatile("v_mbcnt_lo_u32_b32 %0, -1, 0\n\tv_mbcnt_hi_u32_b32 %0, -1, %0" : "=v"(ln_)); const int fr = ln_ & 15, fq = ln_ >> 4; (void)fr_; (void)fq_;
        float rsd[2][4]; row_rstd(SSQ, u.pm, wr, fr, fq, rsd);
        const int col0 = u.pn * 256 + wc * 32 + 8 * fq;
#pragma unroll
        for (int ai = 0; ai < 2; ++ai)
#pragma unroll
            for (int m = 0; m < 4; ++m) { const size_t row = (size_t)u.pm * 256 + ai * 128 + wr * 64 + m * 16 + fr; const float rs = rsd[ai][m];
#pragma unroll
                for (int bj = 0; bj < 2; ++bj) { const f32x4 a0 = acc[ai][bj][m][0] * rs, a1 = acc[ai][bj][m][1] * rs;
                    v4u o; o.x = pk2(a0[0], a0[1]); o.y = pk2(a0[2], a0[3]); o.z = pk2(a1[0], a1[1]); o.w = pk2(a1[2], a1[3]); *(v4u*)(HUP + row * DFF2 + col0 + bj * 128) = o; } }
    }
};

__device__ __forceinline__ float dpp_f(float old, float src, const int ctrl_sel) {
    const int o = __builtin_bit_cast(int, old), v = __builtin_bit_cast(int, src); int r;
    if (ctrl_sel == 0) r = __builtin_amdgcn_update_dpp(o, v, 0x111, 0xf, 0xf, false);
    else if (ctrl_sel == 1) r = __builtin_amdgcn_update_dpp(o, v, 0x112, 0xf, 0xf, false);
    else if (ctrl_sel == 2) r = __builtin_amdgcn_update_dpp(o, v, 0x121, 0xf, 0xf, false);
    else r = __builtin_amdgcn_update_dpp(o, v, 0x122, 0xf, 0xf, false);
    return __builtin_bit_cast(float, r);
}
constexpr int XL_OFF = RING_BYTES + 1024;
struct EpiUpConv {
    static constexpr bool PERM = true, AFTER_DRAIN = false;
    unsigned char* ws; const float* cw; const float* cb; LAS unsigned char* lds;
    __device__ __forceinline__ void operator()(const f32x4 (&acc)[2][2][4][2], const Unit& u, int wr, int wc, int fr_, int fq_) const {
        int ln_; asm volatile("v_mbcnt_lo_u32_b32 %0, -1, 0\n\tv_mbcnt_hi_u32_b32 %0, -1, %0" : "=v"(ln_)); const int fr = ln_ & 15, fq = ln_ >> 4; (void)fr_; (void)fq_;
        bf16* ACT = (bf16*)(ws + WS_ACT0 + A_ACT); const float* SSQ = (const float*)(ws + WS_SSQ); float* HT = (float*)(ws + WS_ACT0 + A_HT);
        float rsd[2][4]; row_rstd(SSQ, u.pm, wr, fr, fq, rsd);
        LAS f32x4* XL = (LAS f32x4*)(lds + XL_OFF);
        const int tcol = u.pn * 256 + wc * 32 + 8 * fq;
#pragma unroll
        for (int ai = 0; ai < 2; ++ai)
#pragma unroll
            for (int bj = 0; bj < 2; ++bj)
#pragma unroll
                for (int n = 0; n < 2; ++n) {
                    if (fr >= 14) { const f32x4 h = acc[ai][bj][3][n] * rsd[ai][3]; XL[((((ai * 2 + wr) * 4 + wc) * 2 + bj) * 2 + n) * 8 + fq * 2 + (fr - 14)] = h;
                        if (ai == 1 && wr == 1) *(f32x4*)(HT + ((size_t)(u.pm * 2 + 1) * 2 + (fr - 14)) * DFF2 + tcol + bj * 128 + 4 * n) = h; }
                    if (ai == 0 && wr == 0 && fr < 2) *(f32x4*)(HT + ((size_t)(u.pm * 2 + 0) * 2 + fr) * DFF2 + tcol + bj * 128 + 4 * n) = acc[0][bj][0][n] * rsd[0][0]; }
        asm volatile("s_waitcnt lgkmcnt(0)" ::: "memory"); __builtin_amdgcn_s_barrier(); asm volatile("" ::: "memory");
        const int ch0 = u.pn * 128 + wc * 32 + 8 * fq; const bool batch_start = (u.pm & 7) == 0;
#pragma unroll
        for (int n = 0; n < 2; ++n) {
            asm volatile("" ::: "memory");
            f32x4 wg[3], wv[3];
#pragma unroll
            for (int k = 0; k < 3; ++k) { wg[k] = *(const f32x4*)(cw + k * DFF2 + ch0 + 4 * n); wv[k] = *(const f32x4*)(cw + k * DFF2 + DFF + ch0 + 4 * n); }
            const f32x4 bg = *(const f32x4*)(cb + ch0 + 4 * n), bv = *(const f32x4*)(cb + DFF + ch0 + 4 * n);
#pragma unroll
            for (int ai = 0; ai < 2; ++ai) {
                f32x4 hgp, hvp;
                { f32x4 pg14 = (f32x4){0.f, 0.f, 0.f, 0.f}, pg15 = pg14, pv14 = pg14, pv15 = pg14;
                  if (!(ai == 0 && wr == 0)) { const int pb = ai * 2 + wr - 1; const LAS f32x4* q = XL + ((((pb * 4 + wc) * 2 + 0) * 2 + n) * 8 + fq * 2); const LAS f32x4* qv = XL + ((((pb * 4 + wc) * 2 + 1) * 2 + n) * 8 + fq * 2);
                      pg14 = q[0]; pg15 = q[1]; pv14 = qv[0]; pv15 = qv[1]; }
                  hgp = (fr == 14) ? pg14 : pg15; hvp = (fr == 14) ? pv14 : pv15; }
#pragma unroll
                for (int m = 0; m < 4; ++m) { const f32x4 hg = acc[ai][0][m][n] * rsd[ai][m], hv = acc[ai][1][m][n] * rsd[ai][m]; f32x4 z;
#pragma unroll
                    for (int e = 0; e < 4; ++e) {
                        const float g1 = dpp_f(dpp_f(0.f, hgp[e], 2), hg[e], 0), g2 = dpp_f(dpp_f(0.f, hgp[e], 3), hg[e], 1);
                        const float v1 = dpp_f(dpp_f(0.f, hvp[e], 2), hv[e], 0), v2 = dpp_f(dpp_f(0.f, hvp[e], 3), hv[e], 1);
                        const float ga = wg[0][e] * g2 + wg[1][e] * g1 + wg[2][e] * hg[e] + bg[e], va = wv[0][e] * v2 + wv[1][e] * v1 + wv[2][e] * hv[e] + bv[e];
                        z[e] = fsilu(ga) * va; }
                    const size_t row = (size_t)u.pm * 256 + ai * 128 + wr * 64 + m * 16 + fr;
                    const bool skip = (ai == 0 && wr == 0 && m == 0 && fr < 2 && !batch_start);
                    if (!skip) { v2u o; o.x = pk2(z[0], z[1]); o.y = pk2(z[2], z[3]); *(v2u*)(ACT + row * DFF + ch0 + 4 * n) = o; }
                    hgp = hg; hvp = hv; } } }
    }
};
__device__ __forceinline__ void ffn_fixup(int pm, const float* HT, bf16* ACT, const float* cw, const float* cb, int tid) {
    if ((pm & 7) == 0) return;
    for (int it = tid; it < 2 * (DFF / 4); it += NTHREADS) { const int rr = it / (DFF / 4), j = (it % (DFF / 4)) * 4, tc = (j >> 7) * 256 + (j & 127);
        const float* h0 = HT + ((size_t)(pm * 2 + 0) * 2 + rr) * DFF2;
        const float* h1 = rr ? HT + ((size_t)(pm * 2 + 0) * 2 + 0) * DFF2 : HT + ((size_t)((pm - 1) * 2 + 1) * 2 + 1) * DFF2;
        const float* h2 = rr ? HT + ((size_t)((pm - 1) * 2 + 1) * 2 + 1) * DFF2 : HT + ((size_t)((pm - 1) * 2 + 1) * 2 + 0) * DFF2;
        const f32x4 g0 = *(const f32x4*)(h0 + tc), g1 = *(const f32x4*)(h1 + tc), g2 = *(const f32x4*)(h2 + tc), v0 = *(const f32x4*)(h0 + tc + 128), v1 = *(const f32x4*)(h1 + tc + 128), v2 = *(const f32x4*)(h2 + tc + 128);
        const f32x4 ga = *(const f32x4*)(cw + j) * g2 + *(const f32x4*)(cw + DFF2 + j) * g1 + *(const f32x4*)(cw + 2 * DFF2 + j) * g0 + *(const f32x4*)(cb + j);
        const f32x4 va = *(const f32x4*)(cw + DFF + j) * v2 + *(const f32x4*)(cw + DFF2 + DFF + j) * v1 + *(const f32x4*)(cw + 2 * DFF2 + DFF + j) * v0 + *(const f32x4*)(cb + DFF + j);
        v2u o; o.x = pk2(fsilu(ga[0]) * va[0], fsilu(ga[1]) * va[1]); o.y = pk2(fsilu(ga[2]) * va[2], fsilu(ga[3]) * va[3]);
        *(v2u*)(ACT + ((size_t)pm * 256 + rr) * DFF + j) = o; }
    asm volatile("s_waitcnt vmcnt(0)" ::: "memory"); __syncthreads();
}

#define XB_TMO      128
#define XB_XCNT(j)  (256  + 64 * (j))
#define XB_XSUB(j)  (1280 + 64 * (j))
#define XB_XGEN(j)  (2304 + 64 * (j))
#define XB_TOP      3328
#define XB_TOPGEN   3392
#define XCD_BAR_WORDS 3456
#define XB_SPIN_CAP (1u << 18)

__device__ __forceinline__ unsigned xb_ld(unsigned* p)              { return __hip_atomic_load(p, __ATOMIC_RELAXED, __HIP_MEMORY_SCOPE_AGENT); }
__device__ __forceinline__ unsigned xb_add(unsigned* p, unsigned v) { return __hip_atomic_fetch_add(p, v, __ATOMIC_RELAXED, __HIP_MEMORY_SCOPE_AGENT); }
__device__ __forceinline__ unsigned xb_xcc_id() { return (unsigned)__builtin_amdgcn_s_getreg((3 << 11) | 20) & 0xFu; }
#define XB_SPIN(cond, bar) do { unsigned _sp = 0; while (cond) { __builtin_amdgcn_s_sleep(1); \
    if ((++_sp & 255u) == 0u) { if (xb_ld(&(bar)[XB_TMO])) break; if (_sp > XB_SPIN_CAP) { atomicAdd(&(bar)[XB_TMO], 1u); break; } } } } while (0)

struct XcdBarrier {
    unsigned* bar; unsigned x;
    volatile LAS unsigned* st;
};

__device__ __forceinline__ XcdBarrier xcd_barrier_post(unsigned* bar, volatile LAS unsigned* st) {
    XcdBarrier b; b.bar = bar; b.x = xb_xcc_id(); b.st = st;
    if (threadIdx.x == 0) (void)xb_add(&bar[XB_XCNT(b.x)], 1u);
    return b;
}
__device__ __forceinline__ void xcd_barrier_complete(unsigned* bar, unsigned x, unsigned& nloc, unsigned& nx) {
    const unsigned G = gridDim.x * gridDim.y * gridDim.z;
    unsigned sum, cnt, mine, sp = 0u;
    for (;;) {
        sum = 0u; cnt = 0u; mine = 0u;
#pragma unroll
        for (unsigned j = 0; j < 16; ++j) { const unsigned c = xb_ld(&bar[XB_XCNT(j)]); sum += c; cnt += (c > 0u) ? 1u : 0u; mine = (j == x) ? c : mine; }
        if (sum == G) break;
        __builtin_amdgcn_s_sleep(1);
        if ((++sp & 255u) == 0u) { if (xb_ld(&bar[XB_TMO])) break; if (sp > XB_SPIN_CAP) { atomicAdd(&bar[XB_TMO], 1u); break; } }
    }
    nloc = mine > 0u ? mine : 1u; nx = cnt > 0u ? cnt : 1u;
}

__device__ __forceinline__ void xcd_barrier(const XcdBarrier& b) {
    asm volatile("s_waitcnt vmcnt(0)" ::: "memory");
    __syncthreads();
    if (threadIdx.x == 0) {
        unsigned* bar = b.bar;
        __builtin_amdgcn_s_waitcnt(0);
        unsigned nloc = b.st[0], nx = b.st[1];
        if (nloc == 0u) { xcd_barrier_complete(bar, b.x, nloc, nx); b.st[0] = nloc; b.st[1] = nx; }
        const unsigned old = xb_add(&bar[XB_XSUB(b.x)], 1u);
        const unsigned gen = old / nloc;
        if (old + 1u == (gen + 1u) * nloc) {
            __builtin_amdgcn_fence(__ATOMIC_RELEASE, "agent");
            asm volatile("s_waitcnt vmcnt(0)" ::: "memory");
            const unsigned og = xb_add(&bar[XB_TOP], 1u);
            const unsigned tg = og / nx;
            if (og + 1u == (tg + 1u) * nx) xb_add(&bar[XB_TOPGEN], 1u);
            else XB_SPIN(xb_ld(&bar[XB_TOPGEN]) == tg, bar);
            __builtin_amdgcn_fence(__ATOMIC_ACQUIRE, "agent");
            xb_add(&bar[XB_XGEN(b.x)], 1u);
            asm volatile("s_waitcnt vmcnt(0)" ::: "memory");
        } else {
            XB_SPIN(xb_ld(&bar[XB_XGEN(b.x)]) == gen, bar);
            __builtin_amdgcn_fence(__ATOMIC_ACQUIRE, "agent");
            asm volatile("s_waitcnt vmcnt(0)" ::: "memory");
        }
    }
    __syncthreads();
}

#ifndef PROBE
#define PROBE 0
#endif
struct Args { Inputs in; float* out; unsigned char* ws; int ph_lo, ph_hi; };
constexpr int NPHASE = 2 + 7 * DEPTH;
#define LAUNDER_S(p) asm volatile("" : "+s"(p))
#define LAUNDER_V(p) asm volatile("" : "+v"(p))
struct Ctx { unsigned char* ws; unsigned char* act0; float* X; int tid, lane, wave, G, bx, gw, ngw; };
__device__ __forceinline__ Ctx make_ctx(const Args& a, int wave_id) {
    Ctx c; size_t z = 0; LAUNDER_S(z); c.ws = a.ws + z; c.X = (float*)((unsigned char*)a.out + z); c.act0 = c.ws + WS_ACT0;
    int ln; asm volatile("v_mbcnt_lo_u32_b32 %0, -1, 0\n\tv_mbcnt_hi_u32_b32 %0, -1, %0" : "=v"(ln)); c.lane = ln; c.wave = wave_id; c.tid = wave_id * 64 + ln;
    c.G = gridDim.x; c.bx = blockIdx.x; c.gw = c.bx * NWAVES + c.wave; c.ngw = c.G * NWAVES; return c;
}
__device__ __forceinline__ unsigned char* slot_of(const Ctx& c, int l) { return c.ws + WS_SLOT0 + (size_t)(l & 1) * SL_BYTES; }
__device__ __forceinline__ unsigned* ctl_word(const Ctx& c, int w) { return (unsigned*)(c.ws + WS_CTL) + w; }
__device__ __forceinline__ void tail_convert(const Args& a, const Ctx& c, int l, int ph, bool drain, LAS unsigned char* lds) {
#if MK_ONE_LAUNCH
    unsigned* fin = ctl_word(c, CW_FIN + 64 * ph);
    if (c.tid == 0) __hip_atomic_fetch_add(fin, 1u, RLX_AGENT);
    if (l == 0 && ph == 1) convert_queue(a.in, 0, slot_of(c, 0), lds, ctl_word(c, CW_QHEAD), CV_WIN_ITEMS, CV_ITEMS, nullptr, c.G, c.tid, c.wave, c.lane);
    if (l + 1 < DEPTH) convert_queue(a.in, l + 1, slot_of(c, l + 1), lds, ctl_word(c, CW_QHEAD + 64 * (l + 1)), 0, CV_ITEMS, drain ? nullptr : fin, c.G, c.tid, c.wave, c.lane);
#else
    if (l == 0 && ph == 1) convert_static(a.in, 0, slot_of(c, 0), lds, CV_WIN_ITEMS, CV_ITEMS, c.gw, c.ngw, c.wave, c.lane);
    if (l + 1 < DEPTH && drain) convert_static(a.in, l + 1, slot_of(c, l + 1), lds, 0, CV_ITEMS, c.gw, c.ngw, c.wave, c.lane);
#endif
}
__device__ __forceinline__ void ph_p0(const Args& a, const int wv, LAS unsigned char* lds) { const Ctx c = make_ctx(a, wv);
    convert_static(a.in, 0, c.ws + WS_SLOT0, lds, 0, CV_WIN_ITEMS, c.gw, c.ngw, c.wave, c.lane); x_prep(a.in.p[0], (bf16*)(c.ws + WS_XB), (float*)(c.ws + WS_SSQ), c.gw, c.ngw, c.lane); }
__device__ __forceinline__ void ph_a(const Args& a, const int wv, int l, int ph, LAS unsigned char* lds) { const Ctx c = make_ctx(a, wv);
    pg8::Gemm g{(const bf16*)(c.ws + WS_XB), (const bf16*)(slot_of(c, l) + SL_WIN), M, NIN, D}; pg8::StaticOrder S; S.init(M, NIN, c.G, c.bx);
    EpiA E{c.act0, (const float*)(c.ws + WS_SSQ), (float*)(c.ws + WS_SVST), a.in.p[4] + (size_t)l * GKEY};
    for (int rep = 0; rep < 1 + (PROBE == 1); ++rep) pg8::gemm_phase<EpiA, pg8::StaticOrder, true, true>(lds, g, S, E, wv);
    { const Ctx c2 = make_ctx(a, wv); tail_convert(a, c2, l, ph, false, lds); } }
__device__ __forceinline__ void ph_b1(const Args& a, const int wv, int l, LAS unsigned char* lds) { const Ctx c = make_ctx(a, wv); const Inputs& I = a.in;
    bf16* Zb = (bf16*)(c.act0 + A_Z); bf16* DUM = (bf16*)(c.ws + WS_END);
    for (int rep = 0; rep < 1 + (PROBE == 2); ++rep)
    for (int it = c.bx; it < 1024; it += c.G) gla_b1_item(it, lds, (const bf16*)(c.act0 + A_K), (const bf16*)(c.act0 + A_V), (const float*)(c.act0 + A_LOGA), (float*)(c.act0 + A_CST), (float*)(c.act0 + A_DEC), c.tid, c.wave, c.lane);
    if (PROBE == 3) for (int it = c.bx; it < 512; it += c.G) sgu_item(it, lds, Zb + (size_t)M * 512, DUM, (const bf16*)(c.act0 + A_SV), (const float*)(c.ws + WS_SVST), I.p[7] + (size_t)l * SGW, I.p[8] + (size_t)l * SGW, (const bf16*)(slot_of(c, l) + SL_SGW), I.p[10] + (size_t)l * 512, c.wave, c.lane);
    for (int it = c.bx; it < 512; it += c.G) sgu_item(it, lds, Zb + (size_t)M * 512, Zb + (size_t)M * 512, (const bf16*)(c.act0 + A_SV), (const float*)(c.ws + WS_SVST), I.p[7] + (size_t)l * SGW, I.p[8] + (size_t)l * SGW, (const bf16*)(slot_of(c, l) + SL_SGW), I.p[10] + (size_t)l * 512, c.wave, c.lane);
    if (PROBE == 4) for (int it = c.bx * NTHREADS + c.tid; it < 131072; it += c.G * NTHREADS) convbr_item(it, Zb + (size_t)2 * M * 512, DUM, (const bf16*)(c.act0 + A_CC), (const bf16*)(c.act0 + A_CX), I.p[12] + (size_t)l * 3 * CW);
    for (int it = c.bx * NTHREADS + c.tid; it < 131072; it += c.G * NTHREADS) convbr_item(it, Zb + (size_t)2 * M * 512, Zb + (size_t)2 * M * 512, (const bf16*)(c.act0 + A_CC), (const bf16*)(c.act0 + A_CX), I.p[12] + (size_t)l * 3 * CW);
}
__device__ __forceinline__ void ph_b2(const Args& a, const int wv, int l, int ph, LAS unsigned char* lds) { const Ctx c = make_ctx(a, wv);
    if (PROBE == 6) for (int it = c.bx; it < 256; it += c.G) gla_b2_unit(it, lds, (const bf16*)(c.act0 + A_Q), (const bf16*)(c.act0 + A_K), (const bf16*)(c.act0 + A_V), (const float*)(c.act0 + A_LOGA), (const float*)(c.act0 + A_CST), (const float*)(c.act0 + A_DEC), (const bf16*)(c.act0 + A_Z), (bf16*)(c.ws + WS_END), c.tid, c.wave, c.lane);
    for (int it = c.bx; it < 256; it += c.G) gla_b2_unit(it, lds, (const bf16*)(c.act0 + A_Q), (const bf16*)(c.act0 + A_K), (const bf16*)(c.act0 + A_V), (const float*)(c.act0 + A_LOGA), (const float*)(c.act0 + A_CST), (const float*)(c.act0 + A_DEC), (const bf16*)(c.act0 + A_Z), (bf16*)(c.act0 + A_Z), c.tid, c.wave, c.lane);
    tail_convert(a, c, l, ph, false, lds); }
__device__ __forceinline__ void ph_c(const Args& a, const int wv, int l, LAS unsigned char* lds) { const Ctx c = make_ctx(a, wv);
    pg8::Gemm g{(const bf16*)(c.act0 + A_Z), (const bf16*)(slot_of(c, l) + SL_WBR), 3 * M, 3 * D, 512}; BranchOrder S{c.G, c.bx}; EpiC E{(const bf16*)(c.act0 + A_G), (bf16*)(c.act0 + A_MERGED)};
    for (int rep = 0; rep < 1 + (PROBE == 7); ++rep) pg8::gemm_phase<EpiC, BranchOrder, true, true>(lds, g, S, E, wv); }
__device__ __forceinline__ void ph_res(const Args& a, const int wv, const bf16* A, const bf16* Bt, int K, int dup, int l, int ph, bool drain, LAS unsigned char* lds) { const Ctx c = make_ctx(a, wv);
    pg8::Gemm g{A, Bt, M, D, K}; pg8::StaticOrder S; S.init(M, D, c.G, c.bx);
    if (dup) { EpiRes E{(const bf16*)(c.ws + WS_XB), (bf16*)(c.ws + WS_END), (float*)(c.ws + WS_END + 32 * MiB)}; pg8::gemm_phase<EpiRes, pg8::StaticOrder, true, true>(lds, g, S, E, wv); }
    if (drain) { pg8::Unit u0; for (int i = 0; S.next(i, u0); ++i) ffn_fixup(u0.pm, (const float*)(c.act0 + A_HT), (bf16*)(c.act0 + A_ACT), a.in.p[17] + (size_t)l * 3 * DFF2, a.in.p[18] + (size_t)l * DFF2, c.tid); }
    EpiRes E{(const bf16*)(c.ws + WS_XB), (bf16*)(c.ws + WS_XB), (float*)(c.ws + WS_SSQ)};
    pg8::gemm_phase<EpiRes, pg8::StaticOrder, true, true>(lds, g, S, E, wv);
    if (drain) { const Ctx c2 = make_ctx(a, wv); tail_convert(a, c2, l, ph, true, lds); } }
__device__ __forceinline__ void ph_e(const Args& a, const int wv, int l, int ph, LAS unsigned char* lds) { const Ctx c = make_ctx(a, wv);
    pg8::Gemm g{(const bf16*)(c.ws + WS_XB), (const bf16*)(slot_of(c, l) + SL_WUP), M, DFF2, D}; pg8::StaticOrder S; S.init(M, DFF2, c.G, c.bx);
    EpiUpConv E{c.ws, a.in.p[17] + (size_t)l * 3 * DFF2, a.in.p[18] + (size_t)l * DFF2, lds};
    for (int rep = 0; rep < 1 + (PROBE == 8); ++rep) pg8::gemm_phase<EpiUpConv, pg8::StaticOrder, true, true>(lds, g, S, E, wv);
    { const Ctx c2 = make_ctx(a, wv); tail_convert(a, c2, l, ph, false, lds); } }
__device__ __forceinline__ void ph_e2(const Args& a, const int wv, int l) { const Ctx c = make_ctx(a, wv);
    for (int rep = 0; rep < 1 + (PROBE == 9); ++rep)
    for (int it = c.bx * NTHREADS + c.tid; it < 1024 * 352; it += c.G * NTHREADS) ffn_act_item(it, (const bf16*)(c.act0 + A_HUP), (bf16*)(c.act0 + A_ACT), a.in.p[17] + (size_t)l * 3 * DFF2, a.in.p[18] + (size_t)l * DFF2); }
__device__ __forceinline__ void ph_fin(const Args& a, const int wv) { const Ctx c = make_ctx(a, wv); final_norm((const bf16*)(c.ws + WS_XB), c.X, (const float*)(c.ws + WS_SSQ), a.in.p[20], c.gw, c.ngw, c.lane); }

#ifndef PHMASK
#define PHMASK 0xFFFF
#endif
#define EN(b) ((PHMASK >> (b)) & 1)
__global__ void __launch_bounds__(NTHREADS, 2) mk_fwd(Args args) {
    extern __shared__ __attribute__((aligned(16))) unsigned char lds_raw[];
    LAS unsigned char* lds = (LAS unsigned char*)lds_raw;
    const int wv = __builtin_amdgcn_readfirstlane(threadIdx.x >> 6);
    const int lo = args.ph_lo, hi = args.ph_hi;
#define IN(k) (lo <= (k) && (k) < hi)
#if MK_ONE_LAUNCH
    volatile LAS unsigned* bst = (volatile LAS unsigned*)(lds + RING_BYTES + 512);
    if (threadIdx.x < 2) bst[threadIdx.x] = 0u;
    __syncthreads();
    const XcdBarrier bar = xcd_barrier_post((unsigned*)(args.ws + WS_CTL) + CW_BAR, bst);
#define SEAM(k) do { if (IN(k) && IN((k) + 1)) { if ((k) == 0) cg::this_grid().sync(); else xcd_barrier(bar); } } while (0)
#else
#define SEAM(k) do { } while (0)
#endif
    int ph = 0;
    if (EN(0) && IN(ph)) ph_p0(args, wv, lds);
    SEAM(ph); ++ph;
    for (int l = 0; l < DEPTH; ++l) {
        if (EN(1) && IN(ph)) ph_a(args, wv, l, ph, lds);
        SEAM(ph); ++ph;
        if (EN(2) && IN(ph)) ph_b1(args, wv, l, lds);
        SEAM(ph); ++ph;
        if (EN(3) && IN(ph)) ph_b2(args, wv, l, ph, lds);
        SEAM(ph); ++ph;
        if (EN(4) && IN(ph)) ph_c(args, wv, l, lds);
        SEAM(ph); ++ph;
        if (EN(5) && IN(ph)) { size_t z = 0; LAUNDER_S(z); unsigned char* ws = args.ws + z; ph_res(args, wv, (const bf16*)(ws + WS_ACT0 + A_MERGED), (const bf16*)(ws + WS_SLOT0 + (size_t)(l & 1) * SL_BYTES + SL_WO), D, PROBE == 10, l, ph, false, lds); }
        SEAM(ph); ++ph;
        if (EN(6) && IN(ph)) ph_e(args, wv, l, ph, lds);
        SEAM(ph); ++ph;
        if (EN(8) && IN(ph)) { size_t z = 0; LAUNDER_S(z); unsigned char* ws = args.ws + z; ph_res(args, wv, (const bf16*)(ws + WS_ACT0 + A_ACT), (const bf16*)(ws + WS_SLOT0 + (size_t)(l & 1) * SL_BYTES + SL_WDN), DFF, PROBE == 11, l, ph, true, lds); }
        SEAM(ph); ++ph;
    }
    if (EN(9) && IN(ph)) ph_fin(args, wv);
#undef IN
#undef SEAM
}

extern "C" void kernel_launch(void* const* d_in, const int* in_sizes, int n_in, void* d_out, int out_size, void* d_ws, size_t ws_size, hipStream_t stream) {
    static int grid = 0;
    if (grid == 0) {
        if (n_in != 21 || out_size != M * D || ws_size < WS_END + (PROBE ? 64 * MiB : 0)) { fprintf(stderr, "kernel_launch: unexpected shapes / workspace (%zu < %zu)\n", ws_size, (size_t)WS_END); grid = -1; return; }
        int dev = 0, cus = 0, per_cu = 0;
        if (hipGetDevice(&dev) != hipSuccess || hipDeviceGetAttribute(&cus, hipDeviceAttributeMultiprocessorCount, dev) != hipSuccess) { grid = -1; return; }
        if (hipFuncSetAttribute((const void*)mk_fwd, hipFuncAttributeMaxDynamicSharedMemorySize, LDS_BYTES) != hipSuccess) { fprintf(stderr, "kernel_launch: hipFuncSetAttribute failed\n"); grid = -1; return; }
        if (hipOccupancyMaxActiveBlocksPerMultiprocessor(&per_cu, (const void*)mk_fwd, NTHREADS, LDS_BYTES) != hipSuccess || per_cu < 1) { fprintf(stderr, "kernel_launch: occupancy query says %d\n", per_cu); per_cu = 1; }
        (void)hipGetLastError();
        grid = cus * 1;
    }
    if (grid < 0) return;
#if MK_ONE_LAUNCH
    if (hipMemsetAsync((char*)d_ws + WS_CTL, 0, 65536, stream) != hipSuccess) { fprintf(stderr, "kernel_launch: memset failed\n"); return; }
#endif
    Args a{};
    for (int i = 0; i < 21; ++i) a.in.p[i] = (const float*)d_in[i];
    a.out = (float*)d_out; a.ws = (unsigned char*)d_ws;
#if MK_ONE_LAUNCH
    a.ph_lo = 0; a.ph_hi = NPHASE;
    void* kargs[] = {&a};
    hipError_t e = hipLaunchCooperativeKernel((const void*)mk_fwd, dim3(grid), dim3(NTHREADS), kargs, LDS_BYTES, stream);
    if (e != hipSuccess) fprintf(stderr, "kernel_launch: cooperative launch failed: %s (grid %d)\n", hipGetErrorString(e), grid);
#else
    for (int p = 0; p < NPHASE; ++p) { a.ph_lo = p; a.ph_hi = p + 1; hipLaunchKernelGGL(mk_fwd, dim3(grid), dim3(NTHREADS), LDS_BYTES, stream, a); }
#endif
}
```

```cpp
#include <hip/hip_runtime.h>
#include <hip/hip_cooperative_groups.h>
#include <cstdio>
#include <cstdint>
#include <cmath>
namespace cg = cooperative_groups;

#ifndef MK_ONE_LAUNCH
#define MK_ONE_LAUNCH 1
#endif

namespace cfg {
constexpr int D = 1024, BATCH = 8, SEQ = 2048, DEPTH = 4, M = BATCH * SEQ;
constexpr int GH = 4, GDK = 64, GDV = 128, GKEY = 256, GVAL = 512, GRANK = 16;
constexpr int SGW = 512, SGC = 128, CW = 512, DFF = 2816, DFF2 = 5632;
constexpr int INC = 7184, NIN = 7424;
constexpr int O_Q = 0, O_K = 256, O_V = 512, O_G = 1024, O_A = 1536, O_SU = 1552, O_SV = 2064, O_CB = 2576, O_CC = 3088, O_CX = 3600, O_GT = 4112;
constexpr float EPS = 1e-6f;
}
using namespace cfg;

namespace pg8 {
#define PG8_LAS __attribute__((address_space(3)))
typedef unsigned short bf16_t;
typedef short bf16x8 __attribute__((ext_vector_type(8)));
typedef float f32x4 __attribute__((ext_vector_type(4)));
typedef unsigned u32x4 __attribute__((ext_vector_type(4)));
constexpr int BM = 256, BK = 64, HALF = 128, HTB = HALF * BK * 2  , STAGE_BYTES = 8 * HTB, NXCD = 8, WGM = 8;

__host__ __device__ __forceinline__ int lds_byte(int r, int c) { const int st = (r >> 4) * 2 + (c >> 5), rr = r & 15, cc = c & 31, ob = rr * 64 + cc * 2; return st * 1024 + (ob ^ (((ob >> 9) & 1) << 5)); }
__host__ __device__ __forceinline__ void stage_rc(int b, int& R, int& C) { const int st = b / 1024, sb = b % 1024, swz = sb ^ (((sb >> 9) & 1) << 5); R = (st >> 1) * 16 + swz / 64; C = (st & 1) * 32 + (swz % 64) / 2; }
__host__ __device__ __forceinline__ int perm32(int rho) { const int n = rho >> 4, i = rho & 15; return 8 * (i >> 2) + 4 * n + (i & 3); }

struct Unit { int pm, pn; };
struct Gemm { const bf16_t* A; const bf16_t* Bt; int M, N, K; };

struct StaticOrder {
    int nM, nN, nwg, G, c;
    __host__ __device__ void init(int M, int N, int G_, int c_) { nM = M / BM; nN = N / BM; nwg = nM * nN; G = G_; c = c_; }
    __host__ __device__ bool next(int i, Unit& u) const {
        const long L = (long)i * G + c; if (L >= nwg) return false;
        int wgid = (int)L; { const int q = nwg / NXCD, r = nwg % NXCD, xcd = wgid % NXCD, off = wgid / NXCD; wgid = (xcd < r ? xcd * (q + 1) : r * (q + 1) + (xcd - r) * q) + off; }
        const int nig = WGM * nN, gid = wgid / nig, fm = gid * WGM, gsz = (nM - fm) < WGM ? (nM - fm) : WGM;
        u.pm = fm + ((wgid % nig) % gsz); u.pn = (wgid % nig) / gsz; return true;
    }
    __device__ __forceinline__ void a_ready(const Unit&) const {}
    __device__ __forceinline__ void done(const Unit&) const {}
};

__device__ __forceinline__ unsigned cvt_pk_bf16(float lo, float hi) { unsigned r; asm volatile("v_cvt_pk_bf16_f32 %0, %1, %2" : "=v"(r) : "v"(lo), "v"(hi)); return r; }
typedef float f32x2 __attribute__((ext_vector_type(2)));
template <class Epi, class Sched, bool ALIGN_EPI = false, bool SP2 = false>
__device__ __forceinline__ void gemm_phase(PG8_LAS unsigned char* lds, const Gemm g, const Sched& S, const Epi& E, const int wave_id) {
    int ln__; asm volatile("v_mbcnt_lo_u32_b32 %0, -1, 0\n\tv_mbcnt_hi_u32_b32 %0, -1, %0" : "=v"(ln__));
    const int tid_ = ln__ + 64 * wave_id;
    const int tid = tid_, wid = __builtin_amdgcn_readfirstlane(tid >> 6), lane = tid & 63, wr = wid >> 2, wc = wid & 3, fr = lane & 15, fq = lane >> 4;
    const int K = g.K, nt = K / BK;
    unsigned voffA[2], voffB[2];
#pragma unroll
    for (int i = 0; i < 2; ++i) { int R, C; stage_rc(tid * 16 + i * 8192, R, C); const int Rb = Epi::PERM ? ((R & ~31) + perm32(R & 31)) : R;
        voffA[i] = (unsigned)(R * K + C) * 2u; voffB[i] = (unsigned)(Rb * K + C) * 2u; }
    const size_t kstep = (size_t)(BK * 2);
    const size_t hstep = (size_t)HALF * K * 2;
    const size_t tstep = 2 * hstep;
    const unsigned ldsw = (unsigned)wid * 1024u;
    const int aoff = lds_byte(wr * 64 + fr, fq * 8), boff = lds_byte(wc * 32 + fr, fq * 8);
#define PG8_SA(b, h) (((b) * 2 + (h)) * HTB)
#define PG8_SB(b, h) ((4 + (b) * 2 + (h)) * HTB)
#define PG8_STAGE(bufoff, gbase, voff) do { _Pragma("unroll") for (int _i = 0; _i < 2; ++_i) \
        __builtin_amdgcn_global_load_lds((const unsigned*)((const char*)(gbase) + (voff)[_i]), (PG8_LAS unsigned*)(lds + (bufoff) + ldsw + _i * 8192), 16, 0, 0); } while (0)
#define PG8_LDA(dst, b, h) do { _Pragma("unroll") for (int m = 0; m < 4; ++m) _Pragma("unroll") for (int k = 0; k < 2; ++k) dst[m][k] = *(const PG8_LAS bf16x8*)(lds + PG8_SA(b, h) + aoff + m * 2048 + k * 1024); } while (0)
#define PG8_LDB(dst, b, h) do { _Pragma("unroll") for (int n = 0; n < 2; ++n) _Pragma("unroll") for (int k = 0; k < 2; ++k) dst[n][k] = *(const PG8_LAS bf16x8*)(lds + PG8_SB(b, h) + boff + n * 2048 + k * 1024); } while (0)
#define PG8_MMA(ai, bj, At, Bt) do { __builtin_amdgcn_s_setprio(1); _Pragma("unroll") for (int m = 0; m < 4; ++m) _Pragma("unroll") for (int n = 0; n < 2; ++n) _Pragma("unroll") for (int k = 0; k < 2; ++k) \
        acc[ai][bj][m][n] = __builtin_amdgcn_mfma_f32_16x16x32_bf16(Bt[n][k], At[m][k], acc[ai][bj][m][n], 0, 0, 0); __builtin_amdgcn_s_setprio(0); } while (0)
#define PG8_WAIT_V(n) asm volatile("s_waitcnt vmcnt(" #n ")" ::: "memory")
#define PG8_WAIT_L(n) asm volatile("s_waitcnt lgkmcnt(" #n ")" ::: "memory")
#define PG8_BAR __builtin_amdgcn_s_barrier()
#define PG8_SCHED __builtin_amdgcn_sched_barrier(0)
    Unit cur, nxt; int ui = 0;
    if (!S.next(0, cur)) return;
    f32x4 acc[2][2][4][2];
#pragma unroll
    for (int a = 0; a < 2; ++a)
#pragma unroll
        for (int b = 0; b < 2; ++b)
#pragma unroll
            for (int m = 0; m < 4; ++m)
#pragma unroll
                for (int n = 0; n < 2; ++n) acc[a][b][m][n] = (f32x4){0.f, 0.f, 0.f, 0.f};
    bf16x8 At[4][2], B0[2][2], B1[2][2];
    const char* cA = (const char*)g.A + (size_t)cur.pm * tstep; const char* cB = (const char*)g.Bt + (size_t)cur.pn * tstep;
    S.a_ready(cur);
    if constexpr (SP2) {
        PG8_STAGE(PG8_SB(0, 0), cB, voffB); PG8_STAGE(PG8_SB(0, 1), cB + hstep, voffB); PG8_STAGE(PG8_SA(0, 0), cA, voffA); PG8_STAGE(PG8_SA(0, 1), cA + hstep, voffA);
        if (wr == 1) PG8_BAR;
        PG8_WAIT_V(2); PG8_BAR;
        PG8_STAGE(PG8_SB(1, 0), cB + kstep, voffB); PG8_STAGE(PG8_SA(1, 0), cA + kstep, voffA); PG8_STAGE(PG8_SB(1, 1), cB + hstep + kstep, voffB);
        PG8_WAIT_V(6); PG8_BAR;
    } else {
        PG8_STAGE(PG8_SB(0, 0), cB, voffB); PG8_STAGE(PG8_SA(0, 0), cA, voffA); PG8_STAGE(PG8_SB(0, 1), cB + hstep, voffB); PG8_STAGE(PG8_SA(0, 1), cA + hstep, voffA);
        if (wr == 1) PG8_BAR;
        PG8_WAIT_V(4); PG8_BAR;
        PG8_STAGE(PG8_SB(1, 0), cB + kstep, voffB); PG8_STAGE(PG8_SA(1, 0), cA + kstep, voffA); PG8_STAGE(PG8_SB(1, 1), cB + hstep + kstep, voffB);
        PG8_WAIT_V(6); PG8_BAR;
    }
    for (;;) {
        const bool has_next = S.next(ui + 1, nxt);
        const char* nA = has_next ? (const char*)g.A + (size_t)nxt.pm * tstep : cA; const char* nB = has_next ? (const char*)g.Bt + (size_t)nxt.pn * tstep : cB;
        for (int t = 0; t < nt; t += 2) {
            const bool last = (t == nt - 2);
            const char* a1 = cA + (size_t)(t + 1) * kstep;
            const char* a2 = last ? nA : cA + (size_t)(t + 2) * kstep; const char* b2 = last ? nB : cB + (size_t)(t + 2) * kstep;
            const char* a3 = a2 + kstep; const char* b3 = b2 + kstep;
            if (last && has_next) S.a_ready(nxt);
            if constexpr (SP2) {
            PG8_LDB(B0, 0, 0); PG8_LDB(B1, 0, 1); PG8_SCHED; PG8_LDA(At, 0, 0); PG8_STAGE(PG8_SA(1, 1), a1 + hstep, voffA);
            PG8_WAIT_V(8); PG8_WAIT_L(0); PG8_BAR; PG8_MMA(0, 0, At, B0); PG8_MMA(0, 1, At, B1); PG8_BAR; PG8_SCHED;
            PG8_LDA(At, 0, 1); PG8_STAGE(PG8_SB(0, 0), b2, voffB); PG8_STAGE(PG8_SB(0, 1), b2 + hstep, voffB); PG8_STAGE(PG8_SA(0, 0), a2, voffA);
            PG8_WAIT_V(8); PG8_WAIT_L(0); PG8_BAR; PG8_MMA(1, 0, At, B0); PG8_MMA(1, 1, At, B1); PG8_BAR; PG8_SCHED;
            PG8_LDB(B0, 1, 0); PG8_LDB(B1, 1, 1); PG8_SCHED; PG8_LDA(At, 1, 0); PG8_STAGE(PG8_SA(0, 1), a2 + hstep, voffA);
            PG8_WAIT_V(8); PG8_WAIT_L(0); PG8_BAR; PG8_MMA(0, 0, At, B0); PG8_MMA(0, 1, At, B1); PG8_BAR; PG8_SCHED;
            PG8_LDA(At, 1, 1); PG8_STAGE(PG8_SB(1, 0), b3, voffB); PG8_STAGE(PG8_SB(1, 1), b3 + hstep, voffB); PG8_STAGE(PG8_SA(1, 0), a3, voffA);
            PG8_WAIT_V(8); PG8_WAIT_L(0); PG8_BAR; PG8_MMA(1, 0, At, B0); PG8_MMA(1, 1, At, B1); PG8_BAR; PG8_SCHED;
            } else {
            PG8_LDB(B0, 0, 0); PG8_SCHED; PG8_LDA(At, 0, 0); PG8_STAGE(PG8_SA(1, 1), a1 + hstep, voffA);
            PG8_WAIT_L(8); PG8_BAR; PG8_WAIT_L(0); PG8_MMA(0, 0, At, B0); PG8_BAR; PG8_SCHED;
            PG8_LDB(B1, 0, 1); PG8_STAGE(PG8_SB(0, 0), b2, voffB);
            PG8_BAR; PG8_WAIT_L(0); PG8_MMA(0, 1, At, B1); PG8_BAR;
            PG8_LDA(At, 0, 1); PG8_STAGE(PG8_SA(0, 0), a2, voffA);
            PG8_BAR; PG8_WAIT_L(0); PG8_MMA(1, 0, At, B0); PG8_BAR; PG8_SCHED;
            PG8_STAGE(PG8_SB(0, 1), b2 + hstep, voffB);
            PG8_WAIT_V(6); PG8_BAR; PG8_MMA(1, 1, At, B1); PG8_BAR;
            PG8_LDB(B0, 1, 0); PG8_SCHED; PG8_LDA(At, 1, 0); PG8_STAGE(PG8_SA(0, 1), a2 + hstep, voffA);
            PG8_WAIT_L(8); PG8_BAR; PG8_WAIT_L(0); PG8_MMA(0, 0, At, B0); PG8_BAR; PG8_SCHED;
            PG8_LDB(B1, 1, 1); PG8_STAGE(PG8_SB(1, 0), b3, voffB);
            PG8_BAR; PG8_WAIT_L(0); PG8_MMA(0, 1, At, B1); PG8_BAR;
            PG8_LDA(At, 1, 1); PG8_STAGE(PG8_SA(1, 0), a3, voffA);
            PG8_BAR; PG8_WAIT_L(0); PG8_MMA(1, 0, At, B0); PG8_BAR; PG8_SCHED;
            PG8_STAGE(PG8_SB(1, 1), b3 + hstep, voffB);
            PG8_WAIT_V(6); PG8_BAR; PG8_MMA(1, 1, At, B1); PG8_BAR;
            }
        }
        if constexpr (ALIGN_EPI) { if (wr == 0) PG8_BAR; }
        if constexpr (!Epi::AFTER_DRAIN) { E(acc, cur, wr, wc, fr, fq); S.done(cur); }
        if (!has_next) break;
#pragma unroll
        for (int a = 0; a < 2; ++a)
#pragma unroll
            for (int b = 0; b < 2; ++b)
#pragma unroll
                for (int m = 0; m < 4; ++m)
#pragma unroll
                    for (int n = 0; n < 2; ++n) acc[a][b][m][n] = (f32x4){0.f, 0.f, 0.f, 0.f};
        cur = nxt; cA = nA; cB = nB; ++ui;
        if constexpr (ALIGN_EPI) { if (wr == 1) PG8_BAR; }
    }
    PG8_WAIT_V(0);
    if constexpr (!ALIGN_EPI) { if (wr == 0) PG8_BAR; }
    PG8_BAR;
    if constexpr (Epi::AFTER_DRAIN) { E.fused(acc, cur, wr, wc, fr, fq, lds, wid, lane); S.done(cur); }
#undef PG8_SA
#undef PG8_SB
#undef PG8_STAGE
#undef PG8_LDA
#undef PG8_LDB
#undef PG8_MMA
#undef PG8_WAIT_V
#undef PG8_WAIT_L
#undef PG8_BAR
#undef PG8_SCHED
}
}

#define GAS __attribute__((address_space(1)))
#define LAS __attribute__((address_space(3)))
typedef unsigned short bf16;
typedef unsigned v4u __attribute__((ext_vector_type(4)));
typedef unsigned v2u __attribute__((ext_vector_type(2)));
typedef float f32x4 __attribute__((ext_vector_type(4)));
typedef float f32x2 __attribute__((ext_vector_type(2)));
typedef short bf16x8 __attribute__((ext_vector_type(8)));
constexpr int NWAVES = 8, NTHREADS = 512;
constexpr int RING_BYTES = 131072, LDS_BYTES = 147456;

constexpr size_t MiB = 1u << 20;
constexpr size_t SL_WIN = 0, SL_WBR = SL_WIN + (size_t)NIN * D * 2, SL_WO = SL_WBR + (size_t)3 * D * 512 * 2, SL_WUP = SL_WO + (size_t)D * D * 2,
                 SL_WDN = SL_WUP + (size_t)DFF2 * D * 2, SL_SGW = SL_WDN + (size_t)D * DFF * 2, SL_END = SL_SGW + (size_t)4 * 128 * 128 * 2, SL_BYTES = 38 * MiB;
static_assert(SL_END <= SL_BYTES, "weight slot");
constexpr size_t WS_CTL = 0, WS_SLOT0 = 1 * MiB, WS_XB = WS_SLOT0 + 2 * SL_BYTES, WS_SSQ = WS_XB + 32 * MiB, WS_SVST = WS_SSQ + 1 * MiB, WS_ACT0 = WS_SVST + 1 * MiB;
constexpr size_t A_Q = 0, A_K = 8 * MiB, A_V = 16 * MiB, A_Z = 32 * MiB, A_SV = 80 * MiB, A_CC = 96 * MiB, A_CX = 112 * MiB, A_LOGA = 128 * MiB, A_G = 144 * MiB,
                 A_CST = 240 * MiB, A_DEC = 272 * MiB, A_END = 273 * MiB;
constexpr size_t A_MERGED = A_Q, A_HUP = 0, A_ACT = 176 * MiB, A_HT = 64 * MiB;
static_assert(A_ACT + (size_t)M * DFF * 2 <= A_END, "overlay");
constexpr size_t WS_END = WS_ACT0 + A_END;
constexpr int CW_BAR = 1024, CW_QHEAD = 6144, CW_FIN = 8192;

__device__ __forceinline__ float bf2f(unsigned h) { return __uint_as_float(h << 16); }
__device__ __forceinline__ unsigned pk2(float lo, float hi) { return pg8::cvt_pk_bf16(lo, hi); }
__device__ __forceinline__ float fsigmoid(float z) { return __builtin_amdgcn_rcpf(1.f + __expf(-z)); }
__device__ __forceinline__ float fsilu(float z) { return z * fsigmoid(z); }
__device__ __forceinline__ float fgelu(float z) { return z * fsigmoid(1.5957691216057308f * (z + 0.044715f * z * z * z)); }
__device__ __forceinline__ float flogsig(float z) { return fminf(z, 0.f) - __logf(1.f + __expf(-fabsf(z))); }
__device__ __forceinline__ float wave_sum(float v) {
#pragma unroll
    for (int o = 1; o < 64; o <<= 1) v += __shfl_xor(v, o);
    return v;
}
#define LDS_WAIT() asm volatile("s_waitcnt lgkmcnt(0)" ::: "memory")
__device__ __forceinline__ f32x4 mfma16(bf16x8 a, bf16x8 b, f32x4 c) { return __builtin_amdgcn_mfma_f32_16x16x32_bf16(a, b, c, 0, 0, 0); }

__device__ __forceinline__ void tr_write(bf16* WT, int K, int k0, LAS float* scr, int lane) {
    LDS_WAIT(); asm volatile("" ::: "memory");
    const int c = lane & 7;
#pragma unroll
    for (int j = 0; j < 4; ++j) { const int n = (lane >> 3) + 8 * j; const LAS float* s = scr + (8 * c) * 33 + n;
        v4u o; o.x = pk2(s[0 * 33], s[1 * 33]); o.y = pk2(s[2 * 33], s[3 * 33]); o.z = pk2(s[4 * 33], s[5 * 33]); o.w = pk2(s[6 * 33], s[7 * 33]);
        *(GAS v4u*)(WT + (size_t)n * K + k0 + 8 * c) = o; }
    LDS_WAIT(); asm volatile("" ::: "memory");
}
__device__ __forceinline__ void tr_item(const float* W, int ldw, int col0, const float* ksc, float sc, bf16* WT, int K, int k0, LAS float* scr, int lane) {
#pragma unroll 8
    for (int i = 0; i < 32; ++i) { const int kk = 2 * i + (lane >> 5); float v = W[(size_t)(k0 + kk) * ldw + col0 + (lane & 31)]; v *= ksc ? ksc[k0 + kk] * sc : sc; scr[kk * 33 + (lane & 31)] = v; }
    tr_write(WT, K, k0, scr, lane);
}
__device__ __forceinline__ void alpha_item(const float* win, const float* wal, const float* g, bf16* WT, int k0, int j0, LAS float* scr, int lane) {
    const int jj = lane & 31, half = lane >> 5; float wa[16];
#pragma unroll
    for (int r = 0; r < 16; ++r) wa[r] = wal[r * GKEY + j0 + jj];
    for (int i = 0; i < 32; ++i) { const int kk = 2 * i + half, k = k0 + kk; const float* wr = win + (size_t)k * INC + O_A; float s = 0.f;
#pragma unroll
        for (int r = 0; r < 16; ++r) s += wr[r] * wa[r];
        scr[kk * 33 + jj] = s * g[k]; }
    tr_write(WT + (size_t)j0 * D, D, k0, scr, lane);
}
struct Inputs { const float* p[21]; };
constexpr int CV_J0 = 16 * 224, CV_J1 = 16 * 8, CV_J2 = 3 * 8 * 32, CV_J3 = 16 * 32, CV_J4 = 16 * 176, CV_J5 = 44 * 32, CV_J6 = 128, CV_ITEMS = CV_J0 + CV_J1 + CV_J2 + CV_J3 + CV_J4 + CV_J5 + CV_J6;
constexpr int CV_WIN_ITEMS = CV_J0 + CV_J1;
__device__ __forceinline__ void convert_item(const Inputs& I, int l, unsigned char* slot, LAS float* scr, int it, int lane) {
    bf16* WIN = (bf16*)(slot + SL_WIN); bf16* WBR = (bf16*)(slot + SL_WBR); bf16* WO = (bf16*)(slot + SL_WO); bf16* WUP = (bf16*)(slot + SL_WUP); bf16* WDN = (bf16*)(slot + SL_WDN); bf16* SGWS = (bf16*)(slot + SL_SGW);
    const float* win = I.p[2] + (size_t)l * D * INC;
        int r = it;
        if (r < CV_J0) { const int kb = r / 224, nb = r % 224; const int drow = nb < 48 ? 32 * nb : 1792 + 32 * (nb - 48), scol = nb < 48 ? 32 * nb : O_SU + 32 * (nb - 48);
            tr_item(win, INC, scol, I.p[1] + (size_t)l * D, drow < 256 ? 0.125f : 1.f, WIN + (size_t)drow * D, D, 64 * kb, scr, lane); return; }
        r -= CV_J0;
        if (r < CV_J1) { const int kb = r / 8, jb = r % 8; alpha_item(win, I.p[3] + (size_t)l * GRANK * GKEY, I.p[1] + (size_t)l * D, WIN + (size_t)1536 * D, 64 * kb, 32 * jb, scr, lane); return; }
        r -= CV_J1;
        if (r < CV_J2) { const int br = r / 256, rr = r % 256, kb = rr / 32, nb = rr % 32;
            const float* W = (br == 0 ? I.p[6] : br == 1 ? I.p[11] : I.p[13]) + (size_t)l * 512 * D;
            tr_item(W, D, 32 * nb, br == 0 ? I.p[5] + (size_t)l * GVAL : nullptr, 1.f, WBR + ((size_t)br * D + 32 * nb) * 512, 512, 64 * kb, scr, lane); return; }
        r -= CV_J2;
        if (r < CV_J3) { const int kb = r / 32, nb = r % 32; tr_item(I.p[14] + (size_t)l * D * D, D, 32 * nb, nullptr, 1.f, WO + (size_t)32 * nb * D, D, 64 * kb, scr, lane); return; }
        r -= CV_J3;
        if (r < CV_J4) { const int kb = r / 176, nb = r % 176, pn = nb / 8, jb = nb % 8; const int scol = jb < 4 ? 128 * pn + 32 * jb : DFF + 128 * pn + 32 * (jb - 4);
            tr_item(I.p[16] + (size_t)l * D * DFF2, DFF2, scol, I.p[15] + (size_t)l * D, 1.f, WUP + (size_t)32 * nb * D, D, 64 * kb, scr, lane); return; }
        r -= CV_J4;
        if (r < CV_J5) { const int kb = r / 32, nb = r % 32; tr_item(I.p[19] + (size_t)l * DFF * D, D, 32 * nb, nullptr, 1.f, WDN + (size_t)32 * nb * DFF, DFF, 64 * kb, scr, lane); return; }
        r -= CV_J5;
        { const int e0 = r * 512 + lane * 8, t = (e0 >> 7) & 127, s0 = e0 & 127; const float* src = I.p[9] + (size_t)l * 4 * 128 * 128 + e0;
          const f32x4 a = *(const f32x4*)src, b = *(const f32x4*)(src + 4); float v[8] = {a[0], a[1], a[2], a[3], b[0], b[1], b[2], b[3]};
#pragma unroll
          for (int e = 0; e < 8; ++e) if (s0 + e > t) v[e] = 0.f;
          v4u o; o.x = pk2(v[0], v[1]); o.y = pk2(v[2], v[3]); o.z = pk2(v[4], v[5]); o.w = pk2(v[6], v[7]); *(GAS v4u*)(SGWS + e0) = o; }
}
__device__ __forceinline__ void convert_static(const Inputs& I, int l, unsigned char* slot, LAS unsigned char* lds, int it_lo, int it_hi, int gw, int ngw, int wave, int lane) {
    LAS float* scr = (LAS float*)(lds + wave * 8448);
    for (int it = it_lo + gw; it < it_hi; it += ngw) convert_item(I, l, slot, scr, it, lane);
}
#define RLX_AGENT __ATOMIC_RELAXED, __HIP_MEMORY_SCOPE_AGENT
__device__ __forceinline__ void convert_queue(const Inputs& I, int l, unsigned char* slot, LAS unsigned char* lds, unsigned* head, int it_lo, int it_hi, unsigned* fin, int G, int tid, int wave, int lane) {
    LAS float* scr = (LAS float*)(lds + wave * 8448); volatile LAS unsigned* bc = (volatile LAS unsigned*)(lds + 8 * 8448);
    for (;;) {
        if (tid == 0) { unsigned v = 0xffffffffu; if (!fin || __hip_atomic_load(fin, RLX_AGENT) < (unsigned)G) v = __hip_atomic_fetch_add(head, 8u, RLX_AGENT); bc[0] = v; }
        __syncthreads();
        const unsigned base = bc[0];
        __syncthreads();
        if (base >= (unsigned)(it_hi - it_lo)) break;
        const int it = it_lo + (int)base + wave; if (it < it_hi) convert_item(I, l, slot, scr, it, lane);
    }
}
__device__ __forceinline__ void x_prep(const float* xin, bf16* xb, float* ssq, int gw, int ngw, int lane) {
    for (int row = gw; row < M; row += ngw) {
        const GAS f32x4* xr = (const GAS f32x4*)(xin + (size_t)row * D) + lane; f32x4 v[4]; float s = 0.f;
#pragma unroll
        for (int j = 0; j < 4; ++j) { v[j] = xr[64 * j]; s += (v[j][0] * v[j][0] + v[j][1] * v[j][1]) + (v[j][2] * v[j][2] + v[j][3] * v[j][3]); }
        s = wave_sum(s);
#pragma unroll
        for (int j = 0; j < 4; ++j) { v2u w; w.x = pk2(v[j][0], v[j][1]); w.y = pk2(v[j][2], v[j][3]); ((GAS v2u*)(xb + (size_t)row * D))[lane + 64 * j] = w; }
        if (lane < 16) ssq[(size_t)row * 16 + lane] = lane == 0 ? s : 0.f;
    }
}
__device__ __forceinline__ void final_norm(const bf16* xb, float* out, const float* ssq, const float* g, int gw, int ngw, int lane) {
    for (int row = gw; row < M; row += ngw) {
        const float pv = lane < 16 ? ssq[(size_t)row * 16 + lane] : 0.f; const float rs = rsqrtf(wave_sum(pv) * (1.f / D) + EPS);
        const GAS v2u* xr = (const GAS v2u*)(xb + (size_t)row * D) + lane; GAS f32x4* orow = (GAS f32x4*)(out + (size_t)row * D) + lane;
#pragma unroll
        for (int j = 0; j < 4; ++j) { const v2u w = xr[64 * j]; const f32x4 gv = ((const GAS f32x4*)g)[lane + 64 * j];
            orow[64 * j] = (f32x4){bf2f(w.x & 0xffffu) * rs * gv[0], bf2f(w.x >> 16) * rs * gv[1], bf2f(w.y & 0xffffu) * rs * gv[2], bf2f(w.y >> 16) * rs * gv[3]}; }
    }
}

constexpr int GP = 72;
constexpr int L_QT = 0, L_KT = 9216, L_KENDT = 18432, L_VT = 27648, L_ST = 46080, L_SEG = 64512, L_DECS = 66560, L_RED = 66816, L_GLA_END = 67328;
constexpr int VP = 136;

__device__ __forceinline__ void sgu_item(int item, LAS unsigned char* lds, const bf16* ZBI, bf16* ZBO, const bf16* SV, const float* SVST, const float* lng, const float* lnb, const bf16* wsb, const float* bs, int wave, int lane) {
    const int h = item & 3, r0 = (item >> 2) * 128; LAS bf16* vnT = (LAS bf16*)lds;
    { const int d0 = 16 * wave, s0 = 2 * lane; float mean[2], rstd[2]; v4u xv[2][2];
#pragma unroll
      for (int rr = 0; rr < 2; ++rr) { const size_t row = (size_t)r0 + s0 + rr; const f32x4* p = (const f32x4*)(SVST + row * 16); const f32x4 a = p[0], b = p[1], c = p[2], d = p[3];
          const float sm = (a[0] + a[2]) + (b[0] + b[2]) + (c[0] + c[2]) + (d[0] + d[2]), sq = (a[1] + a[3]) + (b[1] + b[3]) + (c[1] + c[3]) + (d[1] + d[3]);
          mean[rr] = sm * (1.f / 512.f); rstd[rr] = rsqrtf(fmaxf(sq * (1.f / 512.f) - mean[rr] * mean[rr], 0.f) + EPS);
          const v4u* q = (const v4u*)(SV + row * 512 + h * 128 + d0); xv[rr][0] = q[0]; xv[rr][1] = q[1]; }
#pragma unroll
      for (int j = 0; j < 16; ++j) { const float g = lng[h * 128 + d0 + j], b = lnb[h * 128 + d0 + j]; const unsigned w0 = xv[0][j >> 3][(j >> 1) & 3], w1 = xv[1][j >> 3][(j >> 1) & 3];
          const float x0 = (j & 1) ? bf2f(w0 >> 16) : bf2f(w0 & 0xffffu), x1 = (j & 1) ? bf2f(w1 >> 16) : bf2f(w1 & 0xffffu);
          *(LAS unsigned*)(vnT + (d0 + j) * VP + s0) = pk2((x0 - mean[0]) * rstd[0] * g + b, (x1 - mean[1]) * rstd[1] * g + b); } }
    __syncthreads();
    { const int fr = lane & 15, fq = lane >> 4, t = 16 * wave + fr, nks = (wave >> 1) + 1; bf16x8 bfr[4];
#pragma unroll
      for (int ks = 0; ks < 4; ++ks) bfr[ks] = (ks < nks) ? *(const bf16x8*)(wsb + ((size_t)h * 128 + t) * 128 + 32 * ks + 8 * fq) : (bf16x8){0, 0, 0, 0, 0, 0, 0, 0};
      f32x4 acc[8];
#pragma unroll
      for (int m = 0; m < 8; ++m) { acc[m] = (f32x4){0.f, 0.f, 0.f, 0.f};
#pragma unroll
          for (int ks = 0; ks < 4; ++ks) if (ks < nks) { const bf16x8 a = *(const LAS bf16x8*)(vnT + (16 * m + fr) * VP + 32 * ks + 8 * fq); acc[m] = mfma16(a, bfr[ks], acc[m]); } }
      const size_t row = (size_t)r0 + t; const float bias = bs[h * 128 + t];
#pragma unroll
      for (int m = 0; m < 8; ++m) { const size_t po = row * 512 + h * 128 + 16 * m + 4 * fq; bf16* p = ZBO + po; const v2u su = *(const v2u*)(ZBI + po); v2u o;
          o.x = pk2(bf2f(su.x & 0xffffu) * (acc[m][0] + bias), bf2f(su.x >> 16) * (acc[m][1] + bias)); o.y = pk2(bf2f(su.y & 0xffffu) * (acc[m][2] + bias), bf2f(su.y >> 16) * (acc[m][3] + bias)); *(v2u*)p = o; } }
    __syncthreads();
}
__device__ __forceinline__ void convbr_item(int idx, const bf16* ZCI, bf16* ZCO, const bf16* CC, const bf16* CX, const float* cw) {
    const int c0 = (idx & 63) * 8, r0 = (idx >> 6) * 8; float w[3][8];
#pragma unroll
    for (int k = 0; k < 3; ++k) { const f32x4 a = *(const f32x4*)(cw + k * CW + c0), b = *(const f32x4*)(cw + k * CW + c0 + 4);
#pragma unroll
        for (int e = 0; e < 4; ++e) { w[k][e] = a[e]; w[k][4 + e] = b[e]; } }
    float u2[8], u1[8];
    auto loadu = [&](int row, float (&u)[8]) { const v4u a = *(const v4u*)(CC + (size_t)row * CW + c0), b = *(const v4u*)(CX + (size_t)row * CW + c0);
#pragma unroll
        for (int e = 0; e < 4; ++e) { u[2 * e] = bf2f(a[e] & 0xffffu) * bf2f(b[e] & 0xffffu); u[2 * e + 1] = bf2f(a[e] >> 16) * bf2f(b[e] >> 16); } };
    if ((r0 & (SEQ - 1)) == 0) {
#pragma unroll
        for (int e = 0; e < 8; ++e) { u2[e] = 0.f; u1[e] = 0.f; } }
    else { loadu(r0 - 2, u2); loadu(r0 - 1, u1); }
#pragma unroll
    for (int i = 0; i < 8; ++i) { float u0[8]; loadu(r0 + i, u0); const size_t po = (size_t)(r0 + i) * CW + c0; bf16* p = ZCO + po; const v4u cb = *(const v4u*)(ZCI + po); float z[8];
#pragma unroll
        for (int e = 0; e < 8; ++e) { const float y = w[0][e] * u2[e] + w[1][e] * u1[e] + w[2][e] * u0[e]; const float c = (e & 1) ? bf2f(cb[e >> 1] >> 16) : bf2f(cb[e >> 1] & 0xffffu); z[e] = c * y; u2[e] = u1[e]; u1[e] = u0[e]; }
        v4u o; o.x = pk2(z[0], z[1]); o.y = pk2(z[2], z[3]); o.z = pk2(z[4], z[5]); o.w = pk2(z[6], z[7]); *(v4u*)p = o; }
}
template <bool FULL> __device__ __forceinline__ float gla_stage(LAS unsigned char* lds, size_t r0, int h, const bf16* Q, const bf16* KK, const bf16* V, const float* LOGA, int tid) {
    const int kcol = tid & 63, seg = tid >> 6; LAS float* SEG = (LAS float*)(lds + L_SEG);
    float p[8]; unsigned kq[8], qq[8];
#pragma unroll
    for (int j = 0; j < 8; ++j) { const size_t row = r0 + 8 * seg + j; p[j] = LOGA[row * GKEY + h * 64 + kcol]; kq[j] = KK[row * GKEY + h * 64 + kcol]; if (FULL) qq[j] = Q[row * GKEY + h * 64 + kcol]; }
#pragma unroll
    for (int j = 1; j < 8; ++j) p[j] += p[j - 1];
    SEG[seg * 64 + kcol] = p[7];
    { const int tp = tid & 31, vg = tid >> 5; LAS bf16* VT = (LAS bf16*)(lds + L_VT);
      const v4u a = *(const v4u*)(V + (r0 + 2 * tp) * GVAL + h * 128 + 8 * vg), b = *(const v4u*)(V + (r0 + 2 * tp + 1) * GVAL + h * 128 + 8 * vg);
#pragma unroll
      for (int e = 0; e < 4; ++e) { *(LAS unsigned*)(VT + (8 * vg + 2 * e) * GP + 2 * tp) = (a[e] & 0xffffu) | (b[e] << 16); *(LAS unsigned*)(VT + (8 * vg + 2 * e + 1) * GP + 2 * tp) = (a[e] >> 16) | (b[e] & 0xffff0000u); } }
    __syncthreads();
    float off = 0.f, tot = 0.f;
#pragma unroll
    for (int s = 0; s < 8; ++s) { const float v = SEG[s * 64 + kcol]; tot += v; if (s < seg) off += v; }
    float ke[8];
#pragma unroll
    for (int j = 0; j < 8; ++j) { const float b = off + p[j], kf = bf2f(kq[j]); ke[j] = kf * __expf(tot - b);
        if (FULL) { const int t = 8 * seg + j; ((LAS bf16*)(lds + L_QT))[t * GP + kcol] = (bf16)(pk2(bf2f(qq[j]) * __expf(b), 0.f) & 0xffffu); ((LAS bf16*)(lds + L_KT))[t * GP + kcol] = (bf16)(pk2(kf * __expf(-b), 0.f) & 0xffffu); } }
    v4u o; o.x = pk2(ke[0], ke[1]); o.y = pk2(ke[2], ke[3]); o.z = pk2(ke[4], ke[5]); o.w = pk2(ke[6], ke[7]);
    *(LAS v4u*)((LAS bf16*)(lds + L_KENDT) + kcol * GP + 8 * seg) = o;
    return __expf(tot);
}
__device__ __forceinline__ void gla_b1_item(int item, LAS unsigned char* lds, const bf16* KK, const bf16* V, const float* LOGA, float* CST, float* DEC, int tid, int wave, int lane) {
    const int h = item & 3; const size_t r0 = (size_t)(item >> 2) * 64;
    const float dec = gla_stage<false>(lds, r0, h, nullptr, KK, V, LOGA, tid);
    if (tid < 64) DEC[(size_t)item * 64 + tid] = dec;
    __syncthreads();
    const int fr = lane & 15, fq = lane >> 4; const LAS bf16* VT = (const LAS bf16*)(lds + L_VT); const LAS bf16* KE = (const LAS bf16*)(lds + L_KENDT);
    bf16x8 bv[2];
#pragma unroll
    for (int ks = 0; ks < 2; ++ks) bv[ks] = *(const LAS bf16x8*)(VT + (16 * wave + fr) * GP + 32 * ks + 8 * fq);
#pragma unroll
    for (int m = 0; m < 4; ++m) { f32x4 acc = (f32x4){0.f, 0.f, 0.f, 0.f};
#pragma unroll
        for (int ks = 0; ks < 2; ++ks) acc = mfma16(*(const LAS bf16x8*)(KE + (16 * m + fr) * GP + 32 * ks + 8 * fq), bv[ks], acc);
        *(f32x4*)(CST + (size_t)item * 8192 + (16 * wave + fr) * 64 + 16 * m + 4 * fq) = acc; }
    __syncthreads();
}
__device__ __forceinline__ void gla_b2_unit(int unit, LAS unsigned char* lds, const bf16* Q, const bf16* KK, const bf16* V, const float* LOGA, const float* CST, const float* DEC, const bf16* ZAI, bf16* ZAO, int tid, int wave, int lane) {
    const int g = unit & 7, h = (unit >> 3) & 3, b = unit >> 5, fr = lane & 15, fq = lane >> 4;
    f32x4 S[4];
#pragma unroll
    for (int m = 0; m < 4; ++m) S[m] = (f32x4){0.f, 0.f, 0.f, 0.f};
    for (int j = 0; j < 4 * g; ++j) { const size_t it = ((size_t)(b * 32 + j) * 4 + h); const float* cp = CST + it * 8192 + (16 * wave + fr) * 64 + 4 * fq; const float* dp = DEC + it * 64 + 4 * fq;
#pragma unroll
        for (int m = 0; m < 4; ++m) { const f32x4 c = *(const f32x4*)(cp + 16 * m), d = *(const f32x4*)(dp + 16 * m); S[m] = d * S[m] + c; } }
    const LAS bf16* QT = (const LAS bf16*)(lds + L_QT); const LAS bf16* KT = (const LAS bf16*)(lds + L_KT); const LAS bf16* KE = (const LAS bf16*)(lds + L_KENDT);
    const LAS bf16* VT = (const LAS bf16*)(lds + L_VT); LAS bf16* ST = (LAS bf16*)(lds + L_ST); LAS float* DECS = (LAS float*)(lds + L_DECS); LAS float* RED = (LAS float*)(lds + L_RED);
    const int ih = wave & 3, vh = wave >> 2;
    for (int c = 0; c < 4; ++c) {
        const size_t r0 = (size_t)b * SEQ + (size_t)(4 * g + c) * 64;
#pragma unroll
        for (int m = 0; m < 4; ++m) { v2u w; w.x = pk2(S[m][0], S[m][1]); w.y = pk2(S[m][2], S[m][3]); *(LAS v2u*)(ST + (16 * wave + fr) * GP + 16 * m + 4 * fq) = w; }
        const float dec = gla_stage<true>(lds, r0, h, Q, KK, V, LOGA, tid);
        if (tid < 64) DECS[tid] = dec;
        __syncthreads();
        bf16x8 bq[2];
#pragma unroll
        for (int ks = 0; ks < 2; ++ks) bq[ks] = *(const LAS bf16x8*)(QT + (16 * ih + fr) * GP + 32 * ks + 8 * fq);
        f32x4 X[4];
#pragma unroll
        for (int jt = 0; jt < 4; ++jt) { X[jt] = (f32x4){0.f, 0.f, 0.f, 0.f};
            if (jt <= ih) {
#pragma unroll
                for (int ks = 0; ks < 2; ++ks) X[jt] = mfma16(*(const LAS bf16x8*)(KT + (16 * jt + fr) * GP + 32 * ks + 8 * fq), bq[ks], X[jt]);
#pragma unroll
                for (int r = 0; r < 4; ++r) if (16 * jt + 4 * fq + r > 16 * ih + fr) X[jt][r] = 0.f; } }
        bf16x8 xb[2];
#pragma unroll
        for (int k2 = 0; k2 < 2; ++k2) { v4u w; w.x = pk2(X[2 * k2][0], X[2 * k2][1]); w.y = pk2(X[2 * k2][2], X[2 * k2][3]); w.z = pk2(X[2 * k2 + 1][0], X[2 * k2 + 1][1]); w.w = pk2(X[2 * k2 + 1][2], X[2 * k2 + 1][3]); xb[k2] = __builtin_bit_cast(bf16x8, w); }
        f32x4 O[4]; float ss = 0.f;
#pragma unroll
        for (int mt = 0; mt < 4; ++mt) { const int v = 64 * vh + 16 * mt + fr; f32x4 o = (f32x4){0.f, 0.f, 0.f, 0.f};
#pragma unroll
            for (int k2 = 0; k2 < 2; ++k2) { const v2u lo = *(const LAS v2u*)(VT + v * GP + 32 * k2 + 4 * fq), hi = *(const LAS v2u*)(VT + v * GP + 32 * k2 + 16 + 4 * fq); v4u a; a.x = lo.x; a.y = lo.y; a.z = hi.x; a.w = hi.y;
                o = mfma16(__builtin_bit_cast(bf16x8, a), xb[k2], o); }
#pragma unroll
            for (int ks = 0; ks < 2; ++ks) o = mfma16(*(const LAS bf16x8*)(ST + v * GP + 32 * ks + 8 * fq), bq[ks], o);
            O[mt] = o; ss += (o[0] * o[0] + o[1] * o[1]) + (o[2] * o[2] + o[3] * o[3]); }
        ss += __shfl_xor(ss, 16); ss += __shfl_xor(ss, 32);
        if (fq == 0) RED[(vh * 4 + ih) * 16 + fr] = ss;
        __syncthreads();
        const float rs = rsqrtf((RED[ih * 16 + fr] + RED[(4 + ih) * 16 + fr]) * (1.f / 128.f) + EPS);
        { const size_t row = r0 + 16 * ih + fr;
#pragma unroll
          for (int mt = 0; mt < 4; ++mt) { const size_t po = row * GVAL + h * 128 + 64 * vh + 16 * mt + 4 * fq; bf16* p = ZAO + po; const v2u gt = *(const v2u*)(ZAI + po); v2u o;
              o.x = pk2(O[mt][0] * rs * bf2f(gt.x & 0xffffu), O[mt][1] * rs * bf2f(gt.x >> 16)); o.y = pk2(O[mt][2] * rs * bf2f(gt.y & 0xffffu), O[mt][3] * rs * bf2f(gt.y >> 16)); *(v2u*)p = o; } }
        bf16x8 bv[2];
#pragma unroll
        for (int ks = 0; ks < 2; ++ks) bv[ks] = *(const LAS bf16x8*)(VT + (16 * wave + fr) * GP + 32 * ks + 8 * fq);
#pragma unroll
        for (int m = 0; m < 4; ++m) { const f32x4 d = *(const LAS f32x4*)(DECS + 16 * m + 4 * fq); S[m] = S[m] * d;
#pragma unroll
            for (int ks = 0; ks < 2; ++ks) S[m] = mfma16(*(const LAS bf16x8*)(KE + (16 * m + fr) * GP + 32 * ks + 8 * fq), bv[ks], S[m]); }
        __syncthreads();
    }
}
__device__ __forceinline__ void ffn_act_item(int idx, const bf16* HUP, bf16* ACT, const float* cw, const float* cb) {
    const int cgp = idx % 352, rb = idx / 352, pn = cgp >> 4, c8 = (cgp & 15) * 8, j0 = 128 * pn + c8, r0 = rb * 16;
    float wg[3][8], wv[3][8], bg[8], bv[8];
#pragma unroll
    for (int e = 0; e < 8; ++e) { bg[e] = cb[j0 + e]; bv[e] = cb[DFF + j0 + e];
#pragma unroll
        for (int k = 0; k < 3; ++k) { wg[k][e] = cw[k * DFF2 + j0 + e]; wv[k][e] = cw[k * DFF2 + DFF + j0 + e]; } }
    float g2[8], g1[8], v2[8], v1[8];
    auto ld = [&](int row, float (&g)[8], float (&v)[8]) { const bf16* p = HUP + (size_t)row * DFF2 + 256 * pn + c8; const v4u a = *(const v4u*)p, b = *(const v4u*)(p + 128);
#pragma unroll
        for (int e = 0; e < 4; ++e) { g[2 * e] = bf2f(a[e] & 0xffffu); g[2 * e + 1] = bf2f(a[e] >> 16); v[2 * e] = bf2f(b[e] & 0xffffu); v[2 * e + 1] = bf2f(b[e] >> 16); } };
    if ((r0 & (SEQ - 1)) == 0) {
#pragma unroll
        for (int e = 0; e < 8; ++e) { g2[e] = 0.f; g1[e] = 0.f; v2[e] = 0.f; v1[e] = 0.f; } }
    else { ld(r0 - 2, g2, v2); ld(r0 - 1, g1, v1); }
    for (int i = 0; i < 16; ++i) { float g0[8], v0[8]; ld(r0 + i, g0, v0); float z[8];
#pragma unroll
        for (int e = 0; e < 8; ++e) { const float ga = wg[0][e] * g2[e] + wg[1][e] * g1[e] + wg[2][e] * g0[e] + bg[e], va = wv[0][e] * v2[e] + wv[1][e] * v1[e] + wv[2][e] * v0[e] + bv[e];
            z[e] = fsilu(ga) * va; g2[e] = g1[e]; g1[e] = g0[e]; v2[e] = v1[e]; v1[e] = v0[e]; }
        v4u o; o.x = pk2(z[0], z[1]); o.y = pk2(z[2], z[3]); o.z = pk2(z[4], z[5]); o.w = pk2(z[6], z[7]); *(v4u*)(ACT + (size_t)(r0 + i) * DFF + j0) = o; }
}

using pg8::Unit;
__device__ __forceinline__ void row_rstd(const float* SSQ, int pm, int wr, int fr, int fq, float (&rsd)[2][4]) {
    const int lane = fr + 16 * fq;
#pragma unroll
    for (int ai = 0; ai < 2; ++ai) { const size_t row = (size_t)pm * 256 + ai * 128 + wr * 64 + lane; const f32x4* p = (const f32x4*)(SSQ + row * 16); const f32x4 a = p[0], b = p[1], c = p[2], d = p[3];
        const float s = ((a[0] + a[1]) + (a[2] + a[3])) + ((b[0] + b[1]) + (b[2] + b[3])) + ((c[0] + c[1]) + (c[2] + c[3])) + ((d[0] + d[1]) + (d[2] + d[3]));
        const float rs = rsqrtf(s * (1.f / D) + EPS);
#pragma unroll
        for (int m = 0; m < 4; ++m) rsd[ai][m] = __shfl(rs, 16 * m + fr); }
}
struct EpiA {
    static constexpr bool PERM = true, AFTER_DRAIN = false;
    unsigned char* act0; const float* SSQ; float* SVST; const float* bal;
    __device__ __forceinline__ void operator()(const f32x4 (&acc)[2][2][4][2], const Unit& u, int wr, int wc, int fr_, int fq_) const {
        int ln_; asm volatile("v_mbcnt_lo_u32_b32 %0, -1, 0\n\tv_mbcnt_hi_u32_b32 %0, -1, %0" : "=v"(ln_)); const int fr = ln_ & 15, fq = ln_ >> 4; (void)fr_; (void)fq_;
        float rsd[2][4]; row_rstd(SSQ, u.pm, wr, fr, fq, rsd);
        const int pn = u.pn; int mode, ldc, colt; size_t boff;
        if (pn < 1) { mode = 0; boff = A_Q; ldc = 256; colt = 0; } else if (pn < 2) { mode = 0; boff = A_K; ldc = 256; colt = 0; } else if (pn < 4) { mode = 0; boff = A_V; ldc = 512; colt = (pn - 2) * 256; }
        else if (pn < 6) { mode = 1; boff = A_Z; ldc = 512; colt = (pn - 4) * 256; } else if (pn < 7) { mode = 4; boff = A_LOGA; ldc = 256; colt = 0; }
        else if (pn < 9) { mode = 2; boff = A_Z + (size_t)M * 512 * 2; ldc = 512; colt = (pn - 7) * 256; } else if (pn < 11) { mode = 3; boff = A_SV; ldc = 512; colt = (pn - 9) * 256; }
        else if (pn < 13) { mode = 0; boff = A_Z + (size_t)2 * M * 512 * 2; ldc = 512; colt = (pn - 11) * 256; } else if (pn < 15) { mode = 0; boff = A_CC; ldc = 512; colt = (pn - 13) * 256; }
        else if (pn < 17) { mode = 0; boff = A_CX; ldc = 512; colt = (pn - 15) * 256; } else { mode = 5; boff = A_G; ldc = 3072; colt = (pn - 17) * 256; }
        const int col0 = colt + wc * 32 + 8 * fq;
#pragma unroll
        for (int ai = 0; ai < 2; ++ai)
#pragma unroll
            for (int m = 0; m < 4; ++m) { const size_t row = (size_t)u.pm * 256 + ai * 128 + wr * 64 + m * 16 + fr; const float rs = rsd[ai][m]; float s1 = 0.f, s2 = 0.f;
#pragma unroll
                for (int bj = 0; bj < 2; ++bj) { const f32x4 a0 = acc[ai][bj][m][0] * rs, a1 = acc[ai][bj][m][1] * rs; float v[8] = {a0[0], a0[1], a0[2], a0[3], a1[0], a1[1], a1[2], a1[3]};
                    if (mode == 4) { const f32x4 b0 = *(const f32x4*)(bal + col0 + bj * 128), b1 = *(const f32x4*)(bal + col0 + bj * 128 + 4); f32x4 o0, o1;
#pragma unroll
                        for (int e = 0; e < 4; ++e) { o0[e] = flogsig(v[e] + b0[e]) * 0.0625f; o1[e] = flogsig(v[4 + e] + b1[e]) * 0.0625f; }
                        float* p = (float*)(act0 + boff) + row * 256 + col0 + bj * 128; *(f32x4*)p = o0; *(f32x4*)(p + 4) = o1; }
                    else {
                        if (mode == 1) {
#pragma unroll
                            for (int e = 0; e < 8; ++e) v[e] = fsilu(v[e]); }
                        else if (mode == 2 || mode == 3) {
#pragma unroll
                            for (int e = 0; e < 8; ++e) v[e] = fgelu(v[e]); }
                        else if (mode == 5) {
#pragma unroll
                            for (int e = 0; e < 8; ++e) v[e] = fsigmoid(v[e]); }
                        if (mode == 3) {
#pragma unroll
                            for (int e = 0; e < 8; ++e) { s1 += v[e]; s2 += v[e] * v[e]; } }
                        v4u o; o.x = pk2(v[0], v[1]); o.y = pk2(v[2], v[3]); o.z = pk2(v[4], v[5]); o.w = pk2(v[6], v[7]);
                        *(v4u*)((bf16*)(act0 + boff) + row * ldc + col0 + bj * 128) = o; } }
                if (mode == 3) { s1 += __shfl_xor(s1, 16); s1 += __shfl_xor(s1, 32); s2 += __shfl_xor(s2, 16); s2 += __shfl_xor(s2, 32);
                    if (fq == 0) *(f32x2*)(SVST + row * 16 + ((pn - 9) * 4 + wc) * 2) = (f32x2){s1, s2}; } }
    }
};
struct EpiC {
    static constexpr bool PERM = true, AFTER_DRAIN = false;
    const bf16* G; bf16* MG;
    __device__ __forceinline__ void operator()(const f32x4 (&acc)[2][2][4][2], const Unit& u, int wr, int wc, int fr_, int fq_) const {
        int ln_; asm volatile("v_mbcnt_lo_u32_b32 %0, -1, 0\n\tv_mbcnt_hi_u32_b32 %0, -1, %0" : "=v"(ln_)); const int fr = ln_ & 15, fq = ln_ >> 4; (void)fr_; (void)fq_;
        const int br = u.pm >> 6, pm = u.pm & 63, pn = u.pn & 3; const int col0 = pn * 256 + wc * 32 + 8 * fq;
#pragma unroll
        for (int ai = 0; ai < 2; ++ai) {
            v4u gt[4][2], old[4][2];
#pragma unroll
            for (int m = 0; m < 4; ++m)
#pragma unroll
                for (int bj = 0; bj < 2; ++bj) { const size_t row = (size_t)pm * 256 + ai * 128 + wr * 64 + m * 16 + fr; gt[m][bj] = *(const v4u*)(G + row * 3072 + br * 1024 + col0 + bj * 128);
                    if (br != 0) old[m][bj] = *(const v4u*)(MG + row * 1024 + col0 + bj * 128); }
#pragma unroll
            for (int m = 0; m < 4; ++m) { const size_t row = (size_t)pm * 256 + ai * 128 + wr * 64 + m * 16 + fr;
#pragma unroll
                for (int bj = 0; bj < 2; ++bj) { const f32x4 a0 = acc[ai][bj][m][0], a1 = acc[ai][bj][m][1]; float v[8] = {a0[0], a0[1], a0[2], a0[3], a1[0], a1[1], a1[2], a1[3]};
#pragma unroll
                    for (int e = 0; e < 4; ++e) { v[2 * e] *= bf2f(gt[m][bj][e] & 0xffffu); v[2 * e + 1] *= bf2f(gt[m][bj][e] >> 16); }
                    if (br != 0) {
#pragma unroll
                        for (int e = 0; e < 4; ++e) { v[2 * e] += bf2f(old[m][bj][e] & 0xffffu); v[2 * e + 1] += bf2f(old[m][bj][e] >> 16); } }
                    v4u o; o.x = pk2(v[0], v[1]); o.y = pk2(v[2], v[3]); o.z = pk2(v[4], v[5]); o.w = pk2(v[6], v[7]); *(v4u*)(MG + row * 1024 + col0 + bj * 128) = o; } } }
    }
};
struct BranchOrder {
    int G, c;
    __device__ bool next(int i, Unit& u) const { const int j = i / 3, br = i - 3 * j, T = c + G * j; if (T >= 256) return false;
        const int w = (T & 7) * 32 + (T >> 3), pm = (w >> 5) * 8 + (w & 7), pn = (w & 31) >> 3; u.pm = br * 64 + pm; u.pn = br * 4 + pn; return true; }
    __device__ __forceinline__ void a_ready(const Unit&) const {}
    __device__ __forceinline__ void done(const Unit&) const {}
};
template <int VAR> struct EpiResT {
    static constexpr bool PERM = true, AFTER_DRAIN = false;
    const bf16* XI; bf16* XB; float* SSQ;
    __device__ __forceinline__ void operator()(const f32x4 (&acc)[2][2][4][2], const Unit& u, int wr, int wc, int fr_, int fq_) const {
        int ln_; asm volatile("v_mbcnt_lo_u32_b32 %0, -1, 0\n\tv_mbcnt_hi_u32_b32 %0, -1, %0" : "=v"(ln_)); const int fr = ln_ & 15, fq = ln_ >> 4; (void)fr_; (void)fq_;
        const int col0 = u.pn * 256 + wc * 32 + 8 * fq;
        v4u xo[2][4][2];
#pragma unroll
        for (int ai = 0; ai < 2; ++ai)
#pragma unroll
            for (int m = 0; m < 4; ++m)
#pragma unroll
                for (int bj = 0; bj < 2; ++bj) xo[ai][m][bj] = *(const v4u*)(XI + ((size_t)u.pm * 256 + ai * 128 + wr * 64 + m * 16 + fr) * D + col0 + bj * 128);
#pragma unroll
        for (int ai = 0; ai < 2; ++ai)
#pragma unroll
            for (int m = 0; m < 4; ++m) { const size_t row = (size_t)u.pm * 256 + ai * 128 + wr * 64 + m * 16 + fr; float ss = 0.f;
#pragma unroll
                for (int bj = 0; bj < 2; ++bj) { const size_t off = row * D + col0 + bj * 128; const f32x4 a0 = acc[ai][bj][m][0], a1 = acc[ai][bj][m][1];
                    float v[8] = {a0[0], a0[1], a0[2], a0[3], a1[0], a1[1], a1[2], a1[3]};
#pragma unroll
                    for (int e = 0; e < 4; ++e) { v[2 * e] += bf2f(xo[ai][m][bj][e] & 0xffffu); v[2 * e + 1] += bf2f(xo[ai][m][bj][e] >> 16); }
#pragma unroll
                    for (int e = 0; e < 8; ++e) ss += v[e] * v[e];
                    v4u o; o.x = pk2(v[0], v[1]); o.y = pk2(v[2], v[3]); o.z = pk2(v[4], v[5]); o.w = pk2(v[6], v[7]); if (VAR != 1 || ss == 12345.678f) *(v4u*)(XB + off) = o; }
                if (VAR == 0) { ss += __shfl_xor(ss, 16); ss += __shfl_xor(ss, 32);
                if (fq == 0) SSQ[row * 16 + u.pn * 4 + wc] = ss; } }
    }
};
typedef EpiResT<0> EpiRes;
struct EpiUp {
    static constexpr bool PERM = true, AFTER_DRAIN = false;
    bf16* HUP; const float* SSQ;
    __device__ __forceinline__ void operator()(const f32x4 (&acc)[2][2][4][2], const Unit& u, int wr, int wc, int fr_, int fq_) const {
        int ln_; asm volatile("v_mbcnt_lo_u32_b32 %0, -1, 0\n\tv_mbcnt_hi_u32_b32 %0, -1, %0" : "=v"(ln_)); const int fr = ln_ & 15, fq = ln_ >> 4; (void)fr_; (void)fq_;
        float rsd[2][4]; row_rstd(SSQ, u.pm, wr, fr, fq, rsd);
        const int col0 = u.pn * 256 + wc * 32 + 8 * fq;
#pragma unroll
        for (int ai = 0; ai < 2; ++ai)
#pragma unroll
            for (int m = 0; m < 4; ++m) { const size_t row = (size_t)u.pm * 256 + ai * 128 + wr * 64 + m * 16 + fr; const float rs = rsd[ai][m];
#pragma unroll
                for (int bj = 0; bj < 2; ++bj) { const f32x4 a0 = acc[ai][bj][m][0] * rs, a1 = acc[ai][bj][m][1] * rs;
                    v4u o; o.x = pk2(a0[0], a0[1]); o.y = pk2(a0[2], a0[3]); o.z = pk2(a1[0], a1[1]); o.w = pk2(a1[2], a1[3]); *(v4u*)(HUP + row * DFF2 + col0 + bj * 128) = o; } }
    }
};

__device__ __forceinline__ float dpp_f(float old, float src, const int ctrl_sel) {
    const int o = __builtin_bit_cast(int, old), v = __builtin_bit_cast(int, src); int r;
    if (ctrl_sel == 0) r = __builtin_amdgcn_update_dpp(o, v, 0x111, 0xf, 0xf, false);
    else if (ctrl_sel == 1) r = __builtin_amdgcn_update_dpp(o, v, 0x112, 0xf, 0xf, false);
    else if (ctrl_sel == 2) r = __builtin_amdgcn_update_dpp(o, v, 0x121, 0xf, 0xf, false);
    else r = __builtin_amdgcn_update_dpp(o, v, 0x122, 0xf, 0xf, false);
    return __builtin_bit_cast(float, r);
}
constexpr int XL_OFF = RING_BYTES + 1024;
struct EpiUpConv {
    static constexpr bool PERM = true, AFTER_DRAIN = false;
    unsigned char* ws; const float* cw; const float* cb; LAS unsigned char* lds;
    __device__ __forceinline__ void operator()(const f32x4 (&acc)[2][2][4][2], const Unit& u, int wr, int wc, int fr_, int fq_) const {
        int ln_; asm volatile("v_mbcnt_lo_u32_b32 %0, -1, 0\n\tv_mbcnt_hi_u32_b32 %0, -1, %0" : "=v"(ln_)); const int fr = ln_ & 15, fq = ln_ >> 4; (void)fr_; (void)fq_;
        bf16* ACT = (bf16*)(ws + WS_ACT0 + A_ACT); const float* SSQ = (const float*)(ws + WS_SSQ); float* HT = (float*)(ws + WS_ACT0 + A_HT);
        float rsd[2][4]; row_rstd(SSQ, u.pm, wr, fr, fq, rsd);
        LAS f32x4* XL = (LAS f32x4*)(lds + XL_OFF);
        const int tcol = u.pn * 256 + wc * 32 + 8 * fq;
#pragma unroll
        for (int ai = 0; ai < 2; ++ai)
#pragma unroll
            for (int bj = 0; bj < 2; ++bj)
#pragma unroll
                for (int n = 0; n < 2; ++n) {
                    if (fr >= 14) { const f32x4 h = acc[ai][bj][3][n] * rsd[ai][3]; XL[((((ai * 2 + wr) * 4 + wc) * 2 + bj) * 2 + n) * 8 + fq * 2 + (fr - 14)] = h;
                        if (ai == 1 && wr == 1) *(f32x4*)(HT + ((size_t)(u.pm * 2 + 1) * 2 + (fr - 14)) * DFF2 + tcol + bj * 128 + 4 * n) = h; }
                    if (ai == 0 && wr == 0 && fr < 2) *(f32x4*)(HT + ((size_t)(u.pm * 2 + 0) * 2 + fr) * DFF2 + tcol + bj * 128 + 4 * n) = acc[0][bj][0][n] * rsd[0][0]; }
        asm volatile("s_waitcnt lgkmcnt(0)" ::: "memory"); __builtin_amdgcn_s_barrier(); asm volatile("" ::: "memory");
        const int ch0 = u.pn * 128 + wc * 32 + 8 * fq; const bool batch_start = (u.pm & 7) == 0;
#pragma unroll
        for (int n = 0; n < 2; ++n) {
            asm volatile("" ::: "memory");
            f32x4 wg[3], wv[3];
#pragma unroll
            for (int k = 0; k < 3; ++k) { wg[k] = *(const f32x4*)(cw + k * DFF2 + ch0 + 4 * n); wv[k] = *(const f32x4*)(cw + k * DFF2 + DFF + ch0 + 4 * n); }
            const f32x4 bg = *(const f32x4*)(cb + ch0 + 4 * n), bv = *(const f32x4*)(cb + DFF + ch0 + 4 * n);
#pragma unroll
            for (int ai = 0; ai < 2; ++ai) {
                f32x4 hgp, hvp;
                { f32x4 pg14 = (f32x4){0.f, 0.f, 0.f, 0.f}, pg15 = pg14, pv14 = pg14, pv15 = pg14;
                  if (!(ai == 0 && wr == 0)) { const int pb = ai * 2 + wr - 1; const LAS f32x4* q = XL + ((((pb * 4 + wc) * 2 + 0) * 2 + n) * 8 + fq * 2); const LAS f32x4* qv = XL + ((((pb * 4 + wc) * 2 + 1) * 2 + n) * 8 + fq * 2);
                      pg14 = q[0]; pg15 = q[1]; pv14 = qv[0]; pv15 = qv[1]; }
                  hgp = (fr == 14) ? pg14 : pg15; hvp = (fr == 14) ? pv14 : pv15; }
#pragma unroll
                for (int m = 0; m < 4; ++m) { const f32x4 hg = acc[ai][0][m][n] * rsd[ai][m], hv = acc[ai][1][m][n] * rsd[ai][m]; f32x4 z;
#pragma unroll
                    for (int e = 0; e < 4; ++e) {
                        const float g1 = dpp_f(dpp_f(0.f, hgp[e], 2), hg[e], 0), g2 = dpp_f(dpp_f(0.f, hgp[e], 3), hg[e], 1);
                        const float v1 = dpp_f(dpp_f(0.f, hvp[e], 2), hv[e], 0), v2 = dpp_f(dpp_f(0.f, hvp[e], 3), hv[e], 1);
                        const float ga = wg[0][e] * g2 + wg[1][e] * g1 + wg[2][e] * hg[e] + bg[e], va = wv[0][e] * v2 + wv[1][e] * v1 + wv[2][e] * hv[e] + bv[e];
                        z[e] = fsilu(ga) * va; }
                    const size_t row = (size_t)u.pm * 256 + ai * 128 + wr * 64 + m * 16 + fr;
                    const bool skip = (ai == 0 && wr == 0 && m == 0 && fr < 2 && !batch_start);
                    if (!skip) { v2u o; o.x = pk2(z[0], z[1]); o.y = pk2(z[2], z[3]); *(v2u*)(ACT + row * DFF + ch0 + 4 * n) = o; }
                    hgp = hg; hvp = hv; } } }
    }
};
__device__ __forceinline__ void ffn_fixup(int pm, const float* HT, bf16* ACT, const float* cw, const float* cb, int tid) {
    if ((pm & 7) == 0) return;
    for (int it = tid; it < 2 * (DFF / 4); it += NTHREADS) { const int rr = it / (DFF / 4), j = (it % (DFF / 4)) * 4, tc = (j >> 7) * 256 + (j & 127);
        const float* h0 = HT + ((size_t)(pm * 2 + 0) * 2 + rr) * DFF2;
        const float* h1 = rr ? HT + ((size_t)(pm * 2 + 0) * 2 + 0) * DFF2 : HT + ((size_t)((pm - 1) * 2 + 1) * 2 + 1) * DFF2;
        const float* h2 = rr ? HT + ((size_t)((pm - 1) * 2 + 1) * 2 + 1) * DFF2 : HT + ((size_t)((pm - 1) * 2 + 1) * 2 + 0) * DFF2;
        const f32x4 g0 = *(const f32x4*)(h0 + tc), g1 = *(const f32x4*)(h1 + tc), g2 = *(const f32x4*)(h2 + tc), v0 = *(const f32x4*)(h0 + tc + 128), v1 = *(const f32x4*)(h1 + tc + 128), v2 = *(const f32x4*)(h2 + tc + 128);
        const f32x4 ga = *(const f32x4*)(cw + j) * g2 + *(const f32x4*)(cw + DFF2 + j) * g1 + *(const f32x4*)(cw + 2 * DFF2 + j) * g0 + *(const f32x4*)(cb + j);
        const f32x4 va = *(const f32x4*)(cw + DFF + j) * v2 + *(const f32x4*)(cw + DFF2 + DFF + j) * v1 + *(const f32x4*)(cw + 2 * DFF2 + DFF + j) * v0 + *(const f32x4*)(cb + DFF + j);
        v2u o; o.x = pk2(fsilu(ga[0]) * va[0], fsilu(ga[1]) * va[1]); o.y = pk2(fsilu(ga[2]) * va[2], fsilu(ga[3]) * va[3]);
        *(v2u*)(ACT + ((size_t)pm * 256 + rr) * DFF + j) = o; }
    asm volatile("s_waitcnt vmcnt(0)" ::: "memory"); __syncthreads();
}

template <bool P> struct EpiNull {
    static constexpr bool PERM = P, AFTER_DRAIN = false; float* sink;
    __device__ __forceinline__ void operator()(const f32x4 (&acc)[2][2][4][2], const Unit& u, int wr, int wc, int fr, int fq) const {
        f32x4 s = (f32x4){0.f, 0.f, 0.f, 0.f};
#pragma unroll
        for (int ai = 0; ai < 2; ++ai)
#pragma unroll
            for (int bj = 0; bj < 2; ++bj)
#pragma unroll
                for (int m = 0; m < 4; ++m)
#pragma unroll
                    for (int n = 0; n < 2; ++n) s += acc[ai][bj][m][n];
        if (s[0] + s[1] + s[2] + s[3] == 12345.678f) sink[u.pm + wr + wc + fr + fq] = s[0];
    }
};
#define XB_TMO      128
#define XB_XCNT(j)  (256  + 64 * (j))
#define XB_XSUB(j)  (1280 + 64 * (j))
#define XB_XGEN(j)  (2304 + 64 * (j))
#define XB_TOP      3328
#define XB_TOPGEN   3392
#define XCD_BAR_WORDS 3456
#define XB_SPIN_CAP (1u << 18)

__device__ __forceinline__ unsigned xb_ld(unsigned* p)              { return __hip_atomic_load(p, __ATOMIC_RELAXED, __HIP_MEMORY_SCOPE_AGENT); }
__device__ __forceinline__ unsigned xb_add(unsigned* p, unsigned v) { return __hip_atomic_fetch_add(p, v, __ATOMIC_RELAXED, __HIP_MEMORY_SCOPE_AGENT); }
__device__ __forceinline__ unsigned xb_xcc_id() { return (unsigned)__builtin_amdgcn_s_getreg((3 << 11) | 20) & 0xFu; }
#define XB_SPIN(cond, bar) do { unsigned _sp = 0; while (cond) { __builtin_amdgcn_s_sleep(1); \
    if ((++_sp & 255u) == 0u) { if (xb_ld(&(bar)[XB_TMO])) break; if (_sp > XB_SPIN_CAP) { atomicAdd(&(bar)[XB_TMO], 1u); break; } } } } while (0)

struct XcdBarrier {
    unsigned* bar; unsigned x;
    volatile LAS unsigned* st;
};

__device__ __forceinline__ XcdBarrier xcd_barrier_post(unsigned* bar, volatile LAS unsigned* st) {
    XcdBarrier b; b.bar = bar; b.x = xb_xcc_id(); b.st = st;
    if (threadIdx.x == 0) (void)xb_add(&bar[XB_XCNT(b.x)], 1u);
    return b;
}
__device__ __forceinline__ void xcd_barrier_complete(unsigned* bar, unsigned x, unsigned& nloc, unsigned& nx) {
    const unsigned G = gridDim.x * gridDim.y * gridDim.z;
    unsigned sum, cnt, mine, sp = 0u;
    for (;;) {
        sum = 0u; cnt = 0u; mine = 0u;
#pragma unroll
        for (unsigned j = 0; j < 16; ++j) { const unsigned c = xb_ld(&bar[XB_XCNT(j)]); sum += c; cnt += (c > 0u) ? 1u : 0u; mine = (j == x) ? c : mine; }
        if (sum == G) break;
        __builtin_amdgcn_s_sleep(1);
        if ((++sp & 255u) == 0u) { if (xb_ld(&bar[XB_TMO])) break; if (sp > XB_SPIN_CAP) { atomicAdd(&bar[XB_TMO], 1u); break; } }
    }
    nloc = mine > 0u ? mine : 1u; nx = cnt > 0u ? cnt : 1u;
}

__device__ __forceinline__ void xcd_barrier(const XcdBarrier& b) {
    asm volatile("s_waitcnt vmcnt(0)" ::: "memory");
    __syncthreads();
    if (threadIdx.x == 0) {
        unsigned* bar = b.bar;
        __builtin_amdgcn_s_waitcnt(0);
        unsigned nloc = b.st[0], nx = b.st[1];
        if (nloc == 0u) { xcd_barrier_complete(bar, b.x, nloc, nx); b.st[0] = nloc; b.st[1] = nx; }
        const unsigned old = xb_add(&bar[XB_XSUB(b.x)], 1u);
        const unsigned gen = old / nloc;
        if (old + 1u == (gen + 1u) * nloc) {
            __builtin_amdgcn_fence(__ATOMIC_RELEASE, "agent");
            asm volatile("s_waitcnt vmcnt(0)" ::: "memory");
            const unsigned og = xb_add(&bar[XB_TOP], 1u);
            const unsigned tg = og / nx;
            if (og + 1u == (tg + 1u) * nx) xb_add(&bar[XB_TOPGEN], 1u);
            else XB_SPIN(xb_ld(&bar[XB_TOPGEN]) == tg, bar);
            __builtin_amdgcn_fence(__ATOMIC_ACQUIRE, "agent");
            xb_add(&bar[XB_XGEN(b.x)], 1u);
            asm volatile("s_waitcnt vmcnt(0)" ::: "memory");
        } else {
            XB_SPIN(xb_ld(&bar[XB_XGEN(b.x)]) == gen, bar);
            __builtin_amdgcn_fence(__ATOMIC_ACQUIRE, "agent");
            asm volatile("s_waitcnt vmcnt(0)" ::: "memory");
        }
    }
    __syncthreads();
}

#ifndef PROBE
#define PROBE 0
#endif
struct Args { Inputs in; float* out; unsigned char* ws; int ph_lo, ph_hi; };
constexpr int NPHASE = 2 + 7 * DEPTH;
#define LAUNDER_S(p) asm volatile("" : "+s"(p))
#define LAUNDER_V(p) asm volatile("" : "+v"(p))
struct Ctx { unsigned char* ws; unsigned char* act0; float* X; int tid, lane, wave, G, bx, gw, ngw; };
__device__ __forceinline__ Ctx make_ctx(const Args& a, int wave_id) {
    Ctx c; size_t z = 0; LAUNDER_S(z); c.ws = a.ws + z; c.X = (float*)((unsigned char*)a.out + z); c.act0 = c.ws + WS_ACT0;
    int ln; asm volatile("v_mbcnt_lo_u32_b32 %0, -1, 0\n\tv_mbcnt_hi_u32_b32 %0, -1, %0" : "=v"(ln)); c.lane = ln; c.wave = wave_id; c.tid = wave_id * 64 + ln;
    c.G = gridDim.x; c.bx = blockIdx.x; c.gw = c.bx * NWAVES + c.wave; c.ngw = c.G * NWAVES; return c;
}
__device__ __forceinline__ unsigned char* slot_of(const Ctx& c, int l) { return c.ws + WS_SLOT0 + (size_t)(l & 1) * SL_BYTES; }
__device__ __forceinline__ unsigned* ctl_word(const Ctx& c, int w) { return (unsigned*)(c.ws + WS_CTL) + w; }
__device__ __forceinline__ void tail_convert(const Args& a, const Ctx& c, int l, int ph, bool drain, LAS unsigned char* lds) {
#if MK_ONE_LAUNCH
    unsigned* fin = ctl_word(c, CW_FIN + 64 * ph);
    if (c.tid == 0) __hip_atomic_fetch_add(fin, 1u, RLX_AGENT);
    if (l == 0 && ph == 1) convert_queue(a.in, 0, slot_of(c, 0), lds, ctl_word(c, CW_QHEAD), CV_WIN_ITEMS, CV_ITEMS, nullptr, c.G, c.tid, c.wave, c.lane);
    if (l + 1 < DEPTH) convert_queue(a.in, l + 1, slot_of(c, l + 1), lds, ctl_word(c, CW_QHEAD + 64 * (l + 1)), 0, CV_ITEMS, drain ? nullptr : fin, c.G, c.tid, c.wave, c.lane);
#else
    if (l == 0 && ph == 1) convert_static(a.in, 0, slot_of(c, 0), lds, CV_WIN_ITEMS, CV_ITEMS, c.gw, c.ngw, c.wave, c.lane);
    if (l + 1 < DEPTH && drain) convert_static(a.in, l + 1, slot_of(c, l + 1), lds, 0, CV_ITEMS, c.gw, c.ngw, c.wave, c.lane);
#endif
}
__device__ __forceinline__ void ph_p0(const Args& a, const int wv, LAS unsigned char* lds) { const Ctx c = make_ctx(a, wv);
    convert_static(a.in, 0, c.ws + WS_SLOT0, lds, 0, CV_WIN_ITEMS, c.gw, c.ngw, c.wave, c.lane); x_prep(a.in.p[0], (bf16*)(c.ws + WS_XB), (float*)(c.ws + WS_SSQ), c.gw, c.ngw, c.lane); }
__device__ __forceinline__ void ph_a(const Args& a, const int wv, int l, int ph, LAS unsigned char* lds) { const Ctx c = make_ctx(a, wv);
    pg8::Gemm g{(const bf16*)(c.ws + WS_XB), (const bf16*)(slot_of(c, l) + SL_WIN), M, NIN, D}; pg8::StaticOrder S; S.init(M, NIN, c.G, c.bx);
    EpiA E{c.act0, (const float*)(c.ws + WS_SSQ), (float*)(c.ws + WS_SVST), a.in.p[4] + (size_t)l * GKEY};
    if (PROBE == 21) { EpiNull<true> EN_{(float*)(c.ws + WS_END)}; pg8::gemm_phase<EpiNull<true>, pg8::StaticOrder, true, true>(lds, g, S, EN_, wv); }
    for (int rep = 0; rep < 1 + (PROBE == 1); ++rep) pg8::gemm_phase<EpiA, pg8::StaticOrder, true, true>(lds, g, S, E, wv);
    { const Ctx c2 = make_ctx(a, wv); tail_convert(a, c2, l, ph, false, lds); } }
__device__ __forceinline__ void ph_b1(const Args& a, const int wv, int l, LAS unsigned char* lds) { const Ctx c = make_ctx(a, wv); const Inputs& I = a.in;
    bf16* Zb = (bf16*)(c.act0 + A_Z); bf16* DUM = (bf16*)(c.ws + WS_END);
    for (int rep = 0; rep < 1 + (PROBE == 2); ++rep)
    for (int it = c.bx; it < 1024; it += c.G) gla_b1_item(it, lds, (const bf16*)(c.act0 + A_K), (const bf16*)(c.act0 + A_V), (const float*)(c.act0 + A_LOGA), (float*)(c.act0 + A_CST), (float*)(c.act0 + A_DEC), c.tid, c.wave, c.lane);
    if (PROBE == 3) for (int it = c.bx; it < 512; it += c.G) sgu_item(it, lds, Zb + (size_t)M * 512, DUM, (const bf16*)(c.act0 + A_SV), (const float*)(c.ws + WS_SVST), I.p[7] + (size_t)l * SGW, I.p[8] + (size_t)l * SGW, (const bf16*)(slot_of(c, l) + SL_SGW), I.p[10] + (size_t)l * 512, c.wave, c.lane);
    for (int it = c.bx; it < 512; it += c.G) sgu_item(it, lds, Zb + (size_t)M * 512, Zb + (size_t)M * 512, (const bf16*)(c.act0 + A_SV), (const float*)(c.ws + WS_SVST), I.p[7] + (size_t)l * SGW, I.p[8] + (size_t)l * SGW, (const bf16*)(slot_of(c, l) + SL_SGW), I.p[10] + (size_t)l * 512, c.wave, c.lane);
    if (PROBE == 4) for (int it = c.bx * NTHREADS + c.tid; it < 131072; it += c.G * NTHREADS) convbr_item(it, Zb + (size_t)2 * M * 512, DUM, (const bf16*)(c.act0 + A_CC), (const bf16*)(c.act0 + A_CX), I.p[12] + (size_t)l * 3 * CW);
    for (int it = c.bx * NTHREADS + c.tid; it < 131072; it += c.G * NTHREADS) convbr_item(it, Zb + (size_t)2 * M * 512, Zb + (size_t)2 * M * 512, (const bf16*)(c.act0 + A_CC), (const bf16*)(c.act0 + A_CX), I.p[12] + (size_t)l * 3 * CW);
}
__device__ __forceinline__ void ph_b2(const Args& a, const int wv, int l, int ph, LAS unsigned char* lds) { const Ctx c = make_ctx(a, wv);
    if (PROBE == 6) for (int it = c.bx; it < 256; it += c.G) gla_b2_unit(it, lds, (const bf16*)(c.act0 + A_Q), (const bf16*)(c.act0 + A_K), (const bf16*)(c.act0 + A_V), (const float*)(c.act0 + A_LOGA), (const float*)(c.act0 + A_CST), (const float*)(c.act0 + A_DEC), (const bf16*)(c.act0 + A_Z), (bf16*)(c.ws + WS_END), c.tid, c.wave, c.lane);
    for (int it = c.bx; it < 256; it += c.G) gla_b2_unit(it, lds, (const bf16*)(c.act0 + A_Q), (const bf16*)(c.act0 + A_K), (const bf16*)(c.act0 + A_V), (const float*)(c.act0 + A_LOGA), (const float*)(c.act0 + A_CST), (const float*)(c.act0 + A_DEC), (const bf16*)(c.act0 + A_Z), (bf16*)(c.act0 + A_Z), c.tid, c.wave, c.lane);
    tail_convert(a, c, l, ph, false, lds); }
__device__ __forceinline__ void ph_c(const Args& a, const int wv, int l, LAS unsigned char* lds) { const Ctx c = make_ctx(a, wv);
    pg8::Gemm g{(const bf16*)(c.act0 + A_Z), (const bf16*)(slot_of(c, l) + SL_WBR), 3 * M, 3 * D, 512}; BranchOrder S{c.G, c.bx}; EpiC E{(const bf16*)(c.act0 + A_G), (bf16*)(c.act0 + A_MERGED)};
    for (int rep = 0; rep < 1 + (PROBE == 7); ++rep) pg8::gemm_phase<EpiC, BranchOrder, true, true>(lds, g, S, E, wv); }
__device__ __forceinline__ void ph_res(const Args& a, const int wv, const bf16* A, const bf16* Bt, int K, int dup, int l, int ph, bool drain, LAS unsigned char* lds) { const Ctx c = make_ctx(a, wv);
    pg8::Gemm g{A, Bt, M, D, K}; pg8::StaticOrder S; S.init(M, D, c.G, c.bx);
    if (dup == 2) { EpiNull<true> EN_{(float*)(c.ws + WS_END)}; pg8::gemm_phase<EpiNull<true>, pg8::StaticOrder, true, true>(lds, g, S, EN_, wv); }
    if (dup == 3) { EpiResT<1> E{(const bf16*)(c.ws + WS_XB), (bf16*)(c.ws + WS_END), (float*)(c.ws + WS_END + 32 * MiB)}; pg8::gemm_phase<EpiResT<1>, pg8::StaticOrder, true, true>(lds, g, S, E, wv); }
    if (dup == 4) { EpiResT<2> E{(const bf16*)(c.ws + WS_XB), (bf16*)(c.ws + WS_END), (float*)(c.ws + WS_END + 32 * MiB)}; pg8::gemm_phase<EpiResT<2>, pg8::StaticOrder, true, true>(lds, g, S, E, wv); }
    if (dup == 1) { EpiRes E{(const bf16*)(c.ws + WS_XB), (bf16*)(c.ws + WS_END), (float*)(c.ws + WS_END + 32 * MiB)}; pg8::gemm_phase<EpiRes, pg8::StaticOrder, true, true>(lds, g, S, E, wv); }
    if (drain) { pg8::Unit u0; for (int i = 0; S.next(i, u0); ++i) ffn_fixup(u0.pm, (const float*)(c.act0 + A_HT), (bf16*)(c.act0 + A_ACT), a.in.p[17] + (size_t)l * 3 * DFF2, a.in.p[18] + (size_t)l * DFF2, c.tid); }
    EpiRes E{(const bf16*)(c.ws + WS_XB), (bf16*)(c.ws + WS_XB), (float*)(c.ws + WS_SSQ)};
    pg8::gemm_phase<EpiRes, pg8::StaticOrder, true, true>(lds, g, S, E, wv);
    if (drain) { const Ctx c2 = make_ctx(a, wv); tail_convert(a, c2, l, ph, true, lds); } }
__device__ __forceinline__ void ph_e(const Args& a, const int wv, int l, int ph, LAS unsigned char* lds) { const Ctx c = make_ctx(a, wv);
    pg8::Gemm g{(const bf16*)(c.ws + WS_XB), (const bf16*)(slot_of(c, l) + SL_WUP), M, DFF2, D}; pg8::StaticOrder S; S.init(M, DFF2, c.G, c.bx);
    EpiUpConv E{c.ws, a.in.p[17] + (size_t)l * 3 * DFF2, a.in.p[18] + (size_t)l * DFF2, lds};
    for (int rep = 0; rep < 1 + (PROBE == 8); ++rep) pg8::gemm_phase<EpiUpConv, pg8::StaticOrder, true, true>(lds, g, S, E, wv);
    { const Ctx c2 = make_ctx(a, wv); tail_convert(a, c2, l, ph, false, lds); } }
__device__ __forceinline__ void ph_e2(const Args& a, const int wv, int l) { const Ctx c = make_ctx(a, wv);
    for (int rep = 0; rep < 1 + (PROBE == 9); ++rep)
    for (int it = c.bx * NTHREADS + c.tid; it < 1024 * 352; it += c.G * NTHREADS) ffn_act_item(it, (const bf16*)(c.act0 + A_HUP), (bf16*)(c.act0 + A_ACT), a.in.p[17] + (size_t)l * 3 * DFF2, a.in.p[18] + (size_t)l * DFF2); }
__device__ __forceinline__ void ph_fin(const Args& a, const int wv) { const Ctx c = make_ctx(a, wv); final_norm((const bf16*)(c.ws + WS_XB), c.X, (const float*)(c.ws + WS_SSQ), a.in.p[20], c.gw, c.ngw, c.lane); }

#ifndef PHMASK
#define PHMASK 0xFFFF
#endif
#define EN(b) ((PHMASK >> (b)) & 1)
__global__ void __launch_bounds__(NTHREADS, 2) mk_fwd(Args args) {
    extern __shared__ __attribute__((aligned(16))) unsigned char lds_raw[];
    LAS unsigned char* lds = (LAS unsigned char*)lds_raw;
    const int wv = __builtin_amdgcn_readfirstlane(threadIdx.x >> 6);
    const int lo = args.ph_lo, hi = args.ph_hi;
#define IN(k) (lo <= (k) && (k) < hi)
#if MK_ONE_LAUNCH
    volatile LAS unsigned* bst = (volatile LAS unsigned*)(lds + RING_BYTES + 512);
    if (threadIdx.x < 2) bst[threadIdx.x] = 0u;
    __syncthreads();
    const XcdBarrier bar = xcd_barrier_post((unsigned*)(args.ws + WS_CTL) + CW_BAR, bst);
#define SEAM(k) do { if (IN(k) && IN((k) + 1)) { if ((k) == 0) cg::this_grid().sync(); else xcd_barrier(bar); } } while (0)
#else
#define SEAM(k) do { } while (0)
#endif
#ifdef TPROBE
    unsigned long long tp_acc = 0ull, tp_prev = __builtin_amdgcn_s_memrealtime();
#define TP_MARK(kind) do { const unsigned long long t_ = __builtin_amdgcn_s_memrealtime(); if ((kind) == TPROBE) tp_acc += t_ - tp_prev; tp_prev = t_; } while (0)
#else
#define TP_MARK(kind) do { } while (0)
#endif
    int ph = 0;
    if (EN(0) && IN(ph)) ph_p0(args, wv, lds);
    SEAM(ph); ++ph; TP_MARK(0);
    for (int l = 0; l < DEPTH; ++l) {
        if (EN(1) && IN(ph)) ph_a(args, wv, l, ph, lds);
        SEAM(ph); ++ph; TP_MARK(1);
        if (EN(2) && IN(ph)) ph_b1(args, wv, l, lds);
        SEAM(ph); ++ph; TP_MARK(2);
        if (EN(3) && IN(ph)) ph_b2(args, wv, l, ph, lds);
        SEAM(ph); ++ph; TP_MARK(3);
        if (EN(4) && IN(ph)) ph_c(args, wv, l, lds);
        SEAM(ph); ++ph; TP_MARK(4);
        if (EN(5) && IN(ph)) { size_t z = 0; LAUNDER_S(z); unsigned char* ws = args.ws + z; ph_res(args, wv, (const bf16*)(ws + WS_ACT0 + A_MERGED), (const bf16*)(ws + WS_SLOT0 + (size_t)(l & 1) * SL_BYTES + SL_WO), D, PROBE == 10 ? 1 : (PROBE == 22 ? 2 : (PROBE == 31 ? 3 : (PROBE == 32 ? 4 : 0))), l, ph, false, lds); }
        SEAM(ph); ++ph; TP_MARK(5);
        if (EN(6) && IN(ph)) ph_e(args, wv, l, ph, lds);
        SEAM(ph); ++ph; TP_MARK(6);
        if (EN(8) && IN(ph)) { size_t z = 0; LAUNDER_S(z); unsigned char* ws = args.ws + z; ph_res(args, wv, (const bf16*)(ws + WS_ACT0 + A_ACT), (const bf16*)(ws + WS_SLOT0 + (size_t)(l & 1) * SL_BYTES + SL_WDN), DFF, PROBE == 11 ? 1 : (PROBE == 23 ? 2 : 0), l, ph, true, lds); }
        SEAM(ph); ++ph; TP_MARK(7);
    }
    if (EN(9) && IN(ph)) ph_fin(args, wv);
#ifdef TPROBE
    TP_MARK(8);
    if (blockIdx.x == 0 && wv == 0) { const unsigned long long t0 = __builtin_amdgcn_s_memrealtime(); while (__builtin_amdgcn_s_memrealtime() - t0 < 10ull * tp_acc) __builtin_amdgcn_s_sleep(8); }
#endif
#undef IN
#undef SEAM
}

extern "C" void kernel_launch(void* const* d_in, const int* in_sizes, int n_in, void* d_out, int out_size, void* d_ws, size_t ws_size, hipStream_t stream) {
    static int grid = 0;
    if (grid == 0) {
        if (n_in != 21 || out_size != M * D || ws_size < WS_END + (PROBE ? 64 * MiB : 0)) { fprintf(stderr, "kernel_launch: unexpected shapes / workspace (%zu < %zu)\n", ws_size, (size_t)WS_END); grid = -1; return; }
        int dev = 0, cus = 0, per_cu = 0;
        if (hipGetDevice(&dev) != hipSuccess || hipDeviceGetAttribute(&cus, hipDeviceAttributeMultiprocessorCount, dev) != hipSuccess) { grid = -1; return; }
        if (hipFuncSetAttribute((const void*)mk_fwd, hipFuncAttributeMaxDynamicSharedMemorySize, LDS_BYTES) != hipSuccess) { fprintf(stderr, "kernel_launch: hipFuncSetAttribute failed\n"); grid = -1; return; }
        if (hipOccupancyMaxActiveBlocksPerMultiprocessor(&per_cu, (const void*)mk_fwd, NTHREADS, LDS_BYTES) != hipSuccess || per_cu < 1) { fprintf(stderr, "kernel_launch: occupancy query says %d\n", per_cu); per_cu = 1; }
        (void)hipGetLastError();
        grid = cus * 1;
    }
    if (grid < 0) return;
#if MK_ONE_LAUNCH
    if (hipMemsetAsync((char*)d_ws + WS_CTL, 0, 65536, stream) != hipSuccess) { fprintf(stderr, "kernel_launch: memset failed\n"); return; }
#endif
    Args a{};
    for (int i = 0; i < 21; ++i) a.in.p[i] = (const float*)d_in[i];
    a.out = (float*)d_out; a.ws = (unsigned char*)d_ws;
#if MK_ONE_LAUNCH
    a.ph_lo = 0; a.ph_hi = NPHASE;
    void* kargs[] = {&a};
    hipError_t e = hipLaunchCooperativeKernel((const void*)mk_fwd, dim3(grid), dim3(NTHREADS), kargs, LDS_BYTES, stream);
    if (e != hipSuccess) fprintf(stderr, "kernel_launch: cooperative launch failed: %s (grid %d)\n", hipGetErrorString(e), grid);
#else
    for (int p = 0; p < NPHASE; ++p) { a.ph_lo = p; a.ph_hi = p + 1; hipLaunchKernelGGL(mk_fwd, dim3(grid), dim3(NTHREADS), LDS_BYTES, stream, a); }
#endif
}
```

```cpp
#include <hip/hip_runtime.h>
#include <hip/hip_cooperative_groups.h>
#include <cstdio>
#include <cstdint>
#include <cmath>
namespace cg = cooperative_groups;

#ifndef MK_ONE_LAUNCH
#define MK_ONE_LAUNCH 1
#endif

namespace cfg {
constexpr int D = 1024, BATCH = 8, SEQ = 2048, DEPTH = 4, M = BATCH * SEQ;
constexpr int GH = 4, GDK = 64, GDV = 128, GKEY = 256, GVAL = 512, GRANK = 16;
constexpr int SGW = 512, SGC = 128, CW = 512, DFF = 2816, DFF2 = 5632;
constexpr int INC = 7184, NIN = 7424;
constexpr int O_Q = 0, O_K = 256, O_V = 512, O_G = 1024, O_A = 1536, O_SU = 1552, O_SV = 2064, O_CB = 2576, O_CC = 3088, O_CX = 3600, O_GT = 4112;
constexpr float EPS = 1e-6f;
}
using namespace cfg;

namespace pg8 {
#define PG8_LAS __attribute__((address_space(3)))
typedef unsigned short bf16_t;
typedef short bf16x8 __attribute__((ext_vector_type(8)));
typedef float f32x4 __attribute__((ext_vector_type(4)));
typedef unsigned u32x4 __attribute__((ext_vector_type(4)));
constexpr int BM = 256, BK = 64, HALF = 128, HTB = HALF * BK * 2  , STAGE_BYTES = 8 * HTB, NXCD = 8, WGM = 8;

__host__ __device__ __forceinline__ int lds_byte(int r, int c) { const int st = (r >> 4) * 2 + (c >> 5), rr = r & 15, cc = c & 31, ob = rr * 64 + cc * 2; return st * 1024 + (ob ^ (((ob >> 9) & 1) << 5)); }
__host__ __device__ __forceinline__ void stage_rc(int b, int& R, int& C) { const int st = b / 1024, sb = b % 1024, swz = sb ^ (((sb >> 9) & 1) << 5); R = (st >> 1) * 16 + swz / 64; C = (st & 1) * 32 + (swz % 64) / 2; }
__host__ __device__ __forceinline__ int perm32(int rho) { const int n = rho >> 4, i = rho & 15; return 8 * (i >> 2) + 4 * n + (i & 3); }

struct Unit { int pm, pn; };
struct Gemm { const bf16_t* A; const bf16_t* Bt; int M, N, K; };

struct StaticOrder {
    int nM, nN, nwg, G, c;
    __host__ __device__ void init(int M, int N, int G_, int c_) { nM = M / BM; nN = N / BM; nwg = nM * nN; G = G_; c = c_; }
    __host__ __device__ bool next(int i, Unit& u) const {
        const long L = (long)i * G + c; if (L >= nwg) return false;
        int wgid = (int)L; { const int q = nwg / NXCD, r = nwg % NXCD, xcd = wgid % NXCD, off = wgid / NXCD; wgid = (xcd < r ? xcd * (q + 1) : r * (q + 1) + (xcd - r) * q) + off; }
        const int nig = WGM * nN, gid = wgid / nig, fm = gid * WGM, gsz = (nM - fm) < WGM ? (nM - fm) : WGM;
        u.pm = fm + ((wgid % nig) % gsz); u.pn = (wgid % nig) / gsz; return true;
    }
    __device__ __forceinline__ void a_ready(const Unit&) const {}
    __device__ __forceinline__ void done(const Unit&) const {}
};

__device__ __forceinline__ unsigned cvt_pk_bf16(float lo, float hi) { unsigned r; asm volatile("v_cvt_pk_bf16_f32 %0, %1, %2" : "=v"(r) : "v"(lo), "v"(hi)); return r; }
typedef float f32x2 __attribute__((ext_vector_type(2)));
template <class Epi, class Sched, bool ALIGN_EPI = false, bool SP2 = false>
__device__ __forceinline__ void gemm_phase(PG8_LAS unsigned char* lds, const Gemm g, const Sched& S, const Epi& E, const int wave_id) {
    int ln__; asm volatile("v_mbcnt_lo_u32_b32 %0, -1, 0\n\tv_mbcnt_hi_u32_b32 %0, -1, %0" : "=v"(ln__));
    const int tid_ = ln__ + 64 * wave_id;
    const int tid = tid_, wid = __builtin_amdgcn_readfirstlane(tid >> 6), lane = tid & 63, wr = wid >> 2, wc = wid & 3, fr = lane & 15, fq = lane >> 4;
    const int K = g.K, nt = K / BK;
    unsigned voffA[2], voffB[2];
#pragma unroll
    for (int i = 0; i < 2; ++i) { int R, C; stage_rc(tid * 16 + i * 8192, R, C); const int Rb = Epi::PERM ? ((R & ~31) + perm32(R & 31)) : R;
        voffA[i] = (unsigned)(R * K + C) * 2u; voffB[i] = (unsigned)(Rb * K + C) * 2u; }
    const size_t kstep = (size_t)(BK * 2);
    const size_t hstep = (size_t)HALF * K * 2;
    const size_t tstep = 2 * hstep;
    const unsigned ldsw = (unsigned)wid * 1024u;
    const int aoff = lds_byte(wr * 64 + fr, fq * 8), boff = lds_byte(wc * 32 + fr, fq * 8);
#define PG8_SA(b, h) (((b) * 2 + (h)) * HTB)
#define PG8_SB(b, h) ((4 + (b) * 2 + (h)) * HTB)
#define PG8_STAGE(bufoff, gbase, voff) do { _Pragma("unroll") for (int _i = 0; _i < 2; ++_i) \
        __builtin_amdgcn_global_load_lds((const unsigned*)((const char*)(gbase) + (voff)[_i]), (PG8_LAS unsigned*)(lds + (bufoff) + ldsw + _i * 8192), 16, 0, 0); } while (0)
#define PG8_LDA(dst, b, h) do { _Pragma("unroll") for (int m = 0; m < 4; ++m) _Pragma("unroll") for (int k = 0; k < 2; ++k) dst[m][k] = *(const PG8_LAS bf16x8*)(lds + PG8_SA(b, h) + aoff + m * 2048 + k * 1024); } while (0)
#define PG8_LDB(dst, b, h) do { _Pragma("unroll") for (int n = 0; n < 2; ++n) _Pragma("unroll") for (int k = 0; k < 2; ++k) dst[n][k] = *(const PG8_LAS bf16x8*)(lds + PG8_SB(b, h) + boff + n * 2048 + k * 1024); } while (0)
#define PG8_MMA(ai, bj, At, Bt) do { __builtin_amdgcn_s_setprio(1); _Pragma("unroll") for (int m = 0; m < 4; ++m) _Pragma("unroll") for (int n = 0; n < 2; ++n) _Pragma("unroll") for (int k = 0; k < 2; ++k) \
        acc[ai][bj][m][n] = __builtin_amdgcn_mfma_f32_16x16x32_bf16(Bt[n][k], At[m][k], acc[ai][bj][m][n], 0, 0, 0); __builtin_amdgcn_s_setprio(0); } while (0)
#define PG8_WAIT_V(n) asm volatile("s_waitcnt vmcnt(" #n ")" ::: "memory")
#define PG8_WAIT_L(n) asm volatile("s_waitcnt lgkmcnt(" #n ")" ::: "memory")
#define PG8_BAR __builtin_amdgcn_s_barrier()
#define PG8_SCHED __builtin_amdgcn_sched_barrier(0)
    Unit cur, nxt; int ui = 0;
    if (!S.next(0, cur)) return;
    f32x4 acc[2][2][4][2];
#pragma unroll
    for (int a = 0; a < 2; ++a)
#pragma unroll
        for (int b = 0; b < 2; ++b)
#pragma unroll
            for (int m = 0; m < 4; ++m)
#pragma unroll
                for (int n = 0; n < 2; ++n) acc[a][b][m][n] = (f32x4){0.f, 0.f, 0.f, 0.f};
    bf16x8 At[4][2], B0[2][2], B1[2][2];
    const char* cA = (const char*)g.A + (size_t)cur.pm * tstep; const char* cB = (const char*)g.Bt + (size_t)cur.pn * tstep;
    S.a_ready(cur);
    if constexpr (SP2) {
        PG8_STAGE(PG8_SB(0, 0), cB, voffB); PG8_STAGE(PG8_SB(0, 1), cB + hstep, voffB); PG8_STAGE(PG8_SA(0, 0), cA, voffA); PG8_STAGE(PG8_SA(0, 1), cA + hstep, voffA);
        if (wr == 1) PG8_BAR;
        PG8_WAIT_V(2); PG8_BAR;
        PG8_STAGE(PG8_SB(1, 0), cB + kstep, voffB); PG8_STAGE(PG8_SA(1, 0), cA + kstep, voffA); PG8_STAGE(PG8_SB(1, 1), cB + hstep + kstep, voffB);
        PG8_WAIT_V(6); PG8_BAR;
    } else {
        PG8_STAGE(PG8_SB(0, 0), cB, voffB); PG8_STAGE(PG8_SA(0, 0), cA, voffA); PG8_STAGE(PG8_SB(0, 1), cB + hstep, voffB); PG8_STAGE(PG8_SA(0, 1), cA + hstep, voffA);
        if (wr == 1) PG8_BAR;
        PG8_WAIT_V(4); PG8_BAR;
        PG8_STAGE(PG8_SB(1, 0), cB + kstep, voffB); PG8_STAGE(PG8_SA(1, 0), cA + kstep, voffA); PG8_STAGE(PG8_SB(1, 1), cB + hstep + kstep, voffB);
        PG8_WAIT_V(6); PG8_BAR;
    }
    for (;;) {
        const bool has_next = S.next(ui + 1, nxt);
        const char* nA = has_next ? (const char*)g.A + (size_t)nxt.pm * tstep : cA; const char* nB = has_next ? (const char*)g.Bt + (size_t)nxt.pn * tstep : cB;
        for (int t = 0; t < nt; t += 2) {
            const bool last = (t == nt - 2);
            const char* a1 = cA + (size_t)(t + 1) * kstep;
            const char* a2 = last ? nA : cA + (size_t)(t + 2) * kstep; const char* b2 = last ? nB : cB + (size_t)(t + 2) * kstep;
            const char* a3 = a2 + kstep; const char* b3 = b2 + kstep;
            if (last && has_next) S.a_ready(nxt);
            if constexpr (SP2) {
            PG8_LDB(B0, 0, 0); PG8_LDB(B1, 0, 1); PG8_SCHED; PG8_LDA(At, 0, 0); PG8_STAGE(PG8_SA(1, 1), a1 + hstep, voffA);
            PG8_WAIT_V(8); PG8_WAIT_L(0); PG8_BAR; PG8_MMA(0, 0, At, B0); PG8_MMA(0, 1, At, B1); PG8_BAR; PG8_SCHED;
            PG8_LDA(At, 0, 1); PG8_STAGE(PG8_SB(0, 0), b2, voffB); PG8_STAGE(PG8_SB(0, 1), b2 + hstep, voffB); PG8_STAGE(PG8_SA(0, 0), a2, voffA);
            PG8_WAIT_V(8); PG8_WAIT_L(0); PG8_BAR; PG8_MMA(1, 0, At, B0); PG8_MMA(1, 1, At, B1); PG8_BAR; PG8_SCHED;
            PG8_LDB(B0, 1, 0); PG8_LDB(B1, 1, 1); PG8_SCHED; PG8_LDA(At, 1, 0); PG8_STAGE(PG8_SA(0, 1), a2 + hstep, voffA);
            PG8_WAIT_V(8); PG8_WAIT_L(0); PG8_BAR; PG8_MMA(0, 0, At, B0); PG8_MMA(0, 1, At, B1); PG8_BAR; PG8_SCHED;
            PG8_LDA(At, 1, 1); PG8_STAGE(PG8_SB(1, 0), b3, voffB); PG8_STAGE(PG8_SB(1, 1), b3 + hstep, voffB); PG8_STAGE(PG8_SA(1, 0), a3, voffA);
            PG8_WAIT_V(8); PG8_WAIT_L(0); PG8_BAR; PG8_MMA(1, 0, At, B0); PG8_MMA(1, 1, At, B1); PG8_BAR; PG8_SCHED;
            } else {
            PG8_LDB(B0, 0, 0); PG8_SCHED; PG8_LDA(At, 0, 0); PG8_STAGE(PG8_SA(1, 1), a1 + hstep, voffA);
            PG8_WAIT_L(8); PG8_BAR; PG8_WAIT_L(0); PG8_MMA(0, 0, At, B0); PG8_BAR; PG8_SCHED;
            PG8_LDB(B1, 0, 1); PG8_STAGE(PG8_SB(0, 0), b2, voffB);
            PG8_BAR; PG8_WAIT_L(0); PG8_MMA(0, 1, At, B1); PG8_BAR;
            PG8_LDA(At, 0, 1); PG8_STAGE(PG8_SA(0, 0), a2, voffA);
            PG8_BAR; PG8_WAIT_L(0); PG8_MMA(1, 0, At, B0); PG8_BAR; PG8_SCHED;
            PG8_STAGE(PG8_SB(0, 1), b2 + hstep, voffB);
            PG8_WAIT_V(6); PG8_BAR; PG8_MMA(1, 1, At, B1); PG8_BAR;
            PG8_LDB(B0, 1, 0); PG8_SCHED; PG8_LDA(At, 1, 0); PG8_STAGE(PG8_SA(0, 1), a2 + hstep, voffA);
            PG8_WAIT_L(8); PG8_BAR; PG8_WAIT_L(0); PG8_MMA(0, 0, At, B0); PG8_BAR; PG8_SCHED;
            PG8_LDB(B1, 1, 1); PG8_STAGE(PG8_SB(1, 0), b3, voffB);
            PG8_BAR; PG8_WAIT_L(0); PG8_MMA(0, 1, At, B1); PG8_BAR;
            PG8_LDA(At, 1, 1); PG8_STAGE(PG8_SA(1, 0), a3, voffA);
            PG8_BAR; PG8_WAIT_L(0); PG8_MMA(1, 0, At, B0); PG8_BAR; PG8_SCHED;
            PG8_STAGE(PG8_SB(1, 1), b3 + hstep, voffB);
            PG8_WAIT_V(6); PG8_BAR; PG8_MMA(1, 1, At, B1); PG8_BAR;
            }
        }
        if constexpr (ALIGN_EPI) { if (wr == 0) PG8_BAR; }
        if constexpr (!Epi::AFTER_DRAIN) { E(acc, cur, wr, wc, fr, fq); S.done(cur); }
        if (!has_next) break;
#pragma unroll
        for (int a = 0; a < 2; ++a)
#pragma unroll
            for (int b = 0; b < 2; ++b)
#pragma unroll
                for (int m = 0; m < 4; ++m)
#pragma unroll
                    for (int n = 0; n < 2; ++n) acc[a][b][m][n] = (f32x4){0.f, 0.f, 0.f, 0.f};
        cur = nxt; cA = nA; cB = nB; ++ui;
        if constexpr (ALIGN_EPI) { if (wr == 1) PG8_BAR; }
    }
    PG8_WAIT_V(0);
    if constexpr (!ALIGN_EPI) { if (wr == 0) PG8_BAR; }
    PG8_BAR;
    if constexpr (Epi::AFTER_DRAIN) { E.fused(acc, cur, wr, wc, fr, fq, lds, wid, lane); S.done(cur); }
#undef PG8_SA
#undef PG8_SB
#undef PG8_STAGE
#undef PG8_LDA
#undef PG8_LDB
#undef PG8_MMA
#undef PG8_WAIT_V
#undef PG8_WAIT_L
#undef PG8_BAR
#undef PG8_SCHED
}
}

#define GAS __attribute__((address_space(1)))
#define LAS __attribute__((address_space(3)))
typedef unsigned short bf16;
typedef unsigned v4u __attribute__((ext_vector_type(4)));
typedef unsigned v2u __attribute__((ext_vector_type(2)));
typedef float f32x4 __attribute__((ext_vector_type(4)));
typedef float f32x2 __attribute__((ext_vector_type(2)));
typedef short bf16x8 __attribute__((ext_vector_type(8)));
constexpr int NWAVES = 8, NTHREADS = 512;
constexpr int RING_BYTES = 131072, LDS_BYTES = 147456;

constexpr size_t MiB = 1u << 20;
constexpr size_t SL_WIN = 0, SL_WBR = SL_WIN + (size_t)NIN * D * 2, SL_WO = SL_WBR + (size_t)3 * D * 512 * 2, SL_WUP = SL_WO + (size_t)D * D * 2,
                 SL_WDN = SL_WUP + (size_t)DFF2 * D * 2, SL_SGW = SL_WDN + (size_t)D * DFF * 2, SL_END = SL_SGW + (size_t)4 * 128 * 128 * 2, SL_BYTES = 38 * MiB;
static_assert(SL_END <= SL_BYTES, "weight slot");
constexpr size_t WS_CTL = 0, WS_SLOT0 = 1 * MiB, WS_XB = WS_SLOT0 + 2 * SL_BYTES, WS_SSQ = WS_XB + 32 * MiB, WS_SVST = WS_SSQ + 1 * MiB, WS_ACT0 = WS_SVST + 1 * MiB;
constexpr size_t A_Q = 0, A_K = 8 * MiB, A_V = 16 * MiB, A_Z = 32 * MiB, A_SV = 80 * MiB, A_CC = 96 * MiB, A_CX = 112 * MiB, A_LOGA = 128 * MiB, A_G = 144 * MiB,
                 A_CST = 240 * MiB, A_DEC = 272 * MiB, A_END = 273 * MiB;
constexpr size_t A_MERGED = A_Q, A_HUP = 0, A_ACT = 176 * MiB, A_HT = 64 * MiB;
static_assert(A_ACT + (size_t)M * DFF * 2 <= A_END, "overlay");
constexpr size_t WS_END = WS_ACT0 + A_END;
constexpr int CW_BAR = 1024, CW_QHEAD = 6144, CW_FIN = 8192;

__device__ __forceinline__ float bf2f(unsigned h) { return __uint_as_float(h << 16); }
__device__ __forceinline__ unsigned pk2(float lo, float hi) { return pg8::cvt_pk_bf16(lo, hi); }
__device__ __forceinline__ float fsigmoid(float z) { return __builtin_amdgcn_rcpf(1.f + __expf(-z)); }
__device__ __forceinline__ float fsilu(float z) { return z * fsigmoid(z); }
__device__ __forceinline__ float fgelu(float z) { return z * fsigmoid(1.5957691216057308f * (z + 0.044715f * z * z * z)); }
__device__ __forceinline__ float flogsig(float z) { return fminf(z, 0.f) - __logf(1.f + __expf(-fabsf(z))); }
__device__ __forceinline__ float wave_sum(float v) {
#pragma unroll
    for (int o = 1; o < 64; o <<= 1) v += __shfl_xor(v, o);
    return v;
}
#define LDS_WAIT() asm volatile("s_waitcnt lgkmcnt(0)" ::: "memory")
#define LDS_BARRIER() do { asm volatile("s_waitcnt lgkmcnt(0)" ::: "memory"); __builtin_amdgcn_s_barrier(); asm volatile("" ::: "memory"); } while (0)
__device__ __forceinline__ f32x4 mfma16(bf16x8 a, bf16x8 b, f32x4 c) { return __builtin_amdgcn_mfma_f32_16x16x32_bf16(a, b, c, 0, 0, 0); }

__device__ __forceinline__ void tr_write(bf16* WT, int K, int k0, LAS float* scr, int lane) {
    LDS_WAIT(); asm volatile("" ::: "memory");
    const int c = lane & 7;
#pragma unroll
    for (int j = 0; j < 4; ++j) { const int n = (lane >> 3) + 8 * j; const LAS float* s = scr + (8 * c) * 33 + n;
        v4u o; o.x = pk2(s[0 * 33], s[1 * 33]); o.y = pk2(s[2 * 33], s[3 * 33]); o.z = pk2(s[4 * 33], s[5 * 33]); o.w = pk2(s[6 * 33], s[7 * 33]);
        *(GAS v4u*)(WT + (size_t)n * K + k0 + 8 * c) = o; }
    LDS_WAIT(); asm volatile("" ::: "memory");
}
__device__ __forceinline__ void tr_item(const float* W, int ldw, int col0, const float* ksc, float sc, bf16* WT, int K, int k0, LAS float* scr, int lane) {
    float v[32]; const float* src = W + (size_t)(k0 + (lane >> 5)) * ldw + col0 + (lane & 31);
#pragma unroll
    for (int i = 0; i < 32; ++i) v[i] = src[(size_t)(2 * i) * ldw];
    if (ksc) {
#pragma unroll
        for (int i = 0; i < 32; ++i) v[i] *= ksc[k0 + 2 * i + (lane >> 5)]; }
#pragma unroll
    for (int i = 0; i < 32; ++i) scr[(2 * i + (lane >> 5)) * 33 + (lane & 31)] = v[i] * sc;
    tr_write(WT, K, k0, scr, lane);
}
__device__ __forceinline__ void alpha_item(const float* win, const float* wal, const float* g, bf16* WT, int k0, int j0, LAS float* scr, int lane) {
    const int jj = lane & 31, half = lane >> 5; float wa[16];
#pragma unroll
    for (int r = 0; r < 16; ++r) wa[r] = wal[r * GKEY + j0 + jj];
    for (int i = 0; i < 32; ++i) { const int kk = 2 * i + half, k = k0 + kk; const float* wr = win + (size_t)k * INC + O_A; float s = 0.f;
#pragma unroll
        for (int r = 0; r < 16; ++r) s += wr[r] * wa[r];
        scr[kk * 33 + jj] = s * g[k]; }
    tr_write(WT + (size_t)j0 * D, D, k0, scr, lane);
}
struct Inputs { const float* p[21]; };
constexpr int CV_J0 = 16 * 224, CV_J1 = 16 * 8, CV_J2 = 3 * 8 * 32, CV_J3 = 16 * 32, CV_J4 = 16 * 176, CV_J5 = 44 * 32, CV_J6 = 128, CV_ITEMS = CV_J0 + CV_J1 + CV_J2 + CV_J3 + CV_J4 + CV_J5 + CV_J6;
constexpr int CV_WIN_ITEMS = CV_J0 + CV_J1;
__device__ __forceinline__ void convert_item(const Inputs& I, int l, unsigned char* slot, LAS float* scr, int it, int lane) {
    bf16* WIN = (bf16*)(slot + SL_WIN); bf16* WBR = (bf16*)(slot + SL_WBR); bf16* WO = (bf16*)(slot + SL_WO); bf16* WUP = (bf16*)(slot + SL_WUP); bf16* WDN = (bf16*)(slot + SL_WDN); bf16* SGWS = (bf16*)(slot + SL_SGW);
    const float* win = I.p[2] + (size_t)l * D * INC;
        int r = it;
        if (r < CV_J0) { const int kb = r / 224, nb = r % 224; const int drow = nb < 48 ? 32 * nb : 1792 + 32 * (nb - 48), scol = nb < 48 ? 32 * nb : O_SU + 32 * (nb - 48);
            tr_item(win, INC, scol, I.p[1] + (size_t)l * D, drow < 256 ? 0.125f : 1.f, WIN + (size_t)drow * D, D, 64 * kb, scr, lane); return; }
        r -= CV_J0;
        if (r < CV_J1) { const int kb = r / 8, jb = r % 8; alpha_item(win, I.p[3] + (size_t)l * GRANK * GKEY, I.p[1] + (size_t)l * D, WIN + (size_t)1536 * D, 64 * kb, 32 * jb, scr, lane); return; }
        r -= CV_J1;
        if (r < CV_J2) { const int br = r / 256, rr = r % 256, kb = rr / 32, nb = rr % 32;
            const float* W = (br == 0 ? I.p[6] : br == 1 ? I.p[11] : I.p[13]) + (size_t)l * 512 * D;
            tr_item(W, D, 32 * nb, br == 0 ? I.p[5] + (size_t)l * GVAL : nullptr, 1.f, WBR + ((size_t)br * D + 32 * nb) * 512, 512, 64 * kb, scr, lane); return; }
        r -= CV_J2;
        if (r < CV_J3) { const int kb = r / 32, nb = r % 32; tr_item(I.p[14] + (size_t)l * D * D, D, 32 * nb, nullptr, 1.f, WO + (size_t)32 * nb * D, D, 64 * kb, scr, lane); return; }
        r -= CV_J3;
        if (r < CV_J4) { const int kb = r / 176, nb = r % 176, pn = nb / 8, jb = nb % 8; const int scol = jb < 4 ? 128 * pn + 32 * jb : DFF + 128 * pn + 32 * (jb - 4);
            tr_item(I.p[16] + (size_t)l * D * DFF2, DFF2, scol, I.p[15] + (size_t)l * D, 1.f, WUP + (size_t)32 * nb * D, D, 64 * kb, scr, lane); return; }
        r -= CV_J4;
        if (r < CV_J5) { const int kb = r / 32, nb = r % 32; tr_item(I.p[19] + (size_t)l * DFF * D, D, 32 * nb, nullptr, 1.f, WDN + (size_t)32 * nb * DFF, DFF, 64 * kb, scr, lane); return; }
        r -= CV_J5;
        { const int e0 = r * 512 + lane * 8, t = (e0 >> 7) & 127, s0 = e0 & 127; const float* src = I.p[9] + (size_t)l * 4 * 128 * 128 + e0;
          const f32x4 a = *(const f32x4*)src, b = *(const f32x4*)(src + 4); float v[8] = {a[0], a[1], a[2], a[3], b[0], b[1], b[2], b[3]};
#pragma unroll
          for (int e = 0; e < 8; ++e) if (s0 + e > t) v[e] = 0.f;
          v4u o; o.x = pk2(v[0], v[1]); o.y = pk2(v[2], v[3]); o.z = pk2(v[4], v[5]); o.w = pk2(v[6], v[7]); *(GAS v4u*)(SGWS + e0) = o; }
}
__device__ __forceinline__ void convert_static(const Inputs& I, int l, unsigned char* slot, LAS unsigned char* lds, int it_lo, int it_hi, int gw, int ngw, int wave, int lane) {
    LAS float* scr = (LAS float*)(lds + wave * 8448);
    for (int it = it_lo + gw; it < it_hi; it += ngw) convert_item(I, l, slot, scr, it, lane);
}
#define RLX_AGENT __ATOMIC_RELAXED, __HIP_MEMORY_SCOPE_AGENT
__device__ __forceinline__ void convert_queue(const Inputs& I, int l, unsigned char* slot, LAS unsigned char* lds, unsigned* head, int it_lo, int it_hi, unsigned* fin, int G, int tid, int wave, int lane) {
    LAS float* scr = (LAS float*)(lds + wave * 8448); volatile LAS unsigned* bc = (volatile LAS unsigned*)(lds + 8 * 8448);
    for (;;) {
        if (tid == 0) { unsigned v = 0xffffffffu; if (!fin || __hip_atomic_load(fin, RLX_AGENT) < (unsigned)G) v = __hip_atomic_fetch_add(head, 8u, RLX_AGENT); bc[0] = v; }
        LDS_BARRIER();
        const unsigned base = bc[0];
        LDS_BARRIER();
        if (base >= (unsigned)(it_hi - it_lo)) break;
        const int it = it_lo + (int)base + wave; if (it < it_hi) convert_item(I, l, slot, scr, it, lane);
    }
}
__device__ __forceinline__ void x_prep(const float* xin, bf16* xb, float* ssq, int gw, int ngw, int lane) {
    for (int row = gw; row < M; row += ngw) {
        const GAS f32x4* xr = (const GAS f32x4*)(xin + (size_t)row * D) + lane; f32x4 v[4]; float s = 0.f;
#pragma unroll
        for (int j = 0; j < 4; ++j) { v[j] = xr[64 * j]; s += (v[j][0] * v[j][0] + v[j][1] * v[j][1]) + (v[j][2] * v[j][2] + v[j][3] * v[j][3]); }
        s = wave_sum(s);
#pragma unroll
        for (int j = 0; j < 4; ++j) { v2u w; w.x = pk2(v[j][0], v[j][1]); w.y = pk2(v[j][2], v[j][3]); ((GAS v2u*)(xb + (size_t)row * D))[lane + 64 * j] = w; }
        if (lane < 16) ssq[(size_t)row * 16 + lane] = lane == 0 ? s : 0.f;
    }
}
__device__ __forceinline__ void final_norm(const bf16* xb, float* out, const float* ssq, const float* g, int gw, int ngw, int lane) {
    for (int row = gw; row < M; row += ngw) {
        const float pv = lane < 16 ? ssq[(size_t)row * 16 + lane] : 0.f; const float rs = rsqrtf(wave_sum(pv) * (1.f / D) + EPS);
        const GAS v2u* xr = (const GAS v2u*)(xb + (size_t)row * D) + lane; GAS f32x4* orow = (GAS f32x4*)(out + (size_t)row * D) + lane;
#pragma unroll
        for (int j = 0; j < 4; ++j) { const v2u w = xr[64 * j]; const f32x4 gv = ((const GAS f32x4*)g)[lane + 64 * j];
            orow[64 * j] = (f32x4){bf2f(w.x & 0xffffu) * rs * gv[0], bf2f(w.x >> 16) * rs * gv[1], bf2f(w.y & 0xffffu) * rs * gv[2], bf2f(w.y >> 16) * rs * gv[3]}; }
    }
}

constexpr int GP = 72;
constexpr int L_QT = 0, L_KT = 9216, L_KENDT = 18432, L_VT = 27648, L_ST = 46080, L_SEG = 64512, L_DECS = 66560, L_RED = 66816, L_GLA_END = 67328;
constexpr int VP = 136;

__device__ __forceinline__ void sgu_item(int item, LAS unsigned char* lds, const bf16* ZBI, bf16* ZBO, const bf16* SV, const float* SVST, const float* lng, const float* lnb, const bf16* wsb, const float* bs, int wave, int lane) {
    const int b_ = item & 7, h = (item >> 3) & 3, r0 = b_ * SEQ + (item >> 5) * 128; LAS bf16* vnT = (LAS bf16*)lds;
    const int fr = lane & 15, fq = lane >> 4, t = 16 * wave + fr, nks = (wave >> 1) + 1; const size_t orow = (size_t)r0 + t;
    bf16x8 bfr[4];
#pragma unroll
    for (int ks = 0; ks < 4; ++ks) bfr[ks] = (ks < nks) ? *(const bf16x8*)(wsb + ((size_t)h * 128 + t) * 128 + 32 * ks + 8 * fq) : (bf16x8){0, 0, 0, 0, 0, 0, 0, 0};
    v2u suv[8];
#pragma unroll
    for (int m = 0; m < 8; ++m) suv[m] = *(const v2u*)(ZBI + orow * 512 + h * 128 + 16 * m + 4 * fq);
    const float bias = bs[h * 128 + t];
    { const int d0 = 16 * wave, s0 = 2 * lane; float mean[2], rstd[2]; v4u xv[2][2];
#pragma unroll
      for (int rr = 0; rr < 2; ++rr) { const size_t row = (size_t)r0 + s0 + rr; const f32x4* p = (const f32x4*)(SVST + row * 16); const f32x4 a = p[0], b = p[1], c = p[2], d = p[3];
          const v4u* q = (const v4u*)(SV + row * 512 + h * 128 + d0); xv[rr][0] = q[0]; xv[rr][1] = q[1];
          const float sm = (a[0] + a[2]) + (b[0] + b[2]) + (c[0] + c[2]) + (d[0] + d[2]), sq = (a[1] + a[3]) + (b[1] + b[3]) + (c[1] + c[3]) + (d[1] + d[3]);
          mean[rr] = sm * (1.f / 512.f); rstd[rr] = rsqrtf(fmaxf(sq * (1.f / 512.f) - mean[rr] * mean[rr], 0.f) + EPS); }
      f32x4 gv[4], bv[4];
#pragma unroll
      for (int q4 = 0; q4 < 4; ++q4) { gv[q4] = *(const f32x4*)(lng + h * 128 + d0 + 4 * q4); bv[q4] = *(const f32x4*)(lnb + h * 128 + d0 + 4 * q4); }
#pragma unroll
      for (int j = 0; j < 16; ++j) { const float g = gv[j >> 2][j & 3], b = bv[j >> 2][j & 3]; const unsigned w0 = xv[0][j >> 3][(j >> 1) & 3], w1 = xv[1][j >> 3][(j >> 1) & 3];
          const float x0 = (j & 1) ? bf2f(w0 >> 16) : bf2f(w0 & 0xffffu), x1 = (j & 1) ? bf2f(w1 >> 16) : bf2f(w1 & 0xffffu);
          *(LAS unsigned*)(vnT + (d0 + j) * VP + s0) = pk2((x0 - mean[0]) * rstd[0] * g + b, (x1 - mean[1]) * rstd[1] * g + b); } }
    LDS_BARRIER();
    { f32x4 acc[8];
#pragma unroll
      for (int m = 0; m < 8; ++m) { acc[m] = (f32x4){0.f, 0.f, 0.f, 0.f};
#pragma unroll
          for (int ks = 0; ks < 4; ++ks) if (ks < nks) { const bf16x8 a = *(const LAS bf16x8*)(vnT + (16 * m + fr) * VP + 32 * ks + 8 * fq); acc[m] = mfma16(a, bfr[ks], acc[m]); } }
#pragma unroll
      for (int m = 0; m < 8; ++m) { const v2u su = suv[m]; v2u o;
          o.x = pk2(bf2f(su.x & 0xffffu) * (acc[m][0] + bias), bf2f(su.x >> 16) * (acc[m][1] + bias)); o.y = pk2(bf2f(su.y & 0xffffu) * (acc[m][2] + bias), bf2f(su.y >> 16) * (acc[m][3] + bias));
          *(v2u*)(ZBO + orow * 512 + h * 128 + 16 * m + 4 * fq) = o; } }
    LDS_BARRIER();
}
__device__ __forceinline__ void convbr_item(int idx, const bf16* ZCI, bf16* ZCO, const bf16* CC, const bf16* CX, const float* cw) {
    const int c0 = (idx & 63) * 8, wg_ = idx >> 9, r0 = (wg_ & 7) * SEQ + (wg_ >> 3) * 64 + ((idx >> 6) & 7) * 8; float w[3][8];
#pragma unroll
    for (int k = 0; k < 3; ++k) { const f32x4 a = *(const f32x4*)(cw + k * CW + c0), b = *(const f32x4*)(cw + k * CW + c0 + 4);
#pragma unroll
        for (int e = 0; e < 4; ++e) { w[k][e] = a[e]; w[k][4 + e] = b[e]; } }
    float u2[8], u1[8];
    auto loadu = [&](int row, float (&u)[8]) { const v4u a = *(const v4u*)(CC + (size_t)row * CW + c0), b = *(const v4u*)(CX + (size_t)row * CW + c0);
#pragma unroll
        for (int e = 0; e < 4; ++e) { u[2 * e] = bf2f(a[e] & 0xffffu) * bf2f(b[e] & 0xffffu); u[2 * e + 1] = bf2f(a[e] >> 16) * bf2f(b[e] >> 16); } };
    if ((r0 & (SEQ - 1)) == 0) {
#pragma unroll
        for (int e = 0; e < 8; ++e) { u2[e] = 0.f; u1[e] = 0.f; } }
    else { loadu(r0 - 2, u2); loadu(r0 - 1, u1); }
#pragma unroll
    for (int i = 0; i < 8; ++i) { float u0[8]; loadu(r0 + i, u0); const size_t po = (size_t)(r0 + i) * CW + c0; bf16* p = ZCO + po; const v4u cb = *(const v4u*)(ZCI + po); float z[8];
#pragma unroll
        for (int e = 0; e < 8; ++e) { const float y = w[0][e] * u2[e] + w[1][e] * u1[e] + w[2][e] * u0[e]; const float c = (e & 1) ? bf2f(cb[e >> 1] >> 16) : bf2f(cb[e >> 1] & 0xffffu); z[e] = c * y; u2[e] = u1[e]; u1[e] = u0[e]; }
        v4u o; o.x = pk2(z[0], z[1]); o.y = pk2(z[2], z[3]); o.z = pk2(z[4], z[5]); o.w = pk2(z[6], z[7]); *(v4u*)p = o; }
}
#ifdef TSUB
#define TS_SLOT ((LAS unsigned long long*)(lds + RING_BYTES + 640))
#define TS_BEGIN(k) unsigned long long ts_b##k = 0; if ((k) == TSUB) ts_b##k = __builtin_amdgcn_s_memrealtime()
#define TS_END(k) do { if ((k) == TSUB && blockIdx.x == 7 && tid == 0) *TS_SLOT += __builtin_amdgcn_s_memrealtime() - ts_b##k; } while (0)
#else
#define TS_BEGIN(k) do { } while (0)
#define TS_END(k) do { } while (0)
#endif
__device__ __forceinline__ float wave_scan_incl(float x) {
#define DPP_ADD(ctrl, rmask) x += __builtin_bit_cast(float, __builtin_amdgcn_update_dpp(0, __builtin_bit_cast(int, x), ctrl, rmask, 0xf, true))
    DPP_ADD(0x111, 0xf); DPP_ADD(0x112, 0xf); DPP_ADD(0x114, 0xf); DPP_ADD(0x118, 0xf);
    x += __builtin_bit_cast(float, __builtin_amdgcn_update_dpp(0, __builtin_bit_cast(int, x), 0x142, 0xa, 0xf, false));
    x += __builtin_bit_cast(float, __builtin_amdgcn_update_dpp(0, __builtin_bit_cast(int, x), 0x143, 0xc, 0xf, false));
#undef DPP_ADD
    return x;
}
struct GlaPre { f32x4 la0, la1; v4u kq, qq, va, vb; };
template <bool FULL> __device__ __forceinline__ GlaPre gla_load(size_t r0, int h, const bf16* Q, const bf16* KK, const bf16* V, const float* LOGA, int tid, int wave, int lane) {
    GlaPre p; const size_t row = r0 + lane; const int kc0 = 8 * wave;
    p.la0 = *(const f32x4*)(LOGA + row * GKEY + h * 64 + kc0); p.la1 = *(const f32x4*)(LOGA + row * GKEY + h * 64 + kc0 + 4);
    p.kq = *(const v4u*)(KK + row * GKEY + h * 64 + kc0); if (FULL) p.qq = *(const v4u*)(Q + row * GKEY + h * 64 + kc0); else p.qq = (v4u){0u, 0u, 0u, 0u};
    const int tp = tid & 31, vg = tid >> 5;
    p.va = *(const v4u*)(V + (r0 + 2 * tp) * GVAL + h * 128 + 8 * vg); p.vb = *(const v4u*)(V + (r0 + 2 * tp + 1) * GVAL + h * 128 + 8 * vg);
    return p;
}
template <bool FULL> __device__ __forceinline__ void gla_build(const GlaPre& p, LAS unsigned char* lds, int tid, int wave, int lane, float (&tot)[8]) {
    const int kc0 = 8 * wave; float b[8] = {p.la0[0], p.la0[1], p.la0[2], p.la0[3], p.la1[0], p.la1[1], p.la1[2], p.la1[3]};
#pragma unroll
    for (int j = 0; j < 8; ++j) b[j] = wave_scan_incl(b[j]);
    float kf[8], qf[8];
#pragma unroll
    for (int e = 0; e < 4; ++e) { kf[2 * e] = bf2f(p.kq[e] & 0xffffu); kf[2 * e + 1] = bf2f(p.kq[e] >> 16); qf[2 * e] = bf2f(p.qq[e] & 0xffffu); qf[2 * e + 1] = bf2f(p.qq[e] >> 16); }
    LAS bf16* KE = (LAS bf16*)(lds + L_KENDT);
#pragma unroll
    for (int j = 0; j < 8; ++j) { tot[j] = __builtin_bit_cast(float, __builtin_amdgcn_readlane(__builtin_bit_cast(int, b[j]), 63)); KE[(kc0 + j) * GP + lane] = (bf16)(pk2(kf[j] * __expf(tot[j] - b[j]), 0.f) & 0xffffu); }
    if (FULL) { float qt[8], kt[8];
#pragma unroll
        for (int j = 0; j < 8; ++j) { qt[j] = qf[j] * __expf(b[j]); kt[j] = kf[j] * __expf(-b[j]); }
        v4u o; o.x = pk2(qt[0], qt[1]); o.y = pk2(qt[2], qt[3]); o.z = pk2(qt[4], qt[5]); o.w = pk2(qt[6], qt[7]); *(LAS v4u*)((LAS bf16*)(lds + L_QT) + lane * GP + kc0) = o;
        o.x = pk2(kt[0], kt[1]); o.y = pk2(kt[2], kt[3]); o.z = pk2(kt[4], kt[5]); o.w = pk2(kt[6], kt[7]); *(LAS v4u*)((LAS bf16*)(lds + L_KT) + lane * GP + kc0) = o; }
    if (lane < 8) { float tl = tot[0];
#pragma unroll
        for (int j = 1; j < 8; ++j) tl = (lane == j) ? tot[j] : tl;
        ((LAS float*)(lds + L_DECS))[kc0 + lane] = __expf(tl); }
    { const int tp = tid & 31, vg = tid >> 5; LAS bf16* VT = (LAS bf16*)(lds + L_VT);
#pragma unroll
      for (int e = 0; e < 4; ++e) { *(LAS unsigned*)(VT + (8 * vg + 2 * e) * GP + 2 * tp) = (p.va[e] & 0xffffu) | (p.vb[e] << 16); *(LAS unsigned*)(VT + (8 * vg + 2 * e + 1) * GP + 2 * tp) = (p.va[e] >> 16) | (p.vb[e] & 0xffff0000u); } }
}
__device__ __forceinline__ void gla_state_step(f32x4 (&S)[4], LAS unsigned char* lds, int wave, int fr, int fq) {
    const LAS bf16* VT = (const LAS bf16*)(lds + L_VT); const LAS bf16* KE = (const LAS bf16*)(lds + L_KENDT); const LAS float* DECS = (const LAS float*)(lds + L_DECS);
    bf16x8 bv[2];
#pragma unroll
    for (int ks = 0; ks < 2; ++ks) bv[ks] = *(const LAS bf16x8*)(VT + (16 * wave + fr) * GP + 32 * ks + 8 * fq);
#pragma unroll
    for (int m = 0; m < 4; ++m) { const f32x4 d = *(const LAS f32x4*)(DECS + 16 * m + 4 * fq); S[m] = S[m] * d;
#pragma unroll
        for (int ks = 0; ks < 2; ++ks) S[m] = mfma16(*(const LAS bf16x8*)(KE + (16 * m + fr) * GP + 32 * ks + 8 * fq), bv[ks], S[m]); }
}
__device__ __forceinline__ void gla_b1_item(int item, LAS unsigned char* lds, const bf16* KK, const bf16* V, const float* LOGA, float* CST, float* DEC, int tid, int wave, int lane) {
    const int b = item & 7, g = (item >> 3) & 7, h = item >> 6, fr = lane & 15, fq = lane >> 4;
    if (g == 7) return;
    f32x4 S[4]; float lsum[8];
#pragma unroll
    for (int m = 0; m < 4; ++m) S[m] = (f32x4){0.f, 0.f, 0.f, 0.f};
#pragma unroll
    for (int j = 0; j < 8; ++j) lsum[j] = 0.f;
    const size_t rg = (size_t)b * SEQ + (size_t)g * 256;
    GlaPre pre[4];
#pragma unroll
    for (int c = 0; c < 4; ++c) pre[c] = gla_load<false>(rg + (size_t)c * 64, h, nullptr, KK, V, LOGA, tid, wave, lane);
#pragma unroll
    for (int c = 0; c < 4; ++c) {
        float tot[8]; gla_build<false>(pre[c], lds, tid, wave, lane, tot);
#pragma unroll
        for (int j = 0; j < 8; ++j) lsum[j] += tot[j];
        LDS_BARRIER();
        gla_state_step(S, lds, wave, fr, fq);
        LDS_BARRIER();
    }
#pragma unroll
    for (int m = 0; m < 4; ++m) *(f32x4*)(CST + (size_t)item * 8192 + (16 * wave + fr) * 64 + 16 * m + 4 * fq) = S[m];
    if (lane < 8) { float tl = lsum[0];
#pragma unroll
        for (int j = 1; j < 8; ++j) tl = (lane == j) ? lsum[j] : tl;
        DEC[(size_t)item * 64 + 8 * wave + lane] = tl; }
}
__device__ __forceinline__ void gla_b2_unit(int unit, LAS unsigned char* lds, const bf16* Q, const bf16* KK, const bf16* V, const float* LOGA, const float* CST, const float* DEC, const bf16* ZAI, bf16* ZAO, int tid, int wave, int lane) {
    const int b = unit & 7, g = (unit >> 3) & 7, h = unit >> 6, fr = lane & 15, fq = lane >> 4;
    TS_BEGIN(1); TS_BEGIN(2);
    const size_t rg = (size_t)b * SEQ + (size_t)g * 256;
    const int ih = wave & 3, vh = wave >> 2;
    GlaPre pre[4]; v2u gt[4][4];
#pragma unroll
    for (int c = 0; c < 4; ++c) pre[c] = gla_load<true>(rg + (size_t)c * 64, h, Q, KK, V, LOGA, tid, wave, lane);
#pragma unroll
    for (int c = 0; c < 4; ++c)
#pragma unroll
        for (int mt = 0; mt < 4; ++mt) gt[c][mt] = *(const v2u*)(ZAI + (rg + (size_t)c * 64 + 16 * ih + fr) * GVAL + h * 128 + 64 * vh + 16 * mt + 4 * fq);
    f32x4 S[4];
#pragma unroll
    for (int m = 0; m < 4; ++m) S[m] = (f32x4){0.f, 0.f, 0.f, 0.f};
    { const size_t it0 = (size_t)unit - 8 * g;
      for (int j0 = 0; j0 < g; j0 += 2) { f32x4 cc[2][4], dd[2][4];
#pragma unroll
          for (int jj = 0; jj < 2; ++jj) if (j0 + jj < g) { const float* cp = CST + (it0 + 8 * (j0 + jj)) * 8192 + (16 * wave + fr) * 64 + 4 * fq; const float* dp = DEC + (it0 + 8 * (j0 + jj)) * 64 + 4 * fq;
#pragma unroll
              for (int m = 0; m < 4; ++m) { cc[jj][m] = *(const f32x4*)(cp + 16 * m); dd[jj][m] = *(const f32x4*)(dp + 16 * m); } }
#pragma unroll
          for (int jj = 0; jj < 2; ++jj) if (j0 + jj < g) {
#pragma unroll
              for (int m = 0; m < 4; ++m) { f32x4 d; d[0] = __expf(dd[jj][m][0]); d[1] = __expf(dd[jj][m][1]); d[2] = __expf(dd[jj][m][2]); d[3] = __expf(dd[jj][m][3]); S[m] = d * S[m] + cc[jj][m]; } } } }
    TS_END(2);
    const LAS bf16* QT = (const LAS bf16*)(lds + L_QT); const LAS bf16* KT = (const LAS bf16*)(lds + L_KT);
    const LAS bf16* VT = (const LAS bf16*)(lds + L_VT); LAS bf16* ST = (LAS bf16*)(lds + L_ST); LAS float* RED = (LAS float*)(lds + L_RED);
#pragma unroll
    for (int c = 0; c < 4; ++c) {
        TS_BEGIN(3);
        const size_t r0 = rg + (size_t)c * 64;
#pragma unroll
        for (int m = 0; m < 4; ++m) { v2u w; w.x = pk2(S[m][0], S[m][1]); w.y = pk2(S[m][2], S[m][3]); *(LAS v2u*)(ST + (16 * wave + fr) * GP + 16 * m + 4 * fq) = w; }
        float tot[8]; gla_build<true>(pre[c], lds, tid, wave, lane, tot);
        LDS_BARRIER();
        TS_END(3); TS_BEGIN(4);
        bf16x8 bq[2];
#pragma unroll
        for (int ks = 0; ks < 2; ++ks) bq[ks] = *(const LAS bf16x8*)(QT + (16 * ih + fr) * GP + 32 * ks + 8 * fq);
        f32x4 X[4];
#pragma unroll
        for (int jt = 0; jt < 4; ++jt) { X[jt] = (f32x4){0.f, 0.f, 0.f, 0.f};
            if (jt <= ih) {
#pragma unroll
                for (int ks = 0; ks < 2; ++ks) X[jt] = mfma16(*(const LAS bf16x8*)(KT + (16 * jt + fr) * GP + 32 * ks + 8 * fq), bq[ks], X[jt]);
#pragma unroll
                for (int r = 0; r < 4; ++r) if (16 * jt + 4 * fq + r > 16 * ih + fr) X[jt][r] = 0.f; } }
        bf16x8 xb[2];
#pragma unroll
        for (int k2 = 0; k2 < 2; ++k2) { v4u w; w.x = pk2(X[2 * k2][0], X[2 * k2][1]); w.y = pk2(X[2 * k2][2], X[2 * k2][3]); w.z = pk2(X[2 * k2 + 1][0], X[2 * k2 + 1][1]); w.w = pk2(X[2 * k2 + 1][2], X[2 * k2 + 1][3]); xb[k2] = __builtin_bit_cast(bf16x8, w); }
        f32x4 O[4]; float ss = 0.f;
#pragma unroll
        for (int mt = 0; mt < 4; ++mt) { const int v = 64 * vh + 16 * mt + fr; f32x4 o = (f32x4){0.f, 0.f, 0.f, 0.f};
#pragma unroll
            for (int k2 = 0; k2 < 2; ++k2) { const v2u lo = *(const LAS v2u*)(VT + v * GP + 32 * k2 + 4 * fq), hi = *(const LAS v2u*)(VT + v * GP + 32 * k2 + 16 + 4 * fq); v4u a; a.x = lo.x; a.y = lo.y; a.z = hi.x; a.w = hi.y;
                o = mfma16(__builtin_bit_cast(bf16x8, a), xb[k2], o); }
#pragma unroll
            for (int ks = 0; ks < 2; ++ks) o = mfma16(*(const LAS bf16x8*)(ST + v * GP + 32 * ks + 8 * fq), bq[ks], o);
            O[mt] = o; ss += (o[0] * o[0] + o[1] * o[1]) + (o[2] * o[2] + o[3] * o[3]); }
        ss += __shfl_xor(ss, 16); ss += __shfl_xor(ss, 32);
        if (fq == 0) RED[(vh * 4 + ih) * 16 + fr] = ss;
        gla_state_step(S, lds, wave, fr, fq);
        LDS_BARRIER();
        TS_END(4); TS_BEGIN(5);
        const float rs = rsqrtf((RED[ih * 16 + fr] + RED[(4 + ih) * 16 + fr]) * (1.f / 128.f) + EPS);
        { const size_t row = r0 + 16 * ih + fr;
#pragma unroll
          for (int mt = 0; mt < 4; ++mt) { v2u o;
              o.x = pk2(O[mt][0] * rs * bf2f(gt[c][mt].x & 0xffffu), O[mt][1] * rs * bf2f(gt[c][mt].x >> 16)); o.y = pk2(O[mt][2] * rs * bf2f(gt[c][mt].y & 0xffffu), O[mt][3] * rs * bf2f(gt[c][mt].y >> 16));
              *(v2u*)(ZAO + row * GVAL + h * 128 + 64 * vh + 16 * mt + 4 * fq) = o; } }
        TS_END(5);
    }
    LDS_BARRIER();
    TS_END(1);
}
__device__ __forceinline__ void ffn_act_item(int idx, const bf16* HUP, bf16* ACT, const float* cw, const float* cb) {
    const int cgp = idx % 352, rb = idx / 352, pn = cgp >> 4, c8 = (cgp & 15) * 8, j0 = 128 * pn + c8, r0 = rb * 16;
    float wg[3][8], wv[3][8], bg[8], bv[8];
#pragma unroll
    for (int e = 0; e < 8; ++e) { bg[e] = cb[j0 + e]; bv[e] = cb[DFF + j0 + e];
#pragma unroll
        for (int k = 0; k < 3; ++k) { wg[k][e] = cw[k * DFF2 + j0 + e]; wv[k][e] = cw[k * DFF2 + DFF + j0 + e]; } }
    float g2[8], g1[8], v2[8], v1[8];
    auto ld = [&](int row, float (&g)[8], float (&v)[8]) { const bf16* p = HUP + (size_t)row * DFF2 + 256 * pn + c8; const v4u a = *(const v4u*)p, b = *(const v4u*)(p + 128);
#pragma unroll
        for (int e = 0; e < 4; ++e) { g[2 * e] = bf2f(a[e] & 0xffffu); g[2 * e + 1] = bf2f(a[e] >> 16); v[2 * e] = bf2f(b[e] & 0xffffu); v[2 * e + 1] = bf2f(b[e] >> 16); } };
    if ((r0 & (SEQ - 1)) == 0) {
#pragma unroll
        for (int e = 0; e < 8; ++e) { g2[e] = 0.f; g1[e] = 0.f; v2[e] = 0.f; v1[e] = 0.f; } }
    else { ld(r0 - 2, g2, v2); ld(r0 - 1, g1, v1); }
    for (int i = 0; i < 16; ++i) { float g0[8], v0[8]; ld(r0 + i, g0, v0); float z[8];
#pragma unroll
        for (int e = 0; e < 8; ++e) { const float ga = wg[0][e] * g2[e] + wg[1][e] * g1[e] + wg[2][e] * g0[e] + bg[e], va = wv[0][e] * v2[e] + wv[1][e] * v1[e] + wv[2][e] * v0[e] + bv[e];
            z[e] = fsilu(ga) * va; g2[e] = g1[e]; g1[e] = g0[e]; v2[e] = v1[e]; v1[e] = v0[e]; }
        v4u o; o.x = pk2(z[0], z[1]); o.y = pk2(z[2], z[3]); o.z = pk2(z[4], z[5]); o.w = pk2(z[6], z[7]); *(v4u*)(ACT + (size_t)(r0 + i) * DFF + j0) = o; }
}

using pg8::Unit;
__device__ __forceinline__ void row_rstd(const float* SSQ, int pm, int wr, int fr, int fq, float (&rsd)[2][4]) {
    const int lane = fr + 16 * fq;
#pragma unroll
    for (int ai = 0; ai < 2; ++ai) { const size_t row = (size_t)pm * 256 + ai * 128 + wr * 64 + lane; const f32x4* p = (const f32x4*)(SSQ + row * 16); const f32x4 a = p[0], b = p[1], c = p[2], d = p[3];
        const float s = ((a[0] + a[1]) + (a[2] + a[3])) + ((b[0] + b[1]) + (b[2] + b[3])) + ((c[0] + c[1]) + (c[2] + c[3])) + ((d[0] + d[1]) + (d[2] + d[3]));
        const float rs = rsqrtf(s * (1.f / D) + EPS);
#pragma unroll
        for (int m = 0; m < 4; ++m) rsd[ai][m] = __shfl(rs, 16 * m + fr); }
}
struct EpiA {
    static constexpr bool PERM = true, AFTER_DRAIN = false;
    unsigned char* act0; const float* SSQ; float* SVST; const float* bal;
    __device__ __forceinline__ void operator()(const f32x4 (&acc)[2][2][4][2], const Unit& u, int wr, int wc, int fr_, int fq_) const {
        int ln_; asm volatile("v_mbcnt_lo_u32_b32 %0, -1, 0\n\tv_mbcnt_hi_u32_b32 %0, -1, %0" : "=v"(ln_)); const int fr = ln_ & 15, fq = ln_ >> 4; (void)fr_; (void)fq_;
        float rsd[2][4]; row_rstd(SSQ, u.pm, wr, fr, fq, rsd);
        const int pn = u.pn; int mode, ldc, colt; size_t boff;
        if (pn < 1) { mode = 0; boff = A_Q; ldc = 256; colt = 0; } else if (pn < 2) { mode = 0; boff = A_K; ldc = 256; colt = 0; } else if (pn < 4) { mode = 0; boff = A_V; ldc = 512; colt = (pn - 2) * 256; }
        else if (pn < 6) { mode = 1; boff = A_Z; ldc = 512; colt = (pn - 4) * 256; } else if (pn < 7) { mode = 4; boff = A_LOGA; ldc = 256; colt = 0; }
        else if (pn < 9) { mode = 2; boff = A_Z + (size_t)M * 512 * 2; ldc = 512; colt = (pn - 7) * 256; } else if (pn < 11) { mode = 3; boff = A_SV; ldc = 512; colt = (pn - 9) * 256; }
        else if (pn < 13) { mode = 0; boff = A_Z + (size_t)2 * M * 512 * 2; ldc = 512; colt = (pn - 11) * 256; } else if (pn < 15) { mode = 0; boff = A_CC; ldc = 512; colt = (pn - 13) * 256; }
        else if (pn < 17) { mode = 0; boff = A_CX; ldc = 512; colt = (pn - 15) * 256; } else { mode = 5; boff = A_G; ldc = 3072; colt = (pn - 17) * 256; }
        const int col0 = colt + wc * 32 + 8 * fq;
#pragma unroll
        for (int ai = 0; ai < 2; ++ai)
#pragma unroll
            for (int m = 0; m < 4; ++m) { const size_t row = (size_t)u.pm * 256 + ai * 128 + wr * 64 + m * 16 + fr; const float rs = rsd[ai][m]; float s1 = 0.f, s2 = 0.f;
#pragma unroll
                for (int bj = 0; bj < 2; ++bj) { const f32x4 a0 = acc[ai][bj][m][0] * rs, a1 = acc[ai][bj][m][1] * rs; float v[8] = {a0[0], a0[1], a0[2], a0[3], a1[0], a1[1], a1[2], a1[3]};
                    if (mode == 4) { const f32x4 b0 = *(const f32x4*)(bal + col0 + bj * 128), b1 = *(const f32x4*)(bal + col0 + bj * 128 + 4); f32x4 o0, o1;
#pragma unroll
                        for (int e = 0; e < 4; ++e) { o0[e] = flogsig(v[e] + b0[e]) * 0.0625f; o1[e] = flogsig(v[4 + e] + b1[e]) * 0.0625f; }
                        float* p = (float*)(act0 + boff) + row * 256 + col0 + bj * 128; *(f32x4*)p = o0; *(f32x4*)(p + 4) = o1; }
                    else {
                        if (mode == 1) {
#pragma unroll
                            for (int e = 0; e < 8; ++e) v[e] = fsilu(v[e]); }
                        else if (mode == 2 || mode == 3) {
#pragma unroll
                            for (int e = 0; e < 8; ++e) v[e] = fgelu(v[e]); }
                        else if (mode == 5) {
#pragma unroll
                            for (int e = 0; e < 8; ++e) v[e] = fsigmoid(v[e]); }
                        if (mode == 3) {
#pragma unroll
                            for (int e = 0; e < 8; ++e) { s1 += v[e]; s2 += v[e] * v[e]; } }
                        v4u o; o.x = pk2(v[0], v[1]); o.y = pk2(v[2], v[3]); o.z = pk2(v[4], v[5]); o.w = pk2(v[6], v[7]);
                        *(v4u*)((bf16*)(act0 + boff) + row * ldc + col0 + bj * 128) = o; } }
                if (mode == 3) { s1 += __shfl_xor(s1, 16); s1 += __shfl_xor(s1, 32); s2 += __shfl_xor(s2, 16); s2 += __shfl_xor(s2, 32);
                    if (fq == 0) *(f32x2*)(SVST + row * 16 + ((pn - 9) * 4 + wc) * 2) = (f32x2){s1, s2}; } }
    }
};
struct EpiC {
    static constexpr bool PERM = true, AFTER_DRAIN = false;
    const bf16* G; bf16* MG;
    __device__ __forceinline__ void operator()(const f32x4 (&acc)[2][2][4][2], const Unit& u, int wr, int wc, int fr_, int fq_) const {
        int ln_; asm volatile("v_mbcnt_lo_u32_b32 %0, -1, 0\n\tv_mbcnt_hi_u32_b32 %0, -1, %0" : "=v"(ln_)); const int fr = ln_ & 15, fq = ln_ >> 4; (void)fr_; (void)fq_;
        const int br = u.pm >> 6, pm = u.pm & 63, pn = u.pn & 3; const int col0 = pn * 256 + wc * 32 + 8 * fq;
#pragma unroll
        for (int ai = 0; ai < 2; ++ai) {
            v4u gt[4][2], old[4][2];
#pragma unroll
            for (int m = 0; m < 4; ++m)
#pragma unroll
                for (int bj = 0; bj < 2; ++bj) { const size_t row = (size_t)pm * 256 + ai * 128 + wr * 64 + m * 16 + fr; gt[m][bj] = *(const v4u*)(G + row * 3072 + br * 1024 + col0 + bj * 128);
                    if (br != 0) old[m][bj] = *(const v4u*)(MG + row * 1024 + col0 + bj * 128); }
#pragma unroll
            for (int m = 0; m < 4; ++m) { const size_t row = (size_t)pm * 256 + ai * 128 + wr * 64 + m * 16 + fr;
#pragma unroll
                for (int bj = 0; bj < 2; ++bj) { const f32x4 a0 = acc[ai][bj][m][0], a1 = acc[ai][bj][m][1]; float v[8] = {a0[0], a0[1], a0[2], a0[3], a1[0], a1[1], a1[2], a1[3]};
#pragma unroll
                    for (int e = 0; e < 4; ++e) { v[2 * e] *= bf2f(gt[m][bj][e] & 0xffffu); v[2 * e + 1] *= bf2f(gt[m][bj][e] >> 16); }
                    if (br != 0) {
#pragma unroll
                        for (int e = 0; e < 4; ++e) { v[2 * e] += bf2f(old[m][bj][e] & 0xffffu); v[2 * e + 1] += bf2f(old[m][bj][e] >> 16); } }
                    v4u o; o.x = pk2(v[0], v[1]); o.y = pk2(v[2], v[3]); o.z = pk2(v[4], v[5]); o.w = pk2(v[6], v[7]); *(v4u*)(MG + row * 1024 + col0 + bj * 128) = o; } } }
    }
};
struct BranchOrder {
    int G, c;
    __device__ bool next(int i, Unit& u) const { const int j = i / 3, br = i - 3 * j, T = c + G * j; if (T >= 256) return false;
        const int w = (T & 7) * 32 + (T >> 3), pm = (w >> 5) * 8 + (w & 7), pn = (w & 31) >> 3; u.pm = br * 64 + pm; u.pn = br * 4 + pn; return true; }
    __device__ __forceinline__ void a_ready(const Unit&) const {}
    __device__ __forceinline__ void done(const Unit&) const {}
};
template <int VAR> struct EpiResT {
    static constexpr bool PERM = true, AFTER_DRAIN = false;
    const bf16* XI; bf16* XB; float* SSQ;
    __device__ __forceinline__ void operator()(const f32x4 (&acc)[2][2][4][2], const Unit& u, int wr, int wc, int fr_, int fq_) const {
        int ln_; asm volatile("v_mbcnt_lo_u32_b32 %0, -1, 0\n\tv_mbcnt_hi_u32_b32 %0, -1, %0" : "=v"(ln_)); const int fr = ln_ & 15, fq = ln_ >> 4; (void)fr_; (void)fq_;
        const int col0 = u.pn * 256 + wc * 32 + 8 * fq;
        v4u xo[2][4][2];
#pragma unroll
        for (int ai = 0; ai < 2; ++ai)
#pragma unroll
            for (int m = 0; m < 4; ++m)
#pragma unroll
                for (int bj = 0; bj < 2; ++bj) xo[ai][m][bj] = *(const v4u*)(XI + ((size_t)u.pm * 256 + ai * 128 + wr * 64 + m * 16 + fr) * D + col0 + bj * 128);
#pragma unroll
        for (int ai = 0; ai < 2; ++ai)
#pragma unroll
            for (int m = 0; m < 4; ++m) { const size_t row = (size_t)u.pm * 256 + ai * 128 + wr * 64 + m * 16 + fr; float ss = 0.f;
#pragma unroll
                for (int bj = 0; bj < 2; ++bj) { const size_t off = row * D + col0 + bj * 128; const f32x4 a0 = acc[ai][bj][m][0], a1 = acc[ai][bj][m][1];
                    float v[8] = {a0[0], a0[1], a0[2], a0[3], a1[0], a1[1], a1[2], a1[3]};
#pragma unroll
                    for (int e = 0; e < 4; ++e) { v[2 * e] += bf2f(xo[ai][m][bj][e] & 0xffffu); v[2 * e + 1] += bf2f(xo[ai][m][bj][e] >> 16); }
#pragma unroll
                    for (int e = 0; e < 8; ++e) ss += v[e] * v[e];
                    v4u o; o.x = pk2(v[0], v[1]); o.y = pk2(v[2], v[3]); o.z = pk2(v[4], v[5]); o.w = pk2(v[6], v[7]); if (VAR != 1 || ss == 12345.678f) *(v4u*)(XB + off) = o; }
                if (VAR == 0) { ss += __shfl_xor(ss, 16); ss += __shfl_xor(ss, 32);
                if (fq == 0) SSQ[row * 16 + u.pn * 4 + wc] = ss; } }
    }
};
typedef EpiResT<0> EpiRes;
struct EpiUp {
    static constexpr bool PERM = true, AFTER_DRAIN = false;
    bf16* HUP; const float* SSQ;
    __device__ __forceinline__ void operator()(const f32x4 (&acc)[2][2][4][2], const Unit& u, int wr, int wc, int fr_, int fq_) const {
        int ln_; asm volatile("v_mbcnt_lo_u32_b32 %0, -1, 0\n\tv_mbcnt_hi_u32_b32 %0, -1, %0" : "=v"(ln_)); const int fr = ln_ & 15, fq = ln_ >> 4; (void)fr_; (void)fq_;
        float rsd[2][4]; row_rstd(SSQ, u.pm, wr, fr, fq, rsd);
        const int col0 = u.pn * 256 + wc * 32 + 8 * fq;
#pragma unroll
        for (int ai = 0; ai < 2; ++ai)
#pragma unroll
            for (int m = 0; m < 4; ++m) { const size_t row = (size_t)u.pm * 256 + ai * 128 + wr * 64 + m * 16 + fr; const float rs = rsd[ai][m];
#pragma unroll
                for (int bj = 0; bj < 2; ++bj) { const f32x4 a0 = acc[ai][bj][m][0] * rs, a1 = acc[ai][bj][m][1] * rs;
                    v4u o; o.x = pk2(a0[0], a0[1]); o.y = pk2(a0[2], a0[3]); o.z = pk2(a1[0], a1[1]); o.w = pk2(a1[2], a1[3]); *(v4u*)(HUP + row * DFF2 + col0 + bj * 128) = o; } }
    }
};

__device__ __forceinline__ float dpp_f(float old, float src, const int ctrl_sel) {
    const int o = __builtin_bit_cast(int, old), v = __builtin_bit_cast(int, src); int r;
    if (ctrl_sel == 0) r = __builtin_amdgcn_update_dpp(o, v, 0x111, 0xf, 0xf, false);
    else if (ctrl_sel == 1) r = __builtin_amdgcn_update_dpp(o, v, 0x112, 0xf, 0xf, false);
    else if (ctrl_sel == 2) r = __builtin_amdgcn_update_dpp(o, v, 0x121, 0xf, 0xf, false);
    else r = __builtin_amdgcn_update_dpp(o, v, 0x122, 0xf, 0xf, false);
    return __builtin_bit_cast(float, r);
}
constexpr int XL_OFF = RING_BYTES + 1024;
struct EpiUpConv {
    static constexpr bool PERM = true, AFTER_DRAIN = false;
    unsigned char* ws; const float* cw; const float* cb; LAS unsigned char* lds;
    __device__ __forceinline__ void operator()(const f32x4 (&acc)[2][2][4][2], const Unit& u, int wr, int wc, int fr_, int fq_) const {
        int ln_; asm volatile("v_mbcnt_lo_u32_b32 %0, -1, 0\n\tv_mbcnt_hi_u32_b32 %0, -1, %0" : "=v"(ln_)); const int fr = ln_ & 15, fq = ln_ >> 4; (void)fr_; (void)fq_;
        bf16* ACT = (bf16*)(ws + WS_ACT0 + A_ACT); const float* SSQ = (const float*)(ws + WS_SSQ); float* HT = (float*)(ws + WS_ACT0 + A_HT);
        float rsd[2][4]; row_rstd(SSQ, u.pm, wr, fr, fq, rsd);
        LAS f32x4* XL = (LAS f32x4*)(lds + XL_OFF);
        const int tcol = u.pn * 256 + wc * 32 + 8 * fq;
#pragma unroll
        for (int ai = 0; ai < 2; ++ai)
#pragma unroll
            for (int bj = 0; bj < 2; ++bj)
#pragma unroll
                for (int n = 0; n < 2; ++n) {
                    if (fr >= 14) { const f32x4 h = acc[ai][bj][3][n] * rsd[ai][3]; XL[((((ai * 2 + wr) * 4 + wc) * 2 + bj) * 2 + n) * 8 + fq * 2 + (fr - 14)] = h;
                        if (ai == 1 && wr == 1) *(f32x4*)(HT + ((size_t)(u.pm * 2 + 1) * 2 + (fr - 14)) * DFF2 + tcol + bj * 128 + 4 * n) = h; }
                    if (ai == 0 && wr == 0 && fr < 2) *(f32x4*)(HT + ((size_t)(u.pm * 2 + 0) * 2 + fr) * DFF2 + tcol + bj * 128 + 4 * n) = acc[0][bj][0][n] * rsd[0][0]; }
        asm volatile("s_waitcnt lgkmcnt(0)" ::: "memory"); __builtin_amdgcn_s_barrier(); asm volatile("" ::: "memory");
        const int ch0 = u.pn * 128 + wc * 32 + 8 * fq; const bool batch_start = (u.pm & 7) == 0;
#pragma unroll
        for (int n = 0; n < 2; ++n) {
            asm volatile("" ::: "memory");
            f32x4 wg[3], wv[3];
#pragma unroll
            for (int k = 0; k < 3; ++k) { wg[k] = *(const f32x4*)(cw + k * DFF2 + ch0 + 4 * n); wv[k] = *(const f32x4*)(cw + k * DFF2 + DFF + ch0 + 4 * n); }
            const f32x4 bg = *(const f32x4*)(cb + ch0 + 4 * n), bv = *(const f32x4*)(cb + DFF + ch0 + 4 * n);
#pragma unroll
            for (int ai = 0; ai < 2; ++ai) {
                f32x4 hgp, hvp;
                { f32x4 pg14 = (f32x4){0.f, 0.f, 0.f, 0.f}, pg15 = pg14, pv14 = pg14, pv15 = pg14;
                  if (!(ai == 0 && wr == 0)) { const int pb = ai * 2 + wr - 1; const LAS f32x4* q = XL + ((((pb * 4 + wc) * 2 + 0) * 2 + n) * 8 + fq * 2); const LAS f32x4* qv = XL + ((((pb * 4 + wc) * 2 + 1) * 2 + n) * 8 + fq * 2);
                      pg14 = q[0]; pg15 = q[1]; pv14 = qv[0]; pv15 = qv[1]; }
                  hgp = (fr == 14) ? pg14 : pg15; hvp = (fr == 14) ? pv14 : pv15; }
#pragma unroll
                for (int m = 0; m < 4; ++m) { const f32x4 hg = acc[ai][0][m][n] * rsd[ai][m], hv = acc[ai][1][m][n] * rsd[ai][m]; f32x4 z;
#pragma unroll
                    for (int e = 0; e < 4; ++e) {
                        const float g1 = dpp_f(dpp_f(0.f, hgp[e], 2), hg[e], 0), g2 = dpp_f(dpp_f(0.f, hgp[e], 3), hg[e], 1);
                        const float v1 = dpp_f(dpp_f(0.f, hvp[e], 2), hv[e], 0), v2 = dpp_f(dpp_f(0.f, hvp[e], 3), hv[e], 1);
                        const float ga = wg[0][e] * g2 + wg[1][e] * g1 + wg[2][e] * hg[e] + bg[e], va = wv[0][e] * v2 + wv[1][e] * v1 + wv[2][e] * hv[e] + bv[e];
                        z[e] = fsilu(ga) * va; }
                    const size_t row = (size_t)u.pm * 256 + ai * 128 + wr * 64 + m * 16 + fr;
                    const bool skip = (ai == 0 && wr == 0 && m == 0 && fr < 2 && !batch_start);
                    if (!skip) { v2u o; o.x = pk2(z[0], z[1]); o.y = pk2(z[2], z[3]); *(v2u*)(ACT + row * DFF + ch0 + 4 * n) = o; }
                    hgp = hg; hvp = hv; } } }
    }
};
__device__ __forceinline__ void ffn_fixup(int pm, const float* HT, bf16* ACT, const float* cw, const float* cb, int tid) {
    if ((pm & 7) == 0) return;
    for (int it = tid; it < 2 * (DFF / 4); it += NTHREADS) { const int rr = it / (DFF / 4), j = (it % (DFF / 4)) * 4, tc = (j >> 7) * 256 + (j & 127);
        const float* h0 = HT + ((size_t)(pm * 2 + 0) * 2 + rr) * DFF2;
        const float* h1 = rr ? HT + ((size_t)(pm * 2 + 0) * 2 + 0) * DFF2 : HT + ((size_t)((pm - 1) * 2 + 1) * 2 + 1) * DFF2;
        const float* h2 = rr ? HT + ((size_t)((pm - 1) * 2 + 1) * 2 + 1) * DFF2 : HT + ((size_t)((pm - 1) * 2 + 1) * 2 + 0) * DFF2;
        const f32x4 g0 = *(const f32x4*)(h0 + tc), g1 = *(const f32x4*)(h1 + tc), g2 = *(const f32x4*)(h2 + tc), v0 = *(const f32x4*)(h0 + tc + 128), v1 = *(const f32x4*)(h1 + tc + 128), v2 = *(const f32x4*)(h2 + tc + 128);
        const f32x4 ga = *(const f32x4*)(cw + j) * g2 + *(const f32x4*)(cw + DFF2 + j) * g1 + *(const f32x4*)(cw + 2 * DFF2 + j) * g0 + *(const f32x4*)(cb + j);
        const f32x4 va = *(const f32x4*)(cw + DFF + j) * v2 + *(const f32x4*)(cw + DFF2 + DFF + j) * v1 + *(const f32x4*)(cw + 2 * DFF2 + DFF + j) * v0 + *(const f32x4*)(cb + DFF + j);
        v2u o; o.x = pk2(fsilu(ga[0]) * va[0], fsilu(ga[1]) * va[1]); o.y = pk2(fsilu(ga[2]) * va[2], fsilu(ga[3]) * va[3]);
        *(v2u*)(ACT + ((size_t)pm * 256 + rr) * DFF + j) = o; }
    asm volatile("s_waitcnt vmcnt(0)" ::: "memory"); __syncthreads();
}

template <bool P> struct EpiNull {
    static constexpr bool PERM = P, AFTER_DRAIN = false; float* sink;
    __device__ __forceinline__ void operator()(const f32x4 (&acc)[2][2][4][2], const Unit& u, int wr, int wc, int fr, int fq) const {
        f32x4 s = (f32x4){0.f, 0.f, 0.f, 0.f};
#pragma unroll
        for (int ai = 0; ai < 2; ++ai)
#pragma unroll
            for (int bj = 0; bj < 2; ++bj)
#pragma unroll
                for (int m = 0; m < 4; ++m)
#pragma unroll
                    for (int n = 0; n < 2; ++n) s += acc[ai][bj][m][n];
        if (s[0] + s[1] + s[2] + s[3] == 12345.678f) sink[u.pm + wr + wc + fr + fq] = s[0];
    }
};
#define XB_TMO      128
#define XB_XCNT(j)  (256  + 64 * (j))
#define XB_XSUB(j)  (1280 + 64 * (j))
#define XB_XGEN(j)  (2304 + 64 * (j))
#define XB_TOP      3328
#define XB_TOPGEN   3392
#define XCD_BAR_WORDS 3456
#define XB_SPIN_CAP (1u << 18)

__device__ __forceinline__ unsigned xb_ld(unsigned* p)              { return __hip_atomic_load(p, __ATOMIC_RELAXED, __HIP_MEMORY_SCOPE_AGENT); }
__device__ __forceinline__ unsigned xb_add(unsigned* p, unsigned v) { return __hip_atomic_fetch_add(p, v, __ATOMIC_RELAXED, __HIP_MEMORY_SCOPE_AGENT); }
__device__ __forceinline__ unsigned xb_xcc_id() { return (unsigned)__builtin_amdgcn_s_getreg((3 << 11) | 20) & 0xFu; }
#define XB_SPIN(cond, bar) do { unsigned _sp = 0; while (cond) { __builtin_amdgcn_s_sleep(1); \
    if ((++_sp & 255u) == 0u) { if (xb_ld(&(bar)[XB_TMO])) break; if (_sp > XB_SPIN_CAP) { atomicAdd(&(bar)[XB_TMO], 1u); break; } } } } while (0)

struct XcdBarrier {
    unsigned* bar; unsigned x;
    volatile LAS unsigned* st;
};

__device__ __forceinline__ XcdBarrier xcd_barrier_post(unsigned* bar, volatile LAS unsigned* st) {
    XcdBarrier b; b.bar = bar; b.x = xb_xcc_id(); b.st = st;
    if (threadIdx.x == 0) (void)xb_add(&bar[XB_XCNT(b.x)], 1u);
    return b;
}
__device__ __forceinline__ void xcd_barrier_complete(unsigned* bar, unsigned x, unsigned& nloc, unsigned& nx) {
    const unsigned G = gridDim.x * gridDim.y * gridDim.z;
    unsigned sum, cnt, mine, sp = 0u;
    for (;;) {
        sum = 0u; cnt = 0u; mine = 0u;
#pragma unroll
        for (unsigned j = 0; j < 16; ++j) { const unsigned c = xb_ld(&bar[XB_XCNT(j)]); sum += c; cnt += (c > 0u) ? 1u : 0u; mine = (j == x) ? c : mine; }
        if (sum == G) break;
        __builtin_amdgcn_s_sleep(1);
        if ((++sp & 255u) == 0u) { if (xb_ld(&bar[XB_TMO])) break; if (sp > XB_SPIN_CAP) { atomicAdd(&bar[XB_TMO], 1u); break; } }
    }
    nloc = mine > 0u ? mine : 1u; nx = cnt > 0u ? cnt : 1u;
}

__device__ __forceinline__ void xcd_barrier(const XcdBarrier& b) {
    asm volatile("s_waitcnt vmcnt(0)" ::: "memory");
    __syncthreads();
    if (threadIdx.x == 0) {
        unsigned* bar = b.bar;
        __builtin_amdgcn_s_waitcnt(0);
        unsigned nloc = b.st[0], nx = b.st[1];
        if (nloc == 0u) { xcd_barrier_complete(bar, b.x, nloc, nx); b.st[0] = nloc; b.st[1] = nx; }
        const unsigned old = xb_add(&bar[XB_XSUB(b.x)], 1u);
        const unsigned gen = old / nloc;
        if (old + 1u == (gen + 1u) * nloc) {
            __builtin_amdgcn_fence(__ATOMIC_RELEASE, "agent");
            asm volatile("s_waitcnt vmcnt(0)" ::: "memory");
            const unsigned og = xb_add(&bar[XB_TOP], 1u);
            const unsigned tg = og / nx;
            if (og + 1u == (tg + 1u) * nx) xb_add(&bar[XB_TOPGEN], 1u);
            else XB_SPIN(xb_ld(&bar[XB_TOPGEN]) == tg, bar);
            __builtin_amdgcn_fence(__ATOMIC_ACQUIRE, "agent");
            xb_add(&bar[XB_XGEN(b.x)], 1u);
            asm volatile("s_waitcnt vmcnt(0)" ::: "memory");
        } else {
            XB_SPIN(xb_ld(&bar[XB_XGEN(b.x)]) == gen, bar);
            __builtin_amdgcn_fence(__ATOMIC_ACQUIRE, "agent");
            asm volatile("s_waitcnt vmcnt(0)" ::: "memory");
        }
    }
    __syncthreads();
}

#ifndef PROBE
#define PROBE 0
#endif
struct Args { Inputs in; float* out; unsigned char* ws; int ph_lo, ph_hi; };
constexpr int NPHASE = 2 + 7 * DEPTH;
#define LAUNDER_S(p) asm volatile("" : "+s"(p))
#define LAUNDER_V(p) asm volatile("" : "+v"(p))
struct Ctx { unsigned char* ws; unsigned char* act0; float* X; int tid, lane, wave, G, bx, gw, ngw; };
__device__ __forceinline__ Ctx make_ctx(const Args& a, int wave_id) {
    Ctx c; size_t z = 0; LAUNDER_S(z); c.ws = a.ws + z; c.X = (float*)((unsigned char*)a.out + z); c.act0 = c.ws + WS_ACT0;
    int ln; asm volatile("v_mbcnt_lo_u32_b32 %0, -1, 0\n\tv_mbcnt_hi_u32_b32 %0, -1, %0" : "=v"(ln)); c.lane = ln; c.wave = wave_id; c.tid = wave_id * 64 + ln;
    c.G = gridDim.x; c.bx = blockIdx.x; c.gw = c.bx * NWAVES + c.wave; c.ngw = c.G * NWAVES; return c;
}
__device__ __forceinline__ unsigned char* slot_of(const Ctx& c, int l) { return c.ws + WS_SLOT0 + (size_t)(l & 1) * SL_BYTES; }
__device__ __forceinline__ unsigned* ctl_word(const Ctx& c, int w) { return (unsigned*)(c.ws + WS_CTL) + w; }
__device__ __forceinline__ void tail_convert(const Args& a, const Ctx& c, int l, int ph, bool drain, bool early, LAS unsigned char* lds) {
#if MK_ONE_LAUNCH
    unsigned* fin = ctl_word(c, CW_FIN + 64 * ph);
    if (c.tid == 0) __hip_atomic_fetch_add(fin, 1u, RLX_AGENT);
    if (l == 0 && ph == 1) convert_queue(a.in, 0, slot_of(c, 0), lds, ctl_word(c, CW_QHEAD), CV_WIN_ITEMS, CV_ITEMS, nullptr, c.G, c.tid, c.wave, c.lane);
    if (l + 1 < DEPTH && (drain || early)) convert_queue(a.in, l + 1, slot_of(c, l + 1), lds, ctl_word(c, CW_QHEAD + 64 * (l + 1)), 0, CV_ITEMS, drain ? nullptr : fin, c.G, c.tid, c.wave, c.lane);
#else
    if (l == 0 && ph == 1) convert_static(a.in, 0, slot_of(c, 0), lds, CV_WIN_ITEMS, CV_ITEMS, c.gw, c.ngw, c.wave, c.lane);
    if (l + 1 < DEPTH && drain) convert_static(a.in, l + 1, slot_of(c, l + 1), lds, 0, CV_ITEMS, c.gw, c.ngw, c.wave, c.lane);
#endif
}
__device__ __forceinline__ void ph_p0(const Args& a, const int wv, LAS unsigned char* lds) { const Ctx c = make_ctx(a, wv);
    convert_static(a.in, 0, c.ws + WS_SLOT0, lds, 0, CV_WIN_ITEMS, c.gw, c.ngw, c.wave, c.lane); x_prep(a.in.p[0], (bf16*)(c.ws + WS_XB), (float*)(c.ws + WS_SSQ), c.gw, c.ngw, c.lane); }
__device__ __forceinline__ void ph_a(const Args& a, const int wv, int l, int ph, LAS unsigned char* lds) { const Ctx c = make_ctx(a, wv);
    pg8::Gemm g{(const bf16*)(c.ws + WS_XB), (const bf16*)(slot_of(c, l) + SL_WIN), M, NIN, D}; pg8::StaticOrder S; S.init(M, NIN, c.G, c.bx);
    EpiA E{c.act0, (const float*)(c.ws + WS_SSQ), (float*)(c.ws + WS_SVST), a.in.p[4] + (size_t)l * GKEY};
    if (PROBE == 21) { EpiNull<true> EN_{(float*)(c.ws + WS_END)}; pg8::gemm_phase<EpiNull<true>, pg8::StaticOrder, true, true>(lds, g, S, EN_, wv); }
    for (int rep = 0; rep < 1 + (PROBE == 1); ++rep) pg8::gemm_phase<EpiA, pg8::StaticOrder, true, true>(lds, g, S, E, wv);
    { const Ctx c2 = make_ctx(a, wv); tail_convert(a, c2, l, ph, false, ((NIN / 256) * 64 - 1) / c2.G * c2.G + c2.bx >= (NIN / 256) * 64, lds); } }
__device__ __forceinline__ void ph_b1(const Args& a, const int wv, int l, LAS unsigned char* lds) { const Ctx c = make_ctx(a, wv); const Inputs& I = a.in;
    bf16* Zb = (bf16*)(c.act0 + A_Z); bf16* DUM = (bf16*)(c.ws + WS_END);
    for (int rep = 0; rep < 1 + (PROBE == 2); ++rep)
    for (int it = c.bx; it < 256; it += c.G) gla_b1_item(it, lds, (const bf16*)(c.act0 + A_K), (const bf16*)(c.act0 + A_V), (const float*)(c.act0 + A_LOGA), (float*)(c.act0 + A_CST), (float*)(c.act0 + A_DEC), c.tid, c.wave, c.lane);
    if (PROBE == 3) for (int it = c.bx; it < 512; it += c.G) sgu_item(it, lds, Zb + (size_t)M * 512, DUM, (const bf16*)(c.act0 + A_SV), (const float*)(c.ws + WS_SVST), I.p[7] + (size_t)l * SGW, I.p[8] + (size_t)l * SGW, (const bf16*)(slot_of(c, l) + SL_SGW), I.p[10] + (size_t)l * 512, c.wave, c.lane);
    for (int it = c.bx; it < 512; it += c.G) sgu_item(it, lds, Zb + (size_t)M * 512, Zb + (size_t)M * 512, (const bf16*)(c.act0 + A_SV), (const float*)(c.ws + WS_SVST), I.p[7] + (size_t)l * SGW, I.p[8] + (size_t)l * SGW, (const bf16*)(slot_of(c, l) + SL_SGW), I.p[10] + (size_t)l * 512, c.wave, c.lane);
    if (PROBE == 4) for (int it = c.bx * NTHREADS + c.tid; it < 131072; it += c.G * NTHREADS) convbr_item(it, Zb + (size_t)2 * M * 512, DUM, (const bf16*)(c.act0 + A_CC), (const bf16*)(c.act0 + A_CX), I.p[12] + (size_t)l * 3 * CW);
    for (int it = c.bx * NTHREADS + c.tid; it < 131072; it += c.G * NTHREADS) convbr_item(it, Zb + (size_t)2 * M * 512, Zb + (size_t)2 * M * 512, (const bf16*)(c.act0 + A_CC), (const bf16*)(c.act0 + A_CX), I.p[12] + (size_t)l * 3 * CW);
}
__device__ __forceinline__ void ph_b2(const Args& a, const int wv, int l, int ph, LAS unsigned char* lds) { const Ctx c = make_ctx(a, wv);
    if (PROBE == 6) for (int it = c.bx; it < 256; it += c.G) gla_b2_unit(it, lds, (const bf16*)(c.act0 + A_Q), (const bf16*)(c.act0 + A_K), (const bf16*)(c.act0 + A_V), (const float*)(c.act0 + A_LOGA), (const float*)(c.act0 + A_CST), (const float*)(c.act0 + A_DEC), (const bf16*)(c.act0 + A_Z), (bf16*)(c.ws + WS_END), c.tid, c.wave, c.lane);
    for (int it = c.bx; it < 256; it += c.G) gla_b2_unit(it, lds, (const bf16*)(c.act0 + A_Q), (const bf16*)(c.act0 + A_K), (const bf16*)(c.act0 + A_V), (const float*)(c.act0 + A_LOGA), (const float*)(c.act0 + A_CST), (const float*)(c.act0 + A_DEC), (const bf16*)(c.act0 + A_Z), (bf16*)(c.act0 + A_Z), c.tid, c.wave, c.lane); }
__device__ __forceinline__ void ph_c(const Args& a, const int wv, int l, LAS unsigned char* lds) { const Ctx c = make_ctx(a, wv);
    pg8::Gemm g{(const bf16*)(c.act0 + A_Z), (const bf16*)(slot_of(c, l) + SL_WBR), 3 * M, 3 * D, 512}; BranchOrder S{c.G, c.bx}; EpiC E{(const bf16*)(c.act0 + A_G), (bf16*)(c.act0 + A_MERGED)};
    for (int rep = 0; rep < 1 + (PROBE == 7); ++rep) pg8::gemm_phase<EpiC, BranchOrder, true, true>(lds, g, S, E, wv); }
__device__ __forceinline__ void ph_res(const Args& a, const int wv, const bf16* A, const bf16* Bt, int K, int dup, int l, int ph, bool drain, LAS unsigned char* lds) { const Ctx c = make_ctx(a, wv);
    pg8::Gemm g{A, Bt, M, D, K}; pg8::StaticOrder S; S.init(M, D, c.G, c.bx);
    if (dup == 2) { EpiNull<true> EN_{(float*)(c.ws + WS_END)}; pg8::gemm_phase<EpiNull<true>, pg8::StaticOrder, true, true>(lds, g, S, EN_, wv); }
    if (dup == 3) { EpiResT<1> E{(const bf16*)(c.ws + WS_XB), (bf16*)(c.ws + WS_END), (float*)(c.ws + WS_END + 32 * MiB)}; pg8::gemm_phase<EpiResT<1>, pg8::StaticOrder, true, true>(lds, g, S, E, wv); }
    if (dup == 4) { EpiResT<2> E{(const bf16*)(c.ws + WS_XB), (bf16*)(c.ws + WS_END), (float*)(c.ws + WS_END + 32 * MiB)}; pg8::gemm_phase<EpiResT<2>, pg8::StaticOrder, true, true>(lds, g, S, E, wv); }
    if (dup == 1) { EpiRes E{(const bf16*)(c.ws + WS_XB), (bf16*)(c.ws + WS_END), (float*)(c.ws + WS_END + 32 * MiB)}; pg8::gemm_phase<EpiRes, pg8::StaticOrder, true, true>(lds, g, S, E, wv); }
    if (drain) { pg8::Unit u0; for (int i = 0; S.next(i, u0); ++i) ffn_fixup(u0.pm, (const float*)(c.act0 + A_HT), (bf16*)(c.act0 + A_ACT), a.in.p[17] + (size_t)l * 3 * DFF2, a.in.p[18] + (size_t)l * DFF2, c.tid); }
    EpiRes E{(const bf16*)(c.ws + WS_XB), (bf16*)(c.ws + WS_XB), (float*)(c.ws + WS_SSQ)};
    pg8::gemm_phase<EpiRes, pg8::StaticOrder, true, true>(lds, g, S, E, wv);
    if (drain) { const Ctx c2 = make_ctx(a, wv); tail_convert(a, c2, l, ph, true, true, lds); } }
__device__ __forceinline__ void ph_e(const Args& a, const int wv, int l, int ph, LAS unsigned char* lds) { const Ctx c = make_ctx(a, wv);
    pg8::Gemm g{(const bf16*)(c.ws + WS_XB), (const bf16*)(slot_of(c, l) + SL_WUP), M, DFF2, D}; pg8::StaticOrder S; S.init(M, DFF2, c.G, c.bx);
    EpiUpConv E{c.ws, a.in.p[17] + (size_t)l * 3 * DFF2, a.in.p[18] + (size_t)l * DFF2, lds};
    for (int rep = 0; rep < 1 + (PROBE == 8); ++rep) pg8::gemm_phase<EpiUpConv, pg8::StaticOrder, true, true>(lds, g, S, E, wv);
    { const Ctx c2 = make_ctx(a, wv); tail_convert(a, c2, l, ph, false, ((DFF2 / 256) * 64 - 1) / c2.G * c2.G + c2.bx >= (DFF2 / 256) * 64, lds); } }
__device__ __forceinline__ void ph_e2(const Args& a, const int wv, int l) { const Ctx c = make_ctx(a, wv);
    for (int rep = 0; rep < 1 + (PROBE == 9); ++rep)
    for (int it = c.bx * NTHREADS + c.tid; it < 1024 * 352; it += c.G * NTHREADS) ffn_act_item(it, (const bf16*)(c.act0 + A_HUP), (bf16*)(c.act0 + A_ACT), a.in.p[17] + (size_t)l * 3 * DFF2, a.in.p[18] + (size_t)l * DFF2); }
__device__ __forceinline__ void ph_fin(const Args& a, const int wv) { const Ctx c = make_ctx(a, wv); final_norm((const bf16*)(c.ws + WS_XB), c.X, (const float*)(c.ws + WS_SSQ), a.in.p[20], c.gw, c.ngw, c.lane); }

#ifndef PHMASK
#define PHMASK 0xFFFF
#endif
#define EN(b) ((PHMASK >> (b)) & 1)
__global__ void __launch_bounds__(NTHREADS, 2) mk_fwd(Args args) {
    extern __shared__ __attribute__((aligned(16))) unsigned char lds_raw[];
    LAS unsigned char* lds = (LAS unsigned char*)lds_raw;
    const int wv = __builtin_amdgcn_readfirstlane(threadIdx.x >> 6);
#ifdef TSUB
    if (threadIdx.x == 0) *TS_SLOT = 0ull;
#endif
    const int lo = args.ph_lo, hi = args.ph_hi;
#define IN(k) (lo <= (k) && (k) < hi)
#if MK_ONE_LAUNCH
    volatile LAS unsigned* bst = (volatile LAS unsigned*)(lds + RING_BYTES + 512);
    if (threadIdx.x < 2) bst[threadIdx.x] = 0u;
    __syncthreads();
    const XcdBarrier bar = xcd_barrier_post((unsigned*)(args.ws + WS_CTL) + CW_BAR, bst);
#define SEAM(k) do { if (IN(k) && IN((k) + 1)) { if ((k) == 0) cg::this_grid().sync(); else xcd_barrier(bar); } } while (0)
#else
#define SEAM(k) do { } while (0)
#endif
#ifdef TPROBE
    unsigned long long tp_acc = 0ull, tp_prev = __builtin_amdgcn_s_memrealtime();
#define TP_MARK(kind) do { const unsigned long long t_ = __builtin_amdgcn_s_memrealtime(); if ((kind) == TPROBE) tp_acc += t_ - tp_prev; tp_prev = t_; } while (0)
#else
#define TP_MARK(kind) do { } while (0)
#endif
    int ph = 0;
    if (EN(0) && IN(ph)) ph_p0(args, wv, lds);
    SEAM(ph); ++ph; TP_MARK(0);
    for (int l = 0; l < DEPTH; ++l) {
        if (EN(1) && IN(ph)) ph_a(args, wv, l, ph, lds);
        SEAM(ph); ++ph; TP_MARK(1);
        if (EN(2) && IN(ph)) ph_b1(args, wv, l, lds);
        SEAM(ph); ++ph; TP_MARK(2);
        if (EN(3) && IN(ph)) ph_b2(args, wv, l, ph, lds);
        SEAM(ph); ++ph; TP_MARK(3);
        if (EN(4) && IN(ph)) ph_c(args, wv, l, lds);
        SEAM(ph); ++ph; TP_MARK(4);
        if (EN(5) && IN(ph)) { size_t z = 0; LAUNDER_S(z); unsigned char* ws = args.ws + z; ph_res(args, wv, (const bf16*)(ws + WS_ACT0 + A_MERGED), (const bf16*)(ws + WS_SLOT0 + (size_t)(l & 1) * SL_BYTES + SL_WO), D, PROBE == 10 ? 1 : (PROBE == 22 ? 2 : (PROBE == 31 ? 3 : (PROBE == 32 ? 4 : 0))), l, ph, false, lds); }
        SEAM(ph); ++ph; TP_MARK(5);
        if (EN(6) && IN(ph)) ph_e(args, wv, l, ph, lds);
        SEAM(ph); ++ph; TP_MARK(6);
        if (EN(8) && IN(ph)) { size_t z = 0; LAUNDER_S(z); unsigned char* ws = args.ws + z; ph_res(args, wv, (const bf16*)(ws + WS_ACT0 + A_ACT), (const bf16*)(ws + WS_SLOT0 + (size_t)(l & 1) * SL_BYTES + SL_WDN), DFF, PROBE == 11 ? 1 : (PROBE == 23 ? 2 : 0), l, ph, true, lds); }
        SEAM(ph); ++ph; TP_MARK(7);
    }
    if (EN(9) && IN(ph)) ph_fin(args, wv);
#ifdef TSUB
    if (blockIdx.x == 7 && threadIdx.x == 0) { const unsigned long long tt = *TS_SLOT; const unsigned long long t0 = __builtin_amdgcn_s_memrealtime(); while (__builtin_amdgcn_s_memrealtime() - t0 < 10ull * tt) __builtin_amdgcn_s_sleep(8); }
#endif
#ifdef TPROBE
    TP_MARK(8);
    if (blockIdx.x == 0 && wv == 0) { const unsigned long long t0 = __builtin_amdgcn_s_memrealtime(); while (__builtin_amdgcn_s_memrealtime() - t0 < 10ull * tp_acc) __builtin_amdgcn_s_sleep(8); }
#endif
#undef IN
#undef SEAM
}

extern "C" void kernel_launch(void* const* d_in, const int* in_sizes, int n_in, void* d_out, int out_size, void* d_ws, size_t ws_size, hipStream_t stream) {
    static int grid = 0;
    if (grid == 0) {
        if (n_in != 21 || out_size != M * D || ws_size < WS_END + (PROBE ? 64 * MiB : 0)) { fprintf(stderr, "kernel_launch: unexpected shapes / workspace (%zu < %zu)\n", ws_size, (size_t)WS_END); grid = -1; return; }
        int dev = 0, cus = 0, per_cu = 0;
        if (hipGetDevice(&dev) != hipSuccess || hipDeviceGetAttribute(&cus, hipDeviceAttributeMultiprocessorCount, dev) != hipSuccess) { grid = -1; return; }
        if (hipFuncSetAttribute((const void*)mk_fwd, hipFuncAttributeMaxDynamicSharedMemorySize, LDS_BYTES) != hipSuccess) { fprintf(stderr, "kernel_launch: hipFuncSetAttribute failed\n"); grid = -1; return; }
        if (hipOccupancyMaxActiveBlocksPerMultiprocessor(&per_cu, (const void*)mk_fwd, NTHREADS, LDS_BYTES) != hipSuccess || per_cu < 1) { fprintf(stderr, "kernel_launch: occupancy query says %d\n", per_cu); per_cu = 1; }
        (void)hipGetLastError();
        grid = cus * 1;
    }
    if (grid < 0) return;
#if MK_ONE_LAUNCH
    if (hipMemsetAsync((char*)d_ws + WS_CTL, 0, 65536, stream) != hipSuccess) { fprintf(stderr, "kernel_launch: memset failed\n"); return; }
#endif
    Args a{};
    for (int i = 0; i < 21; ++i) a.in.p[i] = (const float*)d_in[i];
    a.out = (float*)d_out; a.ws = (unsigned char*)d_ws;
#if MK_ONE_LAUNCH
    a.ph_lo = 0; a.ph_hi = NPHASE;
    void* kargs[] = {&a};
    hipError_t e = hipLaunchCooperativeKernel((const void*)mk_fwd, dim3(grid), dim3(NTHREADS), kargs, LDS_BYTES, stream);
    if (e != hipSuccess) fprintf(stderr, "kernel_launch: cooperative launch failed: %s (grid %d)\n", hipGetErrorString(e), grid);
#else
    for (int p = 0; p < NPHASE; ++p) { a.ph_lo = p; a.ph_hi = p + 1; hipLaunchKernelGGL(mk_fwd, dim3(grid), dim3(NTHREADS), LDS_BYTES, stream, a); }
#endif
}
```

```cpp
#include <hip/hip_runtime.h>
#include <hip/hip_cooperative_groups.h>
#include <cstdio>
#include <cstdint>
#include <cmath>
namespace cg = cooperative_groups;

#ifndef MK_ONE_LAUNCH
#define MK_ONE_LAUNCH 1
#endif

namespace cfg {
constexpr int D = 1024, BATCH = 8, SEQ = 2048, DEPTH = 4, M = BATCH * SEQ;
constexpr int GH = 4, GDK = 64, GDV = 128, GKEY = 256, GVAL = 512, GRANK = 16;
constexpr int SGW = 512, SGC = 128, CW = 512, DFF = 2816, DFF2 = 5632;
constexpr int INC = 7184, NIN = 7424;
constexpr int O_Q = 0, O_K = 256, O_V = 512, O_G = 1024, O_A = 1536, O_SU = 1552, O_SV = 2064, O_CB = 2576, O_CC = 3088, O_CX = 3600, O_GT = 4112;
constexpr float EPS = 1e-6f;
}
using namespace cfg;

namespace pg8 {
#define PG8_LAS __attribute__((address_space(3)))
typedef unsigned short bf16_t;
typedef short bf16x8 __attribute__((ext_vector_type(8)));
typedef float f32x4 __attribute__((ext_vector_type(4)));
typedef unsigned u32x4 __attribute__((ext_vector_type(4)));
constexpr int BM = 256, BK = 64, HALF = 128, HTB = HALF * BK * 2  , STAGE_BYTES = 8 * HTB, NXCD = 8, WGM = 8;

__host__ __device__ __forceinline__ int lds_byte(int r, int c) { const int st = (r >> 4) * 2 + (c >> 5), rr = r & 15, cc = c & 31, ob = rr * 64 + cc * 2; return st * 1024 + (ob ^ (((ob >> 9) & 1) << 5)); }
__host__ __device__ __forceinline__ void stage_rc(int b, int& R, int& C) { const int st = b / 1024, sb = b % 1024, swz = sb ^ (((sb >> 9) & 1) << 5); R = (st >> 1) * 16 + swz / 64; C = (st & 1) * 32 + (swz % 64) / 2; }
__host__ __device__ __forceinline__ int perm32(int rho) { const int n = rho >> 4, i = rho & 15; return 8 * (i >> 2) + 4 * n + (i & 3); }

struct Unit { int pm, pn; };
struct Gemm { const bf16_t* A; const bf16_t* Bt; int M, N, K; };

struct StaticOrder {
    int nM, nN, nwg, G, c;
    __host__ __device__ void init(int M, int N, int G_, int c_) { nM = M / BM; nN = N / BM; nwg = nM * nN; G = G_; c = c_; }
    __host__ __device__ bool next(int i, Unit& u) const {
        const long L = (long)i * G + c; if (L >= nwg) return false;
        int wgid = (int)L; { const int q = nwg / NXCD, r = nwg % NXCD, xcd = wgid % NXCD, off = wgid / NXCD; wgid = (xcd < r ? xcd * (q + 1) : r * (q + 1) + (xcd - r) * q) + off; }
        const int nig = WGM * nN, gid = wgid / nig, fm = gid * WGM, gsz = (nM - fm) < WGM ? (nM - fm) : WGM;
        u.pm = fm + ((wgid % nig) % gsz); u.pn = (wgid % nig) / gsz; return true;
    }
    __device__ __forceinline__ void a_ready(const Unit&) const {}
    __device__ __forceinline__ void done(const Unit&) const {}
};

__device__ __forceinline__ unsigned cvt_pk_bf16(float lo, float hi) { unsigned r; asm volatile("v_cvt_pk_bf16_f32 %0, %1, %2" : "=v"(r) : "v"(lo), "v"(hi)); return r; }
typedef float f32x2 __attribute__((ext_vector_type(2)));
#ifdef TSUB
#define PG8_TS_BEGIN(k) unsigned long long ts_b_ = 0; if ((k) == TSUB) ts_b_ = __builtin_amdgcn_s_memrealtime()
#define PG8_TS_END(k) do { if ((k) == TSUB && blockIdx.x == 7 && tid == 0) *(PG8_LAS unsigned long long*)(lds + 131072 + 640) += __builtin_amdgcn_s_memrealtime() - ts_b_; } while (0)
#else
#define PG8_TS_BEGIN(k) do { } while (0)
#define PG8_TS_END(k) do { } while (0)
#endif
template <class Epi, class Sched, bool ALIGN_EPI = false, bool SP2 = false>
__device__ __forceinline__ void gemm_phase(PG8_LAS unsigned char* lds, const Gemm g, const Sched& S, const Epi& E, const int wave_id) {
    int ln__; asm volatile("v_mbcnt_lo_u32_b32 %0, -1, 0\n\tv_mbcnt_hi_u32_b32 %0, -1, %0" : "=v"(ln__));
    const int tid_ = ln__ + 64 * wave_id;
    const int tid = tid_, wid = __builtin_amdgcn_readfirstlane(tid >> 6), lane = tid & 63, wr = wid >> 2, wc = wid & 3, fr = lane & 15, fq = lane >> 4;
    const int K = g.K, nt = K / BK;
    unsigned voffA[2], voffB[2];
#pragma unroll
    for (int i = 0; i < 2; ++i) { int R, C; stage_rc(tid * 16 + i * 8192, R, C); const int Rb = Epi::PERM ? ((R & ~31) + perm32(R & 31)) : R;
        voffA[i] = (unsigned)(R * K + C) * 2u; voffB[i] = (unsigned)(Rb * K + C) * 2u; }
    const size_t kstep = (size_t)(BK * 2);
    const size_t hstep = (size_t)HALF * K * 2;
    const size_t tstep = 2 * hstep;
    const unsigned ldsw = (unsigned)wid * 1024u;
    const int aoff = lds_byte(wr * 64 + fr, fq * 8), boff = lds_byte(wc * 32 + fr, fq * 8);
#define PG8_SA(b, h) (((b) * 2 + (h)) * HTB)
#define PG8_SB(b, h) ((4 + (b) * 2 + (h)) * HTB)
#define PG8_STAGE(bufoff, gbase, voff) do { _Pragma("unroll") for (int _i = 0; _i < 2; ++_i) \
        __builtin_amdgcn_global_load_lds((const unsigned*)((const char*)(gbase) + (voff)[_i]), (PG8_LAS unsigned*)(lds + (bufoff) + ldsw + _i * 8192), 16, 0, 0); } while (0)
#define PG8_LDA(dst, b, h) do { _Pragma("unroll") for (int m = 0; m < 4; ++m) _Pragma("unroll") for (int k = 0; k < 2; ++k) dst[m][k] = *(const PG8_LAS bf16x8*)(lds + PG8_SA(b, h) + aoff + m * 2048 + k * 1024); } while (0)
#define PG8_LDB(dst, b, h) do { _Pragma("unroll") for (int n = 0; n < 2; ++n) _Pragma("unroll") for (int k = 0; k < 2; ++k) dst[n][k] = *(const PG8_LAS bf16x8*)(lds + PG8_SB(b, h) + boff + n * 2048 + k * 1024); } while (0)
#define PG8_MMA(ai, bj, At, Bt) do { __builtin_amdgcn_s_setprio(1); _Pragma("unroll") for (int m = 0; m < 4; ++m) _Pragma("unroll") for (int n = 0; n < 2; ++n) _Pragma("unroll") for (int k = 0; k < 2; ++k) \
        acc[ai][bj][m][n] = __builtin_amdgcn_mfma_f32_16x16x32_bf16(Bt[n][k], At[m][k], acc[ai][bj][m][n], 0, 0, 0); __builtin_amdgcn_s_setprio(0); } while (0)
#define PG8_WAIT_V(n) asm volatile("s_waitcnt vmcnt(" #n ")" ::: "memory")
#define PG8_WAIT_L(n) asm volatile("s_waitcnt lgkmcnt(" #n ")" ::: "memory")
#define PG8_BAR __builtin_amdgcn_s_barrier()
#define PG8_SCHED __builtin_amdgcn_sched_barrier(0)
    Unit cur, nxt; int ui = 0;
    if (!S.next(0, cur)) return;
    f32x4 acc[2][2][4][2];
#pragma unroll
    for (int a = 0; a < 2; ++a)
#pragma unroll
        for (int b = 0; b < 2; ++b)
#pragma unroll
            for (int m = 0; m < 4; ++m)
#pragma unroll
                for (int n = 0; n < 2; ++n) acc[a][b][m][n] = (f32x4){0.f, 0.f, 0.f, 0.f};
    bf16x8 At[4][2], B0[2][2], B1[2][2];
    const char* cA = (const char*)g.A + (size_t)cur.pm * tstep; const char* cB = (const char*)g.Bt + (size_t)cur.pn * tstep;
    S.a_ready(cur);
    if constexpr (SP2) {
        PG8_STAGE(PG8_SB(0, 0), cB, voffB); PG8_STAGE(PG8_SB(0, 1), cB + hstep, voffB); PG8_STAGE(PG8_SA(0, 0), cA, voffA); PG8_STAGE(PG8_SA(0, 1), cA + hstep, voffA);
        if (wr == 1) PG8_BAR;
        PG8_WAIT_V(2); PG8_BAR;
        PG8_STAGE(PG8_SB(1, 0), cB + kstep, voffB); PG8_STAGE(PG8_SA(1, 0), cA + kstep, voffA); PG8_STAGE(PG8_SB(1, 1), cB + hstep + kstep, voffB);
        PG8_WAIT_V(6); PG8_BAR;
    } else {
        PG8_STAGE(PG8_SB(0, 0), cB, voffB); PG8_STAGE(PG8_SA(0, 0), cA, voffA); PG8_STAGE(PG8_SB(0, 1), cB + hstep, voffB); PG8_STAGE(PG8_SA(0, 1), cA + hstep, voffA);
        if (wr == 1) PG8_BAR;
        PG8_WAIT_V(4); PG8_BAR;
        PG8_STAGE(PG8_SB(1, 0), cB + kstep, voffB); PG8_STAGE(PG8_SA(1, 0), cA + kstep, voffA); PG8_STAGE(PG8_SB(1, 1), cB + hstep + kstep, voffB);
        PG8_WAIT_V(6); PG8_BAR;
    }
    for (;;) {
        const bool has_next = S.next(ui + 1, nxt);
        const char* nA = has_next ? (const char*)g.A + (size_t)nxt.pm * tstep : cA; const char* nB = has_next ? (const char*)g.Bt + (size_t)nxt.pn * tstep : cB;
        for (int t = 0; t < nt; t += 2) {
            const bool last = (t == nt - 2);
            const char* a1 = cA + (size_t)(t + 1) * kstep;
            const char* a2 = last ? nA : cA + (size_t)(t + 2) * kstep; const char* b2 = last ? nB : cB + (size_t)(t + 2) * kstep;
            const char* a3 = a2 + kstep; const char* b3 = b2 + kstep;
            if (last && has_next) S.a_ready(nxt);
            if constexpr (SP2) {
            PG8_LDB(B0, 0, 0); PG8_LDB(B1, 0, 1); PG8_SCHED; PG8_LDA(At, 0, 0); PG8_STAGE(PG8_SA(1, 1), a1 + hstep, voffA);
            PG8_WAIT_V(8); PG8_WAIT_L(0); PG8_BAR; PG8_MMA(0, 0, At, B0); PG8_MMA(0, 1, At, B1); PG8_BAR; PG8_SCHED;
            PG8_LDA(At, 0, 1); PG8_STAGE(PG8_SB(0, 0), b2, voffB); PG8_STAGE(PG8_SB(0, 1), b2 + hstep, voffB); PG8_STAGE(PG8_SA(0, 0), a2, voffA);
            PG8_WAIT_V(8); PG8_WAIT_L(0); PG8_BAR; PG8_MMA(1, 0, At, B0); PG8_MMA(1, 1, At, B1); PG8_BAR; PG8_SCHED;
            PG8_LDB(B0, 1, 0); PG8_LDB(B1, 1, 1); PG8_SCHED; PG8_LDA(At, 1, 0); PG8_STAGE(PG8_SA(0, 1), a2 + hstep, voffA);
            PG8_WAIT_V(8); PG8_WAIT_L(0); PG8_BAR; PG8_MMA(0, 0, At, B0); PG8_MMA(0, 1, At, B1); PG8_BAR; PG8_SCHED;
            PG8_LDA(At, 1, 1); PG8_STAGE(PG8_SB(1, 0), b3, voffB); PG8_STAGE(PG8_SB(1, 1), b3 + hstep, voffB); PG8_STAGE(PG8_SA(1, 0), a3, voffA);
            PG8_WAIT_V(8); PG8_WAIT_L(0); PG8_BAR; PG8_MMA(1, 0, At, B0); PG8_MMA(1, 1, At, B1); PG8_BAR; PG8_SCHED;
            } else {
            PG8_LDB(B0, 0, 0); PG8_SCHED; PG8_LDA(At, 0, 0); PG8_STAGE(PG8_SA(1, 1), a1 + hstep, voffA);
            PG8_WAIT_L(8); PG8_BAR; PG8_WAIT_L(0); PG8_MMA(0, 0, At, B0); PG8_BAR; PG8_SCHED;
            PG8_LDB(B1, 0, 1); PG8_STAGE(PG8_SB(0, 0), b2, voffB);
            PG8_BAR; PG8_WAIT_L(0); PG8_MMA(0, 1, At, B1); PG8_BAR;
            PG8_LDA(At, 0, 1); PG8_STAGE(PG8_SA(0, 0), a2, voffA);
            PG8_BAR; PG8_WAIT_L(0); PG8_MMA(1, 0, At, B0); PG8_BAR; PG8_SCHED;
            PG8_STAGE(PG8_SB(0, 1), b2 + hstep, voffB);
            PG8_WAIT_V(6); PG8_BAR; PG8_MMA(1, 1, At, B1); PG8_BAR;
            PG8_LDB(B0, 1, 0); PG8_SCHED; PG8_LDA(At, 1, 0); PG8_STAGE(PG8_SA(0, 1), a2 + hstep, voffA);
            PG8_WAIT_L(8); PG8_BAR; PG8_WAIT_L(0); PG8_MMA(0, 0, At, B0); PG8_BAR; PG8_SCHED;
            PG8_LDB(B1, 1, 1); PG8_STAGE(PG8_SB(1, 0), b3, voffB);
            PG8_BAR; PG8_WAIT_L(0); PG8_MMA(0, 1, At, B1); PG8_BAR;
            PG8_LDA(At, 1, 1); PG8_STAGE(PG8_SA(1, 0), a3, voffA);
            PG8_BAR; PG8_WAIT_L(0); PG8_MMA(1, 0, At, B0); PG8_BAR; PG8_SCHED;
            PG8_STAGE(PG8_SB(1, 1), b3 + hstep, voffB);
            PG8_WAIT_V(6); PG8_BAR; PG8_MMA(1, 1, At, B1); PG8_BAR;
            }
        }
        if constexpr (ALIGN_EPI) { if (wr == 0) PG8_BAR; }
        if constexpr (!Epi::AFTER_DRAIN) { PG8_TS_BEGIN(Epi::TSID); E(acc, cur, wr, wc, fr, fq); PG8_TS_END(Epi::TSID); S.done(cur); }
        if (!has_next) break;
#pragma unroll
        for (int a = 0; a < 2; ++a)
#pragma unroll
            for (int b = 0; b < 2; ++b)
#pragma unroll
                for (int m = 0; m < 4; ++m)
#pragma unroll
                    for (int n = 0; n < 2; ++n) acc[a][b][m][n] = (f32x4){0.f, 0.f, 0.f, 0.f};
        cur = nxt; cA = nA; cB = nB; ++ui;
        if constexpr (ALIGN_EPI) { if (wr == 1) PG8_BAR; }
    }
    PG8_WAIT_V(0);
    if constexpr (!ALIGN_EPI) { if (wr == 0) PG8_BAR; }
    PG8_BAR;
    if constexpr (Epi::AFTER_DRAIN) { E.fused(acc, cur, wr, wc, fr, fq, lds, wid, lane); S.done(cur); }
#undef PG8_SA
#undef PG8_SB
#undef PG8_STAGE
#undef PG8_LDA
#undef PG8_LDB
#undef PG8_MMA
#undef PG8_WAIT_V
#undef PG8_WAIT_L
#undef PG8_BAR
#undef PG8_SCHED
}
}

#define GAS __attribute__((address_space(1)))
#define LAS __attribute__((address_space(3)))
typedef unsigned short bf16;
typedef unsigned v4u __attribute__((ext_vector_type(4)));
typedef unsigned v2u __attribute__((ext_vector_type(2)));
typedef float f32x4 __attribute__((ext_vector_type(4)));
typedef float f32x2 __attribute__((ext_vector_type(2)));
typedef short bf16x8 __attribute__((ext_vector_type(8)));
constexpr int NWAVES = 8, NTHREADS = 512;
constexpr int RING_BYTES = 131072, LDS_BYTES = 153600;
constexpr int RST_OFF = RING_BYTES + 10240;

constexpr size_t MiB = 1u << 20;
constexpr size_t SL_WIN = 0, SL_WBR = SL_WIN + (size_t)NIN * D * 2, SL_WO = SL_WBR + (size_t)3 * D * 512 * 2, SL_WUP = SL_WO + (size_t)D * D * 2,
                 SL_WDN = SL_WUP + (size_t)DFF2 * D * 2, SL_SGW = SL_WDN + (size_t)D * DFF * 2, SL_END = SL_SGW + (size_t)4 * 128 * 128 * 2, SL_BYTES = 38 * MiB;
static_assert(SL_END <= SL_BYTES, "weight slot");
constexpr size_t WS_CTL = 0, WS_SLOT0 = 1 * MiB, WS_XB = WS_SLOT0 + 2 * SL_BYTES, WS_SSQ = WS_XB + 32 * MiB, WS_SVST = WS_SSQ + 1 * MiB, WS_ACT0 = WS_SVST + 1 * MiB;
constexpr size_t A_Q = 0, A_K = 8 * MiB, A_V = 16 * MiB, A_Z = 32 * MiB, A_SV = 80 * MiB, A_CC = 96 * MiB, A_CX = 112 * MiB, A_LOGA = 128 * MiB, A_G = 144 * MiB,
                 A_CST = 240 * MiB, A_DEC = 272 * MiB, A_END = 273 * MiB;
constexpr size_t A_MERGED = A_Q, A_HUP = 0, A_ACT = 176 * MiB, A_HT = 64 * MiB;
static_assert(A_ACT + (size_t)M * DFF * 2 <= A_END, "overlay");
constexpr size_t WS_END = WS_ACT0 + A_END;
constexpr int CW_BAR = 1024, CW_QHEAD = 6144, CW_FIN = 8192;

__device__ __forceinline__ float bf2f(unsigned h) { return __uint_as_float(h << 16); }
__device__ __forceinline__ unsigned pk2(float lo, float hi) { return pg8::cvt_pk_bf16(lo, hi); }
__device__ __forceinline__ float fsigmoid(float z) { return __builtin_amdgcn_rcpf(1.f + __expf(-z)); }
__device__ __forceinline__ float fsilu(float z) { return z * fsigmoid(z); }
__device__ __forceinline__ float fgelu(float z) { return z * fsigmoid(1.5957691216057308f * (z + 0.044715f * z * z * z)); }
__device__ __forceinline__ float flogsig(float z) { return fminf(z, 0.f) - __logf(1.f + __expf(-fabsf(z))); }
__device__ __forceinline__ float wave_sum(float v) {
#pragma unroll
    for (int o = 1; o < 64; o <<= 1) v += __shfl_xor(v, o);
    return v;
}
#define LDS_WAIT() asm volatile("s_waitcnt lgkmcnt(0)" ::: "memory")
#define LDS_BARRIER() do { asm volatile("s_waitcnt lgkmcnt(0)" ::: "memory"); __builtin_amdgcn_s_barrier(); asm volatile("" ::: "memory"); } while (0)
__device__ __forceinline__ f32x4 mfma16(bf16x8 a, bf16x8 b, f32x4 c) { return __builtin_amdgcn_mfma_f32_16x16x32_bf16(a, b, c, 0, 0, 0); }

__device__ __forceinline__ void tr_write(bf16* WT, int K, int k0, LAS float* scr, int lane) {
    LDS_WAIT(); asm volatile("" ::: "memory");
    const int c = lane & 7;
#pragma unroll
    for (int j = 0; j < 4; ++j) { const int n = (lane >> 3) + 8 * j; const LAS float* s = scr + (8 * c) * 33 + n;
        v4u o; o.x = pk2(s[0 * 33], s[1 * 33]); o.y = pk2(s[2 * 33], s[3 * 33]); o.z = pk2(s[4 * 33], s[5 * 33]); o.w = pk2(s[6 * 33], s[7 * 33]);
        *(GAS v4u*)(WT + (size_t)n * K + k0 + 8 * c) = o; }
    LDS_WAIT(); asm volatile("" ::: "memory");
}
__device__ __forceinline__ void tr_item(const float* W, int ldw, int col0, const float* ksc, float sc, bf16* WT, int K, int k0, LAS float* scr, int lane) {
    float v[32]; const float* src = W + (size_t)(k0 + (lane >> 5)) * ldw + col0 + (lane & 31);
#pragma unroll
    for (int i = 0; i < 32; ++i) v[i] = src[(size_t)(2 * i) * ldw];
    if (ksc) {
#pragma unroll
        for (int i = 0; i < 32; ++i) v[i] *= ksc[k0 + 2 * i + (lane >> 5)]; }
#pragma unroll
    for (int i = 0; i < 32; ++i) scr[(2 * i + (lane >> 5)) * 33 + (lane & 31)] = v[i] * sc;
    tr_write(WT, K, k0, scr, lane);
}
__device__ __forceinline__ void alpha_item(const float* win, const float* wal, const float* g, bf16* WT, int k0, int j0, LAS float* scr, int lane) {
    const int jj = lane & 31, half = lane >> 5; float wa[16];
#pragma unroll
    for (int r = 0; r < 16; ++r) wa[r] = wal[r * GKEY + j0 + jj];
    for (int i = 0; i < 32; ++i) { const int kk = 2 * i + half, k = k0 + kk; const float* wr = win + (size_t)k * INC + O_A; float s = 0.f;
#pragma unroll
        for (int r = 0; r < 16; ++r) s += wr[r] * wa[r];
        scr[kk * 33 + jj] = s * g[k]; }
    tr_write(WT + (size_t)j0 * D, D, k0, scr, lane);
}
struct Inputs { const float* p[21]; };
constexpr int CV_J0 = 16 * 224, CV_J1 = 16 * 8, CV_J2 = 3 * 8 * 32, CV_J3 = 16 * 32, CV_J4 = 16 * 176, CV_J5 = 44 * 32, CV_J6 = 128, CV_ITEMS = CV_J0 + CV_J1 + CV_J2 + CV_J3 + CV_J4 + CV_J5 + CV_J6;
constexpr int CV_WIN_ITEMS = CV_J0 + CV_J1;
__device__ __forceinline__ void convert_item(const Inputs& I, int l, unsigned char* slot, LAS float* scr, int it, int lane) {
    bf16* WIN = (bf16*)(slot + SL_WIN); bf16* WBR = (bf16*)(slot + SL_WBR); bf16* WO = (bf16*)(slot + SL_WO); bf16* WUP = (bf16*)(slot + SL_WUP); bf16* WDN = (bf16*)(slot + SL_WDN); bf16* SGWS = (bf16*)(slot + SL_SGW);
    const float* win = I.p[2] + (size_t)l * D * INC;
        int r = it;
        if (r < CV_J0) { const int kb = r / 224, nb = r % 224; const int drow = nb < 48 ? 32 * nb : 1792 + 32 * (nb - 48), scol = nb < 48 ? 32 * nb : O_SU + 32 * (nb - 48);
            tr_item(win, INC, scol, I.p[1] + (size_t)l * D, drow < 256 ? 0.125f : 1.f, WIN + (size_t)drow * D, D, 64 * kb, scr, lane); return; }
        r -= CV_J0;
        if (r < CV_J1) { const int kb = r / 8, jb = r % 8; alpha_item(win, I.p[3] + (size_t)l * GRANK * GKEY, I.p[1] + (size_t)l * D, WIN + (size_t)1536 * D, 64 * kb, 32 * jb, scr, lane); return; }
        r -= CV_J1;
        if (r < CV_J2) { const int br = r / 256, rr = r % 256, kb = rr / 32, nb = rr % 32;
            const float* W = (br == 0 ? I.p[6] : br == 1 ? I.p[11] : I.p[13]) + (size_t)l * 512 * D;
            tr_item(W, D, 32 * nb, br == 0 ? I.p[5] + (size_t)l * GVAL : nullptr, 1.f, WBR + ((size_t)br * D + 32 * nb) * 512, 512, 64 * kb, scr, lane); return; }
        r -= CV_J2;
        if (r < CV_J3) { const int kb = r / 32, nb = r % 32; tr_item(I.p[14] + (size_t)l * D * D, D, 32 * nb, nullptr, 1.f, WO + (size_t)32 * nb * D, D, 64 * kb, scr, lane); return; }
        r -= CV_J3;
        if (r < CV_J4) { const int kb = r / 176, nb = r % 176, pn = nb / 8, jb = nb % 8; const int scol = jb < 4 ? 128 * pn + 32 * jb : DFF + 128 * pn + 32 * (jb - 4);
            tr_item(I.p[16] + (size_t)l * D * DFF2, DFF2, scol, I.p[15] + (size_t)l * D, 1.f, WUP + (size_t)32 * nb * D, D, 64 * kb, scr, lane); return; }
        r -= CV_J4;
        if (r < CV_J5) { const int kb = r / 32, nb = r % 32; tr_item(I.p[19] + (size_t)l * DFF * D, D, 32 * nb, nullptr, 1.f, WDN + (size_t)32 * nb * DFF, DFF, 64 * kb, scr, lane); return; }
        r -= CV_J5;
        { const int e0 = r * 512 + lane * 8, t = (e0 >> 7) & 127, s0 = e0 & 127; const float* src = I.p[9] + (size_t)l * 4 * 128 * 128 + e0;
          const f32x4 a = *(const f32x4*)src, b = *(const f32x4*)(src + 4); float v[8] = {a[0], a[1], a[2], a[3], b[0], b[1], b[2], b[3]};
#pragma unroll
          for (int e = 0; e < 8; ++e) if (s0 + e > t) v[e] = 0.f;
          v4u o; o.x = pk2(v[0], v[1]); o.y = pk2(v[2], v[3]); o.z = pk2(v[4], v[5]); o.w = pk2(v[6], v[7]); *(GAS v4u*)(SGWS + e0) = o; }
}
__device__ __forceinline__ void convert_static(const Inputs& I, int l, unsigned char* slot, LAS unsigned char* lds, int it_lo, int it_hi, int gw, int ngw, int wave, int lane) {
    LAS float* scr = (LAS float*)(lds + wave * 8448);
    for (int it = it_lo + gw; it < it_hi; it += ngw) convert_item(I, l, slot, scr, it, lane);
}
#define RLX_AGENT __ATOMIC_RELAXED, __HIP_MEMORY_SCOPE_AGENT
__device__ __forceinline__ void convert_queue(const Inputs& I, int l, unsigned char* slot, LAS unsigned char* lds, unsigned* head, int it_lo, int it_hi, unsigned* fin, int G, int tid, int wave, int lane) {
    LAS float* scr = (LAS float*)(lds + wave * 8448); volatile LAS unsigned* bc = (volatile LAS unsigned*)(lds + 8 * 8448);
    for (;;) {
        if (tid == 0) { unsigned v = 0xffffffffu; if (!fin || __hip_atomic_load(fin, RLX_AGENT) < (unsigned)G) v = __hip_atomic_fetch_add(head, 8u, RLX_AGENT); bc[0] = v; }
        LDS_BARRIER();
        const unsigned base = bc[0];
        LDS_BARRIER();
        if (base >= (unsigned)(it_hi - it_lo)) break;
        const int it = it_lo + (int)base + wave; if (it < it_hi) convert_item(I, l, slot, scr, it, lane);
    }
}
__device__ __forceinline__ void x_prep(const float* xin, bf16* xb, float* ssq, int gw, int ngw, int lane) {
    for (int row = gw; row < M; row += ngw) {
        const GAS f32x4* xr = (const GAS f32x4*)(xin + (size_t)row * D) + lane; f32x4 v[4]; float s = 0.f;
#pragma unroll
        for (int j = 0; j < 4; ++j) { v[j] = xr[64 * j]; s += (v[j][0] * v[j][0] + v[j][1] * v[j][1]) + (v[j][2] * v[j][2] + v[j][3] * v[j][3]); }
        s = wave_sum(s);
#pragma unroll
        for (int j = 0; j < 4; ++j) { v2u w; w.x = pk2(v[j][0], v[j][1]); w.y = pk2(v[j][2], v[j][3]); ((GAS v2u*)(xb + (size_t)row * D))[lane + 64 * j] = w; }
        if (lane < 16) ssq[(size_t)row * 16 + lane] = lane == 0 ? s : 0.f;
    }
}
__device__ __forceinline__ void final_norm(const bf16* xb, float* out, const float* ssq, const float* g, int gw, int ngw, int lane) {
    for (int row = gw; row < M; row += ngw) {
        const float pv = lane < 16 ? ssq[(size_t)row * 16 + lane] : 0.f; const float rs = rsqrtf(wave_sum(pv) * (1.f / D) + EPS);
        const GAS v2u* xr = (const GAS v2u*)(xb + (size_t)row * D) + lane; GAS f32x4* orow = (GAS f32x4*)(out + (size_t)row * D) + lane;
#pragma unroll
        for (int j = 0; j < 4; ++j) { const v2u w = xr[64 * j]; const f32x4 gv = ((const GAS f32x4*)g)[lane + 64 * j];
            orow[64 * j] = (f32x4){bf2f(w.x & 0xffffu) * rs * gv[0], bf2f(w.x >> 16) * rs * gv[1], bf2f(w.y & 0xffffu) * rs * gv[2], bf2f(w.y >> 16) * rs * gv[3]}; }
    }
}

constexpr int GP = 72;
constexpr int L_QT = 0, L_KT = 9216, L_KENDT = 18432, L_VT = 27648, L_ST = 46080, L_SEG = 64512, L_DECS = 66560, L_RED = 66816, L_GLA_END = 67328;
constexpr int VP = 136;

__device__ __forceinline__ void sgu_item(int item, LAS unsigned char* lds, const bf16* ZBI, bf16* ZBO, const bf16* SV, const float* SVST, const float* lng, const float* lnb, const bf16* wsb, const float* bs, int wave, int lane) {
    const int b_ = item & 7, h = (item >> 3) & 3, r0 = b_ * SEQ + (item >> 5) * 128; LAS bf16* vnT = (LAS bf16*)lds;
    const int fr = lane & 15, fq = lane >> 4, t = 16 * wave + fr, nks = (wave >> 1) + 1; const size_t orow = (size_t)r0 + t;
    bf16x8 bfr[4];
#pragma unroll
    for (int ks = 0; ks < 4; ++ks) bfr[ks] = (ks < nks) ? *(const bf16x8*)(wsb + ((size_t)h * 128 + t) * 128 + 32 * ks + 8 * fq) : (bf16x8){0, 0, 0, 0, 0, 0, 0, 0};
    v2u suv[8];
#pragma unroll
    for (int m = 0; m < 8; ++m) suv[m] = *(const v2u*)(ZBI + orow * 512 + h * 128 + 16 * m + 4 * fq);
    const float bias = bs[h * 128 + t];
    { const int d0 = 16 * wave, s0 = 2 * lane; float mean[2], rstd[2]; v4u xv[2][2];
#pragma unroll
      for (int rr = 0; rr < 2; ++rr) { const size_t row = (size_t)r0 + s0 + rr; const f32x4* p = (const f32x4*)(SVST + row * 16); const f32x4 a = p[0], b = p[1], c = p[2], d = p[3];
          const v4u* q = (const v4u*)(SV + row * 512 + h * 128 + d0); xv[rr][0] = q[0]; xv[rr][1] = q[1];
          const float sm = (a[0] + a[2]) + (b[0] + b[2]) + (c[0] + c[2]) + (d[0] + d[2]), sq = (a[1] + a[3]) + (b[1] + b[3]) + (c[1] + c[3]) + (d[1] + d[3]);
          mean[rr] = sm * (1.f / 512.f); rstd[rr] = rsqrtf(fmaxf(sq * (1.f / 512.f) - mean[rr] * mean[rr], 0.f) + EPS); }
      f32x4 gv[4], bv[4];
#pragma unroll
      for (int q4 = 0; q4 < 4; ++q4) { gv[q4] = *(const f32x4*)(lng + h * 128 + d0 + 4 * q4); bv[q4] = *(const f32x4*)(lnb + h * 128 + d0 + 4 * q4); }
#pragma unroll
      for (int j = 0; j < 16; ++j) { const float g = gv[j >> 2][j & 3], b = bv[j >> 2][j & 3]; const unsigned w0 = xv[0][j >> 3][(j >> 1) & 3], w1 = xv[1][j >> 3][(j >> 1) & 3];
          const float x0 = (j & 1) ? bf2f(w0 >> 16) : bf2f(w0 & 0xffffu), x1 = (j & 1) ? bf2f(w1 >> 16) : bf2f(w1 & 0xffffu);
          *(LAS unsigned*)(vnT + (d0 + j) * VP + s0) = pk2((x0 - mean[0]) * rstd[0] * g + b, (x1 - mean[1]) * rstd[1] * g + b); } }
    LDS_BARRIER();
    { f32x4 acc[8];
#pragma unroll
      for (int m = 0; m < 8; ++m) { acc[m] = (f32x4){0.f, 0.f, 0.f, 0.f};
#pragma unroll
          for (int ks = 0; ks < 4; ++ks) if (ks < nks) { const bf16x8 a = *(const LAS bf16x8*)(vnT + (16 * m + fr) * VP + 32 * ks + 8 * fq); acc[m] = mfma16(a, bfr[ks], acc[m]); } }
#pragma unroll
      for (int m = 0; m < 8; ++m) { const v2u su = suv[m]; v2u o;
          o.x = pk2(bf2f(su.x & 0xffffu) * (acc[m][0] + bias), bf2f(su.x >> 16) * (acc[m][1] + bias)); o.y = pk2(bf2f(su.y & 0xffffu) * (acc[m][2] + bias), bf2f(su.y >> 16) * (acc[m][3] + bias));
          *(v2u*)(ZBO + orow * 512 + h * 128 + 16 * m + 4 * fq) = o; } }
    LDS_BARRIER();
}
__device__ __forceinline__ void convbr_item(int idx, const bf16* ZCI, bf16* ZCO, const bf16* CC, const bf16* CX, const float* cw) {
    const int c0 = (idx & 63) * 8, wg_ = idx >> 9, r0 = (wg_ & 7) * SEQ + (wg_ >> 3) * 64 + ((idx >> 6) & 7) * 8; float w[3][8];
#pragma unroll
    for (int k = 0; k < 3; ++k) { const f32x4 a = *(const f32x4*)(cw + k * CW + c0), b = *(const f32x4*)(cw + k * CW + c0 + 4);
#pragma unroll
        for (int e = 0; e < 4; ++e) { w[k][e] = a[e]; w[k][4 + e] = b[e]; } }
    float u2[8], u1[8];
    auto loadu = [&](int row, float (&u)[8]) { const v4u a = *(const v4u*)(CC + (size_t)row * CW + c0), b = *(const v4u*)(CX + (size_t)row * CW + c0);
#pragma unroll
        for (int e = 0; e < 4; ++e) { u[2 * e] = bf2f(a[e] & 0xffffu) * bf2f(b[e] & 0xffffu); u[2 * e + 1] = bf2f(a[e] >> 16) * bf2f(b[e] >> 16); } };
    if ((r0 & (SEQ - 1)) == 0) {
#pragma unroll
        for (int e = 0; e < 8; ++e) { u2[e] = 0.f; u1[e] = 0.f; } }
    else { loadu(r0 - 2, u2); loadu(r0 - 1, u1); }
#pragma unroll
    for (int i = 0; i < 8; ++i) { float u0[8]; loadu(r0 + i, u0); const size_t po = (size_t)(r0 + i) * CW + c0; bf16* p = ZCO + po; const v4u cb = *(const v4u*)(ZCI + po); float z[8];
#pragma unroll
        for (int e = 0; e < 8; ++e) { const float y = w[0][e] * u2[e] + w[1][e] * u1[e] + w[2][e] * u0[e]; const float c = (e & 1) ? bf2f(cb[e >> 1] >> 16) : bf2f(cb[e >> 1] & 0xffffu); z[e] = c * y; u2[e] = u1[e]; u1[e] = u0[e]; }
        v4u o; o.x = pk2(z[0], z[1]); o.y = pk2(z[2], z[3]); o.z = pk2(z[4], z[5]); o.w = pk2(z[6], z[7]); *(v4u*)p = o; }
}
#ifdef TSUB
#define TS_SLOT ((LAS unsigned long long*)(lds + RING_BYTES + 640))
#define TS_BEGIN(k) unsigned long long ts_b##k = 0; if ((k) == TSUB) ts_b##k = __builtin_amdgcn_s_memrealtime()
#define TS_END(k) do { if ((k) == TSUB && blockIdx.x == 7 && tid == 0) *TS_SLOT += __builtin_amdgcn_s_memrealtime() - ts_b##k; } while (0)
#else
#define TS_BEGIN(k) do { } while (0)
#define TS_END(k) do { } while (0)
#endif
__device__ __forceinline__ float wave_scan_incl(float x) {
#define DPP_ADD(ctrl, rmask) x += __builtin_bit_cast(float, __builtin_amdgcn_update_dpp(0, __builtin_bit_cast(int, x), ctrl, rmask, 0xf, true))
    DPP_ADD(0x111, 0xf); DPP_ADD(0x112, 0xf); DPP_ADD(0x114, 0xf); DPP_ADD(0x118, 0xf);
    x += __builtin_bit_cast(float, __builtin_amdgcn_update_dpp(0, __builtin_bit_cast(int, x), 0x142, 0xa, 0xf, false));
    x += __builtin_bit_cast(float, __builtin_amdgcn_update_dpp(0, __builtin_bit_cast(int, x), 0x143, 0xc, 0xf, false));
#undef DPP_ADD
    return x;
}
struct GlaPre { f32x4 la0, la1; v4u kq, qq, va, vb; };
template <bool FULL> __device__ __forceinline__ GlaPre gla_load(size_t r0, int h, const bf16* Q, const bf16* KK, const bf16* V, const float* LOGA, int tid, int wave, int lane) {
    GlaPre p; const size_t row = r0 + lane; const int kc0 = 8 * wave;
    p.la0 = *(const f32x4*)(LOGA + row * GKEY + h * 64 + kc0); p.la1 = *(const f32x4*)(LOGA + row * GKEY + h * 64 + kc0 + 4);
    p.kq = *(const v4u*)(KK + row * GKEY + h * 64 + kc0); if (FULL) p.qq = *(const v4u*)(Q + row * GKEY + h * 64 + kc0); else p.qq = (v4u){0u, 0u, 0u, 0u};
    const int tp = tid & 31, vg = tid >> 5;
    p.va = *(const v4u*)(V + (r0 + 2 * tp) * GVAL + h * 128 + 8 * vg); p.vb = *(const v4u*)(V + (r0 + 2 * tp + 1) * GVAL + h * 128 + 8 * vg);
    return p;
}
template <bool FULL> __device__ __forceinline__ void gla_build(const GlaPre& p, LAS unsigned char* lds, int tid, int wave, int lane, float (&tot)[8]) {
    const int kc0 = 8 * wave; float b[8] = {p.la0[0], p.la0[1], p.la0[2], p.la0[3], p.la1[0], p.la1[1], p.la1[2], p.la1[3]};
#pragma unroll
    for (int j = 0; j < 8; ++j) b[j] = wave_scan_incl(b[j]);
    float kf[8], qf[8];
#pragma unroll
    for (int e = 0; e < 4; ++e) { kf[2 * e] = bf2f(p.kq[e] & 0xffffu); kf[2 * e + 1] = bf2f(p.kq[e] >> 16); qf[2 * e] = bf2f(p.qq[e] & 0xffffu); qf[2 * e + 1] = bf2f(p.qq[e] >> 16); }
    LAS bf16* KE = (LAS bf16*)(lds + L_KENDT);
#pragma unroll
    for (int j = 0; j < 8; ++j) { tot[j] = __builtin_bit_cast(float, __builtin_amdgcn_readlane(__builtin_bit_cast(int, b[j]), 63)); KE[(kc0 + j) * GP + lane] = (bf16)(pk2(kf[j] * __expf(tot[j] - b[j]), 0.f) & 0xffffu); }
    if (FULL) { float qt[8], kt[8];
#pragma unroll
        for (int j = 0; j < 8; ++j) { qt[j] = qf[j] * __expf(b[j]); kt[j] = kf[j] * __expf(-b[j]); }
        v4u o; o.x = pk2(qt[0], qt[1]); o.y = pk2(qt[2], qt[3]); o.z = pk2(qt[4], qt[5]); o.w = pk2(qt[6], qt[7]); *(LAS v4u*)((LAS bf16*)(lds + L_QT) + lane * GP + kc0) = o;
        o.x = pk2(kt[0], kt[1]); o.y = pk2(kt[2], kt[3]); o.z = pk2(kt[4], kt[5]); o.w = pk2(kt[6], kt[7]); *(LAS v4u*)((LAS bf16*)(lds + L_KT) + lane * GP + kc0) = o; }
    if (lane < 8) { float tl = tot[0];
#pragma unroll
        for (int j = 1; j < 8; ++j) tl = (lane == j) ? tot[j] : tl;
        ((LAS float*)(lds + L_DECS))[kc0 + lane] = __expf(tl); }
    { const int tp = tid & 31, vg = tid >> 5; LAS bf16* VT = (LAS bf16*)(lds + L_VT);
#pragma unroll
      for (int e = 0; e < 4; ++e) { *(LAS unsigned*)(VT + (8 * vg + 2 * e) * GP + 2 * tp) = (p.va[e] & 0xffffu) | (p.vb[e] << 16); *(LAS unsigned*)(VT + (8 * vg + 2 * e + 1) * GP + 2 * tp) = (p.va[e] >> 16) | (p.vb[e] & 0xffff0000u); } }
}
__device__ __forceinline__ void gla_state_step(f32x4 (&S)[4], LAS unsigned char* lds, int wave, int fr, int fq) {
    const LAS bf16* VT = (const LAS bf16*)(lds + L_VT); const LAS bf16* KE = (const LAS bf16*)(lds + L_KENDT); const LAS float* DECS = (const LAS float*)(lds + L_DECS);
    bf16x8 bv[2];
#pragma unroll
    for (int ks = 0; ks < 2; ++ks) bv[ks] = *(const LAS bf16x8*)(VT + (16 * wave + fr) * GP + 32 * ks + 8 * fq);
#pragma unroll
    for (int m = 0; m < 4; ++m) { const f32x4 d = *(const LAS f32x4*)(DECS + 16 * m + 4 * fq); S[m] = S[m] * d;
#pragma unroll
        for (int ks = 0; ks < 2; ++ks) S[m] = mfma16(*(const LAS bf16x8*)(KE + (16 * m + fr) * GP + 32 * ks + 8 * fq), bv[ks], S[m]); }
}
__device__ __forceinline__ void gla_b1_item(int item, LAS unsigned char* lds, const bf16* KK, const bf16* V, const float* LOGA, float* CST, float* DEC, int tid, int wave, int lane) {
    const int b = item & 7, g = (item >> 3) & 7, h = item >> 6, fr = lane & 15, fq = lane >> 4;
    if (g == 7) return;
    f32x4 S[4]; float lsum[8];
#pragma unroll
    for (int m = 0; m < 4; ++m) S[m] = (f32x4){0.f, 0.f, 0.f, 0.f};
#pragma unroll
    for (int j = 0; j < 8; ++j) lsum[j] = 0.f;
    const size_t rg = (size_t)b * SEQ + (size_t)g * 256;
    GlaPre pre[4];
#pragma unroll
    for (int c = 0; c < 4; ++c) pre[c] = gla_load<false>(rg + (size_t)c * 64, h, nullptr, KK, V, LOGA, tid, wave, lane);
#pragma unroll
    for (int c = 0; c < 4; ++c) {
        float tot[8]; gla_build<false>(pre[c], lds, tid, wave, lane, tot);
#pragma unroll
        for (int j = 0; j < 8; ++j) lsum[j] += tot[j];
        LDS_BARRIER();
        gla_state_step(S, lds, wave, fr, fq);
        LDS_BARRIER();
    }
#pragma unroll
    for (int m = 0; m < 4; ++m) *(f32x4*)(CST + (size_t)item * 8192 + (16 * wave + fr) * 64 + 16 * m + 4 * fq) = S[m];
    if (lane < 8) { float tl = lsum[0];
#pragma unroll
        for (int j = 1; j < 8; ++j) tl = (lane == j) ? lsum[j] : tl;
        DEC[(size_t)item * 64 + 8 * wave + lane] = tl; }
}
__device__ __forceinline__ void gla_b2_unit(int unit, LAS unsigned char* lds, const bf16* Q, const bf16* KK, const bf16* V, const float* LOGA, const float* CST, const float* DEC, const bf16* ZAI, bf16* ZAO, int tid, int wave, int lane) {
    const int b = unit & 7, g = (unit >> 3) & 7, h = unit >> 6, fr = lane & 15, fq = lane >> 4;
    TS_BEGIN(1); TS_BEGIN(2);
    const size_t rg = (size_t)b * SEQ + (size_t)g * 256;
    const int ih = wave & 3, vh = wave >> 2;
    GlaPre pre[4]; v2u gt[4][4];
#pragma unroll
    for (int c = 0; c < 4; ++c) pre[c] = gla_load<true>(rg + (size_t)c * 64, h, Q, KK, V, LOGA, tid, wave, lane);
#pragma unroll
    for (int c = 0; c < 4; ++c)
#pragma unroll
        for (int mt = 0; mt < 4; ++mt) gt[c][mt] = *(const v2u*)(ZAI + (rg + (size_t)c * 64 + 16 * ih + fr) * GVAL + h * 128 + 64 * vh + 16 * mt + 4 * fq);
    f32x4 S[4];
#pragma unroll
    for (int m = 0; m < 4; ++m) S[m] = (f32x4){0.f, 0.f, 0.f, 0.f};
    { const size_t it0 = (size_t)unit - 8 * g;
      for (int j0 = 0; j0 < g; j0 += 2) { f32x4 cc[2][4], dd[2][4];
#pragma unroll
          for (int jj = 0; jj < 2; ++jj) if (j0 + jj < g) { const float* cp = CST + (it0 + 8 * (j0 + jj)) * 8192 + (16 * wave + fr) * 64 + 4 * fq; const float* dp = DEC + (it0 + 8 * (j0 + jj)) * 64 + 4 * fq;
#pragma unroll
              for (int m = 0; m < 4; ++m) { cc[jj][m] = *(const f32x4*)(cp + 16 * m); dd[jj][m] = *(const f32x4*)(dp + 16 * m); } }
#pragma unroll
          for (int jj = 0; jj < 2; ++jj) if (j0 + jj < g) {
#pragma unroll
              for (int m = 0; m < 4; ++m) { f32x4 d; d[0] = __expf(dd[jj][m][0]); d[1] = __expf(dd[jj][m][1]); d[2] = __expf(dd[jj][m][2]); d[3] = __expf(dd[jj][m][3]); S[m] = d * S[m] + cc[jj][m]; } } } }
    TS_END(2);
    const LAS bf16* QT = (const LAS bf16*)(lds + L_QT); const LAS bf16* KT = (const LAS bf16*)(lds + L_KT);
    const LAS bf16* VT = (const LAS bf16*)(lds + L_VT); LAS bf16* ST = (LAS bf16*)(lds + L_ST); LAS float* RED = (LAS float*)(lds + L_RED);
#pragma unroll
    for (int c = 0; c < 4; ++c) {
        TS_BEGIN(3);
        const size_t r0 = rg + (size_t)c * 64;
#pragma unroll
        for (int m = 0; m < 4; ++m) { v2u w; w.x = pk2(S[m][0], S[m][1]); w.y = pk2(S[m][2], S[m][3]); *(LAS v2u*)(ST + (16 * wave + fr) * GP + 16 * m + 4 * fq) = w; }
        float tot[8]; gla_build<true>(pre[c], lds, tid, wave, lane, tot);
        LDS_BARRIER();
        TS_END(3); TS_BEGIN(4);
        bf16x8 bq[2];
#pragma unroll
        for (int ks = 0; ks < 2; ++ks) bq[ks] = *(const LAS bf16x8*)(QT + (16 * ih + fr) * GP + 32 * ks + 8 * fq);
        f32x4 X[4];
#pragma unroll
        for (int jt = 0; jt < 4; ++jt) { X[jt] = (f32x4){0.f, 0.f, 0.f, 0.f};
            if (jt <= ih) {
#pragma unroll
                for (int ks = 0; ks < 2; ++ks) X[jt] = mfma16(*(const LAS bf16x8*)(KT + (16 * jt + fr) * GP + 32 * ks + 8 * fq), bq[ks], X[jt]);
#pragma unroll
                for (int r = 0; r < 4; ++r) if (16 * jt + 4 * fq + r > 16 * ih + fr) X[jt][r] = 0.f; } }
        bf16x8 xb[2];
#pragma unroll
        for (int k2 = 0; k2 < 2; ++k2) { v4u w; w.x = pk2(X[2 * k2][0], X[2 * k2][1]); w.y = pk2(X[2 * k2][2], X[2 * k2][3]); w.z = pk2(X[2 * k2 + 1][0], X[2 * k2 + 1][1]); w.w = pk2(X[2 * k2 + 1][2], X[2 * k2 + 1][3]); xb[k2] = __builtin_bit_cast(bf16x8, w); }
        f32x4 O[4]; float ss = 0.f;
#pragma unroll
        for (int mt = 0; mt < 4; ++mt) { const int v = 64 * vh + 16 * mt + fr; f32x4 o = (f32x4){0.f, 0.f, 0.f, 0.f};
#pragma unroll
            for (int k2 = 0; k2 < 2; ++k2) { const v2u lo = *(const LAS v2u*)(VT + v * GP + 32 * k2 + 4 * fq), hi = *(const LAS v2u*)(VT + v * GP + 32 * k2 + 16 + 4 * fq); v4u a; a.x = lo.x; a.y = lo.y; a.z = hi.x; a.w = hi.y;
                o = mfma16(__builtin_bit_cast(bf16x8, a), xb[k2], o); }
#pragma unroll
            for (int ks = 0; ks < 2; ++ks) o = mfma16(*(const LAS bf16x8*)(ST + v * GP + 32 * ks + 8 * fq), bq[ks], o);
            O[mt] = o; ss += (o[0] * o[0] + o[1] * o[1]) + (o[2] * o[2] + o[3] * o[3]); }
        ss += __shfl_xor(ss, 16); ss += __shfl_xor(ss, 32);
        if (fq == 0) RED[(vh * 4 + ih) * 16 + fr] = ss;
        gla_state_step(S, lds, wave, fr, fq);
        LDS_BARRIER();
        TS_END(4); TS_BEGIN(5);
        const float rs = rsqrtf((RED[ih * 16 + fr] + RED[(4 + ih) * 16 + fr]) * (1.f / 128.f) + EPS);
        { const size_t row = r0 + 16 * ih + fr;
#pragma unroll
          for (int mt = 0; mt < 4; ++mt) { v2u o;
              o.x = pk2(O[mt][0] * rs * bf2f(gt[c][mt].x & 0xffffu), O[mt][1] * rs * bf2f(gt[c][mt].x >> 16)); o.y = pk2(O[mt][2] * rs * bf2f(gt[c][mt].y & 0xffffu), O[mt][3] * rs * bf2f(gt[c][mt].y >> 16));
              *(v2u*)(ZAO + row * GVAL + h * 128 + 64 * vh + 16 * mt + 4 * fq) = o; } }
        TS_END(5);
    }
    LDS_BARRIER();
    TS_END(1);
}
__device__ __forceinline__ void ffn_act_item(int idx, const bf16* HUP, bf16* ACT, const float* cw, const float* cb) {
    const int cgp = idx % 352, rb = idx / 352, pn = cgp >> 4, c8 = (cgp & 15) * 8, j0 = 128 * pn + c8, r0 = rb * 16;
    float wg[3][8], wv[3][8], bg[8], bv[8];
#pragma unroll
    for (int e = 0; e < 8; ++e) { bg[e] = cb[j0 + e]; bv[e] = cb[DFF + j0 + e];
#pragma unroll
        for (int k = 0; k < 3; ++k) { wg[k][e] = cw[k * DFF2 + j0 + e]; wv[k][e] = cw[k * DFF2 + DFF + j0 + e]; } }
    float g2[8], g1[8], v2[8], v1[8];
    auto ld = [&](int row, float (&g)[8], float (&v)[8]) { const bf16* p = HUP + (size_t)row * DFF2 + 256 * pn + c8; const v4u a = *(const v4u*)p, b = *(const v4u*)(p + 128);
#pragma unroll
        for (int e = 0; e < 4; ++e) { g[2 * e] = bf2f(a[e] & 0xffffu); g[2 * e + 1] = bf2f(a[e] >> 16); v[2 * e] = bf2f(b[e] & 0xffffu); v[2 * e + 1] = bf2f(b[e] >> 16); } };
    if ((r0 & (SEQ - 1)) == 0) {
#pragma unroll
        for (int e = 0; e < 8; ++e) { g2[e] = 0.f; g1[e] = 0.f; v2[e] = 0.f; v1[e] = 0.f; } }
    else { ld(r0 - 2, g2, v2); ld(r0 - 1, g1, v1); }
    for (int i = 0; i < 16; ++i) { float g0[8], v0[8]; ld(r0 + i, g0, v0); float z[8];
#pragma unroll
        for (int e = 0; e < 8; ++e) { const float ga = wg[0][e] * g2[e] + wg[1][e] * g1[e] + wg[2][e] * g0[e] + bg[e], va = wv[0][e] * v2[e] + wv[1][e] * v1[e] + wv[2][e] * v0[e] + bv[e];
            z[e] = fsilu(ga) * va; g2[e] = g1[e]; g1[e] = g0[e]; v2[e] = v1[e]; v1[e] = v0[e]; }
        v4u o; o.x = pk2(z[0], z[1]); o.y = pk2(z[2], z[3]); o.z = pk2(z[4], z[5]); o.w = pk2(z[6], z[7]); *(v4u*)(ACT + (size_t)(r0 + i) * DFF + j0) = o; }
}

using pg8::Unit;
__device__ __forceinline__ void row_rstd(const float* SSQ, int pm, int wr, int fr, int fq, float (&rsd)[2][4]) {
    const int lane = fr + 16 * fq;
#pragma unroll
    for (int ai = 0; ai < 2; ++ai) { const size_t row = (size_t)pm * 256 + ai * 128 + wr * 64 + lane; const f32x4* p = (const f32x4*)(SSQ + row * 16); const f32x4 a = p[0], b = p[1], c = p[2], d = p[3];
        const float s = ((a[0] + a[1]) + (a[2] + a[3])) + ((b[0] + b[1]) + (b[2] + b[3])) + ((c[0] + c[1]) + (c[2] + c[3])) + ((d[0] + d[1]) + (d[2] + d[3]));
        const float rs = rsqrtf(s * (1.f / D) + EPS);
#pragma unroll
        for (int m = 0; m < 4; ++m) rsd[ai][m] = __shfl(rs, 16 * m + fr); }
}
__device__ __forceinline__ void rstd_table_fill(const float* SSQ, int g8, LAS unsigned char* lds, int tid) {
    LAS float* T = (LAS float*)(lds + RST_OFF);
#pragma unroll
    for (int i = 0; i < 4; ++i) { const int r = tid + i * NTHREADS; const f32x4* p = (const f32x4*)(SSQ + ((size_t)g8 * 2048 + r) * 16); const f32x4 a = p[0], b = p[1], c = p[2], d = p[3];
        const float s = ((a[0] + a[1]) + (a[2] + a[3])) + ((b[0] + b[1]) + (b[2] + b[3])) + ((c[0] + c[1]) + (c[2] + c[3])) + ((d[0] + d[1]) + (d[2] + d[3]));
        T[r] = rsqrtf(s * (1.f / D) + EPS); }
    LDS_BARRIER();
}
__device__ __forceinline__ void row_rstd_tbl(const LAS unsigned char* lds, int pm, int wr, int fr, float (&rsd)[2][4]) {
    const LAS float* T = (const LAS float*)(lds + RST_OFF) + (pm & 7) * 256 + wr * 64 + fr;
#pragma unroll
    for (int ai = 0; ai < 2; ++ai)
#pragma unroll
        for (int m = 0; m < 4; ++m) rsd[ai][m] = T[ai * 128 + m * 16];
}
struct EpiA {
    static constexpr bool PERM = true, AFTER_DRAIN = false; static constexpr int TSID = 21;
    unsigned char* act0; const float* SSQ; float* SVST; const float* bal; LAS unsigned char* lds; bool tbl;
    __device__ __forceinline__ void operator()(const f32x4 (&acc)[2][2][4][2], const Unit& u, int wr, int wc, int fr_, int fq_) const {
        int ln_; asm volatile("v_mbcnt_lo_u32_b32 %0, -1, 0\n\tv_mbcnt_hi_u32_b32 %0, -1, %0" : "=v"(ln_)); const int fr = ln_ & 15, fq = ln_ >> 4; (void)fr_; (void)fq_;
        float rsd[2][4]; if (tbl) row_rstd_tbl(lds, u.pm, wr, fr, rsd); else row_rstd(SSQ, u.pm, wr, fr, fq, rsd);
        const int pn = u.pn; int mode, ldc, colt; size_t boff;
        if (pn < 1) { mode = 0; boff = A_Q; ldc = 256; colt = 0; } else if (pn < 2) { mode = 0; boff = A_K; ldc = 256; colt = 0; } else if (pn < 4) { mode = 0; boff = A_V; ldc = 512; colt = (pn - 2) * 256; }
        else if (pn < 6) { mode = 1; boff = A_Z; ldc = 512; colt = (pn - 4) * 256; } else if (pn < 7) { mode = 4; boff = A_LOGA; ldc = 256; colt = 0; }
        else if (pn < 9) { mode = 2; boff = A_Z + (size_t)M * 512 * 2; ldc = 512; colt = (pn - 7) * 256; } else if (pn < 11) { mode = 3; boff = A_SV; ldc = 512; colt = (pn - 9) * 256; }
        else if (pn < 13) { mode = 0; boff = A_Z + (size_t)2 * M * 512 * 2; ldc = 512; colt = (pn - 11) * 256; } else if (pn < 15) { mode = 0; boff = A_CC; ldc = 512; colt = (pn - 13) * 256; }
        else if (pn < 17) { mode = 0; boff = A_CX; ldc = 512; colt = (pn - 15) * 256; } else { mode = 5; boff = A_G; ldc = 3072; colt = (pn - 17) * 256; }
        const int col0 = colt + wc * 32 + 8 * fq;
#pragma unroll
        for (int ai = 0; ai < 2; ++ai)
#pragma unroll
            for (int m = 0; m < 4; ++m) { const size_t row = (size_t)u.pm * 256 + ai * 128 + wr * 64 + m * 16 + fr; const float rs = rsd[ai][m]; float s1 = 0.f, s2 = 0.f;
#pragma unroll
                for (int bj = 0; bj < 2; ++bj) { const f32x4 a0 = acc[ai][bj][m][0] * rs, a1 = acc[ai][bj][m][1] * rs; float v[8] = {a0[0], a0[1], a0[2], a0[3], a1[0], a1[1], a1[2], a1[3]};
                    if (mode == 4) { const f32x4 b0 = *(const f32x4*)(bal + col0 + bj * 128), b1 = *(const f32x4*)(bal + col0 + bj * 128 + 4); f32x4 o0, o1;
#pragma unroll
                        for (int e = 0; e < 4; ++e) { o0[e] = flogsig(v[e] + b0[e]) * 0.0625f; o1[e] = flogsig(v[4 + e] + b1[e]) * 0.0625f; }
                        float* p = (float*)(act0 + boff) + row * 256 + col0 + bj * 128; *(f32x4*)p = o0; *(f32x4*)(p + 4) = o1; }
                    else {
                        if (mode == 1) {
#pragma unroll
                            for (int e = 0; e < 8; ++e) v[e] = fsilu(v[e]); }
                        else if (mode == 2 || mode == 3) {
#pragma unroll
                            for (int e = 0; e < 8; ++e) v[e] = fgelu(v[e]); }
                        else if (mode == 5) {
#pragma unroll
                            for (int e = 0; e < 8; ++e) v[e] = fsigmoid(v[e]); }
                        if (mode == 3) {
#pragma unroll
                            for (int e = 0; e < 8; ++e) { s1 += v[e]; s2 += v[e] * v[e]; } }
                        v4u o; o.x = pk2(v[0], v[1]); o.y = pk2(v[2], v[3]); o.z = pk2(v[4], v[5]); o.w = pk2(v[6], v[7]);
                        *(v4u*)((bf16*)(act0 + boff) + row * ldc + col0 + bj * 128) = o; } }
                if (mode == 3) { s1 += __shfl_xor(s1, 16); s1 += __shfl_xor(s1, 32); s2 += __shfl_xor(s2, 16); s2 += __shfl_xor(s2, 32);
                    if (fq == 0) *(f32x2*)(SVST + row * 16 + ((pn - 9) * 4 + wc) * 2) = (f32x2){s1, s2}; } }
    }
};
struct EpiC {
    static constexpr bool PERM = true, AFTER_DRAIN = false; static constexpr int TSID = 23;
    const bf16* G; bf16* MG;
    __device__ __forceinline__ void operator()(const f32x4 (&acc)[2][2][4][2], const Unit& u, int wr, int wc, int fr_, int fq_) const {
        int ln_; asm volatile("v_mbcnt_lo_u32_b32 %0, -1, 0\n\tv_mbcnt_hi_u32_b32 %0, -1, %0" : "=v"(ln_)); const int fr = ln_ & 15, fq = ln_ >> 4; (void)fr_; (void)fq_;
        const int br = u.pm >> 6, pm = u.pm & 63, pn = u.pn & 3; const int col0 = pn * 256 + wc * 32 + 8 * fq;
#pragma unroll
        for (int ai = 0; ai < 2; ++ai) {
            v4u gt[4][2], old[4][2];
#pragma unroll
            for (int m = 0; m < 4; ++m)
#pragma unroll
                for (int bj = 0; bj < 2; ++bj) { const size_t row = (size_t)pm * 256 + ai * 128 + wr * 64 + m * 16 + fr; gt[m][bj] = *(const v4u*)(G + row * 3072 + br * 1024 + col0 + bj * 128);
                    if (br != 0) old[m][bj] = *(const v4u*)(MG + row * 1024 + col0 + bj * 128); }
#pragma unroll
            for (int m = 0; m < 4; ++m) { const size_t row = (size_t)pm * 256 + ai * 128 + wr * 64 + m * 16 + fr;
#pragma unroll
                for (int bj = 0; bj < 2; ++bj) { const f32x4 a0 = acc[ai][bj][m][0], a1 = acc[ai][bj][m][1]; float v[8] = {a0[0], a0[1], a0[2], a0[3], a1[0], a1[1], a1[2], a1[3]};
#pragma unroll
                    for (int e = 0; e < 4; ++e) { v[2 * e] *= bf2f(gt[m][bj][e] & 0xffffu); v[2 * e + 1] *= bf2f(gt[m][bj][e] >> 16); }
                    if (br != 0) {
#pragma unroll
                        for (int e = 0; e < 4; ++e) { v[2 * e] += bf2f(old[m][bj][e] & 0xffffu); v[2 * e + 1] += bf2f(old[m][bj][e] >> 16); } }
                    v4u o; o.x = pk2(v[0], v[1]); o.y = pk2(v[2], v[3]); o.z = pk2(v[4], v[5]); o.w = pk2(v[6], v[7]); *(v4u*)(MG + row * 1024 + col0 + bj * 128) = o; } } }
    }
};
struct BranchOrder {
    int G, c;
    __device__ bool next(int i, Unit& u) const { const int j = i / 3, br = i - 3 * j, T = c + G * j; if (T >= 256) return false;
        const int w = (T & 7) * 32 + (T >> 3), pm = (w >> 5) * 8 + (w & 7), pn = (w & 31) >> 3; u.pm = br * 64 + pm; u.pn = br * 4 + pn; return true; }
    __device__ __forceinline__ void a_ready(const Unit&) const {}
    __device__ __forceinline__ void done(const Unit&) const {}
};
template <int VAR> struct EpiResT {
    static constexpr bool PERM = true, AFTER_DRAIN = false; static constexpr int TSID = 24;
    const bf16* XI; bf16* XB; float* SSQ;
    __device__ __forceinline__ void operator()(const f32x4 (&acc)[2][2][4][2], const Unit& u, int wr, int wc, int fr_, int fq_) const {
        int ln_; asm volatile("v_mbcnt_lo_u32_b32 %0, -1, 0\n\tv_mbcnt_hi_u32_b32 %0, -1, %0" : "=v"(ln_)); const int fr = ln_ & 15, fq = ln_ >> 4; (void)fr_; (void)fq_;
        const int col0 = u.pn * 256 + wc * 32 + 8 * fq;
        v4u xo[2][4][2];
#pragma unroll
        for (int ai = 0; ai < 2; ++ai)
#pragma unroll
            for (int m = 0; m < 4; ++m)
#pragma unroll
                for (int bj = 0; bj < 2; ++bj) xo[ai][m][bj] = *(const v4u*)(XI + ((size_t)u.pm * 256 + ai * 128 + wr * 64 + m * 16 + fr) * D + col0 + bj * 128);
#pragma unroll
        for (int ai = 0; ai < 2; ++ai)
#pragma unroll
            for (int m = 0; m < 4; ++m) { const size_t row = (size_t)u.pm * 256 + ai * 128 + wr * 64 + m * 16 + fr; float ss = 0.f;
#pragma unroll
                for (int bj = 0; bj < 2; ++bj) { const size_t off = row * D + col0 + bj * 128; const f32x4 a0 = acc[ai][bj][m][0], a1 = acc[ai][bj][m][1];
                    float v[8] = {a0[0], a0[1], a0[2], a0[3], a1[0], a1[1], a1[2], a1[3]};
#pragma unroll
                    for (int e = 0; e < 4; ++e) { v[2 * e] += bf2f(xo[ai][m][bj][e] & 0xffffu); v[2 * e + 1] += bf2f(xo[ai][m][bj][e] >> 16); }
#pragma unroll
                    for (int e = 0; e < 8; ++e) ss += v[e] * v[e];
                    v4u o; o.x = pk2(v[0], v[1]); o.y = pk2(v[2], v[3]); o.z = pk2(v[4], v[5]); o.w = pk2(v[6], v[7]); if (VAR != 1 || ss == 12345.678f) *(v4u*)(XB + off) = o; }
                if (VAR == 0) { ss += __shfl_xor(ss, 16); ss += __shfl_xor(ss, 32);
                if (fq == 0) SSQ[row * 16 + u.pn * 4 + wc] = ss; } }
    }
};
typedef EpiResT<0> EpiRes;
struct EpiUp {
    static constexpr bool PERM = true, AFTER_DRAIN = false; static constexpr int TSID = 25;
    bf16* HUP; const float* SSQ;
    __device__ __forceinline__ void operator()(const f32x4 (&acc)[2][2][4][2], const Unit& u, int wr, int wc, int fr_, int fq_) const {
        int ln_; asm volatile("v_mbcnt_lo_u32_b32 %0, -1, 0\n\tv_mbcnt_hi_u32_b32 %0, -1, %0" : "=v"(ln_)); const int fr = ln_ & 15, fq = ln_ >> 4; (void)fr_; (void)fq_;
        float rsd[2][4]; row_rstd(SSQ, u.pm, wr, fr, fq, rsd);
        const int col0 = u.pn * 256 + wc * 32 + 8 * fq;
#pragma unroll
        for (int ai = 0; ai < 2; ++ai)
#pragma unroll
            for (int m = 0; m < 4; ++m) { const size_t row = (size_t)u.pm * 256 + ai * 128 + wr * 64 + m * 16 + fr; const float rs = rsd[ai][m];
#pragma unroll
                for (int bj = 0; bj < 2; ++bj) { const f32x4 a0 = acc[ai][bj][m][0] * rs, a1 = acc[ai][bj][m][1] * rs;
                    v4u o; o.x = pk2(a0[0], a0[1]); o.y = pk2(a0[2], a0[3]); o.z = pk2(a1[0], a1[1]); o.w = pk2(a1[2], a1[3]); *(v4u*)(HUP + row * DFF2 + col0 + bj * 128) = o; } }
    }
};

__device__ __forceinline__ float dpp_f(float old, float src, const int ctrl_sel) {
    const int o = __builtin_bit_cast(int, old), v = __builtin_bit_cast(int, src); int r;
    if (ctrl_sel == 0) r = __builtin_amdgcn_update_dpp(o, v, 0x111, 0xf, 0xf, false);
    else if (ctrl_sel == 1) r = __builtin_amdgcn_update_dpp(o, v, 0x112, 0xf, 0xf, false);
    else if (ctrl_sel == 2) r = __builtin_amdgcn_update_dpp(o, v, 0x121, 0xf, 0xf, false);
    else r = __builtin_amdgcn_update_dpp(o, v, 0x122, 0xf, 0xf, false);
    return __builtin_bit_cast(float, r);
}
constexpr int XL_OFF = RING_BYTES + 1024;
struct EpiUpConv {
    static constexpr bool PERM = true, AFTER_DRAIN = false; static constexpr int TSID = 22;
    unsigned char* ws; const float* cw; const float* cb; LAS unsigned char* lds; bool tbl;
    __device__ __forceinline__ void operator()(const f32x4 (&acc)[2][2][4][2], const Unit& u, int wr, int wc, int fr_, int fq_) const {
        int ln_; asm volatile("v_mbcnt_lo_u32_b32 %0, -1, 0\n\tv_mbcnt_hi_u32_b32 %0, -1, %0" : "=v"(ln_)); const int fr = ln_ & 15, fq = ln_ >> 4; (void)fr_; (void)fq_;
        bf16* ACT = (bf16*)(ws + WS_ACT0 + A_ACT); const float* SSQ = (const float*)(ws + WS_SSQ); float* HT = (float*)(ws + WS_ACT0 + A_HT);
        float rsd[2][4]; if (tbl) row_rstd_tbl(lds, u.pm, wr, fr, rsd); else row_rstd(SSQ, u.pm, wr, fr, fq, rsd);
        LAS f32x4* XL = (LAS f32x4*)(lds + XL_OFF);
        const int tcol = u.pn * 256 + wc * 32 + 8 * fq;
        const int ch0 = u.pn * 128 + wc * 32 + 8 * fq; const bool batch_start = (u.pm & 7) == 0;
        f32x4 wgp[3], wvp[3], bgp, bvp;
#pragma unroll
        for (int k = 0; k < 3; ++k) { wgp[k] = *(const f32x4*)(cw + k * DFF2 + ch0); wvp[k] = *(const f32x4*)(cw + k * DFF2 + DFF + ch0); }
        bgp = *(const f32x4*)(cb + ch0); bvp = *(const f32x4*)(cb + DFF + ch0);
#pragma unroll
        for (int ai = 0; ai < 2; ++ai)
#pragma unroll
            for (int bj = 0; bj < 2; ++bj)
#pragma unroll
                for (int n = 0; n < 2; ++n) {
                    if (fr >= 14) { const f32x4 h = acc[ai][bj][3][n] * rsd[ai][3]; XL[((((ai * 2 + wr) * 4 + wc) * 2 + bj) * 2 + n) * 8 + fq * 2 + (fr - 14)] = h;
                        if (ai == 1 && wr == 1) *(f32x4*)(HT + ((size_t)(u.pm * 2 + 1) * 2 + (fr - 14)) * DFF2 + tcol + bj * 128 + 4 * n) = h; }
                    if (ai == 0 && wr == 0 && fr < 2) *(f32x4*)(HT + ((size_t)(u.pm * 2 + 0) * 2 + fr) * DFF2 + tcol + bj * 128 + 4 * n) = acc[0][bj][0][n] * rsd[0][0]; }
        asm volatile("s_waitcnt lgkmcnt(0)" ::: "memory"); __builtin_amdgcn_s_barrier(); asm volatile("" ::: "memory");
#pragma unroll
        for (int n = 0; n < 2; ++n) {
            asm volatile("" ::: "memory");
            f32x4 wg[3], wv[3], bg, bv;
            if (n == 0) {
#pragma unroll
                for (int k = 0; k < 3; ++k) { wg[k] = wgp[k]; wv[k] = wvp[k]; }
                bg = bgp; bv = bvp; }
            else {
#pragma unroll
                for (int k = 0; k < 3; ++k) { wg[k] = *(const f32x4*)(cw + k * DFF2 + ch0 + 4); wv[k] = *(const f32x4*)(cw + k * DFF2 + DFF + ch0 + 4); }
                bg = *(const f32x4*)(cb + ch0 + 4); bv = *(const f32x4*)(cb + DFF + ch0 + 4); }
#pragma unroll
            for (int ai = 0; ai < 2; ++ai) {
                f32x4 hgp, hvp;
                { f32x4 pg14 = (f32x4){0.f, 0.f, 0.f, 0.f}, pg15 = pg14, pv14 = pg14, pv15 = pg14;
                  if (!(ai == 0 && wr == 0)) { const int pb = ai * 2 + wr - 1; const LAS f32x4* q = XL + ((((pb * 4 + wc) * 2 + 0) * 2 + n) * 8 + fq * 2); const LAS f32x4* qv = XL + ((((pb * 4 + wc) * 2 + 1) * 2 + n) * 8 + fq * 2);
                      pg14 = q[0]; pg15 = q[1]; pv14 = qv[0]; pv15 = qv[1]; }
                  hgp = (fr == 14) ? pg14 : pg15; hvp = (fr == 14) ? pv14 : pv15; }
#pragma unroll
                for (int m = 0; m < 4; ++m) { const f32x4 hg = acc[ai][0][m][n] * rsd[ai][m], hv = acc[ai][1][m][n] * rsd[ai][m]; f32x4 z;
#pragma unroll
                    for (int e = 0; e < 4; ++e) {
                        const float g1 = dpp_f(dpp_f(0.f, hgp[e], 2), hg[e], 0), g2 = dpp_f(dpp_f(0.f, hgp[e], 3), hg[e], 1);
                        const float v1 = dpp_f(dpp_f(0.f, hvp[e], 2), hv[e], 0), v2 = dpp_f(dpp_f(0.f, hvp[e], 3), hv[e], 1);
                        const float ga = wg[0][e] * g2 + wg[1][e] * g1 + wg[2][e] * hg[e] + bg[e], va = wv[0][e] * v2 + wv[1][e] * v1 + wv[2][e] * hv[e] + bv[e];
                        z[e] = fsilu(ga) * va; }
                    const size_t row = (size_t)u.pm * 256 + ai * 128 + wr * 64 + m * 16 + fr;
                    const bool skip = (ai == 0 && wr == 0 && m == 0 && fr < 2 && !batch_start);
                    if (!skip) { v2u o; o.x = pk2(z[0], z[1]); o.y = pk2(z[2], z[3]); *(v2u*)(ACT + row * DFF + ch0 + 4 * n) = o; }
                    hgp = hg; hvp = hv; } } }
    }
};
__device__ __forceinline__ void ffn_fixup(int pm, const float* HT, bf16* ACT, const float* cw, const float* cb, int tid) {
    if ((pm & 7) == 0) return;
    for (int it = tid; it < 2 * (DFF / 4); it += NTHREADS) { const int rr = it / (DFF / 4), j = (it % (DFF / 4)) * 4, tc = (j >> 7) * 256 + (j & 127);
        const float* h0 = HT + ((size_t)(pm * 2 + 0) * 2 + rr) * DFF2;
        const float* h1 = rr ? HT + ((size_t)(pm * 2 + 0) * 2 + 0) * DFF2 : HT + ((size_t)((pm - 1) * 2 + 1) * 2 + 1) * DFF2;
        const float* h2 = rr ? HT + ((size_t)((pm - 1) * 2 + 1) * 2 + 1) * DFF2 : HT + ((size_t)((pm - 1) * 2 + 1) * 2 + 0) * DFF2;
        const f32x4 g0 = *(const f32x4*)(h0 + tc), g1 = *(const f32x4*)(h1 + tc), g2 = *(const f32x4*)(h2 + tc), v0 = *(const f32x4*)(h0 + tc + 128), v1 = *(const f32x4*)(h1 + tc + 128), v2 = *(const f32x4*)(h2 + tc + 128);
        const f32x4 ga = *(const f32x4*)(cw + j) * g2 + *(const f32x4*)(cw + DFF2 + j) * g1 + *(const f32x4*)(cw + 2 * DFF2 + j) * g0 + *(const f32x4*)(cb + j);
        const f32x4 va = *(const f32x4*)(cw + DFF + j) * v2 + *(const f32x4*)(cw + DFF2 + DFF + j) * v1 + *(const f32x4*)(cw + 2 * DFF2 + DFF + j) * v0 + *(const f32x4*)(cb + DFF + j);
        v2u o; o.x = pk2(fsilu(ga[0]) * va[0], fsilu(ga[1]) * va[1]); o.y = pk2(fsilu(ga[2]) * va[2], fsilu(ga[3]) * va[3]);
        *(v2u*)(ACT + ((size_t)pm * 256 + rr) * DFF + j) = o; }
    asm volatile("s_waitcnt vmcnt(0)" ::: "memory"); __syncthreads();
}

template <bool P> struct EpiNull {
    static constexpr bool PERM = P, AFTER_DRAIN = false; static constexpr int TSID = 26; float* sink;
    __device__ __forceinline__ void operator()(const f32x4 (&acc)[2][2][4][2], const Unit& u, int wr, int wc, int fr, int fq) const {
        f32x4 s = (f32x4){0.f, 0.f, 0.f, 0.f};
#pragma unroll
        for (int ai = 0; ai < 2; ++ai)
#pragma unroll
            for (int bj = 0; bj < 2; ++bj)
#pragma unroll
                for (int m = 0; m < 4; ++m)
#pragma unroll
                    for (int n = 0; n < 2; ++n) s += acc[ai][bj][m][n];
        if (s[0] + s[1] + s[2] + s[3] == 12345.678f) sink[u.pm + wr + wc + fr + fq] = s[0];
    }
};
#define XB_TMO      128
#define XB_XCNT(j)  (256  + 64 * (j))
#define XB_XSUB(j)  (1280 + 64 * (j))
#define XB_XGEN(j)  (2304 + 64 * (j))
#define XB_TOP      3328
#define XB_TOPGEN   3392
#define XCD_BAR_WORDS 3456
#define XB_SPIN_CAP (1u << 18)

__device__ __forceinline__ unsigned xb_ld(unsigned* p)              { return __hip_atomic_load(p, __ATOMIC_RELAXED, __HIP_MEMORY_SCOPE_AGENT); }
__device__ __forceinline__ unsigned xb_add(unsigned* p, unsigned v) { return __hip_atomic_fetch_add(p, v, __ATOMIC_RELAXED, __HIP_MEMORY_SCOPE_AGENT); }
__device__ __forceinline__ unsigned xb_xcc_id() { return (unsigned)__builtin_amdgcn_s_getreg((3 << 11) | 20) & 0xFu; }
#define XB_SPIN(cond, bar) do { unsigned _sp = 0; while (cond) { __builtin_amdgcn_s_sleep(1); \
    if ((++_sp & 255u) == 0u) { if (xb_ld(&(bar)[XB_TMO])) break; if (_sp > XB_SPIN_CAP) { atomicAdd(&(bar)[XB_TMO], 1u); break; } } } } while (0)

struct XcdBarrier {
    unsigned* bar; unsigned x;
    volatile LAS unsigned* st;
};

__device__ __forceinline__ XcdBarrier xcd_barrier_post(unsigned* bar, volatile LAS unsigned* st) {
    XcdBarrier b; b.bar = bar; b.x = xb_xcc_id(); b.st = st;
    if (threadIdx.x == 0) st[2] = xb_add(&bar[XB_XCNT(b.x)], 1u);
    return b;
}
__device__ __forceinline__ void xcd_barrier_complete(unsigned* bar, unsigned x, unsigned& nloc, unsigned& nx) {
    const unsigned G = gridDim.x * gridDim.y * gridDim.z;
    unsigned sum, cnt, mine, sp = 0u;
    for (;;) {
        sum = 0u; cnt = 0u; mine = 0u;
#pragma unroll
        for (unsigned j = 0; j < 16; ++j) { const unsigned c = xb_ld(&bar[XB_XCNT(j)]); sum += c; cnt += (c > 0u) ? 1u : 0u; mine = (j == x) ? c : mine; }
        if (sum == G) break;
        __builtin_amdgcn_s_sleep(1);
        if ((++sp & 255u) == 0u) { if (xb_ld(&bar[XB_TMO])) break; if (sp > XB_SPIN_CAP) { atomicAdd(&bar[XB_TMO], 1u); break; } }
    }
    nloc = mine > 0u ? mine : 1u; nx = cnt > 0u ? cnt : 1u;
}

__device__ __forceinline__ void xcd_barrier(const XcdBarrier& b) {
    asm volatile("s_waitcnt vmcnt(0)" ::: "memory");
    __syncthreads();
    if (threadIdx.x == 0) {
        unsigned* bar = b.bar;
        __builtin_amdgcn_s_waitcnt(0);
        unsigned nloc = b.st[0], nx = b.st[1];
        if (nloc == 0u) { xcd_barrier_complete(bar, b.x, nloc, nx); b.st[0] = nloc; b.st[1] = nx; }
        const unsigned old = xb_add(&bar[XB_XSUB(b.x)], 1u);
        const unsigned gen = old / nloc;
        if (old + 1u == (gen + 1u) * nloc) {
            __builtin_amdgcn_fence(__ATOMIC_RELEASE, "agent");
            asm volatile("s_waitcnt vmcnt(0)" ::: "memory");
            const unsigned og = xb_add(&bar[XB_TOP], 1u);
            const unsigned tg = og / nx;
            if (og + 1u == (tg + 1u) * nx) xb_add(&bar[XB_TOPGEN], 1u);
            else XB_SPIN(xb_ld(&bar[XB_TOPGEN]) == tg, bar);
            __builtin_amdgcn_fence(__ATOMIC_ACQUIRE, "agent");
            xb_add(&bar[XB_XGEN(b.x)], 1u);
            asm volatile("s_waitcnt vmcnt(0)" ::: "memory");
        } else {
            XB_SPIN(xb_ld(&bar[XB_XGEN(b.x)]) == gen, bar);
            __builtin_amdgcn_fence(__ATOMIC_ACQUIRE, "agent");
            asm volatile("s_waitcnt vmcnt(0)" ::: "memory");
        }
    }
    __syncthreads();
}

__device__ __forceinline__ void xcd_barrier_local(const XcdBarrier& b) {
    asm volatile("s_waitcnt vmcnt(0)" ::: "memory");
    __syncthreads();
    if (threadIdx.x == 0) {
        unsigned* bar = b.bar;
        __builtin_amdgcn_s_waitcnt(0);
        const unsigned nloc = b.st[0];
        const unsigned old = xb_add(&bar[XB_XSUB(b.x)], 1u);
        const unsigned gen = old / nloc;
        if (old + 1u == (gen + 1u) * nloc) xb_add(&bar[XB_XGEN(b.x)], 1u);
        else XB_SPIN(xb_ld(&bar[XB_XGEN(b.x)]) == gen, bar);
        __builtin_amdgcn_fence(__ATOMIC_ACQUIRE, "agent");
        asm volatile("s_waitcnt vmcnt(0)" ::: "memory");
    }
    __syncthreads();
}

#ifndef PROBE
#define PROBE 0
#endif
struct Args { Inputs in; float* out; unsigned char* ws; int ph_lo, ph_hi; };
constexpr int NPHASE = 2 + 7 * DEPTH;
#define LAUNDER_S(p) asm volatile("" : "+s"(p))
#define LAUNDER_V(p) asm volatile("" : "+v"(p))
struct Ctx { unsigned char* ws; unsigned char* act0; float* X; int tid, lane, wave, G, bx, gw, ngw; };
#define BST_OFF (RING_BYTES + 512)
__device__ __forceinline__ Ctx make_ctx(const Args& a, int wave_id, LAS unsigned char* ldsb) {
    Ctx c; size_t z = 0; LAUNDER_S(z); c.ws = a.ws + z; c.X = (float*)((unsigned char*)a.out + z); c.act0 = c.ws + WS_ACT0;
    int ln; asm volatile("v_mbcnt_lo_u32_b32 %0, -1, 0\n\tv_mbcnt_hi_u32_b32 %0, -1, %0" : "=v"(ln)); c.lane = ln; c.wave = wave_id; c.tid = wave_id * 64 + ln;
    c.G = gridDim.x; c.bx = __builtin_amdgcn_readfirstlane(((volatile LAS unsigned*)(ldsb + BST_OFF))[2]); c.gw = c.bx * NWAVES + c.wave; c.ngw = c.G * NWAVES; return c;
}
__device__ __forceinline__ unsigned char* slot_of(const Ctx& c, int l) { return c.ws + WS_SLOT0 + (size_t)(l & 1) * SL_BYTES; }
__device__ __forceinline__ unsigned* ctl_word(const Ctx& c, int w) { return (unsigned*)(c.ws + WS_CTL) + w; }
__device__ __forceinline__ void tail_convert(const Args& a, const Ctx& c, int l, int ph, bool drain, bool early, LAS unsigned char* lds) {
#if MK_ONE_LAUNCH
    const unsigned xcc_ = xb_xcc_id(); const unsigned nloc_ = ((volatile LAS unsigned*)(lds + BST_OFF))[0];
    unsigned* fin = ctl_word(c, CW_FIN + (ph * 8 + (int)(xcc_ & 7u)) * 16);
    if (c.tid == 0) __hip_atomic_fetch_add(fin, 1u, RLX_AGENT);
    if (l == 0 && ph == 1) convert_queue(a.in, 0, slot_of(c, 0), lds, ctl_word(c, CW_QHEAD), CV_WIN_ITEMS, CV_ITEMS, nullptr, c.G, c.tid, c.wave, c.lane);
    if (l + 1 < DEPTH && (drain || early)) convert_queue(a.in, l + 1, slot_of(c, l + 1), lds, ctl_word(c, CW_QHEAD + 64 * (l + 1)), 0, CV_ITEMS, drain ? nullptr : fin, (int)nloc_, c.tid, c.wave, c.lane);
#else
    if (l == 0 && ph == 1) convert_static(a.in, 0, slot_of(c, 0), lds, CV_WIN_ITEMS, CV_ITEMS, c.gw, c.ngw, c.wave, c.lane);
    if (l + 1 < DEPTH && drain) convert_static(a.in, l + 1, slot_of(c, l + 1), lds, 0, CV_ITEMS, c.gw, c.ngw, c.wave, c.lane);
#endif
}
__device__ __forceinline__ void ph_p0(const Args& a, const int wv, LAS unsigned char* lds) { const Ctx c = make_ctx(a, wv, lds);
    convert_static(a.in, 0, c.ws + WS_SLOT0, lds, 0, CV_WIN_ITEMS, c.gw, c.ngw, c.wave, c.lane); x_prep(a.in.p[0], (bf16*)(c.ws + WS_XB), (float*)(c.ws + WS_SSQ), c.gw, c.ngw, c.lane); }
__device__ __forceinline__ void ph_a(const Args& a, const int wv, int l, int ph, LAS unsigned char* lds) { const Ctx c = make_ctx(a, wv, lds);
    pg8::Gemm g{(const bf16*)(c.ws + WS_XB), (const bf16*)(slot_of(c, l) + SL_WIN), M, NIN, D}; pg8::StaticOrder S; S.init(M, NIN, c.G, c.bx);
    const bool tbl = (c.G == 256); if (tbl) rstd_table_fill((const float*)(c.ws + WS_SSQ), c.bx & 7, lds, c.tid);
    EpiA E{c.act0, (const float*)(c.ws + WS_SSQ), (float*)(c.ws + WS_SVST), a.in.p[4] + (size_t)l * GKEY, lds, tbl};
    if (PROBE == 21) { EpiNull<true> EN_{(float*)(c.ws + WS_END)}; pg8::gemm_phase<EpiNull<true>, pg8::StaticOrder, true, true>(lds, g, S, EN_, wv); }
    for (int rep = 0; rep < 1 + (PROBE == 1); ++rep) pg8::gemm_phase<EpiA, pg8::StaticOrder, true, true>(lds, g, S, E, wv);
    { const Ctx c2 = make_ctx(a, wv, lds); tail_convert(a, c2, l, ph, false, ((NIN / 256) * 64 - 1) / c2.G * c2.G + c2.bx >= (NIN / 256) * 64, lds); } }
__device__ __forceinline__ void ph_b1(const Args& a, const int wv, int l, LAS unsigned char* lds) { const Ctx c = make_ctx(a, wv, lds); const Inputs& I = a.in;
    bf16* Zb = (bf16*)(c.act0 + A_Z); bf16* DUM = (bf16*)(c.ws + WS_END); const int tid = c.tid;
    TS_BEGIN(41);
    for (int rep = 0; rep < 1 + (PROBE == 2); ++rep)
    for (int it = c.bx; it < 256; it += c.G) gla_b1_item(it, lds, (const bf16*)(c.act0 + A_K), (const bf16*)(c.act0 + A_V), (const float*)(c.act0 + A_LOGA), (float*)(c.act0 + A_CST), (float*)(c.act0 + A_DEC), c.tid, c.wave, c.lane);
    TS_END(41); TS_BEGIN(42);
    if (PROBE == 3) for (int it = c.bx; it < 512; it += c.G) sgu_item(it, lds, Zb + (size_t)M * 512, DUM, (const bf16*)(c.act0 + A_SV), (const float*)(c.ws + WS_SVST), I.p[7] + (size_t)l * SGW, I.p[8] + (size_t)l * SGW, (const bf16*)(slot_of(c, l) + SL_SGW), I.p[10] + (size_t)l * 512, c.wave, c.lane);
    for (int it = c.bx; it < 512; it += c.G) sgu_item(it, lds, Zb + (size_t)M * 512, Zb + (size_t)M * 512, (const bf16*)(c.act0 + A_SV), (const float*)(c.ws + WS_SVST), I.p[7] + (size_t)l * SGW, I.p[8] + (size_t)l * SGW, (const bf16*)(slot_of(c, l) + SL_SGW), I.p[10] + (size_t)l * 512, c.wave, c.lane);
    TS_END(42); TS_BEGIN(43);
    if (PROBE == 4) for (int it = c.bx * NTHREADS + c.tid; it < 131072; it += c.G * NTHREADS) convbr_item(it, Zb + (size_t)2 * M * 512, DUM, (const bf16*)(c.act0 + A_CC), (const bf16*)(c.act0 + A_CX), I.p[12] + (size_t)l * 3 * CW);
    for (int it = c.bx * NTHREADS + c.tid; it < 131072; it += c.G * NTHREADS) convbr_item(it, Zb + (size_t)2 * M * 512, Zb + (size_t)2 * M * 512, (const bf16*)(c.act0 + A_CC), (const bf16*)(c.act0 + A_CX), I.p[12] + (size_t)l * 3 * CW);
    TS_END(43); }
__device__ __forceinline__ void ph_b2(const Args& a, const int wv, int l, int ph, LAS unsigned char* lds) { const Ctx c = make_ctx(a, wv, lds);
    if (PROBE == 6) for (int it = c.bx; it < 256; it += c.G) gla_b2_unit(it, lds, (const bf16*)(c.act0 + A_Q), (const bf16*)(c.act0 + A_K), (const bf16*)(c.act0 + A_V), (const float*)(c.act0 + A_LOGA), (const float*)(c.act0 + A_CST), (const float*)(c.act0 + A_DEC), (const bf16*)(c.act0 + A_Z), (bf16*)(c.ws + WS_END), c.tid, c.wave, c.lane);
    for (int it = c.bx; it < 256; it += c.G) gla_b2_unit(it, lds, (const bf16*)(c.act0 + A_Q), (const bf16*)(c.act0 + A_K), (const bf16*)(c.act0 + A_V), (const float*)(c.act0 + A_LOGA), (const float*)(c.act0 + A_CST), (const float*)(c.act0 + A_DEC), (const bf16*)(c.act0 + A_Z), (bf16*)(c.act0 + A_Z), c.tid, c.wave, c.lane); }
__device__ __forceinline__ void ph_c(const Args& a, const int wv, int l, LAS unsigned char* lds) { const Ctx c = make_ctx(a, wv, lds);
    pg8::Gemm g{(const bf16*)(c.act0 + A_Z), (const bf16*)(slot_of(c, l) + SL_WBR), 3 * M, 3 * D, 512}; BranchOrder S{c.G, c.bx}; EpiC E{(const bf16*)(c.act0 + A_G), (bf16*)(c.act0 + A_MERGED)};
    for (int rep = 0; rep < 1 + (PROBE == 7); ++rep) pg8::gemm_phase<EpiC, BranchOrder, true, true>(lds, g, S, E, wv); }
__device__ __forceinline__ void ph_res(const Args& a, const int wv, const bf16* A, const bf16* Bt, int K, int dup, int l, int ph, bool drain, LAS unsigned char* lds) { const Ctx c = make_ctx(a, wv, lds);
    pg8::Gemm g{A, Bt, M, D, K}; pg8::StaticOrder S; S.init(M, D, c.G, c.bx);
    if (dup == 2) { EpiNull<true> EN_{(float*)(c.ws + WS_END)}; pg8::gemm_phase<EpiNull<true>, pg8::StaticOrder, true, true>(lds, g, S, EN_, wv); }
    if (dup == 3) { EpiResT<1> E{(const bf16*)(c.ws + WS_XB), (bf16*)(c.ws + WS_END), (float*)(c.ws + WS_END + 32 * MiB)}; pg8::gemm_phase<EpiResT<1>, pg8::StaticOrder, true, true>(lds, g, S, E, wv); }
    if (dup == 4) { EpiResT<2> E{(const bf16*)(c.ws + WS_XB), (bf16*)(c.ws + WS_END), (float*)(c.ws + WS_END + 32 * MiB)}; pg8::gemm_phase<EpiResT<2>, pg8::StaticOrder, true, true>(lds, g, S, E, wv); }
    if (dup == 1) { EpiRes E{(const bf16*)(c.ws + WS_XB), (bf16*)(c.ws + WS_END), (float*)(c.ws + WS_END + 32 * MiB)}; pg8::gemm_phase<EpiRes, pg8::StaticOrder, true, true>(lds, g, S, E, wv); }
    if (drain) { pg8::Unit u0; for (int i = 0; S.next(i, u0); ++i) ffn_fixup(u0.pm, (const float*)(c.act0 + A_HT), (bf16*)(c.act0 + A_ACT), a.in.p[17] + (size_t)l * 3 * DFF2, a.in.p[18] + (size_t)l * DFF2, c.tid); }
    EpiRes E{(const bf16*)(c.ws + WS_XB), (bf16*)(c.ws + WS_XB), (float*)(c.ws + WS_SSQ)};
    pg8::gemm_phase<EpiRes, pg8::StaticOrder, true, true>(lds, g, S, E, wv);
    if (drain) { const Ctx c2 = make_ctx(a, wv, lds); tail_convert(a, c2, l, ph, true, true, lds); } }
__device__ __forceinline__ void ph_e(const Args& a, const int wv, int l, int ph, LAS unsigned char* lds) { const Ctx c = make_ctx(a, wv, lds);
    pg8::Gemm g{(const bf16*)(c.ws + WS_XB), (const bf16*)(slot_of(c, l) + SL_WUP), M, DFF2, D}; pg8::StaticOrder S; S.init(M, DFF2, c.G, c.bx);
    const bool tbl = (c.G == 256); if (tbl) rstd_table_fill((const float*)(c.ws + WS_SSQ), c.bx & 7, lds, c.tid);
    EpiUpConv E{c.ws, a.in.p[17] + (size_t)l * 3 * DFF2, a.in.p[18] + (size_t)l * DFF2, lds, tbl};
    for (int rep = 0; rep < 1 + (PROBE == 8); ++rep) pg8::gemm_phase<EpiUpConv, pg8::StaticOrder, true, true>(lds, g, S, E, wv);
    { const Ctx c2 = make_ctx(a, wv, lds); tail_convert(a, c2, l, ph, false, ((DFF2 / 256) * 64 - 1) / c2.G * c2.G + c2.bx >= (DFF2 / 256) * 64, lds); } }
__device__ __forceinline__ void ph_e2(const Args& a, const int wv, int l, LAS unsigned char* lds) { const Ctx c = make_ctx(a, wv, lds);
    for (int rep = 0; rep < 1 + (PROBE == 9); ++rep)
    for (int it = c.bx * NTHREADS + c.tid; it < 1024 * 352; it += c.G * NTHREADS) ffn_act_item(it, (const bf16*)(c.act0 + A_HUP), (bf16*)(c.act0 + A_ACT), a.in.p[17] + (size_t)l * 3 * DFF2, a.in.p[18] + (size_t)l * DFF2); }
__device__ __forceinline__ void ph_fin(const Args& a, const int wv, LAS unsigned char* lds) { const Ctx c = make_ctx(a, wv, lds); final_norm((const bf16*)(c.ws + WS_XB), c.X, (const float*)(c.ws + WS_SSQ), a.in.p[20], c.gw, c.ngw, c.lane); }

#ifndef PHMASK
#define PHMASK 0xFFFF
#endif
#define EN(b) ((PHMASK >> (b)) & 1)
__global__ void __launch_bounds__(NTHREADS, 2) mk_fwd(Args args) {
    extern __shared__ __attribute__((aligned(16))) unsigned char lds_raw[];
    LAS unsigned char* lds = (LAS unsigned char*)lds_raw;
    const int wv = __builtin_amdgcn_readfirstlane(threadIdx.x >> 6);
#ifdef TSUB
    if (threadIdx.x == 0) *TS_SLOT = 0ull;
#endif
    const int lo = args.ph_lo, hi = args.ph_hi;
#define IN(k) (lo <= (k) && (k) < hi)
#if MK_ONE_LAUNCH
    volatile LAS unsigned* bst = (volatile LAS unsigned*)(lds + BST_OFF);
    if (threadIdx.x < 4) bst[threadIdx.x] = 0u;
    __syncthreads();
    const XcdBarrier bar = xcd_barrier_post((unsigned*)(args.ws + WS_CTL) + CW_BAR, bst);
    __syncthreads();
    const unsigned my_rank = bst[2];
    __syncthreads();
    if (threadIdx.x == 0) bst[2] = blockIdx.x;
    __syncthreads();
#define SEAM_GLOBAL(k) ((k) == 1 || ((k) % 7) == 0)
#define SEAM(k) do { if (IN(k) && IN((k) + 1)) { \
        if ((k) == 0) { cg::this_grid().sync(); \
            if (threadIdx.x == 0) { unsigned* bw = (unsigned*)(args.ws + WS_CTL) + CW_BAR; unsigned nloc_ = 1u, nx_ = 1u; xcd_barrier_complete(bw, bar.x, nloc_, nx_);     \
                bool u32 = (gridDim.x == 256u) && xb_ld(&bw[XB_TMO]) == 0u; \
                for (unsigned j = 0; j < 16; ++j) { const unsigned c_ = xb_ld(&bw[XB_XCNT(j)]); if (j < 8 ? c_ != 32u : c_ != 0u) u32 = false; } \
                bst[0] = nloc_; bst[1] = nx_; bst[3] = u32 ? 1u : 0u; bst[2] = u32 ? my_rank * 8u + bar.x : blockIdx.x; } \
            __syncthreads(); } \
        else if (SEAM_GLOBAL(k) || bst[3] == 0u) xcd_barrier(bar); else xcd_barrier_local(bar); } } while (0)
#else
#define SEAM(k) do { } while (0)
#endif
#ifdef TPROBE
    unsigned long long tp_acc = 0ull, tp_prev = __builtin_amdgcn_s_memrealtime();
#define TP_MARK(kind) do { const unsigned long long t_ = __builtin_amdgcn_s_memrealtime(); if ((kind) == TPROBE) tp_acc += t_ - tp_prev; tp_prev = t_; } while (0)
#else
#define TP_MARK(kind) do { } while (0)
#endif
    int ph = 0;
    if (EN(0) && IN(ph)) ph_p0(args, wv, lds);
    SEAM(ph); ++ph; TP_MARK(0);
    for (int l = 0; l < DEPTH; ++l) {
        if (EN(1) && IN(ph)) ph_a(args, wv, l, ph, lds);
        SEAM(ph); ++ph; TP_MARK(1);
        if (EN(2) && IN(ph)) ph_b1(args, wv, l, lds);
        SEAM(ph); ++ph; TP_MARK(2);
        if (EN(3) && IN(ph)) ph_b2(args, wv, l, ph, lds);
        SEAM(ph); ++ph; TP_MARK(3);
        if (EN(4) && IN(ph)) ph_c(args, wv, l, lds);
        SEAM(ph); ++ph; TP_MARK(4);
        if (EN(5) && IN(ph)) { size_t z = 0; LAUNDER_S(z); unsigned char* ws = args.ws + z; ph_res(args, wv, (const bf16*)(ws + WS_ACT0 + A_MERGED), (const bf16*)(ws + WS_SLOT0 + (size_t)(l & 1) * SL_BYTES + SL_WO), D, PROBE == 10 ? 1 : (PROBE == 22 ? 2 : (PROBE == 31 ? 3 : (PROBE == 32 ? 4 : 0))), l, ph, false, lds); }
        SEAM(ph); ++ph; TP_MARK(5);
        if (EN(6) && IN(ph)) ph_e(args, wv, l, ph, lds);
        SEAM(ph); ++ph; TP_MARK(6);
        if (EN(8) && IN(ph)) { size_t z = 0; LAUNDER_S(z); unsigned char* ws = args.ws + z; ph_res(args, wv, (const bf16*)(ws + WS_ACT0 + A_ACT), (const bf16*)(ws + WS_SLOT0 + (size_t)(l & 1) * SL_BYTES + SL_WDN), DFF, PROBE == 11 ? 1 : (PROBE == 23 ? 2 : 0), l, ph, true, lds); }
        SEAM(ph); ++ph; TP_MARK(7);
    }
    if (EN(9) && IN(ph)) ph_fin(args, wv, lds);
#ifdef TSUB
    if (blockIdx.x == 7 && threadIdx.x == 0) { const unsigned long long tt = *TS_SLOT; const unsigned long long t0 = __builtin_amdgcn_s_memrealtime(); while (__builtin_amdgcn_s_memrealtime() - t0 < 10ull * tt) __builtin_amdgcn_s_sleep(8); }
#endif
#ifdef TPROBE
    TP_MARK(8);
    if (blockIdx.x == 0 && wv == 0) { const unsigned long long t0 = __builtin_amdgcn_s_memrealtime(); while (__builtin_amdgcn_s_memrealtime() - t0 < 10ull * tp_acc) __builtin_amdgcn_s_sleep(8); }
#endif
#undef IN
#undef SEAM
}

extern "C" void kernel_launch(void* const* d_in, const int* in_sizes, int n_in, void* d_out, int out_size, void* d_ws, size_t ws_size, hipStream_t stream) {
    static int grid = 0;
    if (grid == 0) {
        if (n_in != 21 || out_size != M * D || ws_size < WS_END + (PROBE ? 64 * MiB : 0)) { fprintf(stderr, "kernel_launch: unexpected shapes / workspace (%zu < %zu)\n", ws_size, (size_t)WS_END); grid = -1; return; }
        int dev = 0, cus = 0, per_cu = 0;
        if (hipGetDevice(&dev) != hipSuccess || hipDeviceGetAttribute(&cus, hipDeviceAttributeMultiprocessorCount, dev) != hipSuccess) { grid = -1; return; }
        if (hipFuncSetAttribute((const void*)mk_fwd, hipFuncAttributeMaxDynamicSharedMemorySize, LDS_BYTES) != hipSuccess) { fprintf(stderr, "kernel_launch: hipFuncSetAttribute failed\n"); grid = -1; return; }
        if (hipOccupancyMaxActiveBlocksPerMultiprocessor(&per_cu, (const void*)mk_fwd, NTHREADS, LDS_BYTES) != hipSuccess || per_cu < 1) { fprintf(stderr, "kernel_launch: occupancy query says %d\n", per_cu); per_cu = 1; }
        (void)hipGetLastError();
        grid = cus * 1;
    }
    if (grid < 0) return;
#if MK_ONE_LAUNCH
    if (hipMemsetAsync((char*)d_ws + WS_CTL, 0, 65536, stream) != hipSuccess) { fprintf(stderr, "kernel_launch: memset failed\n"); return; }
#endif
    Args a{};
    for (int i = 0; i < 21; ++i) a.in.p[i] = (const float*)d_in[i];
    a.out = (float*)d_out; a.ws = (unsigned char*)d_ws;
#if MK_ONE_LAUNCH
    a.ph_lo = 0; a.ph_hi = NPHASE;
    void* kargs[] = {&a};
    hipError_t e = hipLaunchCooperativeKernel((const void*)mk_fwd, dim3(grid), dim3(NTHREADS), kargs, LDS_BYTES, stream);
    if (e != hipSuccess) fprintf(stderr, "kernel_launch: cooperative launch failed: %s (grid %d)\n", hipGetErrorString(e), grid);
#else
    for (int p = 0; p < NPHASE; ++p) { a.ph_lo = p; a.ph_hi = p + 1; hipLaunchKernelGGL(mk_fwd, dim3(grid), dim3(NTHREADS), LDS_BYTES, stream, a); }
#endif
}
```

```cpp
#include <hip/hip_runtime.h>
#include <hip/hip_cooperative_groups.h>
#include <cstdio>
#include <cstdint>
#include <cmath>
namespace cg = cooperative_groups;

#ifndef MK_ONE_LAUNCH
#define MK_ONE_LAUNCH 1
#endif

namespace cfg {
constexpr int D = 1024, BATCH = 8, SEQ = 2048, DEPTH = 4, M = BATCH * SEQ;
constexpr int GH = 4, GDK = 64, GDV = 128, GKEY = 256, GVAL = 512, GRANK = 16;
constexpr int SGW = 512, SGC = 128, CW = 512, DFF = 2816, DFF2 = 5632;
constexpr int INC = 7184, NIN = 7424;
constexpr int O_Q = 0, O_K = 256, O_V = 512, O_G = 1024, O_A = 1536, O_SU = 1552, O_SV = 2064, O_CB = 2576, O_CC = 3088, O_CX = 3600, O_GT = 4112;
constexpr float EPS = 1e-6f;
}
using namespace cfg;

namespace pg8 {
#define PG8_LAS __attribute__((address_space(3)))
typedef unsigned short bf16_t;
typedef short bf16x8 __attribute__((ext_vector_type(8)));
typedef float f32x4 __attribute__((ext_vector_type(4)));
typedef unsigned u32x4 __attribute__((ext_vector_type(4)));
constexpr int BM = 256, BK = 64, HALF = 128, HTB = HALF * BK * 2  , STAGE_BYTES = 8 * HTB, NXCD = 8, WGM = 8;

__host__ __device__ __forceinline__ int lds_byte(int r, int c) { const int st = (r >> 4) * 2 + (c >> 5), rr = r & 15, cc = c & 31, ob = rr * 64 + cc * 2; return st * 1024 + (ob ^ (((ob >> 9) & 1) << 5)); }
__host__ __device__ __forceinline__ void stage_rc(int b, int& R, int& C) { const int st = b / 1024, sb = b % 1024, swz = sb ^ (((sb >> 9) & 1) << 5); R = (st >> 1) * 16 + swz / 64; C = (st & 1) * 32 + (swz % 64) / 2; }
__host__ __device__ __forceinline__ int perm32(int rho) { const int n = rho >> 4, i = rho & 15; return 8 * (i >> 2) + 4 * n + (i & 3); }

struct Unit { int pm, pn; };
struct Gemm { const bf16_t* A; const bf16_t* Bt; int M, N, K; };

struct StaticOrder {
    int nM, nN, nwg, G, c;
    __host__ __device__ void init(int M, int N, int G_, int c_) { nM = M / BM; nN = N / BM; nwg = nM * nN; G = G_; c = c_; }
    __host__ __device__ bool next(int i, Unit& u) const {
        const long L = (long)i * G + c; if (L >= nwg) return false;
        int wgid = (int)L; { const int q = nwg / NXCD, r = nwg % NXCD, xcd = wgid % NXCD, off = wgid / NXCD; wgid = (xcd < r ? xcd * (q + 1) : r * (q + 1) + (xcd - r) * q) + off; }
        const int nig = WGM * nN, gid = wgid / nig, fm = gid * WGM, gsz = (nM - fm) < WGM ? (nM - fm) : WGM;
        u.pm = fm + ((wgid % nig) % gsz); u.pn = (wgid % nig) / gsz; return true;
    }
    __device__ __forceinline__ void a_ready(const Unit&) const {}
    __device__ __forceinline__ void done(const Unit&) const {}
};

__device__ __forceinline__ unsigned cvt_pk_bf16(float lo, float hi) { unsigned r; asm volatile("v_cvt_pk_bf16_f32 %0, %1, %2" : "=v"(r) : "v"(lo), "v"(hi)); return r; }
typedef float f32x2 __attribute__((ext_vector_type(2)));
#ifdef TSUB
#define PG8_TS_BEGIN(k) unsigned long long ts_b_ = 0; if ((k) == TSUB) ts_b_ = __builtin_amdgcn_s_memrealtime()
#define PG8_TS_END(k) do { if ((k) == TSUB && blockIdx.x == 7 && tid == 0) *(PG8_LAS unsigned long long*)(lds + 131072 + 640) += __builtin_amdgcn_s_memrealtime() - ts_b_; } while (0)
#else
#define PG8_TS_BEGIN(k) do { } while (0)
#define PG8_TS_END(k) do { } while (0)
#endif
template <class Epi, class Sched, bool ALIGN_EPI = false, bool SP2 = false>
__device__ __forceinline__ void gemm_phase(PG8_LAS unsigned char* lds, const Gemm g, const Sched& S, const Epi& E, const int wave_id) {
    int ln__; asm volatile("v_mbcnt_lo_u32_b32 %0, -1, 0\n\tv_mbcnt_hi_u32_b32 %0, -1, %0" : "=v"(ln__));
    const int tid_ = ln__ + 64 * wave_id;
    const int tid = tid_, wid = __builtin_amdgcn_readfirstlane(tid >> 6), lane = tid & 63, wr = wid >> 2, wc = wid & 3, fr = lane & 15, fq = lane >> 4;
    const int K = g.K, nt = K / BK;
    unsigned voffA[2], voffB[2];
#pragma unroll
    for (int i = 0; i < 2; ++i) { int R, C; stage_rc(tid * 16 + i * 8192, R, C); const int Rb = Epi::PERM ? ((R & ~31) + perm32(R & 31)) : R;
        voffA[i] = (unsigned)(R * K + C) * 2u; voffB[i] = (unsigned)(Rb * K + C) * 2u; }
    const size_t kstep = (size_t)(BK * 2);
    const size_t hstep = (size_t)HALF * K * 2;
    const size_t tstep = 2 * hstep;
    const unsigned ldsw = (unsigned)wid * 1024u;
    const int aoff = lds_byte(wr * 64 + fr, fq * 8), boff = lds_byte(wc * 32 + fr, fq * 8);
#define PG8_SA(b, h) (((b) * 2 + (h)) * HTB)
#define PG8_SB(b, h) ((4 + (b) * 2 + (h)) * HTB)
#define PG8_STAGE(bufoff, gbase, voff) do { _Pragma("unroll") for (int _i = 0; _i < 2; ++_i) \
        __builtin_amdgcn_global_load_lds((const unsigned*)((const char*)(gbase) + (voff)[_i]), (PG8_LAS unsigned*)(lds + (bufoff) + ldsw + _i * 8192), 16, 0, 0); } while (0)
#define PG8_LDA(dst, b, h) do { _Pragma("unroll") for (int m = 0; m < 4; ++m) _Pragma("unroll") for (int k = 0; k < 2; ++k) dst[m][k] = *(const PG8_LAS bf16x8*)(lds + PG8_SA(b, h) + aoff + m * 2048 + k * 1024); } while (0)
#define PG8_LDB(dst, b, h) do { _Pragma("unroll") for (int n = 0; n < 2; ++n) _Pragma("unroll") for (int k = 0; k < 2; ++k) dst[n][k] = *(const PG8_LAS bf16x8*)(lds + PG8_SB(b, h) + boff + n * 2048 + k * 1024); } while (0)
#define PG8_MMA(ai, bj, At, Bt) do { __builtin_amdgcn_s_setprio(1); _Pragma("unroll") for (int m = 0; m < 4; ++m) _Pragma("unroll") for (int n = 0; n < 2; ++n) _Pragma("unroll") for (int k = 0; k < 2; ++k) \
        acc[ai][bj][m][n] = __builtin_amdgcn_mfma_f32_16x16x32_bf16(Bt[n][k], At[m][k], acc[ai][bj][m][n], 0, 0, 0); __builtin_amdgcn_s_setprio(0); } while (0)
#define PG8_WAIT_V(n) asm volatile("s_waitcnt vmcnt(" #n ")" ::: "memory")
#define PG8_WAIT_L(n) asm volatile("s_waitcnt lgkmcnt(" #n ")" ::: "memory")
#define PG8_BAR __builtin_amdgcn_s_barrier()
#define PG8_SCHED __builtin_amdgcn_sched_barrier(0)
    Unit cur, nxt; int ui = 0;
    if (!S.next(0, cur)) return;
    f32x4 acc[2][2][4][2];
#pragma unroll
    for (int a = 0; a < 2; ++a)
#pragma unroll
        for (int b = 0; b < 2; ++b)
#pragma unroll
            for (int m = 0; m < 4; ++m)
#pragma unroll
                for (int n = 0; n < 2; ++n) acc[a][b][m][n] = (f32x4){0.f, 0.f, 0.f, 0.f};
    bf16x8 At[4][2], B0[2][2], B1[2][2];
    const char* cA = (const char*)g.A + (size_t)cur.pm * tstep; const char* cB = (const char*)g.Bt + (size_t)cur.pn * tstep;
    S.a_ready(cur);
    if constexpr (SP2) {
        PG8_STAGE(PG8_SB(0, 0), cB, voffB); PG8_STAGE(PG8_SB(0, 1), cB + hstep, voffB); PG8_STAGE(PG8_SA(0, 0), cA, voffA); PG8_STAGE(PG8_SA(0, 1), cA + hstep, voffA);
        if (wr == 1) PG8_BAR;
        PG8_WAIT_V(2); PG8_BAR;
        PG8_STAGE(PG8_SB(1, 0), cB + kstep, voffB); PG8_STAGE(PG8_SA(1, 0), cA + kstep, voffA); PG8_STAGE(PG8_SB(1, 1), cB + hstep + kstep, voffB);
        PG8_WAIT_V(6); PG8_BAR;
    } else {
        PG8_STAGE(PG8_SB(0, 0), cB, voffB); PG8_STAGE(PG8_SA(0, 0), cA, voffA); PG8_STAGE(PG8_SB(0, 1), cB + hstep, voffB); PG8_STAGE(PG8_SA(0, 1), cA + hstep, voffA);
        if (wr == 1) PG8_BAR;
        PG8_WAIT_V(4); PG8_BAR;
        PG8_STAGE(PG8_SB(1, 0), cB + kstep, voffB); PG8_STAGE(PG8_SA(1, 0), cA + kstep, voffA); PG8_STAGE(PG8_SB(1, 1), cB + hstep + kstep, voffB);
        PG8_WAIT_V(6); PG8_BAR;
    }
    for (;;) {
        const bool has_next = S.next(ui + 1, nxt);
        const char* nA = has_next ? (const char*)g.A + (size_t)nxt.pm * tstep : cA; const char* nB = has_next ? (const char*)g.Bt + (size_t)nxt.pn * tstep : cB;
        for (int t = 0; t < nt; t += 2) {
            const bool last = (t == nt - 2);
            const char* a1 = cA + (size_t)(t + 1) * kstep;
            const char* a2 = last ? nA : cA + (size_t)(t + 2) * kstep; const char* b2 = last ? nB : cB + (size_t)(t + 2) * kstep;
            const char* a3 = a2 + kstep; const char* b3 = b2 + kstep;
            if (last && has_next) S.a_ready(nxt);
            if constexpr (SP2) {
            PG8_LDB(B0, 0, 0); PG8_LDB(B1, 0, 1); PG8_SCHED; PG8_LDA(At, 0, 0); PG8_STAGE(PG8_SA(1, 1), a1 + hstep, voffA);
            PG8_WAIT_V(8); PG8_WAIT_L(0); PG8_BAR; PG8_MMA(0, 0, At, B0); PG8_MMA(0, 1, At, B1); PG8_BAR; PG8_SCHED;
            PG8_LDA(At, 0, 1); PG8_STAGE(PG8_SB(0, 0), b2, voffB); PG8_STAGE(PG8_SB(0, 1), b2 + hstep, voffB); PG8_STAGE(PG8_SA(0, 0), a2, voffA);
            PG8_WAIT_V(8); PG8_WAIT_L(0); PG8_BAR; PG8_MMA(1, 0, At, B0); PG8_MMA(1, 1, At, B1); PG8_BAR; PG8_SCHED;
            PG8_LDB(B0, 1, 0); PG8_LDB(B1, 1, 1); PG8_SCHED; PG8_LDA(At, 1, 0); PG8_STAGE(PG8_SA(0, 1), a2 + hstep, voffA);
            PG8_WAIT_V(8); PG8_WAIT_L(0); PG8_BAR; PG8_MMA(0, 0, At, B0); PG8_MMA(0, 1, At, B1); PG8_BAR; PG8_SCHED;
            PG8_LDA(At, 1, 1); PG8_STAGE(PG8_SB(1, 0), b3, voffB); PG8_STAGE(PG8_SB(1, 1), b3 + hstep, voffB); PG8_STAGE(PG8_SA(1, 0), a3, voffA);
            PG8_WAIT_V(8); PG8_WAIT_L(0); PG8_BAR; PG8_MMA(1, 0, At, B0); PG8_MMA(1, 1, At, B1); PG8_BAR; PG8_SCHED;
            } else {
            PG8_LDB(B0, 0, 0); PG8_SCHED; PG8_LDA(At, 0, 0); PG8_STAGE(PG8_SA(1, 1), a1 + hstep, voffA);
            PG8_WAIT_L(8); PG8_BAR; PG8_WAIT_L(0); PG8_MMA(0, 0, At, B0); PG8_BAR; PG8_SCHED;
            PG8_LDB(B1, 0, 1); PG8_STAGE(PG8_SB(0, 0), b2, voffB);
            PG8_BAR; PG8_WAIT_L(0); PG8_MMA(0, 1, At, B1); PG8_BAR;
            PG8_LDA(At, 0, 1); PG8_STAGE(PG8_SA(0, 0), a2, voffA);
            PG8_BAR; PG8_WAIT_L(0); PG8_MMA(1, 0, At, B0); PG8_BAR; PG8_SCHED;
            PG8_STAGE(PG8_SB(0, 1), b2 + hstep, voffB);
            PG8_WAIT_V(6); PG8_BAR; PG8_MMA(1, 1, At, B1); PG8_BAR;
            PG8_LDB(B0, 1, 0); PG8_SCHED; PG8_LDA(At, 1, 0); PG8_STAGE(PG8_SA(0, 1), a2 + hstep, voffA);
            PG8_WAIT_L(8); PG8_BAR; PG8_WAIT_L(0); PG8_MMA(0, 0, At, B0); PG8_BAR; PG8_SCHED;
            PG8_LDB(B1, 1, 1); PG8_STAGE(PG8_SB(1, 0), b3, voffB);
            PG8_BAR; PG8_WAIT_L(0); PG8_MMA(0, 1, At, B1); PG8_BAR;
            PG8_LDA(At, 1, 1); PG8_STAGE(PG8_SA(1, 0), a3, voffA);
            PG8_BAR; PG8_WAIT_L(0); PG8_MMA(1, 0, At, B0); PG8_BAR; PG8_SCHED;
            PG8_STAGE(PG8_SB(1, 1), b3 + hstep, voffB);
            PG8_WAIT_V(6); PG8_BAR; PG8_MMA(1, 1, At, B1); PG8_BAR;
            }
        }
        if constexpr (ALIGN_EPI) { if (wr == 0) PG8_BAR; }
        if constexpr (!Epi::AFTER_DRAIN) { PG8_TS_BEGIN(Epi::TSID); E(acc, cur, wr, wc, fr, fq); PG8_TS_END(Epi::TSID); S.done(cur); }
        if (!has_next) break;
#pragma unroll
        for (int a = 0; a < 2; ++a)
#pragma unroll
            for (int b = 0; b < 2; ++b)
#pragma unroll
                for (int m = 0; m < 4; ++m)
#pragma unroll
                    for (int n = 0; n < 2; ++n) acc[a][b][m][n] = (f32x4){0.f, 0.f, 0.f, 0.f};
        cur = nxt; cA = nA; cB = nB; ++ui;
        if constexpr (ALIGN_EPI) { if (wr == 1) PG8_BAR; }
    }
    PG8_WAIT_V(0);
    if constexpr (!ALIGN_EPI) { if (wr == 0) PG8_BAR; }
    PG8_BAR;
    if constexpr (Epi::AFTER_DRAIN) { E.fused(acc, cur, wr, wc, fr, fq, lds, wid, lane); S.done(cur); }
#undef PG8_SA
#undef PG8_SB
#undef PG8_STAGE
#undef PG8_LDA
#undef PG8_LDB
#undef PG8_MMA
#undef PG8_WAIT_V
#undef PG8_WAIT_L
#undef PG8_BAR
#undef PG8_SCHED
}
}

#define GAS __attribute__((address_space(1)))
#define LAS __attribute__((address_space(3)))
typedef unsigned short bf16;
typedef unsigned v4u __attribute__((ext_vector_type(4)));
typedef unsigned v2u __attribute__((ext_vector_type(2)));
typedef float f32x4 __attribute__((ext_vector_type(4)));
typedef float f32x2 __attribute__((ext_vector_type(2)));
typedef short bf16x8 __attribute__((ext_vector_type(8)));
constexpr int NWAVES = 8, NTHREADS = 512;
constexpr int RING_BYTES = 131072, LDS_BYTES = 153600;
constexpr int RST_OFF = RING_BYTES + 10240;

constexpr size_t MiB = 1u << 20;
constexpr size_t SL_WIN = 0, SL_WBR = SL_WIN + (size_t)NIN * D * 2, SL_WO = SL_WBR + (size_t)3 * D * 512 * 2, SL_WUP = SL_WO + (size_t)D * D * 2,
                 SL_WDN = SL_WUP + (size_t)DFF2 * D * 2, SL_SGW = SL_WDN + (size_t)D * DFF * 2, SL_END = SL_SGW + (size_t)4 * 128 * 128 * 2, SL_BYTES = 38 * MiB;
static_assert(SL_END <= SL_BYTES, "weight slot");
constexpr size_t WS_CTL = 0, WS_SLOT0 = 1 * MiB, WS_XB = WS_SLOT0 + 2 * SL_BYTES, WS_SSQ = WS_XB + 32 * MiB, WS_SVST = WS_SSQ + 1 * MiB, WS_ACT0 = WS_SVST + 1 * MiB;
constexpr size_t A_Q = 0, A_K = 8 * MiB, A_V = 16 * MiB, A_Z = 32 * MiB, A_SV = 80 * MiB, A_CC = 96 * MiB, A_CX = 112 * MiB, A_LOGA = 128 * MiB, A_G = 144 * MiB,
                 A_CST = 240 * MiB, A_DEC = 272 * MiB, A_END = 273 * MiB;
constexpr size_t A_MERGED = A_Q, A_HUP = 0, A_ACT = 176 * MiB, A_HT = 64 * MiB;
static_assert(A_ACT + (size_t)M * DFF * 2 <= A_END, "overlay");
constexpr size_t WS_END = WS_ACT0 + A_END;
constexpr int CW_BAR = 1024, CW_QHEAD = 6144, CW_FIN = 8192;

__device__ __forceinline__ float bf2f(unsigned h) { return __uint_as_float(h << 16); }
__device__ __forceinline__ unsigned pk2(float lo, float hi) { return pg8::cvt_pk_bf16(lo, hi); }
__device__ __forceinline__ float fsigmoid(float z) { return __builtin_amdgcn_rcpf(1.f + __expf(-z)); }
__device__ __forceinline__ float fsilu(float z) { return z * fsigmoid(z); }
__device__ __forceinline__ float fgelu(float z) { return z * fsigmoid(1.5957691216057308f * (z + 0.044715f * z * z * z)); }
__device__ __forceinline__ float flogsig(float z) { return fminf(z, 0.f) - __logf(1.f + __expf(-fabsf(z))); }
__device__ __forceinline__ float wave_sum(float v) {
#pragma unroll
    for (int o = 1; o < 64; o <<= 1) v += __shfl_xor(v, o);
    return v;
}
#define LDS_WAIT() asm volatile("s_waitcnt lgkmcnt(0)" ::: "memory")
#define LDS_BARRIER() do { asm volatile("s_waitcnt lgkmcnt(0)" ::: "memory"); __builtin_amdgcn_s_barrier(); asm volatile("" ::: "memory"); } while (0)
__device__ __forceinline__ f32x4 mfma16(bf16x8 a, bf16x8 b, f32x4 c) { return __builtin_amdgcn_mfma_f32_16x16x32_bf16(a, b, c, 0, 0, 0); }

__device__ __forceinline__ void tr_write(bf16* WT, int K, int k0, LAS float* scr, int lane) {
    LDS_WAIT(); asm volatile("" ::: "memory");
    const int c = lane & 7;
#pragma unroll
    for (int j = 0; j < 4; ++j) { const int n = (lane >> 3) + 8 * j; const LAS float* s = scr + (8 * c) * 33 + n;
        v4u o; o.x = pk2(s[0 * 33], s[1 * 33]); o.y = pk2(s[2 * 33], s[3 * 33]); o.z = pk2(s[4 * 33], s[5 * 33]); o.w = pk2(s[6 * 33], s[7 * 33]);
        *(GAS v4u*)(WT + (size_t)n * K + k0 + 8 * c) = o; }
    LDS_WAIT(); asm volatile("" ::: "memory");
}
__device__ __forceinline__ void tr_item(const float* W, int ldw, int col0, const float* ksc, float sc, bf16* WT, int K, int k0, LAS float* scr, int lane) {
    float v[32]; const float* src = W + (size_t)(k0 + (lane >> 5)) * ldw + col0 + (lane & 31);
#pragma unroll
    for (int i = 0; i < 32; ++i) v[i] = src[(size_t)(2 * i) * ldw];
    if (ksc) {
#pragma unroll
        for (int i = 0; i < 32; ++i) v[i] *= ksc[k0 + 2 * i + (lane >> 5)]; }
#pragma unroll
    for (int i = 0; i < 32; ++i) scr[(2 * i + (lane >> 5)) * 33 + (lane & 31)] = v[i] * sc;
    tr_write(WT, K, k0, scr, lane);
}
__device__ __forceinline__ void alpha_item(const float* win, const float* wal, const float* g, bf16* WT, int k0, int j0, LAS float* scr, int lane) {
    const int jj = lane & 31, half = lane >> 5; float wa[16];
#pragma unroll
    for (int r = 0; r < 16; ++r) wa[r] = wal[r * GKEY + j0 + jj];
    for (int i = 0; i < 32; ++i) { const int kk = 2 * i + half, k = k0 + kk; const float* wr = win + (size_t)k * INC + O_A; float s = 0.f;
#pragma unroll
        for (int r = 0; r < 16; ++r) s += wr[r] * wa[r];
        scr[kk * 33 + jj] = s * g[k]; }
    tr_write(WT + (size_t)j0 * D, D, k0, scr, lane);
}
struct Inputs { const float* p[21]; };
constexpr int CV_J0 = 16 * 224, CV_J1 = 16 * 8, CV_J2 = 3 * 8 * 32, CV_J3 = 16 * 32, CV_J4 = 16 * 176, CV_J5 = 44 * 32, CV_J6 = 128, CV_ITEMS = CV_J0 + CV_J1 + CV_J2 + CV_J3 + CV_J4 + CV_J5 + CV_J6;
constexpr int CV_WIN_ITEMS = CV_J0 + CV_J1;
__device__ __forceinline__ void convert_item(const Inputs& I, int l, unsigned char* slot, LAS float* scr, int it, int lane) {
    bf16* WIN = (bf16*)(slot + SL_WIN); bf16* WBR = (bf16*)(slot + SL_WBR); bf16* WO = (bf16*)(slot + SL_WO); bf16* WUP = (bf16*)(slot + SL_WUP); bf16* WDN = (bf16*)(slot + SL_WDN); bf16* SGWS = (bf16*)(slot + SL_SGW);
    const float* win = I.p[2] + (size_t)l * D * INC;
        int r = it;
        if (r < CV_J0) { const int kb = r / 224, nb = r % 224; const int drow = nb < 48 ? 32 * nb : 1792 + 32 * (nb - 48), scol = nb < 48 ? 32 * nb : O_SU + 32 * (nb - 48);
            tr_item(win, INC, scol, I.p[1] + (size_t)l * D, drow < 256 ? 0.125f : 1.f, WIN + (size_t)drow * D, D, 64 * kb, scr, lane); return; }
        r -= CV_J0;
        if (r < CV_J1) { const int kb = r / 8, jb = r % 8; alpha_item(win, I.p[3] + (size_t)l * GRANK * GKEY, I.p[1] + (size_t)l * D, WIN + (size_t)1536 * D, 64 * kb, 32 * jb, scr, lane); return; }
        r -= CV_J1;
        if (r < CV_J2) { const int br = r / 256, rr = r % 256, kb = rr / 32, nb = rr % 32;
            const float* W = (br == 0 ? I.p[6] : br == 1 ? I.p[11] : I.p[13]) + (size_t)l * 512 * D;
            tr_item(W, D, 32 * nb, br == 0 ? I.p[5] + (size_t)l * GVAL : nullptr, 1.f, WBR + ((size_t)br * D + 32 * nb) * 512, 512, 64 * kb, scr, lane); return; }
        r -= CV_J2;
        if (r < CV_J3) { const int kb = r / 32, nb = r % 32; tr_item(I.p[14] + (size_t)l * D * D, D, 32 * nb, nullptr, 1.f, WO + (size_t)32 * nb * D, D, 64 * kb, scr, lane); return; }
        r -= CV_J3;
        if (r < CV_J4) { const int kb = r / 176, nb = r % 176, pn = nb / 8, jb = nb % 8; const int scol = jb < 4 ? 128 * pn + 32 * jb : DFF + 128 * pn + 32 * (jb - 4);
            tr_item(I.p[16] + (size_t)l * D * DFF2, DFF2, scol, I.p[15] + (size_t)l * D, 1.f, WUP + (size_t)32 * nb * D, D, 64 * kb, scr, lane); return; }
        r -= CV_J4;
        if (r < CV_J5) { const int kb = r / 32, nb = r % 32; tr_item(I.p[19] + (size_t)l * DFF * D, D, 32 * nb, nullptr, 1.f, WDN + (size_t)32 * nb * DFF, DFF, 64 * kb, scr, lane); return; }
        r -= CV_J5;
        { const int e0 = r * 512 + lane * 8, t = (e0 >> 7) & 127, s0 = e0 & 127; const float* src = I.p[9] + (size_t)l * 4 * 128 * 128 + e0;
          const f32x4 a = *(const f32x4*)src, b = *(const f32x4*)(src + 4); float v[8] = {a[0], a[1], a[2], a[3], b[0], b[1], b[2], b[3]};
#pragma unroll
          for (int e = 0; e < 8; ++e) if (s0 + e > t) v[e] = 0.f;
          v4u o; o.x = pk2(v[0], v[1]); o.y = pk2(v[2], v[3]); o.z = pk2(v[4], v[5]); o.w = pk2(v[6], v[7]); *(GAS v4u*)(SGWS + e0) = o; }
}
__device__ __forceinline__ void convert_static(const Inputs& I, int l, unsigned char* slot, LAS unsigned char* lds, int it_lo, int it_hi, int gw, int ngw, int wave, int lane) {
    LAS float* scr = (LAS float*)(lds + wave * 8448);
    for (int it = it_lo + gw; it < it_hi; it += ngw) convert_item(I, l, slot, scr, it, lane);
}
#define RLX_AGENT __ATOMIC_RELAXED, __HIP_MEMORY_SCOPE_AGENT
__device__ __forceinline__ void convert_queue(const Inputs& I, int l, unsigned char* slot, LAS unsigned char* lds, unsigned* head, int it_lo, int it_hi, unsigned* fin, int G, int tid, int wave, int lane) {
    LAS float* scr = (LAS float*)(lds + wave * 8448); volatile LAS unsigned* bc = (volatile LAS unsigned*)(lds + 8 * 8448);
    for (;;) {
        if (tid == 0) { unsigned v = 0xffffffffu; if (!fin || __hip_atomic_load(fin, RLX_AGENT) < (unsigned)G) v = __hip_atomic_fetch_add(head, 8u, RLX_AGENT); bc[0] = v; }
        LDS_BARRIER();
        const unsigned base = bc[0];
        LDS_BARRIER();
        if (base >= (unsigned)(it_hi - it_lo)) break;
        const int it = it_lo + (int)base + wave; if (it < it_hi) convert_item(I, l, slot, scr, it, lane);
    }
}
__device__ __forceinline__ void x_prep(const float* xin, bf16* xb, float* ssq, int gw, int ngw, int lane) {
    for (int row = gw; row < M; row += ngw) {
        const GAS f32x4* xr = (const GAS f32x4*)(xin + (size_t)row * D) + lane; f32x4 v[4]; float s = 0.f;
#pragma unroll
        for (int j = 0; j < 4; ++j) { v[j] = xr[64 * j]; s += (v[j][0] * v[j][0] + v[j][1] * v[j][1]) + (v[j][2] * v[j][2] + v[j][3] * v[j][3]); }
        s = wave_sum(s);
#pragma unroll
        for (int j = 0; j < 4; ++j) { v2u w; w.x = pk2(v[j][0], v[j][1]); w.y = pk2(v[j][2], v[j][3]); ((GAS v2u*)(xb + (size_t)row * D))[lane + 64 * j] = w; }
        if (lane < 16) ssq[(size_t)row * 16 + lane] = lane == 0 ? s : 0.f;
    }
}
__device__ __forceinline__ void final_norm(const bf16* xb, float* out, const float* ssq, const float* g, int gw, int ngw, int lane) {
    for (int row = gw; row < M; row += ngw) {
        const float pv = lane < 16 ? ssq[(size_t)row * 16 + lane] : 0.f; const float rs = rsqrtf(wave_sum(pv) * (1.f / D) + EPS);
        const GAS v2u* xr = (const GAS v2u*)(xb + (size_t)row * D) + lane; GAS f32x4* orow = (GAS f32x4*)(out + (size_t)row * D) + lane;
#pragma unroll
        for (int j = 0; j < 4; ++j) { const v2u w = xr[64 * j]; const f32x4 gv = ((const GAS f32x4*)g)[lane + 64 * j];
            orow[64 * j] = (f32x4){bf2f(w.x & 0xffffu) * rs * gv[0], bf2f(w.x >> 16) * rs * gv[1], bf2f(w.y & 0xffffu) * rs * gv[2], bf2f(w.y >> 16) * rs * gv[3]}; }
    }
}

constexpr int GP = 72;
constexpr int L_QT = 0, L_KT = 9216, L_KENDT = 18432, L_VT = 27648, L_ST = 46080, L_SEG = 64512, L_DECS = 66560, L_RED = 66816, L_GLA_END = 67328;
constexpr int VP = 136;

__device__ __forceinline__ void sgu_item(int item, LAS unsigned char* lds, const bf16* ZBI, bf16* ZBO, const bf16* SV, const float* SVST, const float* lng, const float* lnb, const bf16* wsb, const float* bs, int wave, int lane) {
    const int b_ = item & 7, h = (item >> 3) & 3, r0 = b_ * SEQ + (item >> 5) * 128; LAS bf16* vnT = (LAS bf16*)lds;
    const int fr = lane & 15, fq = lane >> 4, t = 16 * wave + fr, nks = (wave >> 1) + 1; const size_t orow = (size_t)r0 + t;
    bf16x8 bfr[4];
#pragma unroll
    for (int ks = 0; ks < 4; ++ks) bfr[ks] = (ks < nks) ? *(const bf16x8*)(wsb + ((size_t)h * 128 + t) * 128 + 32 * ks + 8 * fq) : (bf16x8){0, 0, 0, 0, 0, 0, 0, 0};
    v2u suv[8];
#pragma unroll
    for (int m = 0; m < 8; ++m) suv[m] = *(const v2u*)(ZBI + orow * 512 + h * 128 + 16 * m + 4 * fq);
    const float bias = bs[h * 128 + t];
    { const int d0 = 16 * wave, s0 = 2 * lane; float mean[2], rstd[2]; v4u xv[2][2];
#pragma unroll
      for (int rr = 0; rr < 2; ++rr) { const size_t row = (size_t)r0 + s0 + rr; const f32x4* p = (const f32x4*)(SVST + row * 16); const f32x4 a = p[0], b = p[1], c = p[2], d = p[3];
          const v4u* q = (const v4u*)(SV + row * 512 + h * 128 + d0); xv[rr][0] = q[0]; xv[rr][1] = q[1];
          const float sm = (a[0] + a[2]) + (b[0] + b[2]) + (c[0] + c[2]) + (d[0] + d[2]), sq = (a[1] + a[3]) + (b[1] + b[3]) + (c[1] + c[3]) + (d[1] + d[3]);
          mean[rr] = sm * (1.f / 512.f); rstd[rr] = rsqrtf(fmaxf(sq * (1.f / 512.f) - mean[rr] * mean[rr], 0.f) + EPS); }
      f32x4 gv[4], bv[4];
#pragma unroll
      for (int q4 = 0; q4 < 4; ++q4) { gv[q4] = *(const f32x4*)(lng + h * 128 + d0 + 4 * q4); bv[q4] = *(const f32x4*)(lnb + h * 128 + d0 + 4 * q4); }
#pragma unroll
      for (int j = 0; j < 16; ++j) { const float g = gv[j >> 2][j & 3], b = bv[j >> 2][j & 3]; const unsigned w0 = xv[0][j >> 3][(j >> 1) & 3], w1 = xv[1][j >> 3][(j >> 1) & 3];
          const float x0 = (j & 1) ? bf2f(w0 >> 16) : bf2f(w0 & 0xffffu), x1 = (j & 1) ? bf2f(w1 >> 16) : bf2f(w1 & 0xffffu);
          *(LAS unsigned*)(vnT + (d0 + j) * VP + s0) = pk2((x0 - mean[0]) * rstd[0] * g + b, (x1 - mean[1]) * rstd[1] * g + b); } }
    LDS_BARRIER();
    { f32x4 acc[8];
#pragma unroll
      for (int m = 0; m < 8; ++m) { acc[m] = (f32x4){0.f, 0.f, 0.f, 0.f};
#pragma unroll
          for (int ks = 0; ks < 4; ++ks) if (ks < nks) { const bf16x8 a = *(const LAS bf16x8*)(vnT + (16 * m + fr) * VP + 32 * ks + 8 * fq); acc[m] = mfma16(a, bfr[ks], acc[m]); } }
#pragma unroll
      for (int m = 0; m < 8; ++m) { const v2u su = suv[m]; v2u o;
          o.x = pk2(bf2f(su.x & 0xffffu) * (acc[m][0] + bias), bf2f(su.x >> 16) * (acc[m][1] + bias)); o.y = pk2(bf2f(su.y & 0xffffu) * (acc[m][2] + bias), bf2f(su.y >> 16) * (acc[m][3] + bias));
          *(v2u*)(ZBO + orow * 512 + h * 128 + 16 * m + 4 * fq) = o; } }
    LDS_BARRIER();
}
__device__ __forceinline__ void convbr_item(int idx, const bf16* ZCI, bf16* ZCO, const bf16* CC, const bf16* CX, const float* cw) {
    const int c0 = (idx & 63) * 8, wg_ = idx >> 9, r0 = (wg_ & 7) * SEQ + (wg_ >> 3) * 64 + ((idx >> 6) & 7) * 8; float w[3][8];
#pragma unroll
    for (int k = 0; k < 3; ++k) { const f32x4 a = *(const f32x4*)(cw + k * CW + c0), b = *(const f32x4*)(cw + k * CW + c0 + 4);
#pragma unroll
        for (int e = 0; e < 4; ++e) { w[k][e] = a[e]; w[k][4 + e] = b[e]; } }
    float u2[8], u1[8];
    auto loadu = [&](int row, float (&u)[8]) { const v4u a = *(const v4u*)(CC + (size_t)row * CW + c0), b = *(const v4u*)(CX + (size_t)row * CW + c0);
#pragma unroll
        for (int e = 0; e < 4; ++e) { u[2 * e] = bf2f(a[e] & 0xffffu) * bf2f(b[e] & 0xffffu); u[2 * e + 1] = bf2f(a[e] >> 16) * bf2f(b[e] >> 16); } };
    if ((r0 & (SEQ - 1)) == 0) {
#pragma unroll
        for (int e = 0; e < 8; ++e) { u2[e] = 0.f; u1[e] = 0.f; } }
    else { loadu(r0 - 2, u2); loadu(r0 - 1, u1); }
#pragma unroll
    for (int i = 0; i < 8; ++i) { float u0[8]; loadu(r0 + i, u0); const size_t po = (size_t)(r0 + i) * CW + c0; bf16* p = ZCO + po; const v4u cb = *(const v4u*)(ZCI + po); float z[8];
#pragma unroll
        for (int e = 0; e < 8; ++e) { const float y = w[0][e] * u2[e] + w[1][e] * u1[e] + w[2][e] * u0[e]; const float c = (e & 1) ? bf2f(cb[e >> 1] >> 16) : bf2f(cb[e >> 1] & 0xffffu); z[e] = c * y; u2[e] = u1[e]; u1[e] = u0[e]; }
        v4u o; o.x = pk2(z[0], z[1]); o.y = pk2(z[2], z[3]); o.z = pk2(z[4], z[5]); o.w = pk2(z[6], z[7]); *(v4u*)p = o; }
}
#ifdef TSUB
#define TS_SLOT ((LAS unsigned long long*)(lds + RING_BYTES + 640))
#define TS_BEGIN(k) unsigned long long ts_b##k = 0; if ((k) == TSUB) ts_b##k = __builtin_amdgcn_s_memrealtime()
#define TS_END(k) do { if ((k) == TSUB && blockIdx.x == 7 && tid == 0) *TS_SLOT += __builtin_amdgcn_s_memrealtime() - ts_b##k; } while (0)
#else
#define TS_BEGIN(k) do { } while (0)
#define TS_END(k) do { } while (0)
#endif
__device__ __forceinline__ float wave_scan_incl(float x) {
#define DPP_ADD(ctrl, rmask) x += __builtin_bit_cast(float, __builtin_amdgcn_update_dpp(0, __builtin_bit_cast(int, x), ctrl, rmask, 0xf, true))
    DPP_ADD(0x111, 0xf); DPP_ADD(0x112, 0xf); DPP_ADD(0x114, 0xf); DPP_ADD(0x118, 0xf);
    x += __builtin_bit_cast(float, __builtin_amdgcn_update_dpp(0, __builtin_bit_cast(int, x), 0x142, 0xa, 0xf, false));
    x += __builtin_bit_cast(float, __builtin_amdgcn_update_dpp(0, __builtin_bit_cast(int, x), 0x143, 0xc, 0xf, false));
#undef DPP_ADD
    return x;
}
struct GlaPre { f32x4 la0, la1; v4u kq, qq, va, vb; };
template <bool FULL> __device__ __forceinline__ GlaPre gla_load(size_t r0, int h, const bf16* Q, const bf16* KK, const bf16* V, const float* LOGA, int tid, int wave, int lane) {
    GlaPre p; const size_t row = r0 + lane; const int kc0 = 8 * wave;
    p.la0 = *(const f32x4*)(LOGA + row * GKEY + h * 64 + kc0); p.la1 = *(const f32x4*)(LOGA + row * GKEY + h * 64 + kc0 + 4);
    p.kq = *(const v4u*)(KK + row * GKEY + h * 64 + kc0); if (FULL) p.qq = *(const v4u*)(Q + row * GKEY + h * 64 + kc0); else p.qq = (v4u){0u, 0u, 0u, 0u};
    const int tp = tid & 31, vg = tid >> 5;
    p.va = *(const v4u*)(V + (r0 + 2 * tp) * GVAL + h * 128 + 8 * vg); p.vb = *(const v4u*)(V + (r0 + 2 * tp + 1) * GVAL + h * 128 + 8 * vg);
    return p;
}
template <bool FULL> __device__ __forceinline__ void gla_build(const GlaPre& p, LAS unsigned char* lds, int tid, int wave, int lane, float (&tot)[8]) {
    const int kc0 = 8 * wave; float b[8] = {p.la0[0], p.la0[1], p.la0[2], p.la0[3], p.la1[0], p.la1[1], p.la1[2], p.la1[3]};
#pragma unroll
    for (int j = 0; j < 8; ++j) b[j] = wave_scan_incl(b[j]);
    float kf[8], qf[8];
#pragma unroll
    for (int e = 0; e < 4; ++e) { kf[2 * e] = bf2f(p.kq[e] & 0xffffu); kf[2 * e + 1] = bf2f(p.kq[e] >> 16); qf[2 * e] = bf2f(p.qq[e] & 0xffffu); qf[2 * e + 1] = bf2f(p.qq[e] >> 16); }
    LAS bf16* KE = (LAS bf16*)(lds + L_KENDT);
#pragma unroll
    for (int j = 0; j < 8; ++j) { tot[j] = __builtin_bit_cast(float, __builtin_amdgcn_readlane(__builtin_bit_cast(int, b[j]), 63)); KE[(kc0 + j) * GP + lane] = (bf16)(pk2(kf[j] * __expf(tot[j] - b[j]), 0.f) & 0xffffu); }
    if (FULL) { float qt[8], kt[8];
#pragma unroll
        for (int j = 0; j < 8; ++j) { qt[j] = qf[j] * __expf(b[j]); kt[j] = kf[j] * __expf(-b[j]); }
        v4u o; o.x = pk2(qt[0], qt[1]); o.y = pk2(qt[2], qt[3]); o.z = pk2(qt[4], qt[5]); o.w = pk2(qt[6], qt[7]); *(LAS v4u*)((LAS bf16*)(lds + L_QT) + lane * GP + kc0) = o;
        o.x = pk2(kt[0], kt[1]); o.y = pk2(kt[2], kt[3]); o.z = pk2(kt[4], kt[5]); o.w = pk2(kt[6], kt[7]); *(LAS v4u*)((LAS bf16*)(lds + L_KT) + lane * GP + kc0) = o; }
    if (lane < 8) { float tl = tot[0];
#pragma unroll
        for (int j = 1; j < 8; ++j) tl = (lane == j) ? tot[j] : tl;
        ((LAS float*)(lds + L_DECS))[kc0 + lane] = __expf(tl); }
    { const int tp = tid & 31, vg = tid >> 5; LAS bf16* VT = (LAS bf16*)(lds + L_VT);
#pragma unroll
      for (int e = 0; e < 4; ++e) { *(LAS unsigned*)(VT + (8 * vg + 2 * e) * GP + 2 * tp) = (p.va[e] & 0xffffu) | (p.vb[e] << 16); *(LAS unsigned*)(VT + (8 * vg + 2 * e + 1) * GP + 2 * tp) = (p.va[e] >> 16) | (p.vb[e] & 0xffff0000u); } }
}
__device__ __forceinline__ void gla_state_step(f32x4 (&S)[4], LAS unsigned char* lds, int wave, int fr, int fq) {
    const LAS bf16* VT = (const LAS bf16*)(lds + L_VT); const LAS bf16* KE = (const LAS bf16*)(lds + L_KENDT); const LAS float* DECS = (const LAS float*)(lds + L_DECS);
    bf16x8 bv[2];
#pragma unroll
    for (int ks = 0; ks < 2; ++ks) bv[ks] = *(const LAS bf16x8*)(VT + (16 * wave + fr) * GP + 32 * ks + 8 * fq);
#pragma unroll
    for (int m = 0; m < 4; ++m) { const f32x4 d = *(const LAS f32x4*)(DECS + 16 * m + 4 * fq); S[m] = S[m] * d;
#pragma unroll
        for (int ks = 0; ks < 2; ++ks) S[m] = mfma16(*(const LAS bf16x8*)(KE + (16 * m + fr) * GP + 32 * ks + 8 * fq), bv[ks], S[m]); }
}
__device__ __forceinline__ void gla_b1_item(int item, LAS unsigned char* lds, const bf16* KK, const bf16* V, const float* LOGA, float* CST, float* DEC, int tid, int wave, int lane) {
    const int b = item & 7, g = (item >> 3) & 7, h = item >> 6, fr = lane & 15, fq = lane >> 4;
    if (g == 7) return;
    f32x4 S[4]; float lsum[8];
#pragma unroll
    for (int m = 0; m < 4; ++m) S[m] = (f32x4){0.f, 0.f, 0.f, 0.f};
#pragma unroll
    for (int j = 0; j < 8; ++j) lsum[j] = 0.f;
    const size_t rg = (size_t)b * SEQ + (size_t)g * 256;
    GlaPre pre[4];
#pragma unroll
    for (int c = 0; c < 4; ++c) pre[c] = gla_load<false>(rg + (size_t)c * 64, h, nullptr, KK, V, LOGA, tid, wave, lane);
#pragma unroll
    for (int c = 0; c < 4; ++c) {
        float tot[8]; gla_build<false>(pre[c], lds, tid, wave, lane, tot);
#pragma unroll
        for (int j = 0; j < 8; ++j) lsum[j] += tot[j];
        LDS_BARRIER();
        gla_state_step(S, lds, wave, fr, fq);
        LDS_BARRIER();
    }
#pragma unroll
    for (int m = 0; m < 4; ++m) *(f32x4*)(CST + (size_t)item * 8192 + (16 * wave + fr) * 64 + 16 * m + 4 * fq) = S[m];
    if (lane < 8) { float tl = lsum[0];
#pragma unroll
        for (int j = 1; j < 8; ++j) tl = (lane == j) ? lsum[j] : tl;
        DEC[(size_t)item * 64 + 8 * wave + lane] = tl; }
}
__device__ __forceinline__ void gla_b2_unit(int unit, LAS unsigned char* lds, const bf16* Q, const bf16* KK, const bf16* V, const float* LOGA, const float* CST, const float* DEC, const bf16* ZAI, bf16* ZAO, int tid, int wave, int lane) {
    const int b = unit & 7, g = (unit >> 3) & 7, h = unit >> 6, fr = lane & 15, fq = lane >> 4;
    TS_BEGIN(1); TS_BEGIN(2);
    const size_t rg = (size_t)b * SEQ + (size_t)g * 256;
    const int ih = wave & 3, vh = wave >> 2;
    GlaPre pre[4]; v2u gt[4][4];
#pragma unroll
    for (int c = 0; c < 4; ++c) pre[c] = gla_load<true>(rg + (size_t)c * 64, h, Q, KK, V, LOGA, tid, wave, lane);
#pragma unroll
    for (int c = 0; c < 4; ++c)
#pragma unroll
        for (int mt = 0; mt < 4; ++mt) gt[c][mt] = *(const v2u*)(ZAI + (rg + (size_t)c * 64 + 16 * ih + fr) * GVAL + h * 128 + 64 * vh + 16 * mt + 4 * fq);
    f32x4 S[4];
#pragma unroll
    for (int m = 0; m < 4; ++m) S[m] = (f32x4){0.f, 0.f, 0.f, 0.f};
    { const size_t it0 = (size_t)unit - 8 * g;
      for (int j0 = 0; j0 < g; j0 += 2) { f32x4 cc[2][4], dd[2][4];
#pragma unroll
          for (int jj = 0; jj < 2; ++jj) if (j0 + jj < g) { const float* cp = CST + (it0 + 8 * (j0 + jj)) * 8192 + (16 * wave + fr) * 64 + 4 * fq; const float* dp = DEC + (it0 + 8 * (j0 + jj)) * 64 + 4 * fq;
#pragma unroll
              for (int m = 0; m < 4; ++m) { cc[jj][m] = *(const f32x4*)(cp + 16 * m); dd[jj][m] = *(const f32x4*)(dp + 16 * m); } }
#pragma unroll
          for (int jj = 0; jj < 2; ++jj) if (j0 + jj < g) {
#pragma unroll
              for (int m = 0; m < 4; ++m) { f32x4 d; d[0] = __expf(dd[jj][m][0]); d[1] = __expf(dd[jj][m][1]); d[2] = __expf(dd[jj][m][2]); d[3] = __expf(dd[jj][m][3]); S[m] = d * S[m] + cc[jj][m]; } } } }
    TS_END(2);
    const LAS bf16* QT = (const LAS bf16*)(lds + L_QT); const LAS bf16* KT = (const LAS bf16*)(lds + L_KT);
    const LAS bf16* VT = (const LAS bf16*)(lds + L_VT); LAS bf16* ST = (LAS bf16*)(lds + L_ST); LAS float* RED = (LAS float*)(lds + L_RED);
#pragma unroll
    for (int c = 0; c < 4; ++c) {
        TS_BEGIN(3);
        const size_t r0 = rg + (size_t)c * 64;
#pragma unroll
        for (int m = 0; m < 4; ++m) { v2u w; w.x = pk2(S[m][0], S[m][1]); w.y = pk2(S[m][2], S[m][3]); *(LAS v2u*)(ST + (16 * wave + fr) * GP + 16 * m + 4 * fq) = w; }
        float tot[8]; gla_build<true>(pre[c], lds, tid, wave, lane, tot);
        LDS_BARRIER();
        TS_END(3); TS_BEGIN(4);
        bf16x8 bq[2];
#pragma unroll
        for (int ks = 0; ks < 2; ++ks) bq[ks] = *(const LAS bf16x8*)(QT + (16 * ih + fr) * GP + 32 * ks + 8 * fq);
        f32x4 X[4];
#pragma unroll
        for (int jt = 0; jt < 4; ++jt) { X[jt] = (f32x4){0.f, 0.f, 0.f, 0.f};
            if (jt <= ih) {
#pragma unroll
                for (int ks = 0; ks < 2; ++ks) X[jt] = mfma16(*(const LAS bf16x8*)(KT + (16 * jt + fr) * GP + 32 * ks + 8 * fq), bq[ks], X[jt]);
#pragma unroll
                for (int r = 0; r < 4; ++r) if (16 * jt + 4 * fq + r > 16 * ih + fr) X[jt][r] = 0.f; } }
        bf16x8 xb[2];
#pragma unroll
        for (int k2 = 0; k2 < 2; ++k2) { v4u w; w.x = pk2(X[2 * k2][0], X[2 * k2][1]); w.y = pk2(X[2 * k2][2], X[2 * k2][3]); w.z = pk2(X[2 * k2 + 1][0], X[2 * k2 + 1][1]); w.w = pk2(X[2 * k2 + 1][2], X[2 * k2 + 1][3]); xb[k2] = __builtin_bit_cast(bf16x8, w); }
        f32x4 O[4]; float ss = 0.f;
#pragma unroll
        for (int mt = 0; mt < 4; ++mt) { const int v = 64 * vh + 16 * mt + fr; f32x4 o = (f32x4){0.f, 0.f, 0.f, 0.f};
#pragma unroll
            for (int k2 = 0; k2 < 2; ++k2) { const v2u lo = *(const LAS v2u*)(VT + v * GP + 32 * k2 + 4 * fq), hi = *(const LAS v2u*)(VT + v * GP + 32 * k2 + 16 + 4 * fq); v4u a; a.x = lo.x; a.y = lo.y; a.z = hi.x; a.w = hi.y;
                o = mfma16(__builtin_bit_cast(bf16x8, a), xb[k2], o); }
#pragma unroll
            for (int ks = 0; ks < 2; ++ks) o = mfma16(*(const LAS bf16x8*)(ST + v * GP + 32 * ks + 8 * fq), bq[ks], o);
            O[mt] = o; ss += (o[0] * o[0] + o[1] * o[1]) + (o[2] * o[2] + o[3] * o[3]); }
        ss += __shfl_xor(ss, 16); ss += __shfl_xor(ss, 32);
        if (fq == 0) RED[(vh * 4 + ih) * 16 + fr] = ss;
        gla_state_step(S, lds, wave, fr, fq);
        LDS_BARRIER();
        TS_END(4); TS_BEGIN(5);
        const float rs = rsqrtf((RED[ih * 16 + fr] + RED[(4 + ih) * 16 + fr]) * (1.f / 128.f) + EPS);
        { const size_t row = r0 + 16 * ih + fr;
#pragma unroll
          for (int mt = 0; mt < 4; ++mt) { v2u o;
              o.x = pk2(O[mt][0] * rs * bf2f(gt[c][mt].x & 0xffffu), O[mt][1] * rs * bf2f(gt[c][mt].x >> 16)); o.y = pk2(O[mt][2] * rs * bf2f(gt[c][mt].y & 0xffffu), O[mt][3] * rs * bf2f(gt[c][mt].y >> 16));
              *(v2u*)(ZAO + row * GVAL + h * 128 + 64 * vh + 16 * mt + 4 * fq) = o; } }
        TS_END(5);
    }
    LDS_BARRIER();
    TS_END(1);
}
__device__ __forceinline__ void ffn_act_item(int idx, const bf16* HUP, bf16* ACT, const float* cw, const float* cb) {
    const int cgp = idx % 352, rb = idx / 352, pn = cgp >> 4, c8 = (cgp & 15) * 8, j0 = 128 * pn + c8, r0 = rb * 16;
    float wg[3][8], wv[3][8], bg[8], bv[8];
#pragma unroll
    for (int e = 0; e < 8; ++e) { bg[e] = cb[j0 + e]; bv[e] = cb[DFF + j0 + e];
#pragma unroll
        for (int k = 0; k < 3; ++k) { wg[k][e] = cw[k * DFF2 + j0 + e]; wv[k][e] = cw[k * DFF2 + DFF + j0 + e]; } }
    float g2[8], g1[8], v2[8], v1[8];
    auto ld = [&](int row, float (&g)[8], float (&v)[8]) { const bf16* p = HUP + (size_t)row * DFF2 + 256 * pn + c8; const v4u a = *(const v4u*)p, b = *(const v4u*)(p + 128);
#pragma unroll
        for (int e = 0; e < 4; ++e) { g[2 * e] = bf2f(a[e] & 0xffffu); g[2 * e + 1] = bf2f(a[e] >> 16); v[2 * e] = bf2f(b[e] & 0xffffu); v[2 * e + 1] = bf2f(b[e] >> 16); } };
    if ((r0 & (SEQ - 1)) == 0) {
#pragma unroll
        for (int e = 0; e < 8; ++e) { g2[e] = 0.f; g1[e] = 0.f; v2[e] = 0.f; v1[e] = 0.f; } }
    else { ld(r0 - 2, g2, v2); ld(r0 - 1, g1, v1); }
    for (int i = 0; i < 16; ++i) { float g0[8], v0[8]; ld(r0 + i, g0, v0); float z[8];
#pragma unroll
        for (int e = 0; e < 8; ++e) { const float ga = wg[0][e] * g2[e] + wg[1][e] * g1[e] + wg[2][e] * g0[e] + bg[e], va = wv[0][e] * v2[e] + wv[1][e] * v1[e] + wv[2][e] * v0[e] + bv[e];
            z[e] = fsilu(ga) * va; g2[e] = g1[e]; g1[e] = g0[e]; v2[e] = v1[e]; v1[e] = v0[e]; }
        v4u o; o.x = pk2(z[0], z[1]); o.y = pk2(z[2], z[3]); o.z = pk2(z[4], z[5]); o.w = pk2(z[6], z[7]); *(v4u*)(ACT + (size_t)(r0 + i) * DFF + j0) = o; }
}

using pg8::Unit;
__device__ __forceinline__ void row_rstd(const float* SSQ, int pm, int wr, int fr, int fq, float (&rsd)[2][4]) {
    const int lane = fr + 16 * fq;
#pragma unroll
    for (int ai = 0; ai < 2; ++ai) { const size_t row = (size_t)pm * 256 + ai * 128 + wr * 64 + lane; const f32x4* p = (const f32x4*)(SSQ + row * 16); const f32x4 a = p[0], b = p[1], c = p[2], d = p[3];
        const float s = ((a[0] + a[1]) + (a[2] + a[3])) + ((b[0] + b[1]) + (b[2] + b[3])) + ((c[0] + c[1]) + (c[2] + c[3])) + ((d[0] + d[1]) + (d[2] + d[3]));
        const float rs = rsqrtf(s * (1.f / D) + EPS);
#pragma unroll
        for (int m = 0; m < 4; ++m) rsd[ai][m] = __shfl(rs, 16 * m + fr); }
}
__device__ __forceinline__ void rstd_table_fill(const float* SSQ, int g8, LAS unsigned char* lds, int tid) {
    LAS float* T = (LAS float*)(lds + RST_OFF);
#pragma unroll
    for (int i = 0; i < 4; ++i) { const int r = tid + i * NTHREADS; const f32x4* p = (const f32x4*)(SSQ + ((size_t)g8 * 2048 + r) * 16); const f32x4 a = p[0], b = p[1], c = p[2], d = p[3];
        const float s = ((a[0] + a[1]) + (a[2] + a[3])) + ((b[0] + b[1]) + (b[2] + b[3])) + ((c[0] + c[1]) + (c[2] + c[3])) + ((d[0] + d[1]) + (d[2] + d[3]));
        T[r] = rsqrtf(s * (1.f / D) + EPS); }
    LDS_BARRIER();
}
__device__ __forceinline__ void row_rstd_tbl(const LAS unsigned char* lds, int pm, int wr, int fr, float (&rsd)[2][4]) {
    const LAS float* T = (const LAS float*)(lds + RST_OFF) + (pm & 7) * 256 + wr * 64 + fr;
#pragma unroll
    for (int ai = 0; ai < 2; ++ai)
#pragma unroll
        for (int m = 0; m < 4; ++m) rsd[ai][m] = T[ai * 128 + m * 16];
}
struct EpiA {
    static constexpr bool PERM = true, AFTER_DRAIN = false; static constexpr int TSID = 21;
    unsigned char* act0; const float* SSQ; float* SVST; const float* bal; LAS unsigned char* lds; bool tbl;
    __device__ __forceinline__ void operator()(const f32x4 (&acc)[2][2][4][2], const Unit& u, int wr, int wc, int fr_, int fq_) const {
        int ln_; asm volatile("v_mbcnt_lo_u32_b32 %0, -1, 0\n\tv_mbcnt_hi_u32_b32 %0, -1, %0" : "=v"(ln_)); const int fr = ln_ & 15, fq = ln_ >> 4; (void)fr_; (void)fq_;
        float rsd[2][4]; if (tbl) row_rstd_tbl(lds, u.pm, wr, fr, rsd); else row_rstd(SSQ, u.pm, wr, fr, fq, rsd);
        const int pn = u.pn; int mode, ldc, colt; size_t boff;
        if (pn < 1) { mode = 0; boff = A_Q; ldc = 256; colt = 0; } else if (pn < 2) { mode = 0; boff = A_K; ldc = 256; colt = 0; } else if (pn < 4) { mode = 0; boff = A_V; ldc = 512; colt = (pn - 2) * 256; }
        else if (pn < 6) { mode = 1; boff = A_Z; ldc = 512; colt = (pn - 4) * 256; } else if (pn < 7) { mode = 4; boff = A_LOGA; ldc = 256; colt = 0; }
        else if (pn < 9) { mode = 2; boff = A_Z + (size_t)M * 512 * 2; ldc = 512; colt = (pn - 7) * 256; } else if (pn < 11) { mode = 3; boff = A_SV; ldc = 512; colt = (pn - 9) * 256; }
        else if (pn < 13) { mode = 0; boff = A_Z + (size_t)2 * M * 512 * 2; ldc = 512; colt = (pn - 11) * 256; } else if (pn < 15) { mode = 0; boff = A_CC; ldc = 512; colt = (pn - 13) * 256; }
        else if (pn < 17) { mode = 0; boff = A_CX; ldc = 512; colt = (pn - 15) * 256; } else { mode = 5; boff = A_G; ldc = 3072; colt = (pn - 17) * 256; }
        const int col0 = colt + wc * 32 + 8 * fq;
#pragma unroll
        for (int ai = 0; ai < 2; ++ai)
#pragma unroll
            for (int m = 0; m < 4; ++m) { const size_t row = (size_t)u.pm * 256 + ai * 128 + wr * 64 + m * 16 + fr; const float rs = rsd[ai][m]; float s1 = 0.f, s2 = 0.f;
#pragma unroll
                for (int bj = 0; bj < 2; ++bj) { const f32x4 a0 = acc[ai][bj][m][0] * rs, a1 = acc[ai][bj][m][1] * rs; float v[8] = {a0[0], a0[1], a0[2], a0[3], a1[0], a1[1], a1[2], a1[3]};
                    if (mode == 4) { const f32x4 b0 = *(const f32x4*)(bal + col0 + bj * 128), b1 = *(const f32x4*)(bal + col0 + bj * 128 + 4); f32x4 o0, o1;
#pragma unroll
                        for (int e = 0; e < 4; ++e) { o0[e] = flogsig(v[e] + b0[e]) * 0.0625f; o1[e] = flogsig(v[4 + e] + b1[e]) * 0.0625f; }
                        float* p = (float*)(act0 + boff) + row * 256 + col0 + bj * 128; *(f32x4*)p = o0; *(f32x4*)(p + 4) = o1; }
                    else {
                        if (mode == 1) {
#pragma unroll
                            for (int e = 0; e < 8; ++e) v[e] = fsilu(v[e]); }
                        else if (mode == 2 || mode == 3) {
#pragma unroll
                            for (int e = 0; e < 8; ++e) v[e] = fgelu(v[e]); }
                        else if (mode == 5) {
#pragma unroll
                            for (int e = 0; e < 8; ++e) v[e] = fsigmoid(v[e]); }
                        if (mode == 3) {
#pragma unroll
                            for (int e = 0; e < 8; ++e) { s1 += v[e]; s2 += v[e] * v[e]; } }
                        v4u o; o.x = pk2(v[0], v[1]); o.y = pk2(v[2], v[3]); o.z = pk2(v[4], v[5]); o.w = pk2(v[6], v[7]);
                        *(v4u*)((bf16*)(act0 + boff) + row * ldc + col0 + bj * 128) = o; } }
                if (mode == 3) { s1 += __shfl_xor(s1, 16); s1 += __shfl_xor(s1, 32); s2 += __shfl_xor(s2, 16); s2 += __shfl_xor(s2, 32);
                    if (fq == 0) *(f32x2*)(SVST + row * 16 + ((pn - 9) * 4 + wc) * 2) = (f32x2){s1, s2}; } }
    }
};
struct EpiC {
    static constexpr bool PERM = true, AFTER_DRAIN = false; static constexpr int TSID = 23;
    const bf16* G; bf16* MG;
    __device__ __forceinline__ void operator()(const f32x4 (&acc)[2][2][4][2], const Unit& u, int wr, int wc, int fr_, int fq_) const {
        int ln_; asm volatile("v_mbcnt_lo_u32_b32 %0, -1, 0\n\tv_mbcnt_hi_u32_b32 %0, -1, %0" : "=v"(ln_)); const int fr = ln_ & 15, fq = ln_ >> 4; (void)fr_; (void)fq_;
        const int br = u.pm >> 6, pm = u.pm & 63, pn = u.pn & 3; const int col0 = pn * 256 + wc * 32 + 8 * fq;
        v4u gt[4][2][2], old[4][2][2];
#define EPIC_LOAD(q) do { _Pragma("unroll") for (int mm = 0; mm < 2; ++mm) _Pragma("unroll") for (int bj = 0; bj < 2; ++bj) { \
            const size_t row = (size_t)pm * 256 + ((q) >> 1) * 128 + wr * 64 + (2 * ((q) & 1) + mm) * 16 + fr; gt[q][mm][bj] = *(const v4u*)(G + row * 3072 + br * 1024 + col0 + bj * 128); \
            if (br != 0) old[q][mm][bj] = *(const v4u*)(MG + row * 1024 + col0 + bj * 128); } } while (0)
#define EPIC_COMP(q) do { _Pragma("unroll") for (int mm = 0; mm < 2; ++mm) { const int ai = (q) >> 1, m = 2 * ((q) & 1) + mm; const size_t row = (size_t)pm * 256 + ai * 128 + wr * 64 + m * 16 + fr; \
            _Pragma("unroll") for (int bj = 0; bj < 2; ++bj) { const f32x4 a0 = acc[ai][bj][m][0], a1 = acc[ai][bj][m][1]; float v[8] = {a0[0], a0[1], a0[2], a0[3], a1[0], a1[1], a1[2], a1[3]}; \
                _Pragma("unroll") for (int e = 0; e < 4; ++e) { v[2 * e] *= bf2f(gt[q][mm][bj][e] & 0xffffu); v[2 * e + 1] *= bf2f(gt[q][mm][bj][e] >> 16); } \
                if (br != 0) { _Pragma("unroll") for (int e = 0; e < 4; ++e) { v[2 * e] += bf2f(old[q][mm][bj][e] & 0xffffu); v[2 * e + 1] += bf2f(old[q][mm][bj][e] >> 16); } } \
                v4u o; o.x = pk2(v[0], v[1]); o.y = pk2(v[2], v[3]); o.z = pk2(v[4], v[5]); o.w = pk2(v[6], v[7]); *(v4u*)(MG + row * 1024 + col0 + bj * 128) = o; } } } while (0)
        EPIC_LOAD(0); EPIC_LOAD(1);
        EPIC_COMP(0); EPIC_LOAD(2); EPIC_COMP(1); EPIC_LOAD(3); EPIC_COMP(2); EPIC_COMP(3);
#undef EPIC_LOAD
#undef EPIC_COMP
    }
};
struct BranchOrder {
    int G, c;
    __device__ bool next(int i, Unit& u) const { const int j = i / 3, br = i - 3 * j, T = c + G * j; if (T >= 256) return false;
        const int w = (T & 7) * 32 + (T >> 3), pm = (w >> 5) * 8 + (w & 7), pn = (w & 31) >> 3; u.pm = br * 64 + pm; u.pn = br * 4 + pn; return true; }
    __device__ __forceinline__ void a_ready(const Unit&) const {}
    __device__ __forceinline__ void done(const Unit&) const {}
};
template <int VAR> struct EpiResT {
    static constexpr bool PERM = true, AFTER_DRAIN = false; static constexpr int TSID = 24;
    const bf16* XI; bf16* XB; float* SSQ;
    __device__ __forceinline__ void operator()(const f32x4 (&acc)[2][2][4][2], const Unit& u, int wr, int wc, int fr_, int fq_) const {
        int ln_; asm volatile("v_mbcnt_lo_u32_b32 %0, -1, 0\n\tv_mbcnt_hi_u32_b32 %0, -1, %0" : "=v"(ln_)); const int fr = ln_ & 15, fq = ln_ >> 4; (void)fr_; (void)fq_;
        const int col0 = u.pn * 256 + wc * 32 + 8 * fq;
        v4u xo[2][4][2];
#pragma unroll
        for (int ai = 0; ai < 2; ++ai)
#pragma unroll
            for (int m = 0; m < 4; ++m)
#pragma unroll
                for (int bj = 0; bj < 2; ++bj) xo[ai][m][bj] = *(const v4u*)(XI + ((size_t)u.pm * 256 + ai * 128 + wr * 64 + m * 16 + fr) * D + col0 + bj * 128);
#pragma unroll
        for (int ai = 0; ai < 2; ++ai)
#pragma unroll
            for (int m = 0; m < 4; ++m) { const size_t row = (size_t)u.pm * 256 + ai * 128 + wr * 64 + m * 16 + fr; float ss = 0.f;
#pragma unroll
                for (int bj = 0; bj < 2; ++bj) { const size_t off = row * D + col0 + bj * 128; const f32x4 a0 = acc[ai][bj][m][0], a1 = acc[ai][bj][m][1];
                    float v[8] = {a0[0], a0[1], a0[2], a0[3], a1[0], a1[1], a1[2], a1[3]};
#pragma unroll
                    for (int e = 0; e < 4; ++e) { v[2 * e] += bf2f(xo[ai][m][bj][e] & 0xffffu); v[2 * e + 1] += bf2f(xo[ai][m][bj][e] >> 16); }
#pragma unroll
                    for (int e = 0; e < 8; ++e) ss += v[e] * v[e];
                    v4u o; o.x = pk2(v[0], v[1]); o.y = pk2(v[2], v[3]); o.z = pk2(v[4], v[5]); o.w = pk2(v[6], v[7]); if (VAR != 1 || ss == 12345.678f) *(v4u*)(XB + off) = o; }
                if (VAR == 0) { ss += __shfl_xor(ss, 16); ss += __shfl_xor(ss, 32);
                if (fq == 0) SSQ[row * 16 + u.pn * 4 + wc] = ss; } }
    }
};
typedef EpiResT<0> EpiRes;
struct EpiUp {
    static constexpr bool PERM = true, AFTER_DRAIN = false; static constexpr int TSID = 25;
    bf16* HUP; const float* SSQ;
    __device__ __forceinline__ void operator()(const f32x4 (&acc)[2][2][4][2], const Unit& u, int wr, int wc, int fr_, int fq_) const {
        int ln_; asm volatile("v_mbcnt_lo_u32_b32 %0, -1, 0\n\tv_mbcnt_hi_u32_b32 %0, -1, %0" : "=v"(ln_)); const int fr = ln_ & 15, fq = ln_ >> 4; (void)fr_; (void)fq_;
        float rsd[2][4]; row_rstd(SSQ, u.pm, wr, fr, fq, rsd);
        const int col0 = u.pn * 256 + wc * 32 + 8 * fq;
#pragma unroll
        for (int ai = 0; ai < 2; ++ai)
#pragma unroll
            for (int m = 0; m < 4; ++m) { const size_t row = (size_t)u.pm * 256 + ai * 128 + wr * 64 + m * 16 + fr; const float rs = rsd[ai][m];
#pragma unroll
                for (int bj = 0; bj < 2; ++bj) { const f32x4 a0 = acc[ai][bj][m][0] * rs, a1 = acc[ai][bj][m][1] * rs;
                    v4u o; o.x = pk2(a0[0], a0[1]); o.y = pk2(a0[2], a0[3]); o.z = pk2(a1[0], a1[1]); o.w = pk2(a1[2], a1[3]); *(v4u*)(HUP + row * DFF2 + col0 + bj * 128) = o; } }
    }
};

__device__ __forceinline__ float dpp_f(float old, float src, const int ctrl_sel) {
    const int o = __builtin_bit_cast(int, old), v = __builtin_bit_cast(int, src); int r;
    if (ctrl_sel == 0) r = __builtin_amdgcn_update_dpp(o, v, 0x111, 0xf, 0xf, false);
    else if (ctrl_sel == 1) r = __builtin_amdgcn_update_dpp(o, v, 0x112, 0xf, 0xf, false);
    else if (ctrl_sel == 2) r = __builtin_amdgcn_update_dpp(o, v, 0x121, 0xf, 0xf, false);
    else r = __builtin_amdgcn_update_dpp(o, v, 0x122, 0xf, 0xf, false);
    return __builtin_bit_cast(float, r);
}
constexpr int XL_OFF = RING_BYTES + 1024;
struct EpiUpConv {
    static constexpr bool PERM = true, AFTER_DRAIN = false; static constexpr int TSID = 22;
    unsigned char* ws; const float* cw; const float* cb; LAS unsigned char* lds; bool tbl;
    __device__ __forceinline__ void operator()(const f32x4 (&acc)[2][2][4][2], const Unit& u, int wr, int wc, int fr_, int fq_) const {
        int ln_; asm volatile("v_mbcnt_lo_u32_b32 %0, -1, 0\n\tv_mbcnt_hi_u32_b32 %0, -1, %0" : "=v"(ln_)); const int fr = ln_ & 15, fq = ln_ >> 4; (void)fr_; (void)fq_;
        bf16* ACT = (bf16*)(ws + WS_ACT0 + A_ACT); const float* SSQ = (const float*)(ws + WS_SSQ); float* HT = (float*)(ws + WS_ACT0 + A_HT);
        float rsd[2][4]; if (tbl) row_rstd_tbl(lds, u.pm, wr, fr, rsd); else row_rstd(SSQ, u.pm, wr, fr, fq, rsd);
        LAS f32x4* XL = (LAS f32x4*)(lds + XL_OFF);
        const int tcol = u.pn * 256 + wc * 32 + 8 * fq;
        const int ch0 = u.pn * 128 + wc * 32 + 8 * fq; const bool batch_start = (u.pm & 7) == 0;
        f32x4 wgp[3], wvp[3], bgp, bvp;
#pragma unroll
        for (int k = 0; k < 3; ++k) { wgp[k] = *(const f32x4*)(cw + k * DFF2 + ch0); wvp[k] = *(const f32x4*)(cw + k * DFF2 + DFF + ch0); }
        bgp = *(const f32x4*)(cb + ch0); bvp = *(const f32x4*)(cb + DFF + ch0);
#pragma unroll
        for (int ai = 0; ai < 2; ++ai)
#pragma unroll
            for (int bj = 0; bj < 2; ++bj)
#pragma unroll
                for (int n = 0; n < 2; ++n) {
                    if (fr >= 14) { const f32x4 h = acc[ai][bj][3][n] * rsd[ai][3]; XL[((((ai * 2 + wr) * 4 + wc) * 2 + bj) * 2 + n) * 8 + fq * 2 + (fr - 14)] = h;
                        if (ai == 1 && wr == 1) *(f32x4*)(HT + ((size_t)(u.pm * 2 + 1) * 2 + (fr - 14)) * DFF2 + tcol + bj * 128 + 4 * n) = h; }
                    if (ai == 0 && wr == 0 && fr < 2) *(f32x4*)(HT + ((size_t)(u.pm * 2 + 0) * 2 + fr) * DFF2 + tcol + bj * 128 + 4 * n) = acc[0][bj][0][n] * rsd[0][0]; }
        asm volatile("s_waitcnt lgkmcnt(0)" ::: "memory"); __builtin_amdgcn_s_barrier(); asm volatile("" ::: "memory");
#pragma unroll
        for (int n = 0; n < 2; ++n) {
            asm volatile("" ::: "memory");
            f32x4 wg[3], wv[3], bg, bv;
            if (n == 0) {
#pragma unroll
                for (int k = 0; k < 3; ++k) { wg[k] = wgp[k]; wv[k] = wvp[k]; }
                bg = bgp; bv = bvp; }
            else {
#pragma unroll
                for (int k = 0; k < 3; ++k) { wg[k] = *(const f32x4*)(cw + k * DFF2 + ch0 + 4); wv[k] = *(const f32x4*)(cw + k * DFF2 + DFF + ch0 + 4); }
                bg = *(const f32x4*)(cb + ch0 + 4); bv = *(const f32x4*)(cb + DFF + ch0 + 4); }
#pragma unroll
            for (int ai = 0; ai < 2; ++ai) {
                f32x4 hgp, hvp;
                { f32x4 pg14 = (f32x4){0.f, 0.f, 0.f, 0.f}, pg15 = pg14, pv14 = pg14, pv15 = pg14;
                  if (!(ai == 0 && wr == 0)) { const int pb = ai * 2 + wr - 1; const LAS f32x4* q = XL + ((((pb * 4 + wc) * 2 + 0) * 2 + n) * 8 + fq * 2); const LAS f32x4* qv = XL + ((((pb * 4 + wc) * 2 + 1) * 2 + n) * 8 + fq * 2);
                      pg14 = q[0]; pg15 = q[1]; pv14 = qv[0]; pv15 = qv[1]; }
                  hgp = (fr == 14) ? pg14 : pg15; hvp = (fr == 14) ? pv14 : pv15; }
#pragma unroll
                for (int m = 0; m < 4; ++m) { const f32x4 hg = acc[ai][0][m][n] * rsd[ai][m], hv = acc[ai][1][m][n] * rsd[ai][m]; f32x4 z;
#pragma unroll
                    for (int e = 0; e < 4; ++e) {
                        const float g1 = dpp_f(dpp_f(0.f, hgp[e], 2), hg[e], 0), g2 = dpp_f(dpp_f(0.f, hgp[e], 3), hg[e], 1);
                        const float v1 = dpp_f(dpp_f(0.f, hvp[e], 2), hv[e], 0), v2 = dpp_f(dpp_f(0.f, hvp[e], 3), hv[e], 1);
                        const float ga = wg[0][e] * g2 + wg[1][e] * g1 + wg[2][e] * hg[e] + bg[e], va = wv[0][e] * v2 + wv[1][e] * v1 + wv[2][e] * hv[e] + bv[e];
                        z[e] = fsilu(ga) * va; }
                    const size_t row = (size_t)u.pm * 256 + ai * 128 + wr * 64 + m * 16 + fr;
                    const bool skip = (ai == 0 && wr == 0 && m == 0 && fr < 2 && !batch_start);
                    if (!skip) { v2u o; o.x = pk2(z[0], z[1]); o.y = pk2(z[2], z[3]); *(v2u*)(ACT + row * DFF + ch0 + 4 * n) = o; }
                    hgp = hg; hvp = hv; } } }
    }
};
__device__ __forceinline__ void ffn_fixup(int pm, const float* HT, bf16* ACT, const float* cw, const float* cb, int tid) {
    if ((pm & 7) == 0) return;
    for (int it = tid; it < 2 * (DFF / 4); it += NTHREADS) { const int rr = it / (DFF / 4), j = (it % (DFF / 4)) * 4, tc = (j >> 7) * 256 + (j & 127);
        const float* h0 = HT + ((size_t)(pm * 2 + 0) * 2 + rr) * DFF2;
        const float* h1 = rr ? HT + ((size_t)(pm * 2 + 0) * 2 + 0) * DFF2 : HT + ((size_t)((pm - 1) * 2 + 1) * 2 + 1) * DFF2;
        const float* h2 = rr ? HT + ((size_t)((pm - 1) * 2 + 1) * 2 + 1) * DFF2 : HT + ((size_t)((pm - 1) * 2 + 1) * 2 + 0) * DFF2;
        const f32x4 g0 = *(const f32x4*)(h0 + tc), g1 = *(const f32x4*)(h1 + tc), g2 = *(const f32x4*)(h2 + tc), v0 = *(const f32x4*)(h0 + tc + 128), v1 = *(const f32x4*)(h1 + tc + 128), v2 = *(const f32x4*)(h2 + tc + 128);
        const f32x4 ga = *(const f32x4*)(cw + j) * g2 + *(const f32x4*)(cw + DFF2 + j) * g1 + *(const f32x4*)(cw + 2 * DFF2 + j) * g0 + *(const f32x4*)(cb + j);
        const f32x4 va = *(const f32x4*)(cw + DFF + j) * v2 + *(const f32x4*)(cw + DFF2 + DFF + j) * v1 + *(const f32x4*)(cw + 2 * DFF2 + DFF + j) * v0 + *(const f32x4*)(cb + DFF + j);
        v2u o; o.x = pk2(fsilu(ga[0]) * va[0], fsilu(ga[1]) * va[1]); o.y = pk2(fsilu(ga[2]) * va[2], fsilu(ga[3]) * va[3]);
        *(v2u*)(ACT + ((size_t)pm * 256 + rr) * DFF + j) = o; }
    asm volatile("s_waitcnt vmcnt(0)" ::: "memory"); __syncthreads();
}

template <bool P> struct EpiNull {
    static constexpr bool PERM = P, AFTER_DRAIN = false; static constexpr int TSID = 26; float* sink;
    __device__ __forceinline__ void operator()(const f32x4 (&acc)[2][2][4][2], const Unit& u, int wr, int wc, int fr, int fq) const {
        f32x4 s = (f32x4){0.f, 0.f, 0.f, 0.f};
#pragma unroll
        for (int ai = 0; ai < 2; ++ai)
#pragma unroll
            for (int bj = 0; bj < 2; ++bj)
#pragma unroll
                for (int m = 0; m < 4; ++m)
#pragma unroll
                    for (int n = 0; n < 2; ++n) s += acc[ai][bj][m][n];
        if (s[0] + s[1] + s[2] + s[3] == 12345.678f) sink[u.pm + wr + wc + fr + fq] = s[0];
    }
};
#define XB_TMO      128
#define XB_XCNT(j)  (256  + 64 * (j))
#define XB_XSUB(j)  (1280 + 64 * (j))
#define XB_XGEN(j)  (2304 + 64 * (j))
#define XB_TOP      3328
#define XB_TOPGEN   3392
#define XCD_BAR_WORDS 3456
#define XB_SPIN_CAP (1u << 18)

__device__ __forceinline__ unsigned xb_ld(unsigned* p)              { return __hip_atomic_load(p, __ATOMIC_RELAXED, __HIP_MEMORY_SCOPE_AGENT); }
__device__ __forceinline__ unsigned xb_add(unsigned* p, unsigned v) { return __hip_atomic_fetch_add(p, v, __ATOMIC_RELAXED, __HIP_MEMORY_SCOPE_AGENT); }
__device__ __forceinline__ unsigned xb_xcc_id() { return (unsigned)__builtin_amdgcn_s_getreg((3 << 11) | 20) & 0xFu; }
#define XB_SPIN(cond, bar) do { unsigned _sp = 0; while (cond) { __builtin_amdgcn_s_sleep(1); \
    if ((++_sp & 255u) == 0u) { if (xb_ld(&(bar)[XB_TMO])) break; if (_sp > XB_SPIN_CAP) { atomicAdd(&(bar)[XB_TMO], 1u); break; } } } } while (0)

struct XcdBarrier {
    unsigned* bar; unsigned x;
    volatile LAS unsigned* st;
};

__device__ __forceinline__ XcdBarrier xcd_barrier_post(unsigned* bar, volatile LAS unsigned* st) {
    XcdBarrier b; b.bar = bar; b.x = xb_xcc_id(); b.st = st;
    if (threadIdx.x == 0) st[2] = xb_add(&bar[XB_XCNT(b.x)], 1u);
    return b;
}
__device__ __forceinline__ void xcd_barrier_complete(unsigned* bar, unsigned x, unsigned& nloc, unsigned& nx) {
    const unsigned G = gridDim.x * gridDim.y * gridDim.z;
    unsigned sum, cnt, mine, sp = 0u;
    for (;;) {
        sum = 0u; cnt = 0u; mine = 0u;
#pragma unroll
        for (unsigned j = 0; j < 16; ++j) { const unsigned c = xb_ld(&bar[XB_XCNT(j)]); sum += c; cnt += (c > 0u) ? 1u : 0u; mine = (j == x) ? c : mine; }
        if (sum == G) break;
        __builtin_amdgcn_s_sleep(1);
        if ((++sp & 255u) == 0u) { if (xb_ld(&bar[XB_TMO])) break; if (sp > XB_SPIN_CAP) { atomicAdd(&bar[XB_TMO], 1u); break; } }
    }
    nloc = mine > 0u ? mine : 1u; nx = cnt > 0u ? cnt : 1u;
}

__device__ __forceinline__ void xcd_barrier(const XcdBarrier& b) {
    asm volatile("s_waitcnt vmcnt(0)" ::: "memory");
    __syncthreads();
    if (threadIdx.x == 0) {
        unsigned* bar = b.bar;
        __builtin_amdgcn_s_waitcnt(0);
        unsigned nloc = b.st[0], nx = b.st[1];
        if (nloc == 0u) { xcd_barrier_complete(bar, b.x, nloc, nx); b.st[0] = nloc; b.st[1] = nx; }
        const unsigned old = xb_add(&bar[XB_XSUB(b.x)], 1u);
        const unsigned gen = old / nloc;
        if (old + 1u == (gen + 1u) * nloc) {
            __builtin_amdgcn_fence(__ATOMIC_RELEASE, "agent");
            asm volatile("s_waitcnt vmcnt(0)" ::: "memory");
            const unsigned og = xb_add(&bar[XB_TOP], 1u);
            const unsigned tg = og / nx;
            if (og + 1u == (tg + 1u) * nx) xb_add(&bar[XB_TOPGEN], 1u);
            else XB_SPIN(xb_ld(&bar[XB_TOPGEN]) == tg, bar);
            __builtin_amdgcn_fence(__ATOMIC_ACQUIRE, "agent");
            xb_add(&bar[XB_XGEN(b.x)], 1u);
            asm volatile("s_waitcnt vmcnt(0)" ::: "memory");
        } else {
            XB_SPIN(xb_ld(&bar[XB_XGEN(b.x)]) == gen, bar);
            __builtin_amdgcn_fence(__ATOMIC_ACQUIRE, "agent");
            asm volatile("s_waitcnt vmcnt(0)" ::: "memory");
        }
    }
    __syncthreads();
}

__device__ __forceinline__ void xcd_barrier_local(const XcdBarrier& b) {
    asm volatile("s_waitcnt vmcnt(0)" ::: "memory");
    __syncthreads();
    if (threadIdx.x == 0) {
        unsigned* bar = b.bar;
        __builtin_amdgcn_s_waitcnt(0);
        const unsigned nloc = b.st[0];
        const unsigned old = xb_add(&bar[XB_XSUB(b.x)], 1u);
        const unsigned gen = old / nloc;
        if (old + 1u == (gen + 1u) * nloc) xb_add(&bar[XB_XGEN(b.x)], 1u);
        else XB_SPIN(xb_ld(&bar[XB_XGEN(b.x)]) == gen, bar);
        __builtin_amdgcn_fence(__ATOMIC_ACQUIRE, "agent");
        asm volatile("s_waitcnt vmcnt(0)" ::: "memory");
    }
    __syncthreads();
}

#ifndef PROBE
#define PROBE 0
#endif
struct Args { Inputs in; float* out; unsigned char* ws; int ph_lo, ph_hi; };
constexpr int NPHASE = 2 + 7 * DEPTH;
#define LAUNDER_S(p) asm volatile("" : "+s"(p))
#define LAUNDER_V(p) asm volatile("" : "+v"(p))
struct Ctx { unsigned char* ws; unsigned char* act0; float* X; int tid, lane, wave, G, bx, gw, ngw; };
#define BST_OFF (RING_BYTES + 512)
__device__ __forceinline__ Ctx make_ctx(const Args& a, int wave_id, LAS unsigned char* ldsb) {
    Ctx c; size_t z = 0; LAUNDER_S(z); c.ws = a.ws + z; c.X = (float*)((unsigned char*)a.out + z); c.act0 = c.ws + WS_ACT0;
    int ln; asm volatile("v_mbcnt_lo_u32_b32 %0, -1, 0\n\tv_mbcnt_hi_u32_b32 %0, -1, %0" : "=v"(ln)); c.lane = ln; c.wave = wave_id; c.tid = wave_id * 64 + ln;
    c.G = gridDim.x; c.bx = __builtin_amdgcn_readfirstlane(((volatile LAS unsigned*)(ldsb + BST_OFF))[2]); c.gw = c.bx * NWAVES + c.wave; c.ngw = c.G * NWAVES; return c;
}
__device__ __forceinline__ unsigned char* slot_of(const Ctx& c, int l) { return c.ws + WS_SLOT0 + (size_t)(l & 1) * SL_BYTES; }
__device__ __forceinline__ unsigned* ctl_word(const Ctx& c, int w) { return (unsigned*)(c.ws + WS_CTL) + w; }
__device__ __forceinline__ void tail_convert(const Args& a, const Ctx& c, int l, int ph, bool drain, bool early, LAS unsigned char* lds) {
#if MK_ONE_LAUNCH
    const unsigned xcc_ = xb_xcc_id(); const unsigned nloc_ = ((volatile LAS unsigned*)(lds + BST_OFF))[0];
    unsigned* fin = ctl_word(c, CW_FIN + (ph * 8 + (int)(xcc_ & 7u)) * 16);
    if (c.tid == 0) __hip_atomic_fetch_add(fin, 1u, RLX_AGENT);
    if (l == 0 && ph == 1) convert_queue(a.in, 0, slot_of(c, 0), lds, ctl_word(c, CW_QHEAD), CV_WIN_ITEMS, CV_ITEMS, nullptr, c.G, c.tid, c.wave, c.lane);
    if (l + 1 < DEPTH && (drain || early)) convert_queue(a.in, l + 1, slot_of(c, l + 1), lds, ctl_word(c, CW_QHEAD + 64 * (l + 1)), 0, CV_ITEMS, drain ? nullptr : fin, (int)nloc_, c.tid, c.wave, c.lane);
#else
    if (l == 0 && ph == 1) convert_static(a.in, 0, slot_of(c, 0), lds, CV_WIN_ITEMS, CV_ITEMS, c.gw, c.ngw, c.wave, c.lane);
    if (l + 1 < DEPTH && drain) convert_static(a.in, l + 1, slot_of(c, l + 1), lds, 0, CV_ITEMS, c.gw, c.ngw, c.wave, c.lane);
#endif
}
__device__ __forceinline__ void ph_p0(const Args& a, const int wv, LAS unsigned char* lds) { const Ctx c = make_ctx(a, wv, lds);
    convert_static(a.in, 0, c.ws + WS_SLOT0, lds, 0, CV_WIN_ITEMS, c.gw, c.ngw, c.wave, c.lane); x_prep(a.in.p[0], (bf16*)(c.ws + WS_XB), (float*)(c.ws + WS_SSQ), c.gw, c.ngw, c.lane); }
__device__ __forceinline__ void ph_a(const Args& a, const int wv, int l, int ph, LAS unsigned char* lds) { const Ctx c = make_ctx(a, wv, lds);
    pg8::Gemm g{(const bf16*)(c.ws + WS_XB), (const bf16*)(slot_of(c, l) + SL_WIN), M, NIN, D}; pg8::StaticOrder S; S.init(M, NIN, c.G, c.bx);
    const bool tbl = (c.G == 256); if (tbl) rstd_table_fill((const float*)(c.ws + WS_SSQ), c.bx & 7, lds, c.tid);
    EpiA E{c.act0, (const float*)(c.ws + WS_SSQ), (float*)(c.ws + WS_SVST), a.in.p[4] + (size_t)l * GKEY, lds, tbl};
    if (PROBE == 21) { EpiNull<true> EN_{(float*)(c.ws + WS_END)}; pg8::gemm_phase<EpiNull<true>, pg8::StaticOrder, true, true>(lds, g, S, EN_, wv); }
    for (int rep = 0; rep < 1 + (PROBE == 1); ++rep) pg8::gemm_phase<EpiA, pg8::StaticOrder, true, true>(lds, g, S, E, wv);
    { const Ctx c2 = make_ctx(a, wv, lds); tail_convert(a, c2, l, ph, false, ((NIN / 256) * 64 - 1) / c2.G * c2.G + c2.bx >= (NIN / 256) * 64, lds); } }
__device__ __forceinline__ void ph_b1(const Args& a, const int wv, int l, LAS unsigned char* lds) { const Ctx c = make_ctx(a, wv, lds); const Inputs& I = a.in;
    bf16* Zb = (bf16*)(c.act0 + A_Z); bf16* DUM = (bf16*)(c.ws + WS_END); const int tid = c.tid;
    TS_BEGIN(41);
    for (int rep = 0; rep < 1 + (PROBE == 2); ++rep)
    for (int it = c.bx; it < 256; it += c.G) gla_b1_item(it, lds, (const bf16*)(c.act0 + A_K), (const bf16*)(c.act0 + A_V), (const float*)(c.act0 + A_LOGA), (float*)(c.act0 + A_CST), (float*)(c.act0 + A_DEC), c.tid, c.wave, c.lane);
    TS_END(41); TS_BEGIN(42);
    if (PROBE == 3) for (int it = c.bx; it < 512; it += c.G) sgu_item(it, lds, Zb + (size_t)M * 512, DUM, (const bf16*)(c.act0 + A_SV), (const float*)(c.ws + WS_SVST), I.p[7] + (size_t)l * SGW, I.p[8] + (size_t)l * SGW, (const bf16*)(slot_of(c, l) + SL_SGW), I.p[10] + (size_t)l * 512, c.wave, c.lane);
    for (int it = c.bx; it < 512; it += c.G) sgu_item(it, lds, Zb + (size_t)M * 512, Zb + (size_t)M * 512, (const bf16*)(c.act0 + A_SV), (const float*)(c.ws + WS_SVST), I.p[7] + (size_t)l * SGW, I.p[8] + (size_t)l * SGW, (const bf16*)(slot_of(c, l) + SL_SGW), I.p[10] + (size_t)l * 512, c.wave, c.lane);
    TS_END(42); TS_BEGIN(43);
    if (PROBE == 4) for (int it = c.bx * NTHREADS + c.tid; it < 131072; it += c.G * NTHREADS) convbr_item(it, Zb + (size_t)2 * M * 512, DUM, (const bf16*)(c.act0 + A_CC), (const bf16*)(c.act0 + A_CX), I.p[12] + (size_t)l * 3 * CW);
    for (int it = c.bx * NTHREADS + c.tid; it < 131072; it += c.G * NTHREADS) convbr_item(it, Zb + (size_t)2 * M * 512, Zb + (size_t)2 * M * 512, (const bf16*)(c.act0 + A_CC), (const bf16*)(c.act0 + A_CX), I.p[12] + (size_t)l * 3 * CW);
    TS_END(43); }
__device__ __forceinline__ void ph_b2(const Args& a, const int wv, int l, int ph, LAS unsigned char* lds) { const Ctx c = make_ctx(a, wv, lds);
    if (PROBE == 6) for (int it = c.bx; it < 256; it += c.G) gla_b2_unit(it, lds, (const bf16*)(c.act0 + A_Q), (const bf16*)(c.act0 + A_K), (const bf16*)(c.act0 + A_V), (const float*)(c.act0 + A_LOGA), (const float*)(c.act0 + A_CST), (const float*)(c.act0 + A_DEC), (const bf16*)(c.act0 + A_Z), (bf16*)(c.ws + WS_END), c.tid, c.wave, c.lane);
    for (int it = c.bx; it < 256; it += c.G) gla_b2_unit(it, lds, (const bf16*)(c.act0 + A_Q), (const bf16*)(c.act0 + A_K), (const bf16*)(c.act0 + A_V), (const float*)(c.act0 + A_LOGA), (const float*)(c.act0 + A_CST), (const float*)(c.act0 + A_DEC), (const bf16*)(c.act0 + A_Z), (bf16*)(c.act0 + A_Z), c.tid, c.wave, c.lane); }
__device__ __forceinline__ void ph_c(const Args& a, const int wv, int l, LAS unsigned char* lds) { const Ctx c = make_ctx(a, wv, lds);
    pg8::Gemm g{(const bf16*)(c.act0 + A_Z), (const bf16*)(slot_of(c, l) + SL_WBR), 3 * M, 3 * D, 512}; BranchOrder S{c.G, c.bx}; EpiC E{(const bf16*)(c.act0 + A_G), (bf16*)(c.act0 + A_MERGED)};
    for (int rep = 0; rep < 1 + (PROBE == 7); ++rep) pg8::gemm_phase<EpiC, BranchOrder, true, true>(lds, g, S, E, wv); }
__device__ __forceinline__ void ph_res(const Args& a, const int wv, const bf16* A, const bf16* Bt, int K, int dup, int l, int ph, bool drain, LAS unsigned char* lds) { const Ctx c = make_ctx(a, wv, lds);
    pg8::Gemm g{A, Bt, M, D, K}; pg8::StaticOrder S; S.init(M, D, c.G, c.bx);
    if (dup == 2) { EpiNull<true> EN_{(float*)(c.ws + WS_END)}; pg8::gemm_phase<EpiNull<true>, pg8::StaticOrder, true, true>(lds, g, S, EN_, wv); }
    if (dup == 3) { EpiResT<1> E{(const bf16*)(c.ws + WS_XB), (bf16*)(c.ws + WS_END), (float*)(c.ws + WS_END + 32 * MiB)}; pg8::gemm_phase<EpiResT<1>, pg8::StaticOrder, true, true>(lds, g, S, E, wv); }
    if (dup == 4) { EpiResT<2> E{(const bf16*)(c.ws + WS_XB), (bf16*)(c.ws + WS_END), (float*)(c.ws + WS_END + 32 * MiB)}; pg8::gemm_phase<EpiResT<2>, pg8::StaticOrder, true, true>(lds, g, S, E, wv); }
    if (dup == 1) { EpiRes E{(const bf16*)(c.ws + WS_XB), (bf16*)(c.ws + WS_END), (float*)(c.ws + WS_END + 32 * MiB)}; pg8::gemm_phase<EpiRes, pg8::StaticOrder, true, true>(lds, g, S, E, wv); }
    if (drain) { pg8::Unit u0; for (int i = 0; S.next(i, u0); ++i) ffn_fixup(u0.pm, (const float*)(c.act0 + A_HT), (bf16*)(c.act0 + A_ACT), a.in.p[17] + (size_t)l * 3 * DFF2, a.in.p[18] + (size_t)l * DFF2, c.tid); }
    EpiRes E{(const bf16*)(c.ws + WS_XB), (bf16*)(c.ws + WS_XB), (float*)(c.ws + WS_SSQ)};
    pg8::gemm_phase<EpiRes, pg8::StaticOrder, true, true>(lds, g, S, E, wv);
    if (drain) { const Ctx c2 = make_ctx(a, wv, lds); tail_convert(a, c2, l, ph, true, true, lds); } }
__device__ __forceinline__ void ph_e(const Args& a, const int wv, int l, int ph, LAS unsigned char* lds) { const Ctx c = make_ctx(a, wv, lds);
    pg8::Gemm g{(const bf16*)(c.ws + WS_XB), (const bf16*)(slot_of(c, l) + SL_WUP), M, DFF2, D}; pg8::StaticOrder S; S.init(M, DFF2, c.G, c.bx);
    const bool tbl = (c.G == 256); if (tbl) rstd_table_fill((const float*)(c.ws + WS_SSQ), c.bx & 7, lds, c.tid);
    EpiUpConv E{c.ws, a.in.p[17] + (size_t)l * 3 * DFF2, a.in.p[18] + (size_t)l * DFF2, lds, tbl};
    for (int rep = 0; rep < 1 + (PROBE == 8); ++rep) pg8::gemm_phase<EpiUpConv, pg8::StaticOrder, true, true>(lds, g, S, E, wv);
    { const Ctx c2 = make_ctx(a, wv, lds); tail_convert(a, c2, l, ph, false, ((DFF2 / 256) * 64 - 1) / c2.G * c2.G + c2.bx >= (DFF2 / 256) * 64, lds); } }
__device__ __forceinline__ void ph_e2(const Args& a, const int wv, int l, LAS unsigned char* lds) { const Ctx c = make_ctx(a, wv, lds);
    for (int rep = 0; rep < 1 + (PROBE == 9); ++rep)
    for (int it = c.bx * NTHREADS + c.tid; it < 1024 * 352; it += c.G * NTHREADS) ffn_act_item(it, (const bf16*)(c.act0 + A_HUP), (bf16*)(c.act0 + A_ACT), a.in.p[17] + (size_t)l * 3 * DFF2, a.in.p[18] + (size_t)l * DFF2); }
__device__ __forceinline__ void ph_fin(const Args& a, const int wv, LAS unsigned char* lds) { const Ctx c = make_ctx(a, wv, lds); final_norm((const bf16*)(c.ws + WS_XB), c.X, (const float*)(c.ws + WS_SSQ), a.in.p[20], c.gw, c.ngw, c.lane); }

#ifndef PHMASK
#define PHMASK 0xFFFF
#endif
#define EN(b) ((PHMASK >> (b)) & 1)
__global__ void __launch_bounds__(NTHREADS, 2) mk_fwd(Args args) {
    extern __shared__ __attribute__((aligned(16))) unsigned char lds_raw[];
    LAS unsigned char* lds = (LAS unsigned char*)lds_raw;
    const int wv = __builtin_amdgcn_readfirstlane(threadIdx.x >> 6);
#ifdef TSUB
    if (threadIdx.x == 0) *TS_SLOT = 0ull;
#endif
    const int lo = args.ph_lo, hi = args.ph_hi;
#define IN(k) (lo <= (k) && (k) < hi)
#if MK_ONE_LAUNCH
    volatile LAS unsigned* bst = (volatile LAS unsigned*)(lds + BST_OFF);
    if (threadIdx.x < 4) bst[threadIdx.x] = 0u;
    __syncthreads();
    const XcdBarrier bar = xcd_barrier_post((unsigned*)(args.ws + WS_CTL) + CW_BAR, bst);
    __syncthreads();
    const unsigned my_rank = bst[2];
    __syncthreads();
    if (threadIdx.x == 0) bst[2] = blockIdx.x;
    __syncthreads();
#define SEAM_GLOBAL(k) ((k) == 1 || ((k) % 7) == 0)
#define SEAM(k) do { if (IN(k) && IN((k) + 1)) { \
        if ((k) == 0) { if (args.ph_hi < 0) cg::this_grid().sync();     \
            xcd_barrier(bar); \
            if (threadIdx.x == 0) { unsigned* bw = (unsigned*)(args.ws + WS_CTL) + CW_BAR; unsigned nloc_ = 1u, nx_ = 1u; xcd_barrier_complete(bw, bar.x, nloc_, nx_);     \
                bool u32 = (gridDim.x == 256u) && xb_ld(&bw[XB_TMO]) == 0u; \
                for (unsigned j = 0; j < 16; ++j) { const unsigned c_ = xb_ld(&bw[XB_XCNT(j)]); if (j < 8 ? c_ != 32u : c_ != 0u) u32 = false; } \
                bst[0] = nloc_; bst[1] = nx_; bst[3] = u32 ? 1u : 0u; bst[2] = u32 ? my_rank * 8u + bar.x : blockIdx.x; } \
            __syncthreads(); } \
        else if (SEAM_GLOBAL(k) || bst[3] == 0u) xcd_barrier(bar); else xcd_barrier_local(bar); } } while (0)
#else
#define SEAM(k) do { } while (0)
#endif
#ifdef TPROBE
    unsigned long long tp_acc = 0ull, tp_prev = __builtin_amdgcn_s_memrealtime();
#define TP_MARK(kind) do { const unsigned long long t_ = __builtin_amdgcn_s_memrealtime(); if ((kind) == TPROBE) tp_acc += t_ - tp_prev; tp_prev = t_; } while (0)
#else
#define TP_MARK(kind) do { } while (0)
#endif
    int ph = 0;
    if (EN(0) && IN(ph)) ph_p0(args, wv, lds);
    SEAM(ph); ++ph; TP_MARK(0);
    for (int l = 0; l < DEPTH; ++l) {
        if (EN(1) && IN(ph)) ph_a(args, wv, l, ph, lds);
        SEAM(ph); ++ph; TP_MARK(1);
        if (EN(2) && IN(ph)) ph_b1(args, wv, l, lds);
        SEAM(ph); ++ph; TP_MARK(2);
        if (EN(3) && IN(ph)) ph_b2(args, wv, l, ph, lds);
        SEAM(ph); ++ph; TP_MARK(3);
        if (EN(4) && IN(ph)) ph_c(args, wv, l, lds);
        SEAM(ph); ++ph; TP_MARK(4);
        if (EN(5) && IN(ph)) { size_t z = 0; LAUNDER_S(z); unsigned char* ws = args.ws + z; ph_res(args, wv, (const bf16*)(ws + WS_ACT0 + A_MERGED), (const bf16*)(ws + WS_SLOT0 + (size_t)(l & 1) * SL_BYTES + SL_WO), D, PROBE == 10 ? 1 : (PROBE == 22 ? 2 : (PROBE == 31 ? 3 : (PROBE == 32 ? 4 : 0))), l, ph, false, lds); }
        SEAM(ph); ++ph; TP_MARK(5);
        if (EN(6) && IN(ph)) ph_e(args, wv, l, ph, lds);
        SEAM(ph); ++ph; TP_MARK(6);
        if (EN(8) && IN(ph)) { size_t z = 0; LAUNDER_S(z); unsigned char* ws = args.ws + z; ph_res(args, wv, (const bf16*)(ws + WS_ACT0 + A_ACT), (const bf16*)(ws + WS_SLOT0 + (size_t)(l & 1) * SL_BYTES + SL_WDN), DFF, PROBE == 11 ? 1 : (PROBE == 23 ? 2 : 0), l, ph, true, lds); }
        SEAM(ph); ++ph; TP_MARK(7);
    }
    if (EN(9) && IN(ph)) ph_fin(args, wv, lds);
#ifdef TSUB
    if (blockIdx.x == 7 && threadIdx.x == 0) { const unsigned long long tt = *TS_SLOT; const unsigned long long t0 = __builtin_amdgcn_s_memrealtime(); while (__builtin_amdgcn_s_memrealtime() - t0 < 10ull * tt) __builtin_amdgcn_s_sleep(8); }
#endif
#ifdef TPROBE
    TP_MARK(8);
    if (blockIdx.x == 0 && wv == 0) { const unsigned long long t0 = __builtin_amdgcn_s_memrealtime(); while (__builtin_amdgcn_s_memrealtime() - t0 < 10ull * tp_acc) __builtin_amdgcn_s_sleep(8); }
#endif
#undef IN
#undef SEAM
}

extern "C" void kernel_launch(void* const* d_in, const int* in_sizes, int n_in, void* d_out, int out_size, void* d_ws, size_t ws_size, hipStream_t stream) {
    static int grid = 0;
    if (grid == 0) {
        if (n_in != 21 || out_size != M * D || ws_size < WS_END + (PROBE ? 64 * MiB : 0)) { fprintf(stderr, "kernel_launch: unexpected shapes / workspace (%zu < %zu)\n", ws_size, (size_t)WS_END); grid = -1; return; }
        int dev = 0, cus = 0, per_cu = 0;
        if (hipGetDevice(&dev) != hipSuccess || hipDeviceGetAttribute(&cus, hipDeviceAttributeMultiprocessorCount, dev) != hipSuccess) { grid = -1; return; }
        if (hipFuncSetAttribute((const void*)mk_fwd, hipFuncAttributeMaxDynamicSharedMemorySize, LDS_BYTES) != hipSuccess) { fprintf(stderr, "kernel_launch: hipFuncSetAttribute failed\n"); grid = -1; return; }
        if (hipOccupancyMaxActiveBlocksPerMultiprocessor(&per_cu, (const void*)mk_fwd, NTHREADS, LDS_BYTES) != hipSuccess || per_cu < 1) { fprintf(stderr, "kernel_launch: occupancy query says %d\n", per_cu); per_cu = 1; }
        (void)hipGetLastError();
        grid = cus * 1;
    }
    if (grid < 0) return;
#if MK_ONE_LAUNCH
    if (hipMemsetAsync((char*)d_ws + WS_CTL, 0, 65536, stream) != hipSuccess) { fprintf(stderr, "kernel_launch: memset failed\n"); return; }
#endif
    Args a{};
    for (int i = 0; i < 21; ++i) a.in.p[i] = (const float*)d_in[i];
    a.out = (float*)d_out; a.ws = (unsigned char*)d_ws;
#if MK_ONE_LAUNCH
    a.ph_lo = 0; a.ph_hi = NPHASE;
    void* kargs[] = {&a};
    hipError_t e = hipLaunchCooperativeKernel((const void*)mk_fwd, dim3(grid), dim3(NTHREADS), kargs, LDS_BYTES, stream);
    if (e != hipSuccess) fprintf(stderr, "kernel_launch: cooperative launch failed: %s (grid %d)\n", hipGetErrorString(e), grid);
#else
    for (int p = 0; p < NPHASE; ++p) { a.ph_lo = p; a.ph_hi = p + 1; hipLaunchKernelGGL(mk_fwd, dim3(grid), dim3(NTHREADS), LDS_BYTES, stream, a); }
#endif
}
```

```cpp
#include <hip/hip_runtime.h>
#include <hip/hip_cooperative_groups.h>
#include <cstdio>
#include <cstdint>
#include <cmath>
namespace cg = cooperative_groups;

#ifndef MK_ONE_LAUNCH
#define MK_ONE_LAUNCH 1
#endif

namespace cfg {
constexpr int D = 1024, BATCH = 8, SEQ = 2048, DEPTH = 4, M = BATCH * SEQ;
constexpr int GH = 4, GDK = 64, GDV = 128, GKEY = 256, GVAL = 512, GRANK = 16;
constexpr int SGW = 512, SGC = 128, CW = 512, DFF = 2816, DFF2 = 5632;
constexpr int INC = 7184, NIN = 7424;
constexpr int O_Q = 0, O_K = 256, O_V = 512, O_G = 1024, O_A = 1536, O_SU = 1552, O_SV = 2064, O_CB = 2576, O_CC = 3088, O_CX = 3600, O_GT = 4112;
constexpr float EPS = 1e-6f;
}
using namespace cfg;

namespace pg8 {
#define PG8_LAS __attribute__((address_space(3)))
typedef unsigned short bf16_t;
typedef short bf16x8 __attribute__((ext_vector_type(8)));
typedef float f32x4 __attribute__((ext_vector_type(4)));
typedef unsigned u32x4 __attribute__((ext_vector_type(4)));
constexpr int BM = 256, BK = 64, HALF = 128, HTB = HALF * BK * 2  , STAGE_BYTES = 8 * HTB, NXCD = 8, WGM = 8;

__host__ __device__ __forceinline__ int lds_byte(int r, int c) { const int st = (r >> 4) * 2 + (c >> 5), rr = r & 15, cc = c & 31, ob = rr * 64 + cc * 2; return st * 1024 + (ob ^ (((ob >> 9) & 1) << 5)); }
__host__ __device__ __forceinline__ void stage_rc(int b, int& R, int& C) { const int st = b / 1024, sb = b % 1024, swz = sb ^ (((sb >> 9) & 1) << 5); R = (st >> 1) * 16 + swz / 64; C = (st & 1) * 32 + (swz % 64) / 2; }
__host__ __device__ __forceinline__ int perm32(int rho) { const int n = rho >> 4, i = rho & 15; return 8 * (i >> 2) + 4 * n + (i & 3); }

struct Unit { int pm, pn; };
struct Gemm { const bf16_t* A; const bf16_t* Bt; int M, N, K; };

struct StaticOrder {
    int nM, nN, nwg, G, c;
    __host__ __device__ void init(int M, int N, int G_, int c_) { nM = M / BM; nN = N / BM; nwg = nM * nN; G = G_; c = c_; }
    __host__ __device__ bool next(int i, Unit& u) const {
        const long L = (long)i * G + c; if (L >= nwg) return false;
        int wgid = (int)L; { const int q = nwg / NXCD, r = nwg % NXCD, xcd = wgid % NXCD, off = wgid / NXCD; wgid = (xcd < r ? xcd * (q + 1) : r * (q + 1) + (xcd - r) * q) + off; }
        const int nig = WGM * nN, gid = wgid / nig, fm = gid * WGM, gsz = (nM - fm) < WGM ? (nM - fm) : WGM;
        u.pm = fm + ((wgid % nig) % gsz); u.pn = (wgid % nig) / gsz; return true;
    }
    __device__ __forceinline__ void a_ready(const Unit&) const {}
    __device__ __forceinline__ void done(const Unit&) const {}
};

__device__ __forceinline__ unsigned cvt_pk_bf16(float lo, float hi) { unsigned r; asm volatile("v_cvt_pk_bf16_f32 %0, %1, %2" : "=v"(r) : "v"(lo), "v"(hi)); return r; }
typedef float f32x2 __attribute__((ext_vector_type(2)));
#ifdef TSUB
#define PG8_TS_BEGIN(k) unsigned long long ts_b_ = 0; if ((k) == TSUB) ts_b_ = __builtin_amdgcn_s_memrealtime()
#define PG8_TS_END(k) do { if ((k) == TSUB && blockIdx.x == 7 && tid == 0) *(PG8_LAS unsigned long long*)(lds + 131072 + 640) += __builtin_amdgcn_s_memrealtime() - ts_b_; } while (0)
#else
#define PG8_TS_BEGIN(k) do { } while (0)
#define PG8_TS_END(k) do { } while (0)
#endif
template <class Epi, class Sched, bool ALIGN_EPI = false, bool SP2 = false>
__device__ __forceinline__ void gemm_phase(PG8_LAS unsigned char* lds, const Gemm g, const Sched& S, const Epi& E, const int wave_id) {
    int ln__; asm volatile("v_mbcnt_lo_u32_b32 %0, -1, 0\n\tv_mbcnt_hi_u32_b32 %0, -1, %0" : "=v"(ln__));
    const int tid_ = ln__ + 64 * wave_id;
    const int tid = tid_, wid = __builtin_amdgcn_readfirstlane(tid >> 6), lane = tid & 63, wr = wid >> 2, wc = wid & 3, fr = lane & 15, fq = lane >> 4;
    const int K = g.K, nt = K / BK;
    unsigned voffA[2], voffB[2];
#pragma unroll
    for (int i = 0; i < 2; ++i) { int R, C; stage_rc(tid * 16 + i * 8192, R, C); const int Rb = Epi::PERM ? ((R & ~31) + perm32(R & 31)) : R;
        voffA[i] = (unsigned)(R * K + C) * 2u; voffB[i] = (unsigned)(Rb * K + C) * 2u; }
    const size_t kstep = (size_t)(BK * 2);
    const size_t hstep = (size_t)HALF * K * 2;
    const size_t tstep = 2 * hstep;
    const unsigned ldsw = (unsigned)wid * 1024u;
    const int aoff = lds_byte(wr * 64 + fr, fq * 8), boff = lds_byte(wc * 32 + fr, fq * 8);
#define PG8_SA(b, h) (((b) * 2 + (h)) * HTB)
#define PG8_SB(b, h) ((4 + (b) * 2 + (h)) * HTB)
#define PG8_STAGE(bufoff, gbase, voff) do { _Pragma("unroll") for (int _i = 0; _i < 2; ++_i) \
        __builtin_amdgcn_global_load_lds((const unsigned*)((const char*)(gbase) + (voff)[_i]), (PG8_LAS unsigned*)(lds + (bufoff) + ldsw + _i * 8192), 16, 0, 0); } while (0)
#define PG8_LDA(dst, b, h) do { _Pragma("unroll") for (int m = 0; m < 4; ++m) _Pragma("unroll") for (int k = 0; k < 2; ++k) dst[m][k] = *(const PG8_LAS bf16x8*)(lds + PG8_SA(b, h) + aoff + m * 2048 + k * 1024); } while (0)
#define PG8_LDB(dst, b, h) do { _Pragma("unroll") for (int n = 0; n < 2; ++n) _Pragma("unroll") for (int k = 0; k < 2; ++k) dst[n][k] = *(const PG8_LAS bf16x8*)(lds + PG8_SB(b, h) + boff + n * 2048 + k * 1024); } while (0)
#define PG8_MMA(ai, bj, At, Bt) do { __builtin_amdgcn_s_setprio(1); _Pragma("unroll") for (int m = 0; m < 4; ++m) _Pragma("unroll") for (int n = 0; n < 2; ++n) _Pragma("unroll") for (int k = 0; k < 2; ++k) \
        acc[ai][bj][m][n] = __builtin_amdgcn_mfma_f32_16x16x32_bf16(Bt[n][k], At[m][k], acc[ai][bj][m][n], 0, 0, 0); __builtin_amdgcn_s_setprio(0); } while (0)
#define PG8_WAIT_V(n) asm volatile("s_waitcnt vmcnt(" #n ")" ::: "memory")
#define PG8_WAIT_L(n) asm volatile("s_waitcnt lgkmcnt(" #n ")" ::: "memory")
#define PG8_BAR __builtin_amdgcn_s_barrier()
#define PG8_SCHED __builtin_amdgcn_sched_barrier(0)
    Unit cur, nxt; int ui = 0;
    if (!S.next(0, cur)) return;
    f32x4 acc[2][2][4][2];
#pragma unroll
    for (int a = 0; a < 2; ++a)
#pragma unroll
        for (int b = 0; b < 2; ++b)
#pragma unroll
            for (int m = 0; m < 4; ++m)
#pragma unroll
                for (int n = 0; n < 2; ++n) acc[a][b][m][n] = (f32x4){0.f, 0.f, 0.f, 0.f};
    bf16x8 At[4][2], B0[2][2], B1[2][2];
    const char* cA = (const char*)g.A + (size_t)cur.pm * tstep; const char* cB = (const char*)g.Bt + (size_t)cur.pn * tstep;
    S.a_ready(cur);
    if constexpr (SP2) {
        PG8_STAGE(PG8_SB(0, 0), cB, voffB); PG8_STAGE(PG8_SB(0, 1), cB + hstep, voffB); PG8_STAGE(PG8_SA(0, 0), cA, voffA); PG8_STAGE(PG8_SA(0, 1), cA + hstep, voffA);
        if (wr == 1) PG8_BAR;
        PG8_WAIT_V(2); PG8_BAR;
        PG8_STAGE(PG8_SB(1, 0), cB + kstep, voffB); PG8_STAGE(PG8_SA(1, 0), cA + kstep, voffA); PG8_STAGE(PG8_SB(1, 1), cB + hstep + kstep, voffB);
        PG8_WAIT_V(6); PG8_BAR;
    } else {
        PG8_STAGE(PG8_SB(0, 0), cB, voffB); PG8_STAGE(PG8_SA(0, 0), cA, voffA); PG8_STAGE(PG8_SB(0, 1), cB + hstep, voffB); PG8_STAGE(PG8_SA(0, 1), cA + hstep, voffA);
        if (wr == 1) PG8_BAR;
        PG8_WAIT_V(4); PG8_BAR;
        PG8_STAGE(PG8_SB(1, 0), cB + kstep, voffB); PG8_STAGE(PG8_SA(1, 0), cA + kstep, voffA); PG8_STAGE(PG8_SB(1, 1), cB + hstep + kstep, voffB);
        PG8_WAIT_V(6); PG8_BAR;
    }
    for (;;) {
        const bool has_next = S.next(ui + 1, nxt);
        const char* nA = has_next ? (const char*)g.A + (size_t)nxt.pm * tstep : cA; const char* nB = has_next ? (const char*)g.Bt + (size_t)nxt.pn * tstep : cB;
        for (int t = 0; t < nt; t += 2) {
            const bool last = (t == nt - 2);
            const char* a1 = cA + (size_t)(t + 1) * kstep;
            const char* a2 = last ? nA : cA + (size_t)(t + 2) * kstep; const char* b2 = last ? nB : cB + (size_t)(t + 2) * kstep;
            const char* a3 = a2 + kstep; const char* b3 = b2 + kstep;
            if (last && has_next) S.a_ready(nxt);
            if constexpr (Epi::MIDHOOK) { if (t == Epi::HOOK_T1 || t == Epi::HOOK_T2) E.mid(acc, cur, t, wr, wc); }
            if constexpr (SP2) {
            PG8_LDB(B0, 0, 0); PG8_LDB(B1, 0, 1); PG8_SCHED; PG8_LDA(At, 0, 0); PG8_STAGE(PG8_SA(1, 1), a1 + hstep, voffA);
            PG8_WAIT_V(8); PG8_WAIT_L(0); PG8_BAR; PG8_MMA(0, 0, At, B0); PG8_MMA(0, 1, At, B1); PG8_BAR; PG8_SCHED;
            PG8_LDA(At, 0, 1); PG8_STAGE(PG8_SB(0, 0), b2, voffB); PG8_STAGE(PG8_SB(0, 1), b2 + hstep, voffB); PG8_STAGE(PG8_SA(0, 0), a2, voffA);
            PG8_WAIT_V(8); PG8_WAIT_L(0); PG8_BAR; PG8_MMA(1, 0, At, B0); PG8_MMA(1, 1, At, B1); PG8_BAR; PG8_SCHED;
            PG8_LDB(B0, 1, 0); PG8_LDB(B1, 1, 1); PG8_SCHED; PG8_LDA(At, 1, 0); PG8_STAGE(PG8_SA(0, 1), a2 + hstep, voffA);
            PG8_WAIT_V(8); PG8_WAIT_L(0); PG8_BAR; PG8_MMA(0, 0, At, B0); PG8_MMA(0, 1, At, B1); PG8_BAR; PG8_SCHED;
            PG8_LDA(At, 1, 1); PG8_STAGE(PG8_SB(1, 0), b3, voffB); PG8_STAGE(PG8_SB(1, 1), b3 + hstep, voffB); PG8_STAGE(PG8_SA(1, 0), a3, voffA);
            PG8_WAIT_V(8); PG8_WAIT_L(0); PG8_BAR; PG8_MMA(1, 0, At, B0); PG8_MMA(1, 1, At, B1); PG8_BAR; PG8_SCHED;
            } else {
            PG8_LDB(B0, 0, 0); PG8_SCHED; PG8_LDA(At, 0, 0); PG8_STAGE(PG8_SA(1, 1), a1 + hstep, voffA);
            PG8_WAIT_L(8); PG8_BAR; PG8_WAIT_L(0); PG8_MMA(0, 0, At, B0); PG8_BAR; PG8_SCHED;
            PG8_LDB(B1, 0, 1); PG8_STAGE(PG8_SB(0, 0), b2, voffB);
            PG8_BAR; PG8_WAIT_L(0); PG8_MMA(0, 1, At, B1); PG8_BAR;
            PG8_LDA(At, 0, 1); PG8_STAGE(PG8_SA(0, 0), a2, voffA);
            PG8_BAR; PG8_WAIT_L(0); PG8_MMA(1, 0, At, B0); PG8_BAR; PG8_SCHED;
            PG8_STAGE(PG8_SB(0, 1), b2 + hstep, voffB);
            PG8_WAIT_V(6); PG8_BAR; PG8_MMA(1, 1, At, B1); PG8_BAR;
            PG8_LDB(B0, 1, 0); PG8_SCHED; PG8_LDA(At, 1, 0); PG8_STAGE(PG8_SA(0, 1), a2 + hstep, voffA);
            PG8_WAIT_L(8); PG8_BAR; PG8_WAIT_L(0); PG8_MMA(0, 0, At, B0); PG8_BAR; PG8_SCHED;
            PG8_LDB(B1, 1, 1); PG8_STAGE(PG8_SB(1, 0), b3, voffB);
            PG8_BAR; PG8_WAIT_L(0); PG8_MMA(0, 1, At, B1); PG8_BAR;
            PG8_LDA(At, 1, 1); PG8_STAGE(PG8_SA(1, 0), a3, voffA);
            PG8_BAR; PG8_WAIT_L(0); PG8_MMA(1, 0, At, B0); PG8_BAR; PG8_SCHED;
            PG8_STAGE(PG8_SB(1, 1), b3 + hstep, voffB);
            PG8_WAIT_V(6); PG8_BAR; PG8_MMA(1, 1, At, B1); PG8_BAR;
            }
        }
        if constexpr (ALIGN_EPI) { if (wr == 0) PG8_BAR; }
        if constexpr (!Epi::AFTER_DRAIN) { PG8_TS_BEGIN(Epi::TSID); E(acc, cur, wr, wc, fr, fq); PG8_TS_END(Epi::TSID); S.done(cur); }
        if (!has_next) break;
#pragma unroll
        for (int a = 0; a < 2; ++a)
#pragma unroll
            for (int b = 0; b < 2; ++b)
#pragma unroll
                for (int m = 0; m < 4; ++m)
#pragma unroll
                    for (int n = 0; n < 2; ++n) acc[a][b][m][n] = (f32x4){0.f, 0.f, 0.f, 0.f};
        cur = nxt; cA = nA; cB = nB; ++ui;
        if constexpr (ALIGN_EPI) { if (wr == 1) PG8_BAR; }
    }
    PG8_WAIT_V(0);
    if constexpr (!ALIGN_EPI) { if (wr == 0) PG8_BAR; }
    PG8_BAR;
    if constexpr (Epi::AFTER_DRAIN) { E.fused(acc, cur, wr, wc, fr, fq, lds, wid, lane); S.done(cur); }
#undef PG8_SA
#undef PG8_SB
#undef PG8_STAGE
#undef PG8_LDA
#undef PG8_LDB
#undef PG8_MMA
#undef PG8_WAIT_V
#undef PG8_WAIT_L
#undef PG8_BAR
#undef PG8_SCHED
}
}

#define GAS __attribute__((address_space(1)))
#define LAS __attribute__((address_space(3)))
typedef unsigned short bf16;
typedef unsigned v4u __attribute__((ext_vector_type(4)));
typedef unsigned v2u __attribute__((ext_vector_type(2)));
typedef float f32x4 __attribute__((ext_vector_type(4)));
typedef float f32x2 __attribute__((ext_vector_type(2)));
typedef short bf16x8 __attribute__((ext_vector_type(8)));
constexpr int NWAVES = 8, NTHREADS = 512;
constexpr int ZPITCH = 1536;
constexpr int RING_BYTES = 131072, LDS_BYTES = 153600;
constexpr int RST_OFF = RING_BYTES + 10240;

constexpr size_t MiB = 1u << 20;
constexpr size_t SL_WIN = 0, SL_WBR = SL_WIN + (size_t)NIN * D * 2, SL_WO = SL_WBR + (size_t)3 * D * 512 * 2, SL_WUP = SL_WO + (size_t)D * D * 2,
                 SL_WDN = SL_WUP + (size_t)DFF2 * D * 2, SL_SGW = SL_WDN + (size_t)D * DFF * 2, SL_END = SL_SGW + (size_t)4 * 128 * 128 * 2, SL_BYTES = 38 * MiB;
static_assert(SL_END <= SL_BYTES, "weight slot");
constexpr size_t WS_CTL = 0, WS_SLOT0 = 1 * MiB, WS_XB = WS_SLOT0 + 2 * SL_BYTES, WS_SSQ = WS_XB + 32 * MiB, WS_SVST = WS_SSQ + 1 * MiB, WS_ACT0 = WS_SVST + 1 * MiB;
constexpr size_t A_Q = 0, A_K = 8 * MiB, A_V = 16 * MiB, A_Z = 32 * MiB, A_SV = 80 * MiB, A_CC = 96 * MiB, A_CX = 112 * MiB, A_LOGA = 128 * MiB, A_G = 144 * MiB,
                 A_CST = 240 * MiB, A_DEC = 272 * MiB, A_END = 273 * MiB;
constexpr size_t A_MERGED = A_Q, A_HUP = 0, A_ACT = 176 * MiB, A_HT = 64 * MiB;
static_assert(A_ACT + (size_t)M * DFF * 2 <= A_END, "overlay");
constexpr size_t WS_END = WS_ACT0 + A_END;
constexpr int CW_BAR = 1024, CW_QHEAD = 6144, CW_FIN = 8192;

__device__ __forceinline__ float bf2f(unsigned h) { return __uint_as_float(h << 16); }
__device__ __forceinline__ unsigned pk2(float lo, float hi) { return pg8::cvt_pk_bf16(lo, hi); }
__device__ __forceinline__ float fsigmoid(float z) { return __builtin_amdgcn_rcpf(1.f + __expf(-z)); }
__device__ __forceinline__ float fsilu(float z) { return z * fsigmoid(z); }
__device__ __forceinline__ float fgelu(float z) { return z * fsigmoid(1.5957691216057308f * (z + 0.044715f * z * z * z)); }
__device__ __forceinline__ float flogsig(float z) { return fminf(z, 0.f) - __logf(1.f + __expf(-fabsf(z))); }
__device__ __forceinline__ float wave_sum(float v) {
#pragma unroll
    for (int o = 1; o < 64; o <<= 1) v += __shfl_xor(v, o);
    return v;
}
#define LDS_WAIT() asm volatile("s_waitcnt lgkmcnt(0)" ::: "memory")
#define LDS_BARRIER() do { asm volatile("s_waitcnt lgkmcnt(0)" ::: "memory"); __builtin_amdgcn_s_barrier(); asm volatile("" ::: "memory"); } while (0)
__device__ __forceinline__ f32x4 mfma16(bf16x8 a, bf16x8 b, f32x4 c) { return __builtin_amdgcn_mfma_f32_16x16x32_bf16(a, b, c, 0, 0, 0); }

__device__ __forceinline__ void tr_write(bf16* WT, int K, int k0, LAS float* scr, int lane) {
    LDS_WAIT(); asm volatile("" ::: "memory");
    const int c = lane & 7;
#pragma unroll
    for (int j = 0; j < 4; ++j) { const int n = (lane >> 3) + 8 * j; const LAS float* s = scr + (8 * c) * 33 + n;
        v4u o; o.x = pk2(s[0 * 33], s[1 * 33]); o.y = pk2(s[2 * 33], s[3 * 33]); o.z = pk2(s[4 * 33], s[5 * 33]); o.w = pk2(s[6 * 33], s[7 * 33]);
        *(GAS v4u*)(WT + (size_t)n * K + k0 + 8 * c) = o; }
    LDS_WAIT(); asm volatile("" ::: "memory");
}
__device__ __forceinline__ void tr_item(const float* W, int ldw, int col0, const float* ksc, float sc, bf16* WT, int K, int k0, LAS float* scr, int lane) {
    float v[32]; const float* src = W + (size_t)(k0 + (lane >> 5)) * ldw + col0 + (lane & 31);
#pragma unroll
    for (int i = 0; i < 32; ++i) v[i] = src[(size_t)(2 * i) * ldw];
    if (ksc) {
#pragma unroll
        for (int i = 0; i < 32; ++i) v[i] *= ksc[k0 + 2 * i + (lane >> 5)]; }
#pragma unroll
    for (int i = 0; i < 32; ++i) scr[(2 * i + (lane >> 5)) * 33 + (lane & 31)] = v[i] * sc;
    tr_write(WT, K, k0, scr, lane);
}
__device__ __forceinline__ void alpha_item(const float* win, const float* wal, const float* g, bf16* WT, int k0, int j0, LAS float* scr, int lane) {
    const int jj = lane & 31, half = lane >> 5; float wa[16];
#pragma unroll
    for (int r = 0; r < 16; ++r) wa[r] = wal[r * GKEY + j0 + jj];
    for (int i = 0; i < 32; ++i) { const int kk = 2 * i + half, k = k0 + kk; const float* wr = win + (size_t)k * INC + O_A; float s = 0.f;
#pragma unroll
        for (int r = 0; r < 16; ++r) s += wr[r] * wa[r];
        scr[kk * 33 + jj] = s * g[k]; }
    tr_write(WT + (size_t)j0 * D, D, k0, scr, lane);
}
struct Inputs { const float* p[21]; };
constexpr int CV_J0 = 16 * 224, CV_J1 = 16 * 8, CV_J2 = 3 * 8 * 32, CV_J3 = 16 * 32, CV_J4 = 16 * 176, CV_J5 = 44 * 32, CV_J6 = 128, CV_ITEMS = CV_J0 + CV_J1 + CV_J2 + CV_J3 + CV_J4 + CV_J5 + CV_J6;
constexpr int CV_WIN_ITEMS = CV_J0 + CV_J1;
__device__ __forceinline__ void convert_item(const Inputs& I, int l, unsigned char* slot, LAS float* scr, int it, int lane) {
    bf16* WIN = (bf16*)(slot + SL_WIN); bf16* WBR = (bf16*)(slot + SL_WBR); bf16* WO = (bf16*)(slot + SL_WO); bf16* WUP = (bf16*)(slot + SL_WUP); bf16* WDN = (bf16*)(slot + SL_WDN); bf16* SGWS = (bf16*)(slot + SL_SGW);
    const float* win = I.p[2] + (size_t)l * D * INC;
        int r = it;
        if (r < CV_J0) { const int kb = r / 224, nb = r % 224; const int drow = nb < 48 ? 32 * nb : 1792 + 32 * (nb - 48), scol = nb < 48 ? 32 * nb : O_SU + 32 * (nb - 48);
            tr_item(win, INC, scol, I.p[1] + (size_t)l * D, drow < 256 ? 0.125f : 1.f, WIN + (size_t)drow * D, D, 64 * kb, scr, lane); return; }
        r -= CV_J0;
        if (r < CV_J1) { const int kb = r / 8, jb = r % 8; alpha_item(win, I.p[3] + (size_t)l * GRANK * GKEY, I.p[1] + (size_t)l * D, WIN + (size_t)1536 * D, 64 * kb, 32 * jb, scr, lane); return; }
        r -= CV_J1;
        if (r < CV_J2) { const int br = r / 256, rr = r % 256, kb = rr / 32, nb = rr % 32;
            const float* W = (br == 0 ? I.p[6] : br == 1 ? I.p[11] : I.p[13]) + (size_t)l * 512 * D;
            tr_item(W, D, 32 * nb, br == 0 ? I.p[5] + (size_t)l * GVAL : nullptr, 1.f, WBR + (size_t)32 * nb * ZPITCH + br * 512, ZPITCH, 64 * kb, scr, lane); return; }
        r -= CV_J2;
        if (r < CV_J3) { const int kb = r / 32, nb = r % 32; tr_item(I.p[14] + (size_t)l * D * D, D, 32 * nb, nullptr, 1.f, WO + (size_t)32 * nb * D, D, 64 * kb, scr, lane); return; }
        r -= CV_J3;
        if (r < CV_J4) { const int kb = r / 176, nb = r % 176, pn = nb / 8, jb = nb % 8; const int scol = jb < 4 ? 128 * pn + 32 * jb : DFF + 128 * pn + 32 * (jb - 4);
            tr_item(I.p[16] + (size_t)l * D * DFF2, DFF2, scol, I.p[15] + (size_t)l * D, 1.f, WUP + (size_t)32 * nb * D, D, 64 * kb, scr, lane); return; }
        r -= CV_J4;
        if (r < CV_J5) { const int kb = r / 32, nb = r % 32; tr_item(I.p[19] + (size_t)l * DFF * D, D, 32 * nb, nullptr, 1.f, WDN + (size_t)32 * nb * DFF, DFF, 64 * kb, scr, lane); return; }
        r -= CV_J5;
        { const int e0 = r * 512 + lane * 8, t = (e0 >> 7) & 127, s0 = e0 & 127; const float* src = I.p[9] + (size_t)l * 4 * 128 * 128 + e0;
          const f32x4 a = *(const f32x4*)src, b = *(const f32x4*)(src + 4); float v[8] = {a[0], a[1], a[2], a[3], b[0], b[1], b[2], b[3]};
#pragma unroll
          for (int e = 0; e < 8; ++e) if (s0 + e > t) v[e] = 0.f;
          v4u o; o.x = pk2(v[0], v[1]); o.y = pk2(v[2], v[3]); o.z = pk2(v[4], v[5]); o.w = pk2(v[6], v[7]); *(GAS v4u*)(SGWS + e0) = o; }
}
__device__ __forceinline__ void convert_static(const Inputs& I, int l, unsigned char* slot, LAS unsigned char* lds, int it_lo, int it_hi, int gw, int ngw, int wave, int lane) {
    LAS float* scr = (LAS float*)(lds + wave * 8448);
    for (int it = it_lo + gw; it < it_hi; it += ngw) convert_item(I, l, slot, scr, it, lane);
}
#define RLX_AGENT __ATOMIC_RELAXED, __HIP_MEMORY_SCOPE_AGENT
__device__ __forceinline__ void convert_queue(const Inputs& I, int l, unsigned char* slot, LAS unsigned char* lds, unsigned* head, int it_lo, int it_hi, unsigned* fin, int G, int tid, int wave, int lane) {
    LAS float* scr = (LAS float*)(lds + wave * 8448); volatile LAS unsigned* bc = (volatile LAS unsigned*)(lds + 8 * 8448);
    for (;;) {
        if (tid == 0) { unsigned v = 0xffffffffu; if (!fin || __hip_atomic_load(fin, RLX_AGENT) < (unsigned)G) v = __hip_atomic_fetch_add(head, 8u, RLX_AGENT); bc[0] = v; }
        LDS_BARRIER();
        const unsigned base = bc[0];
        LDS_BARRIER();
        if (base >= (unsigned)(it_hi - it_lo)) break;
        const int it = it_lo + (int)base + wave; if (it < it_hi) convert_item(I, l, slot, scr, it, lane);
    }
}
__device__ __forceinline__ void x_prep(const float* xin, bf16* xb, float* ssq, int gw, int ngw, int lane) {
    for (int row = gw; row < M; row += ngw) {
        const GAS f32x4* xr = (const GAS f32x4*)(xin + (size_t)row * D) + lane; f32x4 v[4]; float s = 0.f;
#pragma unroll
        for (int j = 0; j < 4; ++j) { v[j] = xr[64 * j]; s += (v[j][0] * v[j][0] + v[j][1] * v[j][1]) + (v[j][2] * v[j][2] + v[j][3] * v[j][3]); }
        s = wave_sum(s);
#pragma unroll
        for (int j = 0; j < 4; ++j) { v2u w; w.x = pk2(v[j][0], v[j][1]); w.y = pk2(v[j][2], v[j][3]); ((GAS v2u*)(xb + (size_t)row * D))[lane + 64 * j] = w; }
        if (lane < 16) ssq[(size_t)row * 16 + lane] = lane == 0 ? s : 0.f;
    }
}
__device__ __forceinline__ void final_norm(const bf16* xb, float* out, const float* ssq, const float* g, int gw, int ngw, int lane) {
    for (int row = gw; row < M; row += ngw) {
        const float pv = lane < 16 ? ssq[(size_t)row * 16 + lane] : 0.f; const float rs = rsqrtf(wave_sum(pv) * (1.f / D) + EPS);
        const GAS v2u* xr = (const GAS v2u*)(xb + (size_t)row * D) + lane; GAS f32x4* orow = (GAS f32x4*)(out + (size_t)row * D) + lane;
#pragma unroll
        for (int j = 0; j < 4; ++j) { const v2u w = xr[64 * j]; const f32x4 gv = ((const GAS f32x4*)g)[lane + 64 * j];
            orow[64 * j] = (f32x4){bf2f(w.x & 0xffffu) * rs * gv[0], bf2f(w.x >> 16) * rs * gv[1], bf2f(w.y & 0xffffu) * rs * gv[2], bf2f(w.y >> 16) * rs * gv[3]}; }
    }
}

constexpr int GP = 72;
constexpr int L_QT = 0, L_KT = 9216, L_KENDT = 18432, L_VT = 27648, L_ST = 46080, L_SEG = 64512, L_DECS = 66560, L_RED = 66816, L_GLA_END = 67328;
constexpr int VP = 136;

__device__ __forceinline__ void sgu_item(int item, LAS unsigned char* lds, const bf16* ZBI, bf16* ZBO, const bf16* SV, const float* SVST, const float* lng, const float* lnb, const bf16* wsb, const float* bs, int wave, int lane) {
    const int b_ = item & 7, h = (item >> 3) & 3, r0 = b_ * SEQ + (item >> 5) * 128; LAS bf16* vnT = (LAS bf16*)lds;
    const int fr = lane & 15, fq = lane >> 4, t = 16 * wave + fr, nks = (wave >> 1) + 1; const size_t orow = (size_t)r0 + t;
    bf16x8 bfr[4];
#pragma unroll
    for (int ks = 0; ks < 4; ++ks) bfr[ks] = (ks < nks) ? *(const bf16x8*)(wsb + ((size_t)h * 128 + t) * 128 + 32 * ks + 8 * fq) : (bf16x8){0, 0, 0, 0, 0, 0, 0, 0};
    v2u suv[8];
#pragma unroll
    for (int m = 0; m < 8; ++m) suv[m] = *(const v2u*)(ZBI + orow * ZPITCH + h * 128 + 16 * m + 4 * fq);
    const float bias = bs[h * 128 + t];
    { const int d0 = 16 * wave, s0 = 2 * lane; float mean[2], rstd[2]; v4u xv[2][2];
#pragma unroll
      for (int rr = 0; rr < 2; ++rr) { const size_t row = (size_t)r0 + s0 + rr; const f32x4* p = (const f32x4*)(SVST + row * 16); const f32x4 a = p[0], b = p[1], c = p[2], d = p[3];
          const v4u* q = (const v4u*)(SV + row * 512 + h * 128 + d0); xv[rr][0] = q[0]; xv[rr][1] = q[1];
          const float sm = (a[0] + a[2]) + (b[0] + b[2]) + (c[0] + c[2]) + (d[0] + d[2]), sq = (a[1] + a[3]) + (b[1] + b[3]) + (c[1] + c[3]) + (d[1] + d[3]);
          mean[rr] = sm * (1.f / 512.f); rstd[rr] = rsqrtf(fmaxf(sq * (1.f / 512.f) - mean[rr] * mean[rr], 0.f) + EPS); }
      f32x4 gv[4], bv[4];
#pragma unroll
      for (int q4 = 0; q4 < 4; ++q4) { gv[q4] = *(const f32x4*)(lng + h * 128 + d0 + 4 * q4); bv[q4] = *(const f32x4*)(lnb + h * 128 + d0 + 4 * q4); }
#pragma unroll
      for (int j = 0; j < 16; ++j) { const float g = gv[j >> 2][j & 3], b = bv[j >> 2][j & 3]; const unsigned w0 = xv[0][j >> 3][(j >> 1) & 3], w1 = xv[1][j >> 3][(j >> 1) & 3];
          const float x0 = (j & 1) ? bf2f(w0 >> 16) : bf2f(w0 & 0xffffu), x1 = (j & 1) ? bf2f(w1 >> 16) : bf2f(w1 & 0xffffu);
          *(LAS unsigned*)(vnT + (d0 + j) * VP + s0) = pk2((x0 - mean[0]) * rstd[0] * g + b, (x1 - mean[1]) * rstd[1] * g + b); } }
    LDS_BARRIER();
    { f32x4 acc[8];
#pragma unroll
      for (int m = 0; m < 8; ++m) { acc[m] = (f32x4){0.f, 0.f, 0.f, 0.f};
#pragma unroll
          for (int ks = 0; ks < 4; ++ks) if (ks < nks) { const bf16x8 a = *(const LAS bf16x8*)(vnT + (16 * m + fr) * VP + 32 * ks + 8 * fq); acc[m] = mfma16(a, bfr[ks], acc[m]); } }
#pragma unroll
      for (int m = 0; m < 8; ++m) { const v2u su = suv[m]; v2u o;
          o.x = pk2(bf2f(su.x & 0xffffu) * (acc[m][0] + bias), bf2f(su.x >> 16) * (acc[m][1] + bias)); o.y = pk2(bf2f(su.y & 0xffffu) * (acc[m][2] + bias), bf2f(su.y >> 16) * (acc[m][3] + bias));
          *(v2u*)(ZBO + orow * ZPITCH + h * 128 + 16 * m + 4 * fq) = o; } }
    LDS_BARRIER();
}
__device__ __forceinline__ void convbr_item(int idx, const bf16* ZCI, bf16* ZCO, const bf16* CC, const bf16* CX, const float* cw) {
    const int c0 = (idx & 63) * 8, wg_ = idx >> 9, r0 = (wg_ & 7) * SEQ + (wg_ >> 3) * 64 + ((idx >> 6) & 7) * 8; float w[3][8];
#pragma unroll
    for (int k = 0; k < 3; ++k) { const f32x4 a = *(const f32x4*)(cw + k * CW + c0), b = *(const f32x4*)(cw + k * CW + c0 + 4);
#pragma unroll
        for (int e = 0; e < 4; ++e) { w[k][e] = a[e]; w[k][4 + e] = b[e]; } }
    float u2[8], u1[8];
    auto loadu = [&](int row, float (&u)[8]) { const v4u a = *(const v4u*)(CC + (size_t)row * CW + c0), b = *(const v4u*)(CX + (size_t)row * CW + c0);
#pragma unroll
        for (int e = 0; e < 4; ++e) { u[2 * e] = bf2f(a[e] & 0xffffu) * bf2f(b[e] & 0xffffu); u[2 * e + 1] = bf2f(a[e] >> 16) * bf2f(b[e] >> 16); } };
    if ((r0 & (SEQ - 1)) == 0) {
#pragma unroll
        for (int e = 0; e < 8; ++e) { u2[e] = 0.f; u1[e] = 0.f; } }
    else { loadu(r0 - 2, u2); loadu(r0 - 1, u1); }
#pragma unroll
    for (int i = 0; i < 8; ++i) { float u0[8]; loadu(r0 + i, u0); const size_t po = (size_t)(r0 + i) * ZPITCH + c0; bf16* p = ZCO + po; const v4u cb = *(const v4u*)(ZCI + po); float z[8];
#pragma unroll
        for (int e = 0; e < 8; ++e) { const float y = w[0][e] * u2[e] + w[1][e] * u1[e] + w[2][e] * u0[e]; const float c = (e & 1) ? bf2f(cb[e >> 1] >> 16) : bf2f(cb[e >> 1] & 0xffffu); z[e] = c * y; u2[e] = u1[e]; u1[e] = u0[e]; }
        v4u o; o.x = pk2(z[0], z[1]); o.y = pk2(z[2], z[3]); o.z = pk2(z[4], z[5]); o.w = pk2(z[6], z[7]); *(v4u*)p = o; }
}
#ifdef TSUB
#define TS_SLOT ((LAS unsigned long long*)(lds + RING_BYTES + 640))
#define TS_BEGIN(k) unsigned long long ts_b##k = 0; if ((k) == TSUB) ts_b##k = __builtin_amdgcn_s_memrealtime()
#define TS_END(k) do { if ((k) == TSUB && blockIdx.x == 7 && tid == 0) *TS_SLOT += __builtin_amdgcn_s_memrealtime() - ts_b##k; } while (0)
#else
#define TS_BEGIN(k) do { } while (0)
#define TS_END(k) do { } while (0)
#endif
__device__ __forceinline__ float wave_scan_incl(float x) {
#define DPP_ADD(ctrl, rmask) x += __builtin_bit_cast(float, __builtin_amdgcn_update_dpp(0, __builtin_bit_cast(int, x), ctrl, rmask, 0xf, true))
    DPP_ADD(0x111, 0xf); DPP_ADD(0x112, 0xf); DPP_ADD(0x114, 0xf); DPP_ADD(0x118, 0xf);
    x += __builtin_bit_cast(float, __builtin_amdgcn_update_dpp(0, __builtin_bit_cast(int, x), 0x142, 0xa, 0xf, false));
    x += __builtin_bit_cast(float, __builtin_amdgcn_update_dpp(0, __builtin_bit_cast(int, x), 0x143, 0xc, 0xf, false));
#undef DPP_ADD
    return x;
}
struct GlaPre { f32x4 la0, la1; v4u kq, qq, va, vb; };
template <bool FULL> __device__ __forceinline__ GlaPre gla_load(size_t r0, int h, const bf16* Q, const bf16* KK, const bf16* V, const float* LOGA, int tid, int wave, int lane) {
    GlaPre p; const size_t row = r0 + lane; const int kc0 = 8 * wave;
    p.la0 = *(const f32x4*)(LOGA + row * GKEY + h * 64 + kc0); p.la1 = *(const f32x4*)(LOGA + row * GKEY + h * 64 + kc0 + 4);
    p.kq = *(const v4u*)(KK + row * GKEY + h * 64 + kc0); if (FULL) p.qq = *(const v4u*)(Q + row * GKEY + h * 64 + kc0); else p.qq = (v4u){0u, 0u, 0u, 0u};
    const int tp = tid & 31, vg = tid >> 5;
    p.va = *(const v4u*)(V + (r0 + 2 * tp) * GVAL + h * 128 + 8 * vg); p.vb = *(const v4u*)(V + (r0 + 2 * tp + 1) * GVAL + h * 128 + 8 * vg);
    return p;
}
template <bool FULL> __device__ __forceinline__ void gla_build(const GlaPre& p, LAS unsigned char* lds, int tid, int wave, int lane, float (&tot)[8]) {
    const int kc0 = 8 * wave; float b[8] = {p.la0[0], p.la0[1], p.la0[2], p.la0[3], p.la1[0], p.la1[1], p.la1[2], p.la1[3]};
#pragma unroll
    for (int j = 0; j < 8; ++j) b[j] = wave_scan_incl(b[j]);
    float kf[8], qf[8];
#pragma unroll
    for (int e = 0; e < 4; ++e) { kf[2 * e] = bf2f(p.kq[e] & 0xffffu); kf[2 * e + 1] = bf2f(p.kq[e] >> 16); qf[2 * e] = bf2f(p.qq[e] & 0xffffu); qf[2 * e + 1] = bf2f(p.qq[e] >> 16); }
    LAS bf16* KE = (LAS bf16*)(lds + L_KENDT);
#pragma unroll
    for (int j = 0; j < 8; ++j) { tot[j] = __builtin_bit_cast(float, __builtin_amdgcn_readlane(__builtin_bit_cast(int, b[j]), 63)); KE[(kc0 + j) * GP + lane] = (bf16)(pk2(kf[j] * __expf(tot[j] - b[j]), 0.f) & 0xffffu); }
    if (FULL) { float qt[8], kt[8];
#pragma unroll
        for (int j = 0; j < 8; ++j) { qt[j] = qf[j] * __expf(b[j]); kt[j] = kf[j] * __expf(-b[j]); }
        v4u o; o.x = pk2(qt[0], qt[1]); o.y = pk2(qt[2], qt[3]); o.z = pk2(qt[4], qt[5]); o.w = pk2(qt[6], qt[7]); *(LAS v4u*)((LAS bf16*)(lds + L_QT) + lane * GP + kc0) = o;
        o.x = pk2(kt[0], kt[1]); o.y = pk2(kt[2], kt[3]); o.z = pk2(kt[4], kt[5]); o.w = pk2(kt[6], kt[7]); *(LAS v4u*)((LAS bf16*)(lds + L_KT) + lane * GP + kc0) = o; }
    if (lane < 8) { float tl = tot[0];
#pragma unroll
        for (int j = 1; j < 8; ++j) tl = (lane == j) ? tot[j] : tl;
        ((LAS float*)(lds + L_DECS))[kc0 + lane] = __expf(tl); }
    { const int tp = tid & 31, vg = tid >> 5; LAS bf16* VT = (LAS bf16*)(lds + L_VT);
#pragma unroll
      for (int e = 0; e < 4; ++e) { *(LAS unsigned*)(VT + (8 * vg + 2 * e) * GP + 2 * tp) = (p.va[e] & 0xffffu) | (p.vb[e] << 16); *(LAS unsigned*)(VT + (8 * vg + 2 * e + 1) * GP + 2 * tp) = (p.va[e] >> 16) | (p.vb[e] & 0xffff0000u); } }
}
__device__ __forceinline__ void gla_state_step(f32x4 (&S)[4], LAS unsigned char* lds, int wave, int fr, int fq) {
    const LAS bf16* VT = (const LAS bf16*)(lds + L_VT); const LAS bf16* KE = (const LAS bf16*)(lds + L_KENDT); const LAS float* DECS = (const LAS float*)(lds + L_DECS);
    bf16x8 bv[2];
#pragma unroll
    for (int ks = 0; ks < 2; ++ks) bv[ks] = *(const LAS bf16x8*)(VT + (16 * wave + fr) * GP + 32 * ks + 8 * fq);
#pragma unroll
    for (int m = 0; m < 4; ++m) { const f32x4 d = *(const LAS f32x4*)(DECS + 16 * m + 4 * fq); S[m] = S[m] * d;
#pragma unroll
        for (int ks = 0; ks < 2; ++ks) S[m] = mfma16(*(const LAS bf16x8*)(KE + (16 * m + fr) * GP + 32 * ks + 8 * fq), bv[ks], S[m]); }
}
__device__ __forceinline__ void gla_b1_item(int item, LAS unsigned char* lds, const bf16* KK, const bf16* V, const float* LOGA, float* CST, float* DEC, int tid, int wave, int lane) {
    const int b = item & 7, g = (item >> 3) & 7, h = item >> 6, fr = lane & 15, fq = lane >> 4;
    if (g == 7) return;
    f32x4 S[4]; float lsum[8];
#pragma unroll
    for (int m = 0; m < 4; ++m) S[m] = (f32x4){0.f, 0.f, 0.f, 0.f};
#pragma unroll
    for (int j = 0; j < 8; ++j) lsum[j] = 0.f;
    const size_t rg = (size_t)b * SEQ + (size_t)g * 256;
    GlaPre pre[4];
#pragma unroll
    for (int c = 0; c < 4; ++c) pre[c] = gla_load<false>(rg + (size_t)c * 64, h, nullptr, KK, V, LOGA, tid, wave, lane);
#pragma unroll
    for (int c = 0; c < 4; ++c) {
        float tot[8]; gla_build<false>(pre[c], lds, tid, wave, lane, tot);
#pragma unroll
        for (int j = 0; j < 8; ++j) lsum[j] += tot[j];
        LDS_BARRIER();
        gla_state_step(S, lds, wave, fr, fq);
        LDS_BARRIER();
    }
#pragma unroll
    for (int m = 0; m < 4; ++m) { v2u w; w.x = pk2(S[m][0], S[m][1]); w.y = pk2(S[m][2], S[m][3]); *(v2u*)((bf16*)CST + (size_t)item * 8192 + (16 * wave + fr) * 64 + 16 * m + 4 * fq) = w; }
    if (lane < 8) { float tl = lsum[0];
#pragma unroll
        for (int j = 1; j < 8; ++j) tl = (lane == j) ? lsum[j] : tl;
        DEC[(size_t)item * 64 + 8 * wave + lane] = tl; }
}
__device__ __forceinline__ void gla_b2_unit(int unit, LAS unsigned char* lds, const bf16* Q, const bf16* KK, const bf16* V, const float* LOGA, const float* CST, const float* DEC, const bf16* ZAI, bf16* ZAO, int tid, int wave, int lane) {
    const int b = unit & 7, g = (unit >> 3) & 7, h = unit >> 6, fr = lane & 15, fq = lane >> 4;
    TS_BEGIN(1); TS_BEGIN(2);
    const size_t rg = (size_t)b * SEQ + (size_t)g * 256;
    const int ih = wave & 3, vh = wave >> 2;
    GlaPre pre[4]; v2u gt[4][4];
#pragma unroll
    for (int c = 0; c < 2; ++c) pre[c] = gla_load<true>(rg + (size_t)c * 64, h, Q, KK, V, LOGA, tid, wave, lane);
    f32x4 S[4];
#pragma unroll
    for (int m = 0; m < 4; ++m) S[m] = (f32x4){0.f, 0.f, 0.f, 0.f};
    { const size_t it0 = (size_t)unit - 8 * g;
      v2u cc[7][4];
#pragma unroll
      for (int j = 0; j < 7; ++j) if (j < g) {
#pragma unroll
          for (int m = 0; m < 4; ++m) cc[j][m] = *(const v2u*)((const bf16*)CST + (it0 + 8 * j) * 8192 + (16 * wave + fr) * 64 + 16 * m + 4 * fq); }
      LAS float* DT = (LAS float*)(lds + L_QT);
      if (tid < 64 * g) DT[tid] = __expf(DEC[(it0 + 8 * (tid >> 6)) * 64 + (tid & 63)]);
      LDS_BARRIER();
#pragma unroll
      for (int j = 0; j < 7; ++j) if (j < g) {
#pragma unroll
          for (int m = 0; m < 4; ++m) { const f32x4 d = *(const LAS f32x4*)(DT + j * 64 + 16 * m + 4 * fq);
              const f32x4 c = (f32x4){bf2f(cc[j][m].x & 0xffffu), bf2f(cc[j][m].x >> 16), bf2f(cc[j][m].y & 0xffffu), bf2f(cc[j][m].y >> 16)}; S[m] = d * S[m] + c; } }
      LDS_BARRIER(); }
#pragma unroll
    for (int c = 2; c < 4; ++c) pre[c] = gla_load<true>(rg + (size_t)c * 64, h, Q, KK, V, LOGA, tid, wave, lane);
#pragma unroll
    for (int c = 0; c < 4; ++c)
#pragma unroll
        for (int mt = 0; mt < 4; ++mt) gt[c][mt] = *(const v2u*)(ZAI + (rg + (size_t)c * 64 + 16 * ih + fr) * ZPITCH + h * 128 + 64 * vh + 16 * mt + 4 * fq);
    TS_END(2);
    const LAS bf16* QT = (const LAS bf16*)(lds + L_QT); const LAS bf16* KT = (const LAS bf16*)(lds + L_KT);
    const LAS bf16* VT = (const LAS bf16*)(lds + L_VT); LAS bf16* ST = (LAS bf16*)(lds + L_ST); LAS float* RED = (LAS float*)(lds + L_RED);
#pragma unroll
    for (int c = 0; c < 4; ++c) {
        TS_BEGIN(3);
        const size_t r0 = rg + (size_t)c * 64;
#pragma unroll
        for (int m = 0; m < 4; ++m) { v2u w; w.x = pk2(S[m][0], S[m][1]); w.y = pk2(S[m][2], S[m][3]); *(LAS v2u*)(ST + (16 * wave + fr) * GP + 16 * m + 4 * fq) = w; }
        float tot[8]; gla_build<true>(pre[c], lds, tid, wave, lane, tot);
        LDS_BARRIER();
        TS_END(3); TS_BEGIN(4);
        bf16x8 bq[2];
#pragma unroll
        for (int ks = 0; ks < 2; ++ks) bq[ks] = *(const LAS bf16x8*)(QT + (16 * ih + fr) * GP + 32 * ks + 8 * fq);
        f32x4 X[4];
#pragma unroll
        for (int jt = 0; jt < 4; ++jt) { X[jt] = (f32x4){0.f, 0.f, 0.f, 0.f};
            if (jt <= ih) {
#pragma unroll
                for (int ks = 0; ks < 2; ++ks) X[jt] = mfma16(*(const LAS bf16x8*)(KT + (16 * jt + fr) * GP + 32 * ks + 8 * fq), bq[ks], X[jt]);
#pragma unroll
                for (int r = 0; r < 4; ++r) if (16 * jt + 4 * fq + r > 16 * ih + fr) X[jt][r] = 0.f; } }
        bf16x8 xb[2];
#pragma unroll
        for (int k2 = 0; k2 < 2; ++k2) { v4u w; w.x = pk2(X[2 * k2][0], X[2 * k2][1]); w.y = pk2(X[2 * k2][2], X[2 * k2][3]); w.z = pk2(X[2 * k2 + 1][0], X[2 * k2 + 1][1]); w.w = pk2(X[2 * k2 + 1][2], X[2 * k2 + 1][3]); xb[k2] = __builtin_bit_cast(bf16x8, w); }
        f32x4 O[4]; float ss = 0.f;
#pragma unroll
        for (int mt = 0; mt < 4; ++mt) { const int v = 64 * vh + 16 * mt + fr; f32x4 o = (f32x4){0.f, 0.f, 0.f, 0.f};
#pragma unroll
            for (int k2 = 0; k2 < 2; ++k2) { const v2u lo = *(const LAS v2u*)(VT + v * GP + 32 * k2 + 4 * fq), hi = *(const LAS v2u*)(VT + v * GP + 32 * k2 + 16 + 4 * fq); v4u a; a.x = lo.x; a.y = lo.y; a.z = hi.x; a.w = hi.y;
                o = mfma16(__builtin_bit_cast(bf16x8, a), xb[k2], o); }
#pragma unroll
            for (int ks = 0; ks < 2; ++ks) o = mfma16(*(const LAS bf16x8*)(ST + v * GP + 32 * ks + 8 * fq), bq[ks], o);
            O[mt] = o; ss += (o[0] * o[0] + o[1] * o[1]) + (o[2] * o[2] + o[3] * o[3]); }
        ss += __shfl_xor(ss, 16); ss += __shfl_xor(ss, 32);
        if (fq == 0) RED[(vh * 4 + ih) * 16 + fr] = ss;
        gla_state_step(S, lds, wave, fr, fq);
        LDS_BARRIER();
        TS_END(4); TS_BEGIN(5);
        const float rs = rsqrtf((RED[ih * 16 + fr] + RED[(4 + ih) * 16 + fr]) * (1.f / 128.f) + EPS);
        { const size_t row = r0 + 16 * ih + fr;
#pragma unroll
          for (int mt = 0; mt < 4; ++mt) { v2u o;
              o.x = pk2(O[mt][0] * rs * bf2f(gt[c][mt].x & 0xffffu), O[mt][1] * rs * bf2f(gt[c][mt].x >> 16)); o.y = pk2(O[mt][2] * rs * bf2f(gt[c][mt].y & 0xffffu), O[mt][3] * rs * bf2f(gt[c][mt].y >> 16));
              *(v2u*)(ZAO + row * ZPITCH + h * 128 + 64 * vh + 16 * mt + 4 * fq) = o; } }
        TS_END(5);
    }
    LDS_BARRIER();
    TS_END(1);
}
__device__ __forceinline__ void ffn_act_item(int idx, const bf16* HUP, bf16* ACT, const float* cw, const float* cb) {
    const int cgp = idx % 352, rb = idx / 352, pn = cgp >> 4, c8 = (cgp & 15) * 8, j0 = 128 * pn + c8, r0 = rb * 16;
    float wg[3][8], wv[3][8], bg[8], bv[8];
#pragma unroll
    for (int e = 0; e < 8; ++e) { bg[e] = cb[j0 + e]; bv[e] = cb[DFF + j0 + e];
#pragma unroll
        for (int k = 0; k < 3; ++k) { wg[k][e] = cw[k * DFF2 + j0 + e]; wv[k][e] = cw[k * DFF2 + DFF + j0 + e]; } }
    float g2[8], g1[8], v2[8], v1[8];
    auto ld = [&](int row, float (&g)[8], float (&v)[8]) { const bf16* p = HUP + (size_t)row * DFF2 + 256 * pn + c8; const v4u a = *(const v4u*)p, b = *(const v4u*)(p + 128);
#pragma unroll
        for (int e = 0; e < 4; ++e) { g[2 * e] = bf2f(a[e] & 0xffffu); g[2 * e + 1] = bf2f(a[e] >> 16); v[2 * e] = bf2f(b[e] & 0xffffu); v[2 * e + 1] = bf2f(b[e] >> 16); } };
    if ((r0 & (SEQ - 1)) == 0) {
#pragma unroll
        for (int e = 0; e < 8; ++e) { g2[e] = 0.f; g1[e] = 0.f; v2[e] = 0.f; v1[e] = 0.f; } }
    else { ld(r0 - 2, g2, v2); ld(r0 - 1, g1, v1); }
    for (int i = 0; i < 16; ++i) { float g0[8], v0[8]; ld(r0 + i, g0, v0); float z[8];
#pragma unroll
        for (int e = 0; e < 8; ++e) { const float ga = wg[0][e] * g2[e] + wg[1][e] * g1[e] + wg[2][e] * g0[e] + bg[e], va = wv[0][e] * v2[e] + wv[1][e] * v1[e] + wv[2][e] * v0[e] + bv[e];
            z[e] = fsilu(ga) * va; g2[e] = g1[e]; g1[e] = g0[e]; v2[e] = v1[e]; v1[e] = v0[e]; }
        v4u o; o.x = pk2(z[0], z[1]); o.y = pk2(z[2], z[3]); o.z = pk2(z[4], z[5]); o.w = pk2(z[6], z[7]); *(v4u*)(ACT + (size_t)(r0 + i) * DFF + j0) = o; }
}

using pg8::Unit;
__device__ __forceinline__ void row_rstd(const float* SSQ, int pm, int wr, int fr, int fq, float (&rsd)[2][4]) {
    const int lane = fr + 16 * fq;
#pragma unroll
    for (int ai = 0; ai < 2; ++ai) { const size_t row = (size_t)pm * 256 + ai * 128 + wr * 64 + lane; const f32x4* p = (const f32x4*)(SSQ + row * 16); const f32x4 a = p[0], b = p[1], c = p[2], d = p[3];
        const float s = ((a[0] + a[1]) + (a[2] + a[3])) + ((b[0] + b[1]) + (b[2] + b[3])) + ((c[0] + c[1]) + (c[2] + c[3])) + ((d[0] + d[1]) + (d[2] + d[3]));
        const float rs = rsqrtf(s * (1.f / D) + EPS);
#pragma unroll
        for (int m = 0; m < 4; ++m) rsd[ai][m] = __shfl(rs, 16 * m + fr); }
}
__device__ __forceinline__ void rstd_table_fill(const float* SSQ, int g8, LAS unsigned char* lds, int tid) {
    LAS float* T = (LAS float*)(lds + RST_OFF);
#pragma unroll
    for (int i = 0; i < 4; ++i) { const int r = tid + i * NTHREADS; const f32x4* p = (const f32x4*)(SSQ + ((size_t)g8 * 2048 + r) * 16); const f32x4 a = p[0], b = p[1], c = p[2], d = p[3];
        const float s = ((a[0] + a[1]) + (a[2] + a[3])) + ((b[0] + b[1]) + (b[2] + b[3])) + ((c[0] + c[1]) + (c[2] + c[3])) + ((d[0] + d[1]) + (d[2] + d[3]));
        T[r] = rsqrtf(s * (1.f / D) + EPS); }
    LDS_BARRIER();
}
__device__ __forceinline__ void row_rstd_tbl(const LAS unsigned char* lds, int pm, int wr, int fr, float (&rsd)[2][4]) {
    const LAS float* T = (const LAS float*)(lds + RST_OFF) + (pm & 7) * 256 + wr * 64 + fr;
#pragma unroll
    for (int ai = 0; ai < 2; ++ai)
#pragma unroll
        for (int m = 0; m < 4; ++m) rsd[ai][m] = T[ai * 128 + m * 16];
}
struct EpiA {
    static constexpr bool PERM = true, AFTER_DRAIN = false, MIDHOOK = false; static constexpr int TSID = 21;
    unsigned char* act0; const float* SSQ; float* SVST; const float* bal; LAS unsigned char* lds; bool tbl;
    __device__ __forceinline__ void operator()(const f32x4 (&acc)[2][2][4][2], const Unit& u, int wr, int wc, int fr_, int fq_) const {
        int ln_; asm volatile("v_mbcnt_lo_u32_b32 %0, -1, 0\n\tv_mbcnt_hi_u32_b32 %0, -1, %0" : "=v"(ln_)); const int fr = ln_ & 15, fq = ln_ >> 4; (void)fr_; (void)fq_;
        float rsd[2][4]; if (tbl) row_rstd_tbl(lds, u.pm, wr, fr, rsd); else row_rstd(SSQ, u.pm, wr, fr, fq, rsd);
        const int pn = u.pn; int mode, ldc, colt; size_t boff;
        if (pn < 1) { mode = 0; boff = A_Q; ldc = 256; colt = 0; } else if (pn < 2) { mode = 0; boff = A_K; ldc = 256; colt = 0; } else if (pn < 4) { mode = 0; boff = A_V; ldc = 512; colt = (pn - 2) * 256; }
        else if (pn < 6) { mode = 1; boff = A_Z; ldc = ZPITCH; colt = (pn - 4) * 256; } else if (pn < 7) { mode = 4; boff = A_LOGA; ldc = 256; colt = 0; }
        else if (pn < 9) { mode = 2; boff = A_Z; ldc = ZPITCH; colt = 512 + (pn - 7) * 256; } else if (pn < 11) { mode = 3; boff = A_SV; ldc = 512; colt = (pn - 9) * 256; }
        else if (pn < 13) { mode = 0; boff = A_Z; ldc = ZPITCH; colt = 1024 + (pn - 11) * 256; } else if (pn < 15) { mode = 0; boff = A_CC; ldc = 512; colt = (pn - 13) * 256; }
        else if (pn < 17) { mode = 0; boff = A_CX; ldc = 512; colt = (pn - 15) * 256; } else { mode = 5; boff = A_G; ldc = 3072; colt = (pn - 17) * 256; }
        const int col0 = colt + wc * 32 + 8 * fq;
#pragma unroll
        for (int ai = 0; ai < 2; ++ai)
#pragma unroll
            for (int m = 0; m < 4; ++m) { const size_t row = (size_t)u.pm * 256 + ai * 128 + wr * 64 + m * 16 + fr; const float rs = rsd[ai][m]; float s1 = 0.f, s2 = 0.f;
#pragma unroll
                for (int bj = 0; bj < 2; ++bj) { const f32x4 a0 = acc[ai][bj][m][0] * rs, a1 = acc[ai][bj][m][1] * rs; float v[8] = {a0[0], a0[1], a0[2], a0[3], a1[0], a1[1], a1[2], a1[3]};
                    if (mode == 4) { const f32x4 b0 = *(const f32x4*)(bal + col0 + bj * 128), b1 = *(const f32x4*)(bal + col0 + bj * 128 + 4); f32x4 o0, o1;
#pragma unroll
                        for (int e = 0; e < 4; ++e) { o0[e] = flogsig(v[e] + b0[e]) * 0.0625f; o1[e] = flogsig(v[4 + e] + b1[e]) * 0.0625f; }
                        float* p = (float*)(act0 + boff) + row * 256 + col0 + bj * 128; *(f32x4*)p = o0; *(f32x4*)(p + 4) = o1; }
                    else {
                        if (mode == 1) {
#pragma unroll
                            for (int e = 0; e < 8; ++e) v[e] = fsilu(v[e]); }
                        else if (mode == 2 || mode == 3) {
#pragma unroll
                            for (int e = 0; e < 8; ++e) v[e] = fgelu(v[e]); }
                        else if (mode == 5) {
#pragma unroll
                            for (int e = 0; e < 8; ++e) v[e] = fsigmoid(v[e]); }
                        if (mode == 3) {
#pragma unroll
                            for (int e = 0; e < 8; ++e) { s1 += v[e]; s2 += v[e] * v[e]; } }
                        v4u o; o.x = pk2(v[0], v[1]); o.y = pk2(v[2], v[3]); o.z = pk2(v[4], v[5]); o.w = pk2(v[6], v[7]);
                        *(v4u*)((bf16*)(act0 + boff) + row * ldc + col0 + bj * 128) = o; } }
                if (mode == 3) { s1 += __shfl_xor(s1, 16); s1 += __shfl_xor(s1, 32); s2 += __shfl_xor(s2, 16); s2 += __shfl_xor(s2, 32);
                    if (fq == 0) *(f32x2*)(SVST + row * 16 + ((pn - 9) * 4 + wc) * 2) = (f32x2){s1, s2}; } }
    }
};
struct EpiC {
    static constexpr bool PERM = true, AFTER_DRAIN = false, MIDHOOK = true; static constexpr int TSID = 23, HOOK_T1 = 8, HOOK_T2 = 16;
    const bf16* G; bf16* MG;
    __device__ __forceinline__ void mid(f32x4 (&acc)[2][2][4][2], const Unit& u, int t, int wr, int wc) const {
        int ln_; asm volatile("v_mbcnt_lo_u32_b32 %0, -1, 0\n\tv_mbcnt_hi_u32_b32 %0, -1, %0" : "=v"(ln_)); const int fr = ln_ & 15, fq = ln_ >> 4;
        const int br = t >> 3;
        const int col0 = u.pn * 256 + wc * 32 + 8 * fq;
        v4u ga[2][2][2], gb[2][2][2];
#define EPIC_LD(slot, q) do { _Pragma("unroll") for (int mm = 0; mm < 2; ++mm) _Pragma("unroll") for (int bj = 0; bj < 2; ++bj) { \
            const size_t row = (size_t)u.pm * 256 + ((q) >> 1) * 128 + wr * 64 + (2 * ((q) & 1) + mm) * 16 + fr; const bf16* gp = G + row * 3072 + (br - 1) * 1024 + col0 + bj * 128; \
            ga[slot][mm][bj] = *(const v4u*)gp; gb[slot][mm][bj] = *(const v4u*)(gp + 1024); } } while (0)
#define EPIC_SC(slot, q) do { _Pragma("unroll") for (int mm = 0; mm < 2; ++mm) _Pragma("unroll") for (int bj = 0; bj < 2; ++bj) { const int ai = (q) >> 1, m = 2 * ((q) & 1) + mm; \
            _Pragma("unroll") for (int e = 0; e < 4; ++e) { const float r0 = bf2f(ga[slot][mm][bj][e] & 0xffffu) * __builtin_amdgcn_rcpf(fmaxf(bf2f(gb[slot][mm][bj][e] & 0xffffu), 1e-20f)), \
                r1 = bf2f(ga[slot][mm][bj][e] >> 16) * __builtin_amdgcn_rcpf(fmaxf(bf2f(gb[slot][mm][bj][e] >> 16), 1e-20f)); \
                acc[ai][bj][m][e >> 1][(2 * e) & 3] *= r0; acc[ai][bj][m][e >> 1][(2 * e + 1) & 3] *= r1; } } } while (0)
        EPIC_LD(0, 0); EPIC_LD(1, 1); EPIC_SC(0, 0); EPIC_LD(0, 2); EPIC_SC(1, 1); EPIC_LD(1, 3); EPIC_SC(0, 2); EPIC_SC(1, 3);
#undef EPIC_LD
#undef EPIC_SC
    }
    __device__ __forceinline__ void operator()(const f32x4 (&acc)[2][2][4][2], const Unit& u, int wr, int wc, int fr_, int fq_) const {
        int ln_; asm volatile("v_mbcnt_lo_u32_b32 %0, -1, 0\n\tv_mbcnt_hi_u32_b32 %0, -1, %0" : "=v"(ln_)); const int fr = ln_ & 15, fq = ln_ >> 4; (void)fr_; (void)fq_;
        const int col0 = u.pn * 256 + wc * 32 + 8 * fq;
        v4u gt[2][4][2];
#pragma unroll
        for (int ai = 0; ai < 2; ++ai)
#pragma unroll
            for (int m = 0; m < 4; ++m)
#pragma unroll
                for (int bj = 0; bj < 2; ++bj) gt[ai][m][bj] = *(const v4u*)(G + ((size_t)u.pm * 256 + ai * 128 + wr * 64 + m * 16 + fr) * 3072 + 2048 + col0 + bj * 128);
#pragma unroll
        for (int ai = 0; ai < 2; ++ai)
#pragma unroll
            for (int m = 0; m < 4; ++m) { const size_t row = (size_t)u.pm * 256 + ai * 128 + wr * 64 + m * 16 + fr;
#pragma unroll
                for (int bj = 0; bj < 2; ++bj) { const f32x4 a0 = acc[ai][bj][m][0], a1 = acc[ai][bj][m][1]; float v[8] = {a0[0], a0[1], a0[2], a0[3], a1[0], a1[1], a1[2], a1[3]};
#pragma unroll
                    for (int e = 0; e < 4; ++e) { v[2 * e] *= bf2f(gt[ai][m][bj][e] & 0xffffu); v[2 * e + 1] *= bf2f(gt[ai][m][bj][e] >> 16); }
                    v4u o; o.x = pk2(v[0], v[1]); o.y = pk2(v[2], v[3]); o.z = pk2(v[4], v[5]); o.w = pk2(v[6], v[7]); *(v4u*)(MG + row * 1024 + col0 + bj * 128) = o; } }
    }
};
template <int VAR> struct EpiResT {
    static constexpr bool PERM = true, AFTER_DRAIN = false, MIDHOOK = false; static constexpr int TSID = 24;
    const bf16* XI; bf16* XB; float* SSQ;
    __device__ __forceinline__ void operator()(const f32x4 (&acc)[2][2][4][2], const Unit& u, int wr, int wc, int fr_, int fq_) const {
        int ln_; asm volatile("v_mbcnt_lo_u32_b32 %0, -1, 0\n\tv_mbcnt_hi_u32_b32 %0, -1, %0" : "=v"(ln_)); const int fr = ln_ & 15, fq = ln_ >> 4; (void)fr_; (void)fq_;
        const int col0 = u.pn * 256 + wc * 32 + 8 * fq;
        v4u xo[2][4][2];
#pragma unroll
        for (int ai = 0; ai < 2; ++ai)
#pragma unroll
            for (int m = 0; m < 4; ++m)
#pragma unroll
                for (int bj = 0; bj < 2; ++bj) xo[ai][m][bj] = *(const v4u*)(XI + ((size_t)u.pm * 256 + ai * 128 + wr * 64 + m * 16 + fr) * D + col0 + bj * 128);
#pragma unroll
        for (int ai = 0; ai < 2; ++ai)
#pragma unroll
            for (int m = 0; m < 4; ++m) { const size_t row = (size_t)u.pm * 256 + ai * 128 + wr * 64 + m * 16 + fr; float ss = 0.f;
#pragma unroll
                for (int bj = 0; bj < 2; ++bj) { const size_t off = row * D + col0 + bj * 128; const f32x4 a0 = acc[ai][bj][m][0], a1 = acc[ai][bj][m][1];
                    float v[8] = {a0[0], a0[1], a0[2], a0[3], a1[0], a1[1], a1[2], a1[3]};
#pragma unroll
                    for (int e = 0; e < 4; ++e) { v[2 * e] += bf2f(xo[ai][m][bj][e] & 0xffffu); v[2 * e + 1] += bf2f(xo[ai][m][bj][e] >> 16); }
#pragma unroll
                    for (int e = 0; e < 8; ++e) ss += v[e] * v[e];
                    v4u o; o.x = pk2(v[0], v[1]); o.y = pk2(v[2], v[3]); o.z = pk2(v[4], v[5]); o.w = pk2(v[6], v[7]); if (VAR != 1 || ss == 12345.678f) *(v4u*)(XB + off) = o; }
                if (VAR == 0) { ss += __shfl_xor(ss, 16); ss += __shfl_xor(ss, 32);
                if (fq == 0) SSQ[row * 16 + u.pn * 4 + wc] = ss; } }
    }
};
typedef EpiResT<0> EpiRes;
struct EpiUp {
    static constexpr bool PERM = true, AFTER_DRAIN = false, MIDHOOK = false; static constexpr int TSID = 25;
    bf16* HUP; const float* SSQ;
    __device__ __forceinline__ void operator()(const f32x4 (&acc)[2][2][4][2], const Unit& u, int wr, int wc, int fr_, int fq_) const {
        int ln_; asm volatile("v_mbcnt_lo_u32_b32 %0, -1, 0\n\tv_mbcnt_hi_u32_b32 %0, -1, %0" : "=v"(ln_)); const int fr = ln_ & 15, fq = ln_ >> 4; (void)fr_; (void)fq_;
        float rsd[2][4]; row_rstd(SSQ, u.pm, wr, fr, fq, rsd);
        const int col0 = u.pn * 256 + wc * 32 + 8 * fq;
#pragma unroll
        for (int ai = 0; ai < 2; ++ai)
#pragma unroll
            for (int m = 0; m < 4; ++m) { const size_t row = (size_t)u.pm * 256 + ai * 128 + wr * 64 + m * 16 + fr; const float rs = rsd[ai][m];
#pragma unroll
                for (int bj = 0; bj < 2; ++bj) { const f32x4 a0 = acc[ai][bj][m][0] * rs, a1 = acc[ai][bj][m][1] * rs;
                    v4u o; o.x = pk2(a0[0], a0[1]); o.y = pk2(a0[2], a0[3]); o.z = pk2(a1[0], a1[1]); o.w = pk2(a1[2], a1[3]); *(v4u*)(HUP + row * DFF2 + col0 + bj * 128) = o; } }
    }
};

__device__ __forceinline__ float dpp_f(float old, float src, const int ctrl_sel) {
    const int o = __builtin_bit_cast(int, old), v = __builtin_bit_cast(int, src); int r;
    if (ctrl_sel == 0) r = __builtin_amdgcn_update_dpp(o, v, 0x111, 0xf, 0xf, false);
    else if (ctrl_sel == 1) r = __builtin_amdgcn_update_dpp(o, v, 0x112, 0xf, 0xf, false);
    else if (ctrl_sel == 2) r = __builtin_amdgcn_update_dpp(o, v, 0x121, 0xf, 0xf, false);
    else r = __builtin_amdgcn_update_dpp(o, v, 0x122, 0xf, 0xf, false);
    return __builtin_bit_cast(float, r);
}
constexpr int XL_OFF = RING_BYTES + 1024;
struct EpiUpConv {
    static constexpr bool PERM = true, AFTER_DRAIN = false, MIDHOOK = false; static constexpr int TSID = 22;
    unsigned char* ws; const float* cw; const float* cb; LAS unsigned char* lds; bool tbl;
    __device__ __forceinline__ void operator()(const f32x4 (&acc)[2][2][4][2], const Unit& u, int wr, int wc, int fr_, int fq_) const {
        int ln_; asm volatile("v_mbcnt_lo_u32_b32 %0, -1, 0\n\tv_mbcnt_hi_u32_b32 %0, -1, %0" : "=v"(ln_)); const int fr = ln_ & 15, fq = ln_ >> 4; (void)fr_; (void)fq_;
        bf16* ACT = (bf16*)(ws + WS_ACT0 + A_ACT); const float* SSQ = (const float*)(ws + WS_SSQ); float* HT = (float*)(ws + WS_ACT0 + A_HT);
        float rsd[2][4]; if (tbl) row_rstd_tbl(lds, u.pm, wr, fr, rsd); else row_rstd(SSQ, u.pm, wr, fr, fq, rsd);
        LAS f32x4* XL = (LAS f32x4*)(lds + XL_OFF);
        const int tcol = u.pn * 256 + wc * 32 + 8 * fq;
        const int ch0 = u.pn * 128 + wc * 32 + 8 * fq; const bool batch_start = (u.pm & 7) == 0;
        f32x4 wgp[3], wvp[3], bgp, bvp;
#pragma unroll
        for (int k = 0; k < 3; ++k) { wgp[k] = *(const f32x4*)(cw + k * DFF2 + ch0); wvp[k] = *(const f32x4*)(cw + k * DFF2 + DFF + ch0); }
        bgp = *(const f32x4*)(cb + ch0); bvp = *(const f32x4*)(cb + DFF + ch0);
#pragma unroll
        for (int ai = 0; ai < 2; ++ai)
#pragma unroll
            for (int bj = 0; bj < 2; ++bj)
#pragma unroll
                for (int n = 0; n < 2; ++n) {
                    if (fr >= 14) { const f32x4 h = acc[ai][bj][3][n] * rsd[ai][3]; XL[((((ai * 2 + wr) * 4 + wc) * 2 + bj) * 2 + n) * 8 + fq * 2 + (fr - 14)] = h;
                        if (ai == 1 && wr == 1) *(f32x4*)(HT + ((size_t)(u.pm * 2 + 1) * 2 + (fr - 14)) * DFF2 + tcol + bj * 128 + 4 * n) = h; }
                    if (ai == 0 && wr == 0 && fr < 2) *(f32x4*)(HT + ((size_t)(u.pm * 2 + 0) * 2 + fr) * DFF2 + tcol + bj * 128 + 4 * n) = acc[0][bj][0][n] * rsd[0][0]; }
        asm volatile("s_waitcnt lgkmcnt(0)" ::: "memory"); __builtin_amdgcn_s_barrier(); asm volatile("" ::: "memory");
#pragma unroll
        for (int n = 0; n < 2; ++n) {
            asm volatile("" ::: "memory");
            f32x4 wg[3], wv[3], bg, bv;
            if (n == 0) {
#pragma unroll
                for (int k = 0; k < 3; ++k) { wg[k] = wgp[k]; wv[k] = wvp[k]; }
                bg = bgp; bv = bvp; }
            else {
#pragma unroll
                for (int k = 0; k < 3; ++k) { wg[k] = *(const f32x4*)(cw + k * DFF2 + ch0 + 4); wv[k] = *(const f32x4*)(cw + k * DFF2 + DFF + ch0 + 4); }
                bg = *(const f32x4*)(cb + ch0 + 4); bv = *(const f32x4*)(cb + DFF + ch0 + 4); }
#pragma unroll
            for (int ai = 0; ai < 2; ++ai) {
                f32x4 hgp, hvp;
                { f32x4 pg14 = (f32x4){0.f, 0.f, 0.f, 0.f}, pg15 = pg14, pv14 = pg14, pv15 = pg14;
                  if (!(ai == 0 && wr == 0)) { const int pb = ai * 2 + wr - 1; const LAS f32x4* q = XL + ((((pb * 4 + wc) * 2 + 0) * 2 + n) * 8 + fq * 2); const LAS f32x4* qv = XL + ((((pb * 4 + wc) * 2 + 1) * 2 + n) * 8 + fq * 2);
                      pg14 = q[0]; pg15 = q[1]; pv14 = qv[0]; pv15 = qv[1]; }
                  hgp = (fr == 14) ? pg14 : pg15; hvp = (fr == 14) ? pv14 : pv15; }
#pragma unroll
                for (int m = 0; m < 4; ++m) { const f32x4 hg = acc[ai][0][m][n] * rsd[ai][m], hv = acc[ai][1][m][n] * rsd[ai][m]; f32x4 z;
#pragma unroll
                    for (int e = 0; e < 4; ++e) {
                        const float g1 = dpp_f(dpp_f(0.f, hgp[e], 2), hg[e], 0), g2 = dpp_f(dpp_f(0.f, hgp[e], 3), hg[e], 1);
                        const float v1 = dpp_f(dpp_f(0.f, hvp[e], 2), hv[e], 0), v2 = dpp_f(dpp_f(0.f, hvp[e], 3), hv[e], 1);
                        const float ga = wg[0][e] * g2 + wg[1][e] * g1 + wg[2][e] * hg[e] + bg[e], va = wv[0][e] * v2 + wv[1][e] * v1 + wv[2][e] * hv[e] + bv[e];
                        z[e] = fsilu(ga) * va; }
                    const size_t row = (size_t)u.pm * 256 + ai * 128 + wr * 64 + m * 16 + fr;
                    const bool skip = (ai == 0 && wr == 0 && m == 0 && fr < 2 && !batch_start);
                    if (!skip) { v2u o; o.x = pk2(z[0], z[1]); o.y = pk2(z[2], z[3]); *(v2u*)(ACT + row * DFF + ch0 + 4 * n) = o; }
                    hgp = hg; hvp = hv; } } }
    }
};
__device__ __forceinline__ void ffn_fixup(int pm, const float* HT, bf16* ACT, const float* cw, const float* cb, int tid) {
    if ((pm & 7) == 0) return;
    for (int it = tid; it < 2 * (DFF / 4); it += NTHREADS) { const int rr = it / (DFF / 4), j = (it % (DFF / 4)) * 4, tc = (j >> 7) * 256 + (j & 127);
        const float* h0 = HT + ((size_t)(pm * 2 + 0) * 2 + rr) * DFF2;
        const float* h1 = rr ? HT + ((size_t)(pm * 2 + 0) * 2 + 0) * DFF2 : HT + ((size_t)((pm - 1) * 2 + 1) * 2 + 1) * DFF2;
        const float* h2 = rr ? HT + ((size_t)((pm - 1) * 2 + 1) * 2 + 1) * DFF2 : HT + ((size_t)((pm - 1) * 2 + 1) * 2 + 0) * DFF2;
        const f32x4 g0 = *(const f32x4*)(h0 + tc), g1 = *(const f32x4*)(h1 + tc), g2 = *(const f32x4*)(h2 + tc), v0 = *(const f32x4*)(h0 + tc + 128), v1 = *(const f32x4*)(h1 + tc + 128), v2 = *(const f32x4*)(h2 + tc + 128);
        const f32x4 ga = *(const f32x4*)(cw + j) * g2 + *(const f32x4*)(cw + DFF2 + j) * g1 + *(const f32x4*)(cw + 2 * DFF2 + j) * g0 + *(const f32x4*)(cb + j);
        const f32x4 va = *(const f32x4*)(cw + DFF + j) * v2 + *(const f32x4*)(cw + DFF2 + DFF + j) * v1 + *(const f32x4*)(cw + 2 * DFF2 + DFF + j) * v0 + *(const f32x4*)(cb + DFF + j);
        v2u o; o.x = pk2(fsilu(ga[0]) * va[0], fsilu(ga[1]) * va[1]); o.y = pk2(fsilu(ga[2]) * va[2], fsilu(ga[3]) * va[3]);
        *(v2u*)(ACT + ((size_t)pm * 256 + rr) * DFF + j) = o; }
    asm volatile("s_waitcnt vmcnt(0)" ::: "memory"); __syncthreads();
}

template <bool P> struct EpiNull {
    static constexpr bool PERM = P, AFTER_DRAIN = false, MIDHOOK = false; static constexpr int TSID = 26; float* sink;
    __device__ __forceinline__ void operator()(const f32x4 (&acc)[2][2][4][2], const Unit& u, int wr, int wc, int fr, int fq) const {
        f32x4 s = (f32x4){0.f, 0.f, 0.f, 0.f};
#pragma unroll
        for (int ai = 0; ai < 2; ++ai)
#pragma unroll
            for (int bj = 0; bj < 2; ++bj)
#pragma unroll
                for (int m = 0; m < 4; ++m)
#pragma unroll
                    for (int n = 0; n < 2; ++n) s += acc[ai][bj][m][n];
        if (s[0] + s[1] + s[2] + s[3] == 12345.678f) sink[u.pm + wr + wc + fr + fq] = s[0];
    }
};
#define XB_TMO      128
#define XB_XCNT(j)  (256  + 64 * (j))
#define XB_XSUB(j)  (1280 + 64 * (j))
#define XB_XGEN(j)  (2304 + 64 * (j))
#define XB_TOP      3328
#define XB_TOPGEN   3392
#define XCD_BAR_WORDS 3456
#define XB_SPIN_CAP (1u << 18)

__device__ __forceinline__ unsigned xb_ld(unsigned* p)              { return __hip_atomic_load(p, __ATOMIC_RELAXED, __HIP_MEMORY_SCOPE_AGENT); }
__device__ __forceinline__ unsigned xb_add(unsigned* p, unsigned v) { return __hip_atomic_fetch_add(p, v, __ATOMIC_RELAXED, __HIP_MEMORY_SCOPE_AGENT); }
__device__ __forceinline__ unsigned xb_xcc_id() { return (unsigned)__builtin_amdgcn_s_getreg((3 << 11) | 20) & 0xFu; }
#define XB_SPIN(cond, bar) do { unsigned _sp = 0; while (cond) { __builtin_amdgcn_s_sleep(1); \
    if ((++_sp & 255u) == 0u) { if (xb_ld(&(bar)[XB_TMO])) break; if (_sp > XB_SPIN_CAP) { atomicAdd(&(bar)[XB_TMO], 1u); break; } } } } while (0)

struct XcdBarrier {
    unsigned* bar; unsigned x;
    volatile LAS unsigned* st;
};

__device__ __forceinline__ XcdBarrier xcd_barrier_post(unsigned* bar, volatile LAS unsigned* st) {
    XcdBarrier b; b.bar = bar; b.x = xb_xcc_id(); b.st = st;
    if (threadIdx.x == 0) st[2] = xb_add(&bar[XB_XCNT(b.x)], 1u);
    return b;
}
__device__ __forceinline__ void xcd_barrier_complete(unsigned* bar, unsigned x, unsigned& nloc, unsigned& nx) {
    const unsigned G = gridDim.x * gridDim.y * gridDim.z;
    unsigned sum, cnt, mine, sp = 0u;
    for (;;) {
        sum = 0u; cnt = 0u; mine = 0u;
#pragma unroll
        for (unsigned j = 0; j < 16; ++j) { const unsigned c = xb_ld(&bar[XB_XCNT(j)]); sum += c; cnt += (c > 0u) ? 1u : 0u; mine = (j == x) ? c : mine; }
        if (sum == G) break;
        __builtin_amdgcn_s_sleep(1);
        if ((++sp & 255u) == 0u) { if (xb_ld(&bar[XB_TMO])) break; if (sp > XB_SPIN_CAP) { atomicAdd(&bar[XB_TMO], 1u); break; } }
    }
    nloc = mine > 0u ? mine : 1u; nx = cnt > 0u ? cnt : 1u;
}

__device__ __forceinline__ void xcd_barrier(const XcdBarrier& b) {
    asm volatile("s_waitcnt vmcnt(0)" ::: "memory");
    __syncthreads();
    if (threadIdx.x == 0) {
        unsigned* bar = b.bar;
        __builtin_amdgcn_s_waitcnt(0);
        unsigned nloc = b.st[0], nx = b.st[1];
        if (nloc == 0u) { xcd_barrier_complete(bar, b.x, nloc, nx); b.st[0] = nloc; b.st[1] = nx; }
        const unsigned old = xb_add(&bar[XB_XSUB(b.x)], 1u);
        const unsigned gen = old / nloc;
        if (old + 1u == (gen + 1u) * nloc) {
            __builtin_amdgcn_fence(__ATOMIC_RELEASE, "agent");
            asm volatile("s_waitcnt vmcnt(0)" ::: "memory");
            const unsigned og = xb_add(&bar[XB_TOP], 1u);
            const unsigned tg = og / nx;
            if (og + 1u == (tg + 1u) * nx) xb_add(&bar[XB_TOPGEN], 1u);
            else XB_SPIN(xb_ld(&bar[XB_TOPGEN]) == tg, bar);
            __builtin_amdgcn_fence(__ATOMIC_ACQUIRE, "agent");
            xb_add(&bar[XB_XGEN(b.x)], 1u);
            asm volatile("s_waitcnt vmcnt(0)" ::: "memory");
        } else {
            XB_SPIN(xb_ld(&bar[XB_XGEN(b.x)]) == gen, bar);
            __builtin_amdgcn_fence(__ATOMIC_ACQUIRE, "agent");
            asm volatile("s_waitcnt vmcnt(0)" ::: "memory");
        }
    }
    __syncthreads();
}

__device__ __forceinline__ void xcd_barrier_local(const XcdBarrier& b) {
    asm volatile("s_waitcnt vmcnt(0)" ::: "memory");
    __syncthreads();
    if (threadIdx.x == 0) {
        unsigned* bar = b.bar;
        __builtin_amdgcn_s_waitcnt(0);
        const unsigned nloc = b.st[0];
        const unsigned old = xb_add(&bar[XB_XSUB(b.x)], 1u);
        const unsigned gen = old / nloc;
        if (old + 1u == (gen + 1u) * nloc) xb_add(&bar[XB_XGEN(b.x)], 1u);
        else XB_SPIN(xb_ld(&bar[XB_XGEN(b.x)]) == gen, bar);
        __builtin_amdgcn_fence(__ATOMIC_ACQUIRE, "agent");
        asm volatile("s_waitcnt vmcnt(0)" ::: "memory");
    }
    __syncthreads();
}

#ifndef PROBE
#define PROBE 0
#endif
struct Args { Inputs in; float* out; unsigned char* ws; int ph_lo, ph_hi; };
constexpr int NPHASE = 2 + 7 * DEPTH;
#define LAUNDER_S(p) asm volatile("" : "+s"(p))
#define LAUNDER_V(p) asm volatile("" : "+v"(p))
struct Ctx { unsigned char* ws; unsigned char* act0; float* X; int tid, lane, wave, G, bx, gw, ngw; };
#define BST_OFF (RING_BYTES + 512)
__device__ __forceinline__ Ctx make_ctx(const Args& a, int wave_id, LAS unsigned char* ldsb) {
    Ctx c; size_t z = 0; LAUNDER_S(z); c.ws = a.ws + z; c.X = (float*)((unsigned char*)a.out + z); c.act0 = c.ws + WS_ACT0;
    int ln; asm volatile("v_mbcnt_lo_u32_b32 %0, -1, 0\n\tv_mbcnt_hi_u32_b32 %0, -1, %0" : "=v"(ln)); c.lane = ln; c.wave = wave_id; c.tid = wave_id * 64 + ln;
    c.G = gridDim.x; c.bx = __builtin_amdgcn_readfirstlane(((volatile LAS unsigned*)(ldsb + BST_OFF))[2]); c.gw = c.bx * NWAVES + c.wave; c.ngw = c.G * NWAVES; return c;
}
__device__ __forceinline__ unsigned char* slot_of(const Ctx& c, int l) { return c.ws + WS_SLOT0 + (size_t)(l & 1) * SL_BYTES; }
__device__ __forceinline__ unsigned* ctl_word(const Ctx& c, int w) { return (unsigned*)(c.ws + WS_CTL) + w; }
__device__ __forceinline__ void tail_convert(const Args& a, const Ctx& c, int l, int ph, bool drain, bool early, LAS unsigned char* lds) {
#if MK_ONE_LAUNCH
    const unsigned xcc_ = xb_xcc_id(); const unsigned nloc_ = ((volatile LAS unsigned*)(lds + BST_OFF))[0];
    unsigned* fin = ctl_word(c, CW_FIN + (ph * 8 + (int)(xcc_ & 7u)) * 16);
    if (c.tid == 0) __hip_atomic_fetch_add(fin, 1u, RLX_AGENT);
    if (l == 0 && ph == 1) convert_queue(a.in, 0, slot_of(c, 0), lds, ctl_word(c, CW_QHEAD), CV_WIN_ITEMS, CV_ITEMS, nullptr, c.G, c.tid, c.wave, c.lane);
    if (l + 1 < DEPTH && (drain || early)) convert_queue(a.in, l + 1, slot_of(c, l + 1), lds, ctl_word(c, CW_QHEAD + 64 * (l + 1)), 0, CV_ITEMS, drain ? nullptr : fin, (int)nloc_, c.tid, c.wave, c.lane);
#else
    if (l == 0 && ph == 1) convert_static(a.in, 0, slot_of(c, 0), lds, CV_WIN_ITEMS, CV_ITEMS, c.gw, c.ngw, c.wave, c.lane);
    if (l + 1 < DEPTH && drain) convert_static(a.in, l + 1, slot_of(c, l + 1), lds, 0, CV_ITEMS, c.gw, c.ngw, c.wave, c.lane);
#endif
}
__device__ __forceinline__ void ph_p0(const Args& a, const int wv, LAS unsigned char* lds) { const Ctx c = make_ctx(a, wv, lds);
    convert_static(a.in, 0, c.ws + WS_SLOT0, lds, 0, CV_WIN_ITEMS, c.gw, c.ngw, c.wave, c.lane); x_prep(a.in.p[0], (bf16*)(c.ws + WS_XB), (float*)(c.ws + WS_SSQ), c.gw, c.ngw, c.lane); }
__device__ __forceinline__ void ph_a(const Args& a, const int wv, int l, int ph, LAS unsigned char* lds) { const Ctx c = make_ctx(a, wv, lds);
    pg8::Gemm g{(const bf16*)(c.ws + WS_XB), (const bf16*)(slot_of(c, l) + SL_WIN), M, NIN, D}; pg8::StaticOrder S; S.init(M, NIN, c.G, c.bx);
    const bool tbl = (c.G == 256); if (tbl) rstd_table_fill((const float*)(c.ws + WS_SSQ), c.bx & 7, lds, c.tid);
    EpiA E{c.act0, (const float*)(c.ws + WS_SSQ), (float*)(c.ws + WS_SVST), a.in.p[4] + (size_t)l * GKEY, lds, tbl};
    if (PROBE == 21) { EpiNull<true> EN_{(float*)(c.ws + WS_END)}; pg8::gemm_phase<EpiNull<true>, pg8::StaticOrder, true, true>(lds, g, S, EN_, wv); }
    for (int rep = 0; rep < 1 + (PROBE == 1); ++rep) pg8::gemm_phase<EpiA, pg8::StaticOrder, true, true>(lds, g, S, E, wv);
    { const Ctx c2 = make_ctx(a, wv, lds); tail_convert(a, c2, l, ph, false, ((NIN / 256) * 64 - 1) / c2.G * c2.G + c2.bx >= (NIN / 256) * 64, lds); } }
__device__ __forceinline__ void ph_b1(const Args& a, const int wv, int l, LAS unsigned char* lds) { const Ctx c = make_ctx(a, wv, lds); const Inputs& I = a.in;
    bf16* Zb = (bf16*)(c.act0 + A_Z); bf16* DUM = (bf16*)(c.ws + WS_END); const int tid = c.tid;
    TS_BEGIN(41);
    for (int rep = 0; rep < 1 + (PROBE == 2); ++rep)
    for (int it = c.bx; it < 256; it += c.G) gla_b1_item(it, lds, (const bf16*)(c.act0 + A_K), (const bf16*)(c.act0 + A_V), (const float*)(c.act0 + A_LOGA), (float*)(c.act0 + A_CST), (float*)(c.act0 + A_DEC), c.tid, c.wave, c.lane);
    TS_END(41); TS_BEGIN(42);
    if (PROBE == 3) for (int it = c.bx; it < 512; it += c.G) sgu_item(it, lds, Zb + 512, DUM, (const bf16*)(c.act0 + A_SV), (const float*)(c.ws + WS_SVST), I.p[7] + (size_t)l * SGW, I.p[8] + (size_t)l * SGW, (const bf16*)(slot_of(c, l) + SL_SGW), I.p[10] + (size_t)l * 512, c.wave, c.lane);
    for (int it = c.bx; it < 512; it += c.G) sgu_item(it, lds, Zb + 512, Zb + 512, (const bf16*)(c.act0 + A_SV), (const float*)(c.ws + WS_SVST), I.p[7] + (size_t)l * SGW, I.p[8] + (size_t)l * SGW, (const bf16*)(slot_of(c, l) + SL_SGW), I.p[10] + (size_t)l * 512, c.wave, c.lane);
    TS_END(42); TS_BEGIN(43);
    if (PROBE == 4) for (int it = c.bx * NTHREADS + c.tid; it < 131072; it += c.G * NTHREADS) convbr_item(it, Zb + 1024, DUM, (const bf16*)(c.act0 + A_CC), (const bf16*)(c.act0 + A_CX), I.p[12] + (size_t)l * 3 * CW);
    for (int it = c.bx * NTHREADS + c.tid; it < 131072; it += c.G * NTHREADS) convbr_item(it, Zb + 1024, Zb + 1024, (const bf16*)(c.act0 + A_CC), (const bf16*)(c.act0 + A_CX), I.p[12] + (size_t)l * 3 * CW);
    TS_END(43); }
__device__ __forceinline__ void ph_b2(const Args& a, const int wv, int l, int ph, LAS unsigned char* lds) { const Ctx c = make_ctx(a, wv, lds);
    if (PROBE == 6) for (int it = c.bx; it < 256; it += c.G) gla_b2_unit(it, lds, (const bf16*)(c.act0 + A_Q), (const bf16*)(c.act0 + A_K), (const bf16*)(c.act0 + A_V), (const float*)(c.act0 + A_LOGA), (const float*)(c.act0 + A_CST), (const float*)(c.act0 + A_DEC), (const bf16*)(c.act0 + A_Z), (bf16*)(c.ws + WS_END), c.tid, c.wave, c.lane);
    for (int it = c.bx; it < 256; it += c.G) gla_b2_unit(it, lds, (const bf16*)(c.act0 + A_Q), (const bf16*)(c.act0 + A_K), (const bf16*)(c.act0 + A_V), (const float*)(c.act0 + A_LOGA), (const float*)(c.act0 + A_CST), (const float*)(c.act0 + A_DEC), (const bf16*)(c.act0 + A_Z), (bf16*)(c.act0 + A_Z), c.tid, c.wave, c.lane); }
__device__ __forceinline__ void ph_c(const Args& a, const int wv, int l, LAS unsigned char* lds) { const Ctx c = make_ctx(a, wv, lds);
    pg8::Gemm g{(const bf16*)(c.act0 + A_Z), (const bf16*)(slot_of(c, l) + SL_WBR), M, D, ZPITCH}; pg8::StaticOrder S; S.init(M, D, c.G, c.bx); EpiC E{(const bf16*)(c.act0 + A_G), (bf16*)(c.act0 + A_MERGED)};
    const int tid = c.tid; TS_BEGIN(51);
    for (int rep = 0; rep < 1 + (PROBE == 7); ++rep) pg8::gemm_phase<EpiC, pg8::StaticOrder, true, true>(lds, g, S, E, wv);
    TS_END(51); }
__device__ __forceinline__ void ph_res(const Args& a, const int wv, const bf16* A, const bf16* Bt, int K, int dup, int l, int ph, bool drain, LAS unsigned char* lds) { const Ctx c = make_ctx(a, wv, lds);
    pg8::Gemm g{A, Bt, M, D, K}; pg8::StaticOrder S; S.init(M, D, c.G, c.bx);
    if (dup == 2) { EpiNull<true> EN_{(float*)(c.ws + WS_END)}; pg8::gemm_phase<EpiNull<true>, pg8::StaticOrder, true, true>(lds, g, S, EN_, wv); }
    if (dup == 3) { EpiResT<1> E{(const bf16*)(c.ws + WS_XB), (bf16*)(c.ws + WS_END), (float*)(c.ws + WS_END + 32 * MiB)}; pg8::gemm_phase<EpiResT<1>, pg8::StaticOrder, true, true>(lds, g, S, E, wv); }
    if (dup == 4) { EpiResT<2> E{(const bf16*)(c.ws + WS_XB), (bf16*)(c.ws + WS_END), (float*)(c.ws + WS_END + 32 * MiB)}; pg8::gemm_phase<EpiResT<2>, pg8::StaticOrder, true, true>(lds, g, S, E, wv); }
    if (dup == 1) { EpiRes E{(const bf16*)(c.ws + WS_XB), (bf16*)(c.ws + WS_END), (float*)(c.ws + WS_END + 32 * MiB)}; pg8::gemm_phase<EpiRes, pg8::StaticOrder, true, true>(lds, g, S, E, wv); }
    if (drain) { pg8::Unit u0; for (int i = 0; S.next(i, u0); ++i) ffn_fixup(u0.pm, (const float*)(c.act0 + A_HT), (bf16*)(c.act0 + A_ACT), a.in.p[17] + (size_t)l * 3 * DFF2, a.in.p[18] + (size_t)l * DFF2, c.tid); }
    EpiRes E{(const bf16*)(c.ws + WS_XB), (bf16*)(c.ws + WS_XB), (float*)(c.ws + WS_SSQ)};
    pg8::gemm_phase<EpiRes, pg8::StaticOrder, true, true>(lds, g, S, E, wv);
    if (drain) { const Ctx c2 = make_ctx(a, wv, lds); tail_convert(a, c2, l, ph, true, true, lds); } }
__device__ __forceinline__ void ph_e(const Args& a, const int wv, int l, int ph, LAS unsigned char* lds) { const Ctx c = make_ctx(a, wv, lds);
    pg8::Gemm g{(const bf16*)(c.ws + WS_XB), (const bf16*)(slot_of(c, l) + SL_WUP), M, DFF2, D}; pg8::StaticOrder S; S.init(M, DFF2, c.G, c.bx);
    const bool tbl = (c.G == 256); if (tbl) rstd_table_fill((const float*)(c.ws + WS_SSQ), c.bx & 7, lds, c.tid);
    EpiUpConv E{c.ws, a.in.p[17] + (size_t)l * 3 * DFF2, a.in.p[18] + (size_t)l * DFF2, lds, tbl};
    for (int rep = 0; rep < 1 + (PROBE == 8); ++rep) pg8::gemm_phase<EpiUpConv, pg8::StaticOrder, true, true>(lds, g, S, E, wv);
    { const Ctx c2 = make_ctx(a, wv, lds); tail_convert(a, c2, l, ph, false, ((DFF2 / 256) * 64 - 1) / c2.G * c2.G + c2.bx >= (DFF2 / 256) * 64, lds); } }
__device__ __forceinline__ void ph_e2(const Args& a, const int wv, int l, LAS unsigned char* lds) { const Ctx c = make_ctx(a, wv, lds);
    for (int rep = 0; rep < 1 + (PROBE == 9); ++rep)
    for (int it = c.bx * NTHREADS + c.tid; it < 1024 * 352; it += c.G * NTHREADS) ffn_act_item(it, (const bf16*)(c.act0 + A_HUP), (bf16*)(c.act0 + A_ACT), a.in.p[17] + (size_t)l * 3 * DFF2, a.in.p[18] + (size_t)l * DFF2); }
__device__ __forceinline__ void ph_fin(const Args& a, const int wv, LAS unsigned char* lds) { const Ctx c = make_ctx(a, wv, lds); final_norm((const bf16*)(c.ws + WS_XB), c.X, (const float*)(c.ws + WS_SSQ), a.in.p[20], c.gw, c.ngw, c.lane); }

#ifndef PHMASK
#define PHMASK 0xFFFF
#endif
#define EN(b) ((PHMASK >> (b)) & 1)
__global__ void __launch_bounds__(NTHREADS, 2) mk_fwd(Args args) {
    extern __shared__ __attribute__((aligned(16))) unsigned char lds_raw[];
    LAS unsigned char* lds = (LAS unsigned char*)lds_raw;
    const int wv = __builtin_amdgcn_readfirstlane(threadIdx.x >> 6);
#ifdef TSUB
    if (threadIdx.x == 0) *TS_SLOT = 0ull;
#endif
    const int lo = args.ph_lo, hi = args.ph_hi;
#define IN(k) (lo <= (k) && (k) < hi)
#if MK_ONE_LAUNCH
    volatile LAS unsigned* bst = (volatile LAS unsigned*)(lds + BST_OFF);
    if (threadIdx.x < 4) bst[threadIdx.x] = 0u;
    __syncthreads();
    const XcdBarrier bar = xcd_barrier_post((unsigned*)(args.ws + WS_CTL) + CW_BAR, bst);
    __syncthreads();
    const unsigned my_rank = bst[2];
    __syncthreads();
    if (threadIdx.x == 0) bst[2] = blockIdx.x;
    __syncthreads();
#define SEAM_GLOBAL(k) ((k) == 1 || ((k) % 7) == 0)
#define SEAM(k) do { if (IN(k) && IN((k) + 1)) { \
        if ((k) == 0) { if (args.ph_hi < 0) cg::this_grid().sync();     \
            xcd_barrier(bar); \
            if (threadIdx.x == 0) { unsigned* bw = (unsigned*)(args.ws + WS_CTL) + CW_BAR; unsigned nloc_ = 1u, nx_ = 1u; xcd_barrier_complete(bw, bar.x, nloc_, nx_);     \
                bool u32 = (gridDim.x == 256u) && xb_ld(&bw[XB_TMO]) == 0u; \
                for (unsigned j = 0; j < 16; ++j) { const unsigned c_ = xb_ld(&bw[XB_XCNT(j)]); if (j < 8 ? c_ != 32u : c_ != 0u) u32 = false; } \
                bst[0] = nloc_; bst[1] = nx_; bst[3] = u32 ? 1u : 0u; bst[2] = u32 ? my_rank * 8u + bar.x : blockIdx.x; } \
            __syncthreads(); } \
        else if (SEAM_GLOBAL(k) || bst[3] == 0u) xcd_barrier(bar); else xcd_barrier_local(bar); } } while (0)
#else
#define SEAM(k) do { } while (0)
#endif
#ifdef TPROBE
    unsigned long long tp_acc = 0ull, tp_prev = __builtin_amdgcn_s_memrealtime();
#define TP_MARK(kind) do { const unsigned long long t_ = __builtin_amdgcn_s_memrealtime(); if ((kind) == TPROBE) tp_acc += t_ - tp_prev; tp_prev = t_; } while (0)
#else
#define TP_MARK(kind) do { } while (0)
#endif
    int ph = 0;
    if (EN(0) && IN(ph)) ph_p0(args, wv, lds);
    SEAM(ph); ++ph; TP_MARK(0);
    for (int l = 0; l < DEPTH; ++l) {
        if (EN(1) && IN(ph)) ph_a(args, wv, l, ph, lds);
        SEAM(ph); ++ph; TP_MARK(1);
        if (EN(2) && IN(ph)) ph_b1(args, wv, l, lds);
        SEAM(ph); ++ph; TP_MARK(2);
        if (EN(3) && IN(ph)) ph_b2(args, wv, l, ph, lds);
        SEAM(ph); ++ph; TP_MARK(3);
        if (EN(4) && IN(ph)) ph_c(args, wv, l, lds);
        SEAM(ph); ++ph; TP_MARK(4);
        if (EN(5) && IN(ph)) { size_t z = 0; LAUNDER_S(z); unsigned char* ws = args.ws + z; ph_res(args, wv, (const bf16*)(ws + WS_ACT0 + A_MERGED), (const bf16*)(ws + WS_SLOT0 + (size_t)(l & 1) * SL_BYTES + SL_WO), D, PROBE == 10 ? 1 : (PROBE == 22 ? 2 : (PROBE == 31 ? 3 : (PROBE == 32 ? 4 : 0))), l, ph, false, lds); }
        SEAM(ph); ++ph; TP_MARK(5);
        if (EN(6) && IN(ph)) ph_e(args, wv, l, ph, lds);
        SEAM(ph); ++ph; TP_MARK(6);
        if (EN(8) && IN(ph)) { size_t z = 0; LAUNDER_S(z); unsigned char* ws = args.ws + z; ph_res(args, wv, (const bf16*)(ws + WS_ACT0 + A_ACT), (const bf16*)(ws + WS_SLOT0 + (size_t)(l & 1) * SL_BYTES + SL_WDN), DFF, PROBE == 11 ? 1 : (PROBE == 23 ? 2 : 0), l, ph, true, lds); }
        SEAM(ph); ++ph; TP_MARK(7);
    }
    if (EN(9) && IN(ph)) ph_fin(args, wv, lds);
#ifdef TSUB
    if (blockIdx.x == 7 && threadIdx.x == 0) { const unsigned long long tt = *TS_SLOT; const unsigned long long t0 = __builtin_amdgcn_s_memrealtime(); while (__builtin_amdgcn_s_memrealtime() - t0 < 10ull * tt) __builtin_amdgcn_s_sleep(8); }
#endif
#ifdef TPROBE
    TP_MARK(8);
    if (blockIdx.x == 0 && wv == 0) { const unsigned long long t0 = __builtin_amdgcn_s_memrealtime(); while (__builtin_amdgcn_s_memrealtime() - t0 < 10ull * tp_acc) __builtin_amdgcn_s_sleep(8); }
#endif
#undef IN
#undef SEAM
}

extern "C" void kernel_launch(void* const* d_in, const int* in_sizes, int n_in, void* d_out, int out_size, void* d_ws, size_t ws_size, hipStream_t stream) {
    static int grid = 0;
    if (grid == 0) {
        if (n_in != 21 || out_size != M * D || ws_size < WS_END + (PROBE ? 64 * MiB : 0)) { fprintf(stderr, "kernel_launch: unexpected shapes / workspace (%zu < %zu)\n", ws_size, (size_t)WS_END); grid = -1; return; }
        int dev = 0, cus = 0, per_cu = 0;
        if (hipGetDevice(&dev) != hipSuccess || hipDeviceGetAttribute(&cus, hipDeviceAttributeMultiprocessorCount, dev) != hipSuccess) { grid = -1; return; }
        if (hipFuncSetAttribute((const void*)mk_fwd, hipFuncAttributeMaxDynamicSharedMemorySize, LDS_BYTES) != hipSuccess) { fprintf(stderr, "kernel_launch: hipFuncSetAttribute failed\n"); grid = -1; return; }
        if (hipOccupancyMaxActiveBlocksPerMultiprocessor(&per_cu, (const void*)mk_fwd, NTHREADS, LDS_BYTES) != hipSuccess || per_cu < 1) { fprintf(stderr, "kernel_launch: occupancy query says %d\n", per_cu); per_cu = 1; }
        (void)hipGetLastError();
        grid = cus * 1;
    }
    if (grid < 0) return;
#if MK_ONE_LAUNCH
    if (hipMemsetAsync((char*)d_ws + WS_CTL, 0, 65536, stream) != hipSuccess) { fprintf(stderr, "kernel_launch: memset failed\n"); return; }
#endif
    Args a{};
    for (int i = 0; i < 21; ++i) a.in.p[i] = (const float*)d_in[i];
    a.out = (float*)d_out; a.ws = (unsigned char*)d_ws;
#if MK_ONE_LAUNCH
    a.ph_lo = 0; a.ph_hi = NPHASE;
    void* kargs[] = {&a};
    hipError_t e = hipLaunchCooperativeKernel((const void*)mk_fwd, dim3(grid), dim3(NTHREADS), kargs, LDS_BYTES, stream);
    if (e != hipSuccess) fprintf(stderr, "kernel_launch: cooperative launch failed: %s (grid %d)\n", hipGetErrorString(e), grid);
#else
    for (int p = 0; p < NPHASE; ++p) { a.ph_lo = p; a.ph_hi = p + 1; hipLaunchKernelGGL(mk_fwd, dim3(grid), dim3(NTHREADS), LDS_BYTES, stream, a); }
#endif
}
```

```cpp
#include <hip/hip_runtime.h>
#include <hip/hip_cooperative_groups.h>
#include <cstdio>
#include <cstdint>
#include <cmath>
namespace cg = cooperative_groups;

#ifndef MK_ONE_LAUNCH
#define MK_ONE_LAUNCH 1
#endif

namespace cfg {
constexpr int D = 1024, BATCH = 8, SEQ = 2048, DEPTH = 4, M = BATCH * SEQ;
constexpr int GH = 4, GDK = 64, GDV = 128, GKEY = 256, GVAL = 512, GRANK = 16;
constexpr int SGW = 512, SGC = 128, CW = 512, DFF = 2816, DFF2 = 5632;
constexpr int INC = 7184, NIN = 7424;
constexpr int O_Q = 0, O_K = 256, O_V = 512, O_G = 1024, O_A = 1536, O_SU = 1552, O_SV = 2064, O_CB = 2576, O_CC = 3088, O_CX = 3600, O_GT = 4112;
constexpr float EPS = 1e-6f;
}
using namespace cfg;

namespace pg8 {
#define PG8_LAS __attribute__((address_space(3)))
typedef unsigned short bf16_t;
typedef short bf16x8 __attribute__((ext_vector_type(8)));
typedef float f32x4 __attribute__((ext_vector_type(4)));
typedef unsigned u32x4 __attribute__((ext_vector_type(4)));
constexpr int BM = 256, BK = 64, HALF = 128, HTB = HALF * BK * 2  , STAGE_BYTES = 8 * HTB, NXCD = 8, WGM = 8;

__host__ __device__ __forceinline__ int lds_byte(int r, int c) { const int st = (r >> 4) * 2 + (c >> 5), rr = r & 15, cc = c & 31, ob = rr * 64 + cc * 2; return st * 1024 + (ob ^ (((ob >> 9) & 1) << 5)); }
__host__ __device__ __forceinline__ void stage_rc(int b, int& R, int& C) { const int st = b / 1024, sb = b % 1024, swz = sb ^ (((sb >> 9) & 1) << 5); R = (st >> 1) * 16 + swz / 64; C = (st & 1) * 32 + (swz % 64) / 2; }
__host__ __device__ __forceinline__ int perm32(int rho) { const int n = rho >> 4, i = rho & 15; return 8 * (i >> 2) + 4 * n + (i & 3); }

struct Unit { int pm, pn; };
struct Gemm { const bf16_t* A; const bf16_t* Bt; int M, N, K; };

struct StaticOrder {
    int nM, nN, nwg, G, c;
    __host__ __device__ void init(int M, int N, int G_, int c_) { nM = M / BM; nN = N / BM; nwg = nM * nN; G = G_; c = c_; }
    __host__ __device__ bool next(int i, Unit& u) const {
        const long L = (long)i * G + c; if (L >= nwg) return false;
        int wgid = (int)L; { const int q = nwg / NXCD, r = nwg % NXCD, xcd = wgid % NXCD, off = wgid / NXCD; wgid = (xcd < r ? xcd * (q + 1) : r * (q + 1) + (xcd - r) * q) + off; }
        const int nig = WGM * nN, gid = wgid / nig, fm = gid * WGM, gsz = (nM - fm) < WGM ? (nM - fm) : WGM;
        u.pm = fm + ((wgid % nig) % gsz); u.pn = (wgid % nig) / gsz; return true;
    }
    __device__ __forceinline__ void a_ready(const Unit&) const {}
    __device__ __forceinline__ void done(const Unit&) const {}
};

__device__ __forceinline__ unsigned cvt_pk_bf16(float lo, float hi) { unsigned r; asm volatile("v_cvt_pk_bf16_f32 %0, %1, %2" : "=v"(r) : "v"(lo), "v"(hi)); return r; }
typedef float f32x2 __attribute__((ext_vector_type(2)));
#ifdef TSUB
#define PG8_TS_BEGIN(k) unsigned long long ts_b_ = 0; if ((k) == TSUB) ts_b_ = __builtin_amdgcn_s_memrealtime()
#define PG8_TS_END(k) do { if ((k) == TSUB && blockIdx.x == 7 && tid == 0) *(PG8_LAS unsigned long long*)(lds + 131072 + 640) += __builtin_amdgcn_s_memrealtime() - ts_b_; } while (0)
#else
#define PG8_TS_BEGIN(k) do { } while (0)
#define PG8_TS_END(k) do { } while (0)
#endif
template <class Epi, class Sched, bool ALIGN_EPI = false, bool SP2 = false>
__device__ __forceinline__ void gemm_phase(PG8_LAS unsigned char* lds, const Gemm g, const Sched& S, const Epi& E, const int wave_id) {
    int ln__; asm volatile("v_mbcnt_lo_u32_b32 %0, -1, 0\n\tv_mbcnt_hi_u32_b32 %0, -1, %0" : "=v"(ln__));
    const int tid_ = ln__ + 64 * wave_id;
    const int tid = tid_, wid = __builtin_amdgcn_readfirstlane(tid >> 6), lane = tid & 63, wr = wid >> 2, wc = wid & 3, fr = lane & 15, fq = lane >> 4;
    const int K = g.K, nt = K / BK;
    unsigned voffA[2], voffB[2];
#pragma unroll
    for (int i = 0; i < 2; ++i) { int R, C; stage_rc(tid * 16 + i * 8192, R, C); const int Rb = Epi::PERM ? ((R & ~31) + perm32(R & 31)) : R;
        voffA[i] = (unsigned)(R * K + C) * 2u; voffB[i] = (unsigned)(Rb * K + C) * 2u; }
    const size_t kstep = (size_t)(BK * 2);
    const size_t hstep = (size_t)HALF * K * 2;
    const size_t tstep = 2 * hstep;
    const unsigned ldsw = (unsigned)wid * 1024u;
    const int aoff = lds_byte(wr * 64 + fr, fq * 8), boff = lds_byte(wc * 32 + fr, fq * 8);
#define PG8_SA(b, h) (((b) * 2 + (h)) * HTB)
#define PG8_SB(b, h) ((4 + (b) * 2 + (h)) * HTB)
#define PG8_STAGE(bufoff, gbase, voff) do { _Pragma("unroll") for (int _i = 0; _i < 2; ++_i) \
        __builtin_amdgcn_global_load_lds((const unsigned*)((const char*)(gbase) + (voff)[_i]), (PG8_LAS unsigned*)(lds + (bufoff) + ldsw + _i * 8192), 16, 0, 0); } while (0)
#define PG8_LDA(dst, b, h) do { _Pragma("unroll") for (int m = 0; m < 4; ++m) _Pragma("unroll") for (int k = 0; k < 2; ++k) dst[m][k] = *(const PG8_LAS bf16x8*)(lds + PG8_SA(b, h) + aoff + m * 2048 + k * 1024); } while (0)
#define PG8_LDB(dst, b, h) do { _Pragma("unroll") for (int n = 0; n < 2; ++n) _Pragma("unroll") for (int k = 0; k < 2; ++k) dst[n][k] = *(const PG8_LAS bf16x8*)(lds + PG8_SB(b, h) + boff + n * 2048 + k * 1024); } while (0)
#define PG8_MMA(ai, bj, At, Bt) do { __builtin_amdgcn_s_setprio(1); _Pragma("unroll") for (int m = 0; m < 4; ++m) _Pragma("unroll") for (int n = 0; n < 2; ++n) _Pragma("unroll") for (int k = 0; k < 2; ++k) \
        acc[ai][bj][m][n] = __builtin_amdgcn_mfma_f32_16x16x32_bf16(Bt[n][k], At[m][k], acc[ai][bj][m][n], 0, 0, 0); __builtin_amdgcn_s_setprio(0); } while (0)
#define PG8_WAIT_V(n) asm volatile("s_waitcnt vmcnt(" #n ")" ::: "memory")
#define PG8_WAIT_L(n) asm volatile("s_waitcnt lgkmcnt(" #n ")" ::: "memory")
#define PG8_BAR __builtin_amdgcn_s_barrier()
#define PG8_SCHED __builtin_amdgcn_sched_barrier(0)
    Unit cur, nxt; int ui = 0;
    if (!S.next(0, cur)) return;
    f32x4 acc[2][2][4][2];
#pragma unroll
    for (int a = 0; a < 2; ++a)
#pragma unroll
        for (int b = 0; b < 2; ++b)
#pragma unroll
            for (int m = 0; m < 4; ++m)
#pragma unroll
                for (int n = 0; n < 2; ++n) acc[a][b][m][n] = (f32x4){0.f, 0.f, 0.f, 0.f};
    bf16x8 At[4][2], B0[2][2], B1[2][2];
    const char* cA = (const char*)g.A + (size_t)cur.pm * tstep; const char* cB = (const char*)g.Bt + (size_t)cur.pn * tstep;
    S.a_ready(cur);
    if constexpr (SP2) {
        PG8_STAGE(PG8_SB(0, 0), cB, voffB); PG8_STAGE(PG8_SB(0, 1), cB + hstep, voffB); PG8_STAGE(PG8_SA(0, 0), cA, voffA); PG8_STAGE(PG8_SA(0, 1), cA + hstep, voffA);
        if (wr == 1) PG8_BAR;
        PG8_WAIT_V(2); PG8_BAR;
        PG8_STAGE(PG8_SB(1, 0), cB + kstep, voffB); PG8_STAGE(PG8_SA(1, 0), cA + kstep, voffA); PG8_STAGE(PG8_SB(1, 1), cB + hstep + kstep, voffB);
        PG8_WAIT_V(6); PG8_BAR;
    } else {
        PG8_STAGE(PG8_SB(0, 0), cB, voffB); PG8_STAGE(PG8_SA(0, 0), cA, voffA); PG8_STAGE(PG8_SB(0, 1), cB + hstep, voffB); PG8_STAGE(PG8_SA(0, 1), cA + hstep, voffA);
        if (wr == 1) PG8_BAR;
        PG8_WAIT_V(4); PG8_BAR;
        PG8_STAGE(PG8_SB(1, 0), cB + kstep, voffB); PG8_STAGE(PG8_SA(1, 0), cA + kstep, voffA); PG8_STAGE(PG8_SB(1, 1), cB + hstep + kstep, voffB);
        PG8_WAIT_V(6); PG8_BAR;
    }
    for (;;) {
        const bool has_next = S.next(ui + 1, nxt);
        const char* nA = has_next ? (const char*)g.A + (size_t)nxt.pm * tstep : cA; const char* nB = has_next ? (const char*)g.Bt + (size_t)nxt.pn * tstep : cB;
        for (int t = 0; t < nt; t += 2) {
            const bool last = (t == nt - 2);
            const char* a1 = cA + (size_t)(t + 1) * kstep;
            const char* a2 = last ? nA : cA + (size_t)(t + 2) * kstep; const char* b2 = last ? nB : cB + (size_t)(t + 2) * kstep;
            const char* a3 = a2 + kstep; const char* b3 = b2 + kstep;
            if (last && has_next) S.a_ready(nxt);
            if constexpr (Epi::MIDHOOK) { if (t == Epi::HOOK_T1 || t == Epi::HOOK_T2) E.mid(acc, cur, t, wr, wc); }
            if constexpr (SP2) {
            PG8_LDB(B0, 0, 0); PG8_LDB(B1, 0, 1); PG8_SCHED; PG8_LDA(At, 0, 0); PG8_STAGE(PG8_SA(1, 1), a1 + hstep, voffA);
            PG8_WAIT_V(8); PG8_WAIT_L(0); PG8_BAR; PG8_MMA(0, 0, At, B0); PG8_MMA(0, 1, At, B1); PG8_BAR; PG8_SCHED;
            PG8_LDA(At, 0, 1); PG8_STAGE(PG8_SB(0, 0), b2, voffB); PG8_STAGE(PG8_SB(0, 1), b2 + hstep, voffB); PG8_STAGE(PG8_SA(0, 0), a2, voffA);
            PG8_WAIT_V(8); PG8_WAIT_L(0); PG8_BAR; PG8_MMA(1, 0, At, B0); PG8_MMA(1, 1, At, B1); PG8_BAR; PG8_SCHED;
            PG8_LDB(B0, 1, 0); PG8_LDB(B1, 1, 1); PG8_SCHED; PG8_LDA(At, 1, 0); PG8_STAGE(PG8_SA(0, 1), a2 + hstep, voffA);
            PG8_WAIT_V(8); PG8_WAIT_L(0); PG8_BAR; PG8_MMA(0, 0, At, B0); PG8_MMA(0, 1, At, B1); PG8_BAR; PG8_SCHED;
            PG8_LDA(At, 1, 1); PG8_STAGE(PG8_SB(1, 0), b3, voffB); PG8_STAGE(PG8_SB(1, 1), b3 + hstep, voffB); PG8_STAGE(PG8_SA(1, 0), a3, voffA);
            PG8_WAIT_V(8); PG8_WAIT_L(0); PG8_BAR; PG8_MMA(1, 0, At, B0); PG8_MMA(1, 1, At, B1); PG8_BAR; PG8_SCHED;
            } else {
            PG8_LDB(B0, 0, 0); PG8_SCHED; PG8_LDA(At, 0, 0); PG8_STAGE(PG8_SA(1, 1), a1 + hstep, voffA);
            PG8_WAIT_L(8); PG8_BAR; PG8_WAIT_L(0); PG8_MMA(0, 0, At, B0); PG8_BAR; PG8_SCHED;
            PG8_LDB(B1, 0, 1); PG8_STAGE(PG8_SB(0, 0), b2, voffB);
            PG8_BAR; PG8_WAIT_L(0); PG8_MMA(0, 1, At, B1); PG8_BAR;
            PG8_LDA(At, 0, 1); PG8_STAGE(PG8_SA(0, 0), a2, voffA);
            PG8_BAR; PG8_WAIT_L(0); PG8_MMA(1, 0, At, B0); PG8_BAR; PG8_SCHED;
            PG8_STAGE(PG8_SB(0, 1), b2 + hstep, voffB);
            PG8_WAIT_V(6); PG8_BAR; PG8_MMA(1, 1, At, B1); PG8_BAR;
            PG8_LDB(B0, 1, 0); PG8_SCHED; PG8_LDA(At, 1, 0); PG8_STAGE(PG8_SA(0, 1), a2 + hstep, voffA);
            PG8_WAIT_L(8); PG8_BAR; PG8_WAIT_L(0); PG8_MMA(0, 0, At, B0); PG8_BAR; PG8_SCHED;
            PG8_LDB(B1, 1, 1); PG8_STAGE(PG8_SB(1, 0), b3, voffB);
            PG8_BAR; PG8_WAIT_L(0); PG8_MMA(0, 1, At, B1); PG8_BAR;
            PG8_LDA(At, 1, 1); PG8_STAGE(PG8_SA(1, 0), a3, voffA);
            PG8_BAR; PG8_WAIT_L(0); PG8_MMA(1, 0, At, B0); PG8_BAR; PG8_SCHED;
            PG8_STAGE(PG8_SB(1, 1), b3 + hstep, voffB);
            PG8_WAIT_V(6); PG8_BAR; PG8_MMA(1, 1, At, B1); PG8_BAR;
            }
        }
        if constexpr (ALIGN_EPI) { if (wr == 0) PG8_BAR; }
        if constexpr (!Epi::AFTER_DRAIN) { PG8_TS_BEGIN(Epi::TSID); E(acc, cur, wr, wc, fr, fq); PG8_TS_END(Epi::TSID); S.done(cur); }
        if (!has_next) break;
#pragma unroll
        for (int a = 0; a < 2; ++a)
#pragma unroll
            for (int b = 0; b < 2; ++b)
#pragma unroll
                for (int m = 0; m < 4; ++m)
#pragma unroll
                    for (int n = 0; n < 2; ++n) acc[a][b][m][n] = (f32x4){0.f, 0.f, 0.f, 0.f};
        cur = nxt; cA = nA; cB = nB; ++ui;
        if constexpr (ALIGN_EPI) { if (wr == 1) PG8_BAR; }
    }
    PG8_WAIT_V(0);
    if constexpr (!ALIGN_EPI) { if (wr == 0) PG8_BAR; }
    PG8_BAR;
    if constexpr (Epi::AFTER_DRAIN) { E.fused(acc, cur, wr, wc, fr, fq, lds, wid, lane); S.done(cur); }
#undef PG8_SA
#undef PG8_SB
#undef PG8_STAGE
#undef PG8_LDA
#undef PG8_LDB
#undef PG8_MMA
#undef PG8_WAIT_V
#undef PG8_WAIT_L
#undef PG8_BAR
#undef PG8_SCHED
}
}

#define GAS __attribute__((address_space(1)))
#define LAS __attribute__((address_space(3)))
typedef unsigned short bf16;
typedef unsigned v4u __attribute__((ext_vector_type(4)));
typedef unsigned v2u __attribute__((ext_vector_type(2)));
typedef float f32x4 __attribute__((ext_vector_type(4)));
typedef float f32x2 __attribute__((ext_vector_type(2)));
typedef short bf16x8 __attribute__((ext_vector_type(8)));
constexpr int NWAVES = 8, NTHREADS = 512;
constexpr int ZPITCH = 1536;
constexpr int RING_BYTES = 131072, LDS_BYTES = 153600;
constexpr int RST_OFF = RING_BYTES + 10240;

constexpr size_t MiB = 1u << 20;
constexpr size_t SL_WIN = 0, SL_WBR = SL_WIN + (size_t)NIN * D * 2, SL_WO = SL_WBR + (size_t)3 * D * 512 * 2, SL_WUP = SL_WO + (size_t)D * D * 2,
                 SL_WDN = SL_WUP + (size_t)DFF2 * D * 2, SL_SGW = SL_WDN + (size_t)D * DFF * 2, SL_END = SL_SGW + (size_t)4 * 128 * 128 * 2, SL_BYTES = 38 * MiB;
static_assert(SL_END <= SL_BYTES, "weight slot");
constexpr size_t WS_CTL = 0, WS_SLOT0 = 1 * MiB, WS_XB = WS_SLOT0 + 2 * SL_BYTES, WS_SSQ = WS_XB + 32 * MiB, WS_SVST = WS_SSQ + 1 * MiB, WS_ACT0 = WS_SVST + 1 * MiB;
constexpr size_t A_Q = 0, A_K = 8 * MiB, A_V = 16 * MiB, A_Z = 32 * MiB, A_SV = 80 * MiB, A_CC = 96 * MiB, A_CX = 112 * MiB, A_LOGA = 128 * MiB, A_G = 144 * MiB,
                 A_CST = 240 * MiB, A_DEC = 272 * MiB, A_END = 273 * MiB;
constexpr size_t A_MERGED = A_Q, A_HUP = 0, A_ACT = 176 * MiB, A_HT = 64 * MiB;
static_assert(A_ACT + (size_t)M * DFF * 2 <= A_END, "overlay");
constexpr size_t WS_END = WS_ACT0 + A_END;
constexpr int CW_BAR = 1024, CW_QHEAD = 6144, CW_FIN = 8192, CW_AB = 12288;

__device__ __forceinline__ float bf2f(unsigned h) { return __uint_as_float(h << 16); }
__device__ __forceinline__ unsigned pk2(float lo, float hi) { return pg8::cvt_pk_bf16(lo, hi); }
__device__ __forceinline__ float fsigmoid(float z) { return __builtin_amdgcn_rcpf(1.f + __expf(-z)); }
__device__ __forceinline__ float fsilu(float z) { return z * fsigmoid(z); }
__device__ __forceinline__ float fgelu(float z) { return z * fsigmoid(1.5957691216057308f * (z + 0.044715f * z * z * z)); }
__device__ __forceinline__ float flogsig(float z) { return fminf(z, 0.f) - __logf(1.f + __expf(-fabsf(z))); }
__device__ __forceinline__ float wave_sum(float v) {
#pragma unroll
    for (int o = 1; o < 64; o <<= 1) v += __shfl_xor(v, o);
    return v;
}
#define LDS_WAIT() asm volatile("s_waitcnt lgkmcnt(0)" ::: "memory")
#define LDS_BARRIER() do { asm volatile("s_waitcnt lgkmcnt(0)" ::: "memory"); __builtin_amdgcn_s_barrier(); asm volatile("" ::: "memory"); } while (0)
__device__ __forceinline__ f32x4 mfma16(bf16x8 a, bf16x8 b, f32x4 c) { return __builtin_amdgcn_mfma_f32_16x16x32_bf16(a, b, c, 0, 0, 0); }

__device__ __forceinline__ void tr_write(bf16* WT, int K, int k0, LAS float* scr, int lane) {
    LDS_WAIT(); asm volatile("" ::: "memory");
    const int c = lane & 7;
#pragma unroll
    for (int j = 0; j < 4; ++j) { const int n = (lane >> 3) + 8 * j; const LAS float* s = scr + (8 * c) * 33 + n;
        v4u o; o.x = pk2(s[0 * 33], s[1 * 33]); o.y = pk2(s[2 * 33], s[3 * 33]); o.z = pk2(s[4 * 33], s[5 * 33]); o.w = pk2(s[6 * 33], s[7 * 33]);
        *(GAS v4u*)(WT + (size_t)n * K + k0 + 8 * c) = o; }
    LDS_WAIT(); asm volatile("" ::: "memory");
}
__device__ __forceinline__ void tr_item(const float* W, int ldw, int col0, const float* ksc, float sc, bf16* WT, int K, int k0, LAS float* scr, int lane) {
    float v[32]; const float* src = W + (size_t)(k0 + (lane >> 5)) * ldw + col0 + (lane & 31);
#pragma unroll
    for (int i = 0; i < 32; ++i) v[i] = src[(size_t)(2 * i) * ldw];
    if (ksc) {
#pragma unroll
        for (int i = 0; i < 32; ++i) v[i] *= ksc[k0 + 2 * i + (lane >> 5)]; }
#pragma unroll
    for (int i = 0; i < 32; ++i) scr[(2 * i + (lane >> 5)) * 33 + (lane & 31)] = v[i] * sc;
    tr_write(WT, K, k0, scr, lane);
}
__device__ __forceinline__ void alpha_item(const float* win, const float* wal, const float* g, bf16* WT, int k0, int j0, LAS float* scr, int lane) {
    const int jj = lane & 31, half = lane >> 5; float wa[16];
#pragma unroll
    for (int r = 0; r < 16; ++r) wa[r] = wal[r * GKEY + j0 + jj];
    for (int i = 0; i < 32; ++i) { const int kk = 2 * i + half, k = k0 + kk; const float* wr = win + (size_t)k * INC + O_A; float s = 0.f;
#pragma unroll
        for (int r = 0; r < 16; ++r) s += wr[r] * wa[r];
        scr[kk * 33 + jj] = s * g[k]; }
    tr_write(WT + (size_t)j0 * D, D, k0, scr, lane);
}
struct Inputs { const float* p[21]; };
constexpr int CV_J0 = 16 * 224, CV_J1 = 16 * 8, CV_J2 = 3 * 8 * 32, CV_J3 = 16 * 32, CV_J4 = 16 * 176, CV_J5 = 44 * 32, CV_J6 = 128, CV_ITEMS = CV_J0 + CV_J1 + CV_J2 + CV_J3 + CV_J4 + CV_J5 + CV_J6;
constexpr int CV_WIN_ITEMS = CV_J0 + CV_J1;
__device__ __forceinline__ void convert_item(const Inputs& I, int l, unsigned char* slot, LAS float* scr, int it, int lane) {
    bf16* WIN = (bf16*)(slot + SL_WIN); bf16* WBR = (bf16*)(slot + SL_WBR); bf16* WO = (bf16*)(slot + SL_WO); bf16* WUP = (bf16*)(slot + SL_WUP); bf16* WDN = (bf16*)(slot + SL_WDN); bf16* SGWS = (bf16*)(slot + SL_SGW);
    const float* win = I.p[2] + (size_t)l * D * INC;
        int r = it;
        if (r < CV_J0) { const int kb = r / 224, nb = r % 224; const int drow = nb < 48 ? 32 * nb : 1792 + 32 * (nb - 48), scol = nb < 48 ? 32 * nb : O_SU + 32 * (nb - 48);
            tr_item(win, INC, scol, I.p[1] + (size_t)l * D, drow < 256 ? 0.125f : 1.f, WIN + (size_t)drow * D, D, 64 * kb, scr, lane); return; }
        r -= CV_J0;
        if (r < CV_J1) { const int kb = r / 8, jb = r % 8; alpha_item(win, I.p[3] + (size_t)l * GRANK * GKEY, I.p[1] + (size_t)l * D, WIN + (size_t)1536 * D, 64 * kb, 32 * jb, scr, lane); return; }
        r -= CV_J1;
        if (r < CV_J2) { const int br = r / 256, rr = r % 256, kb = rr / 32, nb = rr % 32;
            const float* W = (br == 0 ? I.p[6] : br == 1 ? I.p[11] : I.p[13]) + (size_t)l * 512 * D;
            tr_item(W, D, 32 * nb, br == 0 ? I.p[5] + (size_t)l * GVAL : nullptr, 1.f, WBR + (size_t)32 * nb * ZPITCH + br * 512, ZPITCH, 64 * kb, scr, lane); return; }
        r -= CV_J2;
        if (r < CV_J3) { const int kb = r / 32, nb = r % 32; tr_item(I.p[14] + (size_t)l * D * D, D, 32 * nb, nullptr, 1.f, WO + (size_t)32 * nb * D, D, 64 * kb, scr, lane); return; }
        r -= CV_J3;
        if (r < CV_J4) { const int kb = r / 176, nb = r % 176, pn = nb / 8, jb = nb % 8; const int scol = jb < 4 ? 128 * pn + 32 * jb : DFF + 128 * pn + 32 * (jb - 4);
            tr_item(I.p[16] + (size_t)l * D * DFF2, DFF2, scol, I.p[15] + (size_t)l * D, 1.f, WUP + (size_t)32 * nb * D, D, 64 * kb, scr, lane); return; }
        r -= CV_J4;
        if (r < CV_J5) { const int kb = r / 32, nb = r % 32; tr_item(I.p[19] + (size_t)l * DFF * D, D, 32 * nb, nullptr, 1.f, WDN + (size_t)32 * nb * DFF, DFF, 64 * kb, scr, lane); return; }
        r -= CV_J5;
        { const int e0 = r * 512 + lane * 8, t = (e0 >> 7) & 127, s0 = e0 & 127; const float* src = I.p[9] + (size_t)l * 4 * 128 * 128 + e0;
          const f32x4 a = *(const f32x4*)src, b = *(const f32x4*)(src + 4); float v[8] = {a[0], a[1], a[2], a[3], b[0], b[1], b[2], b[3]};
#pragma unroll
          for (int e = 0; e < 8; ++e) if (s0 + e > t) v[e] = 0.f;
          v4u o; o.x = pk2(v[0], v[1]); o.y = pk2(v[2], v[3]); o.z = pk2(v[4], v[5]); o.w = pk2(v[6], v[7]); *(GAS v4u*)(SGWS + e0) = o; }
}
__device__ __forceinline__ void convert_static(const Inputs& I, int l, unsigned char* slot, LAS unsigned char* lds, int it_lo, int it_hi, int gw, int ngw, int wave, int lane) {
    LAS float* scr = (LAS float*)(lds + wave * 8448);
    for (int it = it_lo + gw; it < it_hi; it += ngw) convert_item(I, l, slot, scr, it, lane);
}
#define RLX_AGENT __ATOMIC_RELAXED, __HIP_MEMORY_SCOPE_AGENT
__device__ __forceinline__ void convert_queue(const Inputs& I, int l, unsigned char* slot, LAS unsigned char* lds, unsigned* head, int it_lo, int it_hi, unsigned* fin, int G, int tid, int wave, int lane) {
    LAS float* scr = (LAS float*)(lds + wave * 8448); volatile LAS unsigned* bc = (volatile LAS unsigned*)(lds + RING_BYTES + 768);
    for (;;) {
        if (tid == 0) { unsigned v = 0xffffffffu; if (!fin || __hip_atomic_load(fin, RLX_AGENT) < (unsigned)G) v = __hip_atomic_fetch_add(head, 8u, RLX_AGENT); bc[0] = v; }
        LDS_BARRIER();
        const unsigned base = bc[0];
        LDS_BARRIER();
        if (base >= (unsigned)(it_hi - it_lo)) break;
        const int it = it_lo + (int)base + wave; if (it < it_hi) convert_item(I, l, slot, scr, it, lane);
    }
}
__device__ __forceinline__ void x_prep(const float* xin, bf16* xb, float* ssq, int gw, int ngw, int lane) {
    for (int row = gw; row < M; row += ngw) {
        const GAS f32x4* xr = (const GAS f32x4*)(xin + (size_t)row * D) + lane; f32x4 v[4]; float s = 0.f;
#pragma unroll
        for (int j = 0; j < 4; ++j) { v[j] = xr[64 * j]; s += (v[j][0] * v[j][0] + v[j][1] * v[j][1]) + (v[j][2] * v[j][2] + v[j][3] * v[j][3]); }
        s = wave_sum(s);
#pragma unroll
        for (int j = 0; j < 4; ++j) { v2u w; w.x = pk2(v[j][0], v[j][1]); w.y = pk2(v[j][2], v[j][3]); ((GAS v2u*)(xb + (size_t)row * D))[lane + 64 * j] = w; }
        if (lane < 16) ssq[(size_t)row * 16 + lane] = lane == 0 ? s : 0.f;
    }
}
__device__ __forceinline__ void final_norm(const bf16* xb, float* out, const float* ssq, const float* g, int gw, int ngw, int lane) {
    for (int row = gw; row < M; row += ngw) {
        const float pv = lane < 16 ? ssq[(size_t)row * 16 + lane] : 0.f; const float rs = rsqrtf(wave_sum(pv) * (1.f / D) + EPS);
        const GAS v2u* xr = (const GAS v2u*)(xb + (size_t)row * D) + lane; GAS f32x4* orow = (GAS f32x4*)(out + (size_t)row * D) + lane;
#pragma unroll
        for (int j = 0; j < 4; ++j) { const v2u w = xr[64 * j]; const f32x4 gv = ((const GAS f32x4*)g)[lane + 64 * j];
            orow[64 * j] = (f32x4){bf2f(w.x & 0xffffu) * rs * gv[0], bf2f(w.x >> 16) * rs * gv[1], bf2f(w.y & 0xffffu) * rs * gv[2], bf2f(w.y >> 16) * rs * gv[3]}; }
    }
}

constexpr int GP = 72;
constexpr int L_QT = 0, L_KT = 9216, L_KENDT = 18432, L_VT = 27648, L_ST = 46080, L_SEG = 64512, L_DECS = 66560, L_RED = 66816, L_GLA_END = 67328;
constexpr int VP = 136;

typedef short s16x4 __attribute__((ext_vector_type(4)));
constexpr int SG_VNP = 288, SG_OUTP = 272, SG_VN = 0, SG_OUT = 128 * SG_VNP, SG_ST = SG_OUT + 128 * SG_OUTP;
__device__ __forceinline__ void sgu_item(int item, LAS unsigned char* lds, const bf16* ZBI, bf16* ZBO, const bf16* SV, const float* SVST, const float* lng, const float* lnb, const bf16* wsb, const float* bs, int wave, int lane) {
    const int b_ = item & 7, h = (item >> 3) & 3, r0 = b_ * SEQ + (item >> 5) * 128;
    const int tid = wave * 64 + lane, fr = lane & 15, fq = lane >> 4, t = 16 * wave + fr, nks = (wave >> 1) + 1;
    const int cc = tid & 15, rg = tid >> 4;
    f32x4 st4[4];
    if (tid < 128) { const f32x4* p = (const f32x4*)(SVST + ((size_t)r0 + tid) * 16); st4[0] = p[0]; st4[1] = p[1]; st4[2] = p[2]; st4[3] = p[3]; }
    v4u svv[4], suv[4];
#pragma unroll
    for (int i = 0; i < 4; ++i) { const size_t row = (size_t)r0 + rg + 32 * i; svv[i] = *(const v4u*)(SV + row * 512 + h * 128 + 8 * cc); suv[i] = *(const v4u*)(ZBI + row * ZPITCH + h * 128 + 8 * cc); }
    const f32x4 g0 = *(const f32x4*)(lng + h * 128 + 8 * cc), g1 = *(const f32x4*)(lng + h * 128 + 8 * cc + 4), b0 = *(const f32x4*)(lnb + h * 128 + 8 * cc), b1 = *(const f32x4*)(lnb + h * 128 + 8 * cc + 4);
    bf16x8 bfr[4];
#pragma unroll
    for (int ks = 0; ks < 4; ++ks) bfr[ks] = (ks < nks) ? *(const bf16x8*)(wsb + ((size_t)h * 128 + t) * 128 + 32 * ks + 8 * fq) : (bf16x8){0, 0, 0, 0, 0, 0, 0, 0};
    const float bias = bs[h * 128 + t];
    if (tid < 128) { const f32x4 a = st4[0], b = st4[1], c = st4[2], d = st4[3];
        const float sm = (a[0] + a[2]) + (b[0] + b[2]) + (c[0] + c[2]) + (d[0] + d[2]), sq = (a[1] + a[3]) + (b[1] + b[3]) + (c[1] + c[3]) + (d[1] + d[3]);
        const float mean = sm * (1.f / 512.f); *(LAS f32x2*)(lds + SG_ST + tid * 8) = (f32x2){mean, rsqrtf(fmaxf(sq * (1.f / 512.f) - mean * mean, 0.f) + EPS)}; }
    LDS_BARRIER();
#pragma unroll
    for (int i = 0; i < 4; ++i) { const int srow = rg + 32 * i; const f32x2 ms = *(const LAS f32x2*)(lds + SG_ST + srow * 8); float v[8];
#pragma unroll
        for (int e = 0; e < 4; ++e) { v[2 * e] = bf2f(svv[i][e] & 0xffffu); v[2 * e + 1] = bf2f(svv[i][e] >> 16); }
#pragma unroll
        for (int e = 0; e < 4; ++e) { v[e] = (v[e] - ms[0]) * ms[1] * g0[e] + b0[e]; v[4 + e] = (v[4 + e] - ms[0]) * ms[1] * g1[e] + b1[e]; }
        v4u o; o.x = pk2(v[0], v[1]); o.y = pk2(v[2], v[3]); o.z = pk2(v[4], v[5]); o.w = pk2(v[6], v[7]); *(LAS v4u*)(lds + SG_VN + srow * SG_VNP + cc * 16) = o; }
    LDS_BARRIER();
    { f32x4 acc[8]; const int gk = lane >> 4, qq = (lane & 15) >> 2, pp = lane & 3;
#pragma unroll
      for (int m = 0; m < 8; ++m) { acc[m] = (f32x4){0.f, 0.f, 0.f, 0.f};
#pragma unroll
          for (int ks = 0; ks < 4; ++ks) if (ks < nks) {
              const s16x4 lo = __builtin_amdgcn_ds_read_tr16_b64_v4i16((LAS s16x4*)(lds + SG_VN + (32 * ks + 8 * gk + qq) * SG_VNP + (16 * m + 4 * pp) * 2));
              const s16x4 hi = __builtin_amdgcn_ds_read_tr16_b64_v4i16((LAS s16x4*)(lds + SG_VN + (32 * ks + 8 * gk + 4 + qq) * SG_VNP + (16 * m + 4 * pp) * 2));
              const bf16x8 a = {lo[0], lo[1], lo[2], lo[3], hi[0], hi[1], hi[2], hi[3]}; acc[m] = mfma16(a, bfr[ks], acc[m]); } }
#pragma unroll
      for (int m = 0; m < 8; ++m) { v2u w; w.x = pk2(acc[m][0] + bias, acc[m][1] + bias); w.y = pk2(acc[m][2] + bias, acc[m][3] + bias); *(LAS v2u*)(lds + SG_OUT + t * SG_OUTP + (16 * m + 4 * fq) * 2) = w; } }
    LDS_BARRIER();
#pragma unroll
    for (int i = 0; i < 4; ++i) { const int srow = rg + 32 * i; const v4u mx = *(const LAS v4u*)(lds + SG_OUT + srow * SG_OUTP + cc * 16); v4u o;
#pragma unroll
        for (int e = 0; e < 4; ++e) o[e] = pk2(bf2f(suv[i][e] & 0xffffu) * bf2f(mx[e] & 0xffffu), bf2f(suv[i][e] >> 16) * bf2f(mx[e] >> 16));
        *(v4u*)(ZBO + ((size_t)r0 + srow) * ZPITCH + h * 128 + 8 * cc) = o; }
    LDS_BARRIER();
}
__device__ __forceinline__ void convbr_item(int idx, const bf16* ZCI, bf16* ZCO, const bf16* CC, const bf16* CX, const float* cw) {
    const int c0 = (idx & 63) * 8, wg_ = idx >> 9, r0 = (wg_ & 7) * SEQ + (wg_ >> 3) * 64 + ((idx >> 6) & 7) * 8; float w[3][8];
#pragma unroll
    for (int k = 0; k < 3; ++k) { const f32x4 a = *(const f32x4*)(cw + k * CW + c0), b = *(const f32x4*)(cw + k * CW + c0 + 4);
#pragma unroll
        for (int e = 0; e < 4; ++e) { w[k][e] = a[e]; w[k][4 + e] = b[e]; } }
    float u2[8], u1[8];
    auto loadu = [&](int row, float (&u)[8]) { const v4u a = *(const v4u*)(CC + (size_t)row * CW + c0), b = *(const v4u*)(CX + (size_t)row * CW + c0);
#pragma unroll
        for (int e = 0; e < 4; ++e) { u[2 * e] = bf2f(a[e] & 0xffffu) * bf2f(b[e] & 0xffffu); u[2 * e + 1] = bf2f(a[e] >> 16) * bf2f(b[e] >> 16); } };
    if ((r0 & (SEQ - 1)) == 0) {
#pragma unroll
        for (int e = 0; e < 8; ++e) { u2[e] = 0.f; u1[e] = 0.f; } }
    else { loadu(r0 - 2, u2); loadu(r0 - 1, u1); }
#pragma unroll
    for (int i = 0; i < 8; ++i) { float u0[8]; loadu(r0 + i, u0); const size_t po = (size_t)(r0 + i) * ZPITCH + c0; bf16* p = ZCO + po; const v4u cb = *(const v4u*)(ZCI + po); float z[8];
#pragma unroll
        for (int e = 0; e < 8; ++e) { const float y = w[0][e] * u2[e] + w[1][e] * u1[e] + w[2][e] * u0[e]; const float c = (e & 1) ? bf2f(cb[e >> 1] >> 16) : bf2f(cb[e >> 1] & 0xffffu); z[e] = c * y; u2[e] = u1[e]; u1[e] = u0[e]; }
        v4u o; o.x = pk2(z[0], z[1]); o.y = pk2(z[2], z[3]); o.z = pk2(z[4], z[5]); o.w = pk2(z[6], z[7]); *(v4u*)p = o; }
}
#ifdef TSUB
#define TS_SLOT ((LAS unsigned long long*)(lds + RING_BYTES + 640))
#define TS_BEGIN(k) unsigned long long ts_b##k = 0; if ((k) == TSUB) ts_b##k = __builtin_amdgcn_s_memrealtime()
#define TS_END(k) do { if ((k) == TSUB && blockIdx.x == 7 && tid == 0) *TS_SLOT += __builtin_amdgcn_s_memrealtime() - ts_b##k; } while (0)
#else
#define TS_BEGIN(k) do { } while (0)
#define TS_END(k) do { } while (0)
#endif
__device__ __forceinline__ float wave_scan_incl(float x) {
#define DPP_ADD(ctrl, rmask) x += __builtin_bit_cast(float, __builtin_amdgcn_update_dpp(0, __builtin_bit_cast(int, x), ctrl, rmask, 0xf, true))
    DPP_ADD(0x111, 0xf); DPP_ADD(0x112, 0xf); DPP_ADD(0x114, 0xf); DPP_ADD(0x118, 0xf);
    x += __builtin_bit_cast(float, __builtin_amdgcn_update_dpp(0, __builtin_bit_cast(int, x), 0x142, 0xa, 0xf, false));
    x += __builtin_bit_cast(float, __builtin_amdgcn_update_dpp(0, __builtin_bit_cast(int, x), 0x143, 0xc, 0xf, false));
#undef DPP_ADD
    return x;
}
struct GlaPre { f32x4 la0, la1; v4u kq, qq, va, vb; };
template <bool FULL> __device__ __forceinline__ GlaPre gla_load(size_t r0, int h, const bf16* Q, const bf16* KK, const bf16* V, const float* LOGA, int tid, int wave, int lane) {
    GlaPre p; const size_t row = r0 + lane; const int kc0 = 8 * wave;
    p.la0 = *(const f32x4*)(LOGA + row * GKEY + h * 64 + kc0); p.la1 = *(const f32x4*)(LOGA + row * GKEY + h * 64 + kc0 + 4);
    p.kq = *(const v4u*)(KK + row * GKEY + h * 64 + kc0); if (FULL) p.qq = *(const v4u*)(Q + row * GKEY + h * 64 + kc0); else p.qq = (v4u){0u, 0u, 0u, 0u};
    const int tp = tid & 31, vg = tid >> 5;
    p.va = *(const v4u*)(V + (r0 + 2 * tp) * GVAL + h * 128 + 8 * vg); p.vb = *(const v4u*)(V + (r0 + 2 * tp + 1) * GVAL + h * 128 + 8 * vg);
    return p;
}
template <bool FULL> __device__ __forceinline__ void gla_build(const GlaPre& p, LAS unsigned char* lds, int tid, int wave, int lane, float (&tot)[8]) {
    const int kc0 = 8 * wave; float b[8] = {p.la0[0], p.la0[1], p.la0[2], p.la0[3], p.la1[0], p.la1[1], p.la1[2], p.la1[3]};
#pragma unroll
    for (int j = 0; j < 8; ++j) b[j] = wave_scan_incl(b[j]);
    float kf[8], qf[8];
#pragma unroll
    for (int e = 0; e < 4; ++e) { kf[2 * e] = bf2f(p.kq[e] & 0xffffu); kf[2 * e + 1] = bf2f(p.kq[e] >> 16); qf[2 * e] = bf2f(p.qq[e] & 0xffffu); qf[2 * e + 1] = bf2f(p.qq[e] >> 16); }
    LAS bf16* KE = (LAS bf16*)(lds + L_KENDT);
#pragma unroll
    for (int j = 0; j < 8; ++j) { tot[j] = __builtin_bit_cast(float, __builtin_amdgcn_readlane(__builtin_bit_cast(int, b[j]), 63)); KE[(kc0 + j) * GP + lane] = (bf16)(pk2(kf[j] * __expf(tot[j] - b[j]), 0.f) & 0xffffu); }
    if (FULL) { float qt[8], kt[8];
#pragma unroll
        for (int j = 0; j < 8; ++j) { qt[j] = qf[j] * __expf(b[j]); kt[j] = kf[j] * __expf(-b[j]); }
        v4u o; o.x = pk2(qt[0], qt[1]); o.y = pk2(qt[2], qt[3]); o.z = pk2(qt[4], qt[5]); o.w = pk2(qt[6], qt[7]); *(LAS v4u*)((LAS bf16*)(lds + L_QT) + lane * GP + kc0) = o;
        o.x = pk2(kt[0], kt[1]); o.y = pk2(kt[2], kt[3]); o.z = pk2(kt[4], kt[5]); o.w = pk2(kt[6], kt[7]); *(LAS v4u*)((LAS bf16*)(lds + L_KT) + lane * GP + kc0) = o; }
    if (lane < 8) { float tl = tot[0];
#pragma unroll
        for (int j = 1; j < 8; ++j) tl = (lane == j) ? tot[j] : tl;
        ((LAS float*)(lds + L_DECS))[kc0 + lane] = __expf(tl); }
    { const int tp = tid & 31, vg = tid >> 5; LAS bf16* VT = (LAS bf16*)(lds + L_VT);
#pragma unroll
      for (int e = 0; e < 4; ++e) { *(LAS unsigned*)(VT + (8 * vg + 2 * e) * GP + 2 * tp) = (p.va[e] & 0xffffu) | (p.vb[e] << 16); *(LAS unsigned*)(VT + (8 * vg + 2 * e + 1) * GP + 2 * tp) = (p.va[e] >> 16) | (p.vb[e] & 0xffff0000u); } }
}
__device__ __forceinline__ void gla_state_step(f32x4 (&S)[4], LAS unsigned char* lds, int wave, int fr, int fq) {
    const LAS bf16* VT = (const LAS bf16*)(lds + L_VT); const LAS bf16* KE = (const LAS bf16*)(lds + L_KENDT); const LAS float* DECS = (const LAS float*)(lds + L_DECS);
    bf16x8 bv[2];
#pragma unroll
    for (int ks = 0; ks < 2; ++ks) bv[ks] = *(const LAS bf16x8*)(VT + (16 * wave + fr) * GP + 32 * ks + 8 * fq);
#pragma unroll
    for (int m = 0; m < 4; ++m) { const f32x4 d = *(const LAS f32x4*)(DECS + 16 * m + 4 * fq); S[m] = S[m] * d;
#pragma unroll
        for (int ks = 0; ks < 2; ++ks) S[m] = mfma16(*(const LAS bf16x8*)(KE + (16 * m + fr) * GP + 32 * ks + 8 * fq), bv[ks], S[m]); }
}
__device__ __forceinline__ void gla_b1_item(int item, LAS unsigned char* lds, const bf16* KK, const bf16* V, const float* LOGA, float* CST, float* DEC, int tid, int wave, int lane) {
    const int b = item & 7, g = (item >> 3) & 7, h = item >> 6, fr = lane & 15, fq = lane >> 4;
    if (g == 7) return;
    f32x4 S[4]; float lsum[8];
#pragma unroll
    for (int m = 0; m < 4; ++m) S[m] = (f32x4){0.f, 0.f, 0.f, 0.f};
#pragma unroll
    for (int j = 0; j < 8; ++j) lsum[j] = 0.f;
    const size_t rg = (size_t)b * SEQ + (size_t)g * 256;
    GlaPre pre[4];
#pragma unroll
    for (int c = 0; c < 4; ++c) pre[c] = gla_load<false>(rg + (size_t)c * 64, h, nullptr, KK, V, LOGA, tid, wave, lane);
#pragma unroll
    for (int c = 0; c < 4; ++c) {
        float tot[8]; gla_build<false>(pre[c], lds, tid, wave, lane, tot);
#pragma unroll
        for (int j = 0; j < 8; ++j) lsum[j] += tot[j];
        LDS_BARRIER();
        gla_state_step(S, lds, wave, fr, fq);
        LDS_BARRIER();
    }
#pragma unroll
    for (int m = 0; m < 4; ++m) { v2u w; w.x = pk2(S[m][0], S[m][1]); w.y = pk2(S[m][2], S[m][3]); *(v2u*)((bf16*)CST + (size_t)item * 8192 + (16 * wave + fr) * 64 + 16 * m + 4 * fq) = w; }
    if (lane < 8) { float tl = lsum[0];
#pragma unroll
        for (int j = 1; j < 8; ++j) tl = (lane == j) ? lsum[j] : tl;
        DEC[(size_t)item * 64 + 8 * wave + lane] = tl; }
}
__device__ __forceinline__ void gla_b2_unit(int unit, LAS unsigned char* lds, const bf16* Q, const bf16* KK, const bf16* V, const float* LOGA, const float* CST, const float* DEC, const bf16* ZAI, bf16* ZAO, int tid, int wave, int lane) {
    const int b = unit & 7, g = (unit >> 3) & 7, h = unit >> 6, fr = lane & 15, fq = lane >> 4;
    TS_BEGIN(1); TS_BEGIN(2);
    const size_t rg = (size_t)b * SEQ + (size_t)g * 256;
    const int ih = wave & 3, vh = wave >> 2;
    GlaPre pre[4]; v2u gt[4][4];
#pragma unroll
    for (int c = 0; c < 2; ++c) pre[c] = gla_load<true>(rg + (size_t)c * 64, h, Q, KK, V, LOGA, tid, wave, lane);
    f32x4 S[4];
#pragma unroll
    for (int m = 0; m < 4; ++m) S[m] = (f32x4){0.f, 0.f, 0.f, 0.f};
    { const size_t it0 = (size_t)unit - 8 * g;
      v2u cc[7][4];
#pragma unroll
      for (int j = 0; j < 7; ++j) if (j < g) {
#pragma unroll
          for (int m = 0; m < 4; ++m) cc[j][m] = *(const v2u*)((const bf16*)CST + (it0 + 8 * j) * 8192 + (16 * wave + fr) * 64 + 16 * m + 4 * fq); }
      LAS float* DT = (LAS float*)(lds + L_QT);
      if (tid < 64 * g) DT[tid] = __expf(DEC[(it0 + 8 * (tid >> 6)) * 64 + (tid & 63)]);
      LDS_BARRIER();
#pragma unroll
      for (int j = 0; j < 7; ++j) if (j < g) {
#pragma unroll
          for (int m = 0; m < 4; ++m) { const f32x4 d = *(const LAS f32x4*)(DT + j * 64 + 16 * m + 4 * fq);
              const f32x4 c = (f32x4){bf2f(cc[j][m].x & 0xffffu), bf2f(cc[j][m].x >> 16), bf2f(cc[j][m].y & 0xffffu), bf2f(cc[j][m].y >> 16)}; S[m] = d * S[m] + c; } }
      LDS_BARRIER(); }
#pragma unroll
    for (int c = 2; c < 4; ++c) pre[c] = gla_load<true>(rg + (size_t)c * 64, h, Q, KK, V, LOGA, tid, wave, lane);
#pragma unroll
    for (int c = 0; c < 4; ++c)
#pragma unroll
        for (int mt = 0; mt < 4; ++mt) gt[c][mt] = *(const v2u*)(ZAI + (rg + (size_t)c * 64 + 16 * ih + fr) * ZPITCH + h * 128 + 64 * vh + 16 * mt + 4 * fq);
    TS_END(2);
    const LAS bf16* QT = (const LAS bf16*)(lds + L_QT); const LAS bf16* KT = (const LAS bf16*)(lds + L_KT);
    const LAS bf16* VT = (const LAS bf16*)(lds + L_VT); LAS bf16* ST = (LAS bf16*)(lds + L_ST); LAS float* RED = (LAS float*)(lds + L_RED);
#pragma unroll
    for (int c = 0; c < 4; ++c) {
        TS_BEGIN(3);
        const size_t r0 = rg + (size_t)c * 64;
#pragma unroll
        for (int m = 0; m < 4; ++m) { v2u w; w.x = pk2(S[m][0], S[m][1]); w.y = pk2(S[m][2], S[m][3]); *(LAS v2u*)(ST + (16 * wave + fr) * GP + 16 * m + 4 * fq) = w; }
        float tot[8]; gla_build<true>(pre[c], lds, tid, wave, lane, tot);
        LDS_BARRIER();
        TS_END(3); TS_BEGIN(4);
        bf16x8 bq[2];
#pragma unroll
        for (int ks = 0; ks < 2; ++ks) bq[ks] = *(const LAS bf16x8*)(QT + (16 * ih + fr) * GP + 32 * ks + 8 * fq);
        f32x4 X[4];
#pragma unroll
        for (int jt = 0; jt < 4; ++jt) { X[jt] = (f32x4){0.f, 0.f, 0.f, 0.f};
            if (jt <= ih) {
#pragma unroll
                for (int ks = 0; ks < 2; ++ks) X[jt] = mfma16(*(const LAS bf16x8*)(KT + (16 * jt + fr) * GP + 32 * ks + 8 * fq), bq[ks], X[jt]);
#pragma unroll
                for (int r = 0; r < 4; ++r) if (16 * jt + 4 * fq + r > 16 * ih + fr) X[jt][r] = 0.f; } }
        bf16x8 xb[2];
#pragma unroll
        for (int k2 = 0; k2 < 2; ++k2) { v4u w; w.x = pk2(X[2 * k2][0], X[2 * k2][1]); w.y = pk2(X[2 * k2][2], X[2 * k2][3]); w.z = pk2(X[2 * k2 + 1][0], X[2 * k2 + 1][1]); w.w = pk2(X[2 * k2 + 1][2], X[2 * k2 + 1][3]); xb[k2] = __builtin_bit_cast(bf16x8, w); }
        f32x4 O[4]; float ss = 0.f;
#pragma unroll
        for (int mt = 0; mt < 4; ++mt) { const int v = 64 * vh + 16 * mt + fr; f32x4 o = (f32x4){0.f, 0.f, 0.f, 0.f};
#pragma unroll
            for (int k2 = 0; k2 < 2; ++k2) { const v2u lo = *(const LAS v2u*)(VT + v * GP + 32 * k2 + 4 * fq), hi = *(const LAS v2u*)(VT + v * GP + 32 * k2 + 16 + 4 * fq); v4u a; a.x = lo.x; a.y = lo.y; a.z = hi.x; a.w = hi.y;
                o = mfma16(__builtin_bit_cast(bf16x8, a), xb[k2], o); }
#pragma unroll
            for (int ks = 0; ks < 2; ++ks) o = mfma16(*(const LAS bf16x8*)(ST + v * GP + 32 * ks + 8 * fq), bq[ks], o);
            O[mt] = o; ss += (o[0] * o[0] + o[1] * o[1]) + (o[2] * o[2] + o[3] * o[3]); }
        ss += __shfl_xor(ss, 16); ss += __shfl_xor(ss, 32);
        if (fq == 0) RED[(vh * 4 + ih) * 16 + fr] = ss;
        gla_state_step(S, lds, wave, fr, fq);
        LDS_BARRIER();
        TS_END(4); TS_BEGIN(5);
        const float rs = rsqrtf((RED[ih * 16 + fr] + RED[(4 + ih) * 16 + fr]) * (1.f / 128.f) + EPS);
        { const size_t row = r0 + 16 * ih + fr;
#pragma unroll
          for (int mt = 0; mt < 4; ++mt) { v2u o;
              o.x = pk2(O[mt][0] * rs * bf2f(gt[c][mt].x & 0xffffu), O[mt][1] * rs * bf2f(gt[c][mt].x >> 16)); o.y = pk2(O[mt][2] * rs * bf2f(gt[c][mt].y & 0xffffu), O[mt][3] * rs * bf2f(gt[c][mt].y >> 16));
              *(v2u*)(ZAO + row * ZPITCH + h * 128 + 64 * vh + 16 * mt + 4 * fq) = o; } }
        TS_END(5);
    }
    LDS_BARRIER();
    TS_END(1);
}
__device__ __forceinline__ void ffn_act_item(int idx, const bf16* HUP, bf16* ACT, const float* cw, const float* cb) {
    const int cgp = idx % 352, rb = idx / 352, pn = cgp >> 4, c8 = (cgp & 15) * 8, j0 = 128 * pn + c8, r0 = rb * 16;
    float wg[3][8], wv[3][8], bg[8], bv[8];
#pragma unroll
    for (int e = 0; e < 8; ++e) { bg[e] = cb[j0 + e]; bv[e] = cb[DFF + j0 + e];
#pragma unroll
        for (int k = 0; k < 3; ++k) { wg[k][e] = cw[k * DFF2 + j0 + e]; wv[k][e] = cw[k * DFF2 + DFF + j0 + e]; } }
    float g2[8], g1[8], v2[8], v1[8];
    auto ld = [&](int row, float (&g)[8], float (&v)[8]) { const bf16* p = HUP + (size_t)row * DFF2 + 256 * pn + c8; const v4u a = *(const v4u*)p, b = *(const v4u*)(p + 128);
#pragma unroll
        for (int e = 0; e < 4; ++e) { g[2 * e] = bf2f(a[e] & 0xffffu); g[2 * e + 1] = bf2f(a[e] >> 16); v[2 * e] = bf2f(b[e] & 0xffffu); v[2 * e + 1] = bf2f(b[e] >> 16); } };
    if ((r0 & (SEQ - 1)) == 0) {
#pragma unroll
        for (int e = 0; e < 8; ++e) { g2[e] = 0.f; g1[e] = 0.f; v2[e] = 0.f; v1[e] = 0.f; } }
    else { ld(r0 - 2, g2, v2); ld(r0 - 1, g1, v1); }
    for (int i = 0; i < 16; ++i) { float g0[8], v0[8]; ld(r0 + i, g0, v0); float z[8];
#pragma unroll
        for (int e = 0; e < 8; ++e) { const float ga = wg[0][e] * g2[e] + wg[1][e] * g1[e] + wg[2][e] * g0[e] + bg[e], va = wv[0][e] * v2[e] + wv[1][e] * v1[e] + wv[2][e] * v0[e] + bv[e];
            z[e] = fsilu(ga) * va; g2[e] = g1[e]; g1[e] = g0[e]; v2[e] = v1[e]; v1[e] = v0[e]; }
        v4u o; o.x = pk2(z[0], z[1]); o.y = pk2(z[2], z[3]); o.z = pk2(z[4], z[5]); o.w = pk2(z[6], z[7]); *(v4u*)(ACT + (size_t)(r0 + i) * DFF + j0) = o; }
}

using pg8::Unit;
__device__ __forceinline__ void row_rstd(const float* SSQ, int pm, int wr, int fr, int fq, float (&rsd)[2][4]) {
    const int lane = fr + 16 * fq;
#pragma unroll
    for (int ai = 0; ai < 2; ++ai) { const size_t row = (size_t)pm * 256 + ai * 128 + wr * 64 + lane; const f32x4* p = (const f32x4*)(SSQ + row * 16); const f32x4 a = p[0], b = p[1], c = p[2], d = p[3];
        const float s = ((a[0] + a[1]) + (a[2] + a[3])) + ((b[0] + b[1]) + (b[2] + b[3])) + ((c[0] + c[1]) + (c[2] + c[3])) + ((d[0] + d[1]) + (d[2] + d[3]));
        const float rs = rsqrtf(s * (1.f / D) + EPS);
#pragma unroll
        for (int m = 0; m < 4; ++m) rsd[ai][m] = __shfl(rs, 16 * m + fr); }
}
__device__ __forceinline__ void rstd_table_fill(const float* SSQ, int g8, LAS unsigned char* lds, int tid) {
    LAS float* T = (LAS float*)(lds + RST_OFF);
#pragma unroll
    for (int i = 0; i < 4; ++i) { const int r = tid + i * NTHREADS; const f32x4* p = (const f32x4*)(SSQ + ((size_t)g8 * 2048 + r) * 16); const f32x4 a = p[0], b = p[1], c = p[2], d = p[3];
        const float s = ((a[0] + a[1]) + (a[2] + a[3])) + ((b[0] + b[1]) + (b[2] + b[3])) + ((c[0] + c[1]) + (c[2] + c[3])) + ((d[0] + d[1]) + (d[2] + d[3]));
        T[r] = rsqrtf(s * (1.f / D) + EPS); }
    LDS_BARRIER();
}
__device__ __forceinline__ void row_rstd_tbl(const LAS unsigned char* lds, int pm, int wr, int fr, float (&rsd)[2][4]) {
    const LAS float* T = (const LAS float*)(lds + RST_OFF) + (pm & 7) * 256 + wr * 64 + fr;
#pragma unroll
    for (int ai = 0; ai < 2; ++ai)
#pragma unroll
        for (int m = 0; m < 4; ++m) rsd[ai][m] = T[ai * 128 + m * 16];
}
struct EpiA {
    static constexpr bool PERM = true, AFTER_DRAIN = false, MIDHOOK = false; static constexpr int TSID = 21;
    unsigned char* act0; const float* SSQ; float* SVST; const float* bal; LAS unsigned char* lds; bool tbl;
    __device__ __forceinline__ void operator()(const f32x4 (&acc)[2][2][4][2], const Unit& u, int wr, int wc, int fr_, int fq_) const {
        int ln_; asm volatile("v_mbcnt_lo_u32_b32 %0, -1, 0\n\tv_mbcnt_hi_u32_b32 %0, -1, %0" : "=v"(ln_)); const int fr = ln_ & 15, fq = ln_ >> 4; (void)fr_; (void)fq_;
        float rsd[2][4]; if (tbl) row_rstd_tbl(lds, u.pm, wr, fr, rsd); else row_rstd(SSQ, u.pm, wr, fr, fq, rsd);
        const int pn = u.pn; int mode, ldc, colt; size_t boff;
        if (pn < 1) { mode = 0; boff = A_Q; ldc = 256; colt = 0; } else if (pn < 2) { mode = 0; boff = A_K; ldc = 256; colt = 0; } else if (pn < 4) { mode = 0; boff = A_V; ldc = 512; colt = (pn - 2) * 256; }
        else if (pn < 6) { mode = 1; boff = A_Z; ldc = ZPITCH; colt = (pn - 4) * 256; } else if (pn < 7) { mode = 4; boff = A_LOGA; ldc = 256; colt = 0; }
        else if (pn < 9) { mode = 2; boff = A_Z; ldc = ZPITCH; colt = 512 + (pn - 7) * 256; } else if (pn < 11) { mode = 3; boff = A_SV; ldc = 512; colt = (pn - 9) * 256; }
        else if (pn < 13) { mode = 0; boff = A_Z; ldc = ZPITCH; colt = 1024 + (pn - 11) * 256; } else if (pn < 15) { mode = 0; boff = A_CC; ldc = 512; colt = (pn - 13) * 256; }
        else if (pn < 17) { mode = 0; boff = A_CX; ldc = 512; colt = (pn - 15) * 256; } else { mode = 5; boff = A_G; ldc = 3072; colt = (pn - 17) * 256; }
        const int col0 = colt + wc * 32 + 8 * fq;
#pragma unroll
        for (int ai = 0; ai < 2; ++ai)
#pragma unroll
            for (int m = 0; m < 4; ++m) { const size_t row = (size_t)u.pm * 256 + ai * 128 + wr * 64 + m * 16 + fr; const float rs = rsd[ai][m]; float s1 = 0.f, s2 = 0.f;
#pragma unroll
                for (int bj = 0; bj < 2; ++bj) { const f32x4 a0 = acc[ai][bj][m][0] * rs, a1 = acc[ai][bj][m][1] * rs; float v[8] = {a0[0], a0[1], a0[2], a0[3], a1[0], a1[1], a1[2], a1[3]};
                    if (mode == 4) { const f32x4 b0 = *(const f32x4*)(bal + col0 + bj * 128), b1 = *(const f32x4*)(bal + col0 + bj * 128 + 4); f32x4 o0, o1;
#pragma unroll
                        for (int e = 0; e < 4; ++e) { o0[e] = flogsig(v[e] + b0[e]) * 0.0625f; o1[e] = flogsig(v[4 + e] + b1[e]) * 0.0625f; }
                        float* p = (float*)(act0 + boff) + row * 256 + col0 + bj * 128; *(f32x4*)p = o0; *(f32x4*)(p + 4) = o1; }
                    else {
                        if (mode == 1) {
#pragma unroll
                            for (int e = 0; e < 8; ++e) v[e] = fsilu(v[e]); }
                        else if (mode == 2 || mode == 3) {
#pragma unroll
                            for (int e = 0; e < 8; ++e) v[e] = fgelu(v[e]); }
                        else if (mode == 5) {
#pragma unroll
                            for (int e = 0; e < 8; ++e) v[e] = fsigmoid(v[e]); }
                        if (mode == 3) {
#pragma unroll
                            for (int e = 0; e < 8; ++e) { s1 += v[e]; s2 += v[e] * v[e]; } }
                        v4u o; o.x = pk2(v[0], v[1]); o.y = pk2(v[2], v[3]); o.z = pk2(v[4], v[5]); o.w = pk2(v[6], v[7]);
                        *(v4u*)((bf16*)(act0 + boff) + row * ldc + col0 + bj * 128) = o; } }
                if (mode == 3) { s1 += __shfl_xor(s1, 16); s1 += __shfl_xor(s1, 32); s2 += __shfl_xor(s2, 16); s2 += __shfl_xor(s2, 32);
                    if (fq == 0) *(f32x2*)(SVST + row * 16 + ((pn - 9) * 4 + wc) * 2) = (f32x2){s1, s2}; } }
    }
};
struct EpiC {
    static constexpr bool PERM = true, AFTER_DRAIN = false, MIDHOOK = true; static constexpr int TSID = 23, HOOK_T1 = 8, HOOK_T2 = 16;
    const bf16* G; bf16* MG;
    __device__ __forceinline__ void mid(f32x4 (&acc)[2][2][4][2], const Unit& u, int t, int wr, int wc) const {
        int ln_; asm volatile("v_mbcnt_lo_u32_b32 %0, -1, 0\n\tv_mbcnt_hi_u32_b32 %0, -1, %0" : "=v"(ln_)); const int fr = ln_ & 15, fq = ln_ >> 4;
        const int br = t >> 3;
        const int col0 = u.pn * 256 + wc * 32 + 8 * fq;
        v4u ga[2][2][2], gb[2][2][2];
#define EPIC_LD(slot, q) do { _Pragma("unroll") for (int mm = 0; mm < 2; ++mm) _Pragma("unroll") for (int bj = 0; bj < 2; ++bj) { \
            const size_t row = (size_t)u.pm * 256 + ((q) >> 1) * 128 + wr * 64 + (2 * ((q) & 1) + mm) * 16 + fr; const bf16* gp = G + row * 3072 + (br - 1) * 1024 + col0 + bj * 128; \
            ga[slot][mm][bj] = *(const v4u*)gp; gb[slot][mm][bj] = *(const v4u*)(gp + 1024); } } while (0)
#define EPIC_SC(slot, q) do { _Pragma("unroll") for (int mm = 0; mm < 2; ++mm) _Pragma("unroll") for (int bj = 0; bj < 2; ++bj) { const int ai = (q) >> 1, m = 2 * ((q) & 1) + mm; \
            _Pragma("unroll") for (int e = 0; e < 4; ++e) { const float r0 = bf2f(ga[slot][mm][bj][e] & 0xffffu) * __builtin_amdgcn_rcpf(fmaxf(bf2f(gb[slot][mm][bj][e] & 0xffffu), 1e-20f)), \
                r1 = bf2f(ga[slot][mm][bj][e] >> 16) * __builtin_amdgcn_rcpf(fmaxf(bf2f(gb[slot][mm][bj][e] >> 16), 1e-20f)); \
                acc[ai][bj][m][e >> 1][(2 * e) & 3] *= r0; acc[ai][bj][m][e >> 1][(2 * e + 1) & 3] *= r1; } } } while (0)
        EPIC_LD(0, 0); EPIC_LD(1, 1); EPIC_SC(0, 0); EPIC_LD(0, 2); EPIC_SC(1, 1); EPIC_LD(1, 3); EPIC_SC(0, 2); EPIC_SC(1, 3);
#undef EPIC_LD
#undef EPIC_SC
    }
    __device__ __forceinline__ void operator()(const f32x4 (&acc)[2][2][4][2], const Unit& u, int wr, int wc, int fr_, int fq_) const {
        int ln_; asm volatile("v_mbcnt_lo_u32_b32 %0, -1, 0\n\tv_mbcnt_hi_u32_b32 %0, -1, %0" : "=v"(ln_)); const int fr = ln_ & 15, fq = ln_ >> 4; (void)fr_; (void)fq_;
        const int col0 = u.pn * 256 + wc * 32 + 8 * fq;
        v4u gt[2][4][2];
#pragma unroll
        for (int ai = 0; ai < 2; ++ai)
#pragma unroll
            for (int m = 0; m < 4; ++m)
#pragma unroll
                for (int bj = 0; bj < 2; ++bj) gt[ai][m][bj] = *(const v4u*)(G + ((size_t)u.pm * 256 + ai * 128 + wr * 64 + m * 16 + fr) * 3072 + 2048 + col0 + bj * 128);
#pragma unroll
        for (int ai = 0; ai < 2; ++ai)
#pragma unroll
            for (int m = 0; m < 4; ++m) { const size_t row = (size_t)u.pm * 256 + ai * 128 + wr * 64 + m * 16 + fr;
#pragma unroll
                for (int bj = 0; bj < 2; ++bj) { const f32x4 a0 = acc[ai][bj][m][0], a1 = acc[ai][bj][m][1]; float v[8] = {a0[0], a0[1], a0[2], a0[3], a1[0], a1[1], a1[2], a1[3]};
#pragma unroll
                    for (int e = 0; e < 4; ++e) { v[2 * e] *= bf2f(gt[ai][m][bj][e] & 0xffffu); v[2 * e + 1] *= bf2f(gt[ai][m][bj][e] >> 16); }
                    v4u o; o.x = pk2(v[0], v[1]); o.y = pk2(v[2], v[3]); o.z = pk2(v[4], v[5]); o.w = pk2(v[6], v[7]); *(v4u*)(MG + row * 1024 + col0 + bj * 128) = o; } }
    }
};
template <int VAR> struct EpiResT {
    static constexpr bool PERM = true, AFTER_DRAIN = false, MIDHOOK = false; static constexpr int TSID = 24;
    const bf16* XI; bf16* XB; float* SSQ;
    __device__ __forceinline__ void operator()(const f32x4 (&acc)[2][2][4][2], const Unit& u, int wr, int wc, int fr_, int fq_) const {
        int ln_; asm volatile("v_mbcnt_lo_u32_b32 %0, -1, 0\n\tv_mbcnt_hi_u32_b32 %0, -1, %0" : "=v"(ln_)); const int fr = ln_ & 15, fq = ln_ >> 4; (void)fr_; (void)fq_;
        const int col0 = u.pn * 256 + wc * 32 + 8 * fq;
        v4u xo[2][4][2];
#pragma unroll
        for (int ai = 0; ai < 2; ++ai)
#pragma unroll
            for (int m = 0; m < 4; ++m)
#pragma unroll
                for (int bj = 0; bj < 2; ++bj) xo[ai][m][bj] = *(const v4u*)(XI + ((size_t)u.pm * 256 + ai * 128 + wr * 64 + m * 16 + fr) * D + col0 + bj * 128);
#pragma unroll
        for (int ai = 0; ai < 2; ++ai)
#pragma unroll
            for (int m = 0; m < 4; ++m) { const size_t row = (size_t)u.pm * 256 + ai * 128 + wr * 64 + m * 16 + fr; float ss = 0.f;
#pragma unroll
                for (int bj = 0; bj < 2; ++bj) { const size_t off = row * D + col0 + bj * 128; const f32x4 a0 = acc[ai][bj][m][0], a1 = acc[ai][bj][m][1];
                    float v[8] = {a0[0], a0[1], a0[2], a0[3], a1[0], a1[1], a1[2], a1[3]};
#pragma unroll
                    for (int e = 0; e < 4; ++e) { v[2 * e] += bf2f(xo[ai][m][bj][e] & 0xffffu); v[2 * e + 1] += bf2f(xo[ai][m][bj][e] >> 16); }
#pragma unroll
                    for (int e = 0; e < 8; ++e) ss += v[e] * v[e];
                    v4u o; o.x = pk2(v[0], v[1]); o.y = pk2(v[2], v[3]); o.z = pk2(v[4], v[5]); o.w = pk2(v[6], v[7]); if (VAR != 1 || ss == 12345.678f) *(v4u*)(XB + off) = o; }
                if (VAR == 0) { ss += __shfl_xor(ss, 16); ss += __shfl_xor(ss, 32);
                if (fq == 0) SSQ[row * 16 + u.pn * 4 + wc] = ss; } }
    }
};
typedef EpiResT<0> EpiRes;
struct EpiUp {
    static constexpr bool PERM = true, AFTER_DRAIN = false, MIDHOOK = false; static constexpr int TSID = 25;
    bf16* HUP; const float* SSQ;
    __device__ __forceinline__ void operator()(const f32x4 (&acc)[2][2][4][2], const Unit& u, int wr, int wc, int fr_, int fq_) const {
        int ln_; asm volatile("v_mbcnt_lo_u32_b32 %0, -1, 0\n\tv_mbcnt_hi_u32_b32 %0, -1, %0" : "=v"(ln_)); const int fr = ln_ & 15, fq = ln_ >> 4; (void)fr_; (void)fq_;
        float rsd[2][4]; row_rstd(SSQ, u.pm, wr, fr, fq, rsd);
        const int col0 = u.pn * 256 + wc * 32 + 8 * fq;
#pragma unroll
        for (int ai = 0; ai < 2; ++ai)
#pragma unroll
            for (int m = 0; m < 4; ++m) { const size_t row = (size_t)u.pm * 256 + ai * 128 + wr * 64 + m * 16 + fr; const float rs = rsd[ai][m];
#pragma unroll
                for (int bj = 0; bj < 2; ++bj) { const f32x4 a0 = acc[ai][bj][m][0] * rs, a1 = acc[ai][bj][m][1] * rs;
                    v4u o; o.x = pk2(a0[0], a0[1]); o.y = pk2(a0[2], a0[3]); o.z = pk2(a1[0], a1[1]); o.w = pk2(a1[2], a1[3]); *(v4u*)(HUP + row * DFF2 + col0 + bj * 128) = o; } }
    }
};

__device__ __forceinline__ float dpp_f(float old, float src, const int ctrl_sel) {
    const int o = __builtin_bit_cast(int, old), v = __builtin_bit_cast(int, src); int r;
    if (ctrl_sel == 0) r = __builtin_amdgcn_update_dpp(o, v, 0x111, 0xf, 0xf, false);
    else if (ctrl_sel == 1) r = __builtin_amdgcn_update_dpp(o, v, 0x112, 0xf, 0xf, false);
    else if (ctrl_sel == 2) r = __builtin_amdgcn_update_dpp(o, v, 0x121, 0xf, 0xf, false);
    else r = __builtin_amdgcn_update_dpp(o, v, 0x122, 0xf, 0xf, false);
    return __builtin_bit_cast(float, r);
}
constexpr int XL_OFF = RING_BYTES + 1024;
struct EpiUpConv {
    static constexpr bool PERM = true, AFTER_DRAIN = false, MIDHOOK = false; static constexpr int TSID = 22;
    unsigned char* ws; const float* cw; const float* cb; LAS unsigned char* lds; bool tbl;
    __device__ __forceinline__ void operator()(const f32x4 (&acc)[2][2][4][2], const Unit& u, int wr, int wc, int fr_, int fq_) const {
        int ln_; asm volatile("v_mbcnt_lo_u32_b32 %0, -1, 0\n\tv_mbcnt_hi_u32_b32 %0, -1, %0" : "=v"(ln_)); const int fr = ln_ & 15, fq = ln_ >> 4; (void)fr_; (void)fq_;
        bf16* ACT = (bf16*)(ws + WS_ACT0 + A_ACT); const float* SSQ = (const float*)(ws + WS_SSQ); float* HT = (float*)(ws + WS_ACT0 + A_HT);
        float rsd[2][4]; if (tbl) row_rstd_tbl(lds, u.pm, wr, fr, rsd); else row_rstd(SSQ, u.pm, wr, fr, fq, rsd);
        LAS f32x4* XL = (LAS f32x4*)(lds + XL_OFF);
        const int tcol = u.pn * 256 + wc * 32 + 8 * fq;
        const int ch0 = u.pn * 128 + wc * 32 + 8 * fq; const bool batch_start = (u.pm & 7) == 0;
        f32x4 wgp[3], wvp[3], bgp, bvp;
#pragma unroll
        for (int k = 0; k < 3; ++k) { wgp[k] = *(const f32x4*)(cw + k * DFF2 + ch0); wvp[k] = *(const f32x4*)(cw + k * DFF2 + DFF + ch0); }
        bgp = *(const f32x4*)(cb + ch0); bvp = *(const f32x4*)(cb + DFF + ch0);
#pragma unroll
        for (int ai = 0; ai < 2; ++ai)
#pragma unroll
            for (int bj = 0; bj < 2; ++bj)
#pragma unroll
                for (int n = 0; n < 2; ++n) {
                    if (fr >= 14) { const f32x4 h = acc[ai][bj][3][n] * rsd[ai][3]; XL[((((ai * 2 + wr) * 4 + wc) * 2 + bj) * 2 + n) * 8 + fq * 2 + (fr - 14)] = h;
                        if (ai == 1 && wr == 1) *(f32x4*)(HT + ((size_t)(u.pm * 2 + 1) * 2 + (fr - 14)) * DFF2 + tcol + bj * 128 + 4 * n) = h; }
                    if (ai == 0 && wr == 0 && fr < 2) *(f32x4*)(HT + ((size_t)(u.pm * 2 + 0) * 2 + fr) * DFF2 + tcol + bj * 128 + 4 * n) = acc[0][bj][0][n] * rsd[0][0]; }
        asm volatile("s_waitcnt lgkmcnt(0)" ::: "memory"); __builtin_amdgcn_s_barrier(); asm volatile("" ::: "memory");
#pragma unroll
        for (int n = 0; n < 2; ++n) {
            asm volatile("" ::: "memory");
            f32x4 wg[3], wv[3], bg, bv;
            if (n == 0) {
#pragma unroll
                for (int k = 0; k < 3; ++k) { wg[k] = wgp[k]; wv[k] = wvp[k]; }
                bg = bgp; bv = bvp; }
            else {
#pragma unroll
                for (int k = 0; k < 3; ++k) { wg[k] = *(const f32x4*)(cw + k * DFF2 + ch0 + 4); wv[k] = *(const f32x4*)(cw + k * DFF2 + DFF + ch0 + 4); }
                bg = *(const f32x4*)(cb + ch0 + 4); bv = *(const f32x4*)(cb + DFF + ch0 + 4); }
#pragma unroll
            for (int ai = 0; ai < 2; ++ai) {
                f32x4 hgp, hvp;
                { f32x4 pg14 = (f32x4){0.f, 0.f, 0.f, 0.f}, pg15 = pg14, pv14 = pg14, pv15 = pg14;
                  if (!(ai == 0 && wr == 0)) { const int pb = ai * 2 + wr - 1; const LAS f32x4* q = XL + ((((pb * 4 + wc) * 2 + 0) * 2 + n) * 8 + fq * 2); const LAS f32x4* qv = XL + ((((pb * 4 + wc) * 2 + 1) * 2 + n) * 8 + fq * 2);
                      pg14 = q[0]; pg15 = q[1]; pv14 = qv[0]; pv15 = qv[1]; }
                  hgp = (fr == 14) ? pg14 : pg15; hvp = (fr == 14) ? pv14 : pv15; }
#pragma unroll
                for (int m = 0; m < 4; ++m) { const f32x4 hg = acc[ai][0][m][n] * rsd[ai][m], hv = acc[ai][1][m][n] * rsd[ai][m]; f32x4 z;
#pragma unroll
                    for (int e = 0; e < 4; ++e) {
                        const float g1 = dpp_f(dpp_f(0.f, hgp[e], 2), hg[e], 0), g2 = dpp_f(dpp_f(0.f, hgp[e], 3), hg[e], 1);
                        const float v1 = dpp_f(dpp_f(0.f, hvp[e], 2), hv[e], 0), v2 = dpp_f(dpp_f(0.f, hvp[e], 3), hv[e], 1);
                        const float ga = wg[0][e] * g2 + wg[1][e] * g1 + wg[2][e] * hg[e] + bg[e], va = wv[0][e] * v2 + wv[1][e] * v1 + wv[2][e] * hv[e] + bv[e];
                        z[e] = fsilu(ga) * va; }
                    const size_t row = (size_t)u.pm * 256 + ai * 128 + wr * 64 + m * 16 + fr;
                    const bool skip = (ai == 0 && wr == 0 && m == 0 && fr < 2 && !batch_start);
                    if (!skip) { v2u o; o.x = pk2(z[0], z[1]); o.y = pk2(z[2], z[3]); *(v2u*)(ACT + row * DFF + ch0 + 4 * n) = o; }
                    hgp = hg; hvp = hv; } } }
    }
};
__device__ __forceinline__ void ffn_fixup(int pm, const float* HT, bf16* ACT, const float* cw, const float* cb, int tid) {
    if ((pm & 7) == 0) return;
    for (int it = tid; it < 2 * (DFF / 4); it += NTHREADS) { const int rr = it / (DFF / 4), j = (it % (DFF / 4)) * 4, tc = (j >> 7) * 256 + (j & 127);
        const float* h0 = HT + ((size_t)(pm * 2 + 0) * 2 + rr) * DFF2;
        const float* h1 = rr ? HT + ((size_t)(pm * 2 + 0) * 2 + 0) * DFF2 : HT + ((size_t)((pm - 1) * 2 + 1) * 2 + 1) * DFF2;
        const float* h2 = rr ? HT + ((size_t)((pm - 1) * 2 + 1) * 2 + 1) * DFF2 : HT + ((size_t)((pm - 1) * 2 + 1) * 2 + 0) * DFF2;
        const f32x4 g0 = *(const f32x4*)(h0 + tc), g1 = *(const f32x4*)(h1 + tc), g2 = *(const f32x4*)(h2 + tc), v0 = *(const f32x4*)(h0 + tc + 128), v1 = *(const f32x4*)(h1 + tc + 128), v2 = *(const f32x4*)(h2 + tc + 128);
        const f32x4 ga = *(const f32x4*)(cw + j) * g2 + *(const f32x4*)(cw + DFF2 + j) * g1 + *(const f32x4*)(cw + 2 * DFF2 + j) * g0 + *(const f32x4*)(cb + j);
        const f32x4 va = *(const f32x4*)(cw + DFF + j) * v2 + *(const f32x4*)(cw + DFF2 + DFF + j) * v1 + *(const f32x4*)(cw + 2 * DFF2 + DFF + j) * v0 + *(const f32x4*)(cb + DFF + j);
        v2u o; o.x = pk2(fsilu(ga[0]) * va[0], fsilu(ga[1]) * va[1]); o.y = pk2(fsilu(ga[2]) * va[2], fsilu(ga[3]) * va[3]);
        *(v2u*)(ACT + ((size_t)pm * 256 + rr) * DFF + j) = o; }
    asm volatile("s_waitcnt vmcnt(0)" ::: "memory"); __syncthreads();
}

template <bool P> struct EpiNull {
    static constexpr bool PERM = P, AFTER_DRAIN = false, MIDHOOK = false; static constexpr int TSID = 26; float* sink;
    __device__ __forceinline__ void operator()(const f32x4 (&acc)[2][2][4][2], const Unit& u, int wr, int wc, int fr, int fq) const {
        f32x4 s = (f32x4){0.f, 0.f, 0.f, 0.f};
#pragma unroll
        for (int ai = 0; ai < 2; ++ai)
#pragma unroll
            for (int bj = 0; bj < 2; ++bj)
#pragma unroll
                for (int m = 0; m < 4; ++m)
#pragma unroll
                    for (int n = 0; n < 2; ++n) s += acc[ai][bj][m][n];
        if (s[0] + s[1] + s[2] + s[3] == 12345.678f) sink[u.pm + wr + wc + fr + fq] = s[0];
    }
};
#define XB_TMO      128
#define XB_XCNT(j)  (256  + 64 * (j))
#define XB_XSUB(j)  (1280 + 64 * (j))
#define XB_XGEN(j)  (2304 + 64 * (j))
#define XB_TOP      3328
#define XB_TOPGEN   3392
#define XCD_BAR_WORDS 3456
#define XB_SPIN_CAP (1u << 18)

__device__ __forceinline__ unsigned xb_ld(unsigned* p)              { return __hip_atomic_load(p, __ATOMIC_RELAXED, __HIP_MEMORY_SCOPE_AGENT); }
__device__ __forceinline__ unsigned xb_add(unsigned* p, unsigned v) { return __hip_atomic_fetch_add(p, v, __ATOMIC_RELAXED, __HIP_MEMORY_SCOPE_AGENT); }
__device__ __forceinline__ unsigned xb_xcc_id() { return (unsigned)__builtin_amdgcn_s_getreg((3 << 11) | 20) & 0xFu; }
#define XB_SPIN(cond, bar) do { unsigned _sp = 0; while (cond) { __builtin_amdgcn_s_sleep(1); \
    if ((++_sp & 255u) == 0u) { if (xb_ld(&(bar)[XB_TMO])) break; if (_sp > XB_SPIN_CAP) { atomicAdd(&(bar)[XB_TMO], 1u); break; } } } } while (0)

struct XcdBarrier {
    unsigned* bar; unsigned x;
    volatile LAS unsigned* st;
};

__device__ __forceinline__ XcdBarrier xcd_barrier_post(unsigned* bar, volatile LAS unsigned* st) {
    XcdBarrier b; b.bar = bar; b.x = xb_xcc_id(); b.st = st;
    if (threadIdx.x == 0) st[2] = xb_add(&bar[XB_XCNT(b.x)], 1u);
    return b;
}
__device__ __forceinline__ void xcd_barrier_complete(unsigned* bar, unsigned x, unsigned& nloc, unsigned& nx) {
    const unsigned G = gridDim.x * gridDim.y * gridDim.z;
    unsigned sum, cnt, mine, sp = 0u;
    for (;;) {
        sum = 0u; cnt = 0u; mine = 0u;
#pragma unroll
        for (unsigned j = 0; j < 16; ++j) { const unsigned c = xb_ld(&bar[XB_XCNT(j)]); sum += c; cnt += (c > 0u) ? 1u : 0u; mine = (j == x) ? c : mine; }
        if (sum == G) break;
        __builtin_amdgcn_s_sleep(1);
        if ((++sp & 255u) == 0u) { if (xb_ld(&bar[XB_TMO])) break; if (sp > XB_SPIN_CAP) { atomicAdd(&bar[XB_TMO], 1u); break; } }
    }
    nloc = mine > 0u ? mine : 1u; nx = cnt > 0u ? cnt : 1u;
}

__device__ __forceinline__ void xcd_barrier(const XcdBarrier& b) {
    asm volatile("s_waitcnt vmcnt(0)" ::: "memory");
    __syncthreads();
    if (threadIdx.x == 0) {
        unsigned* bar = b.bar;
        __builtin_amdgcn_s_waitcnt(0);
        unsigned nloc = b.st[0], nx = b.st[1];
        if (nloc == 0u) { xcd_barrier_complete(bar, b.x, nloc, nx); b.st[0] = nloc; b.st[1] = nx; }
        const unsigned old = xb_add(&bar[XB_XSUB(b.x)], 1u);
        const unsigned gen = old / nloc;
        if (old + 1u == (gen + 1u) * nloc) {
            __builtin_amdgcn_fence(__ATOMIC_RELEASE, "agent");
            asm volatile("s_waitcnt vmcnt(0)" ::: "memory");
            const unsigned og = xb_add(&bar[XB_TOP], 1u);
            const unsigned tg = og / nx;
            if (og + 1u == (tg + 1u) * nx) xb_add(&bar[XB_TOPGEN], 1u);
            else XB_SPIN(xb_ld(&bar[XB_TOPGEN]) == tg, bar);
            __builtin_amdgcn_fence(__ATOMIC_ACQUIRE, "agent");
            xb_add(&bar[XB_XGEN(b.x)], 1u);
            asm volatile("s_waitcnt vmcnt(0)" ::: "memory");
        } else {
            XB_SPIN(xb_ld(&bar[XB_XGEN(b.x)]) == gen, bar);
            __builtin_amdgcn_fence(__ATOMIC_ACQUIRE, "agent");
            asm volatile("s_waitcnt vmcnt(0)" ::: "memory");
        }
    }
    __syncthreads();
}

__device__ __forceinline__ void xcd_barrier_local(const XcdBarrier& b) {
    asm volatile("s_waitcnt vmcnt(0)" ::: "memory");
    __syncthreads();
    if (threadIdx.x == 0) {
        unsigned* bar = b.bar;
        __builtin_amdgcn_s_waitcnt(0);
        const unsigned nloc = b.st[0];
        const unsigned old = xb_add(&bar[XB_XSUB(b.x)], 1u);
        const unsigned gen = old / nloc;
        if (old + 1u == (gen + 1u) * nloc) xb_add(&bar[XB_XGEN(b.x)], 1u);
        else XB_SPIN(xb_ld(&bar[XB_XGEN(b.x)]) == gen, bar);
        __builtin_amdgcn_fence(__ATOMIC_ACQUIRE, "agent");
        asm volatile("s_waitcnt vmcnt(0)" ::: "memory");
    }
    __syncthreads();
}

#ifndef PROBE
#define PROBE 0
#endif
struct Args { Inputs in; float* out; unsigned char* ws; int ph_lo, ph_hi; };
constexpr int NPHASE = 2 + 7 * DEPTH;
#define LAUNDER_S(p) asm volatile("" : "+s"(p))
#define LAUNDER_V(p) asm volatile("" : "+v"(p))
struct Ctx { unsigned char* ws; unsigned char* act0; float* X; int tid, lane, wave, G, bx, gw, ngw; };
#define BST_OFF (RING_BYTES + 512)
__device__ __forceinline__ Ctx make_ctx(const Args& a, int wave_id, LAS unsigned char* ldsb) {
    Ctx c; size_t z = 0; LAUNDER_S(z); c.ws = a.ws + z; c.X = (float*)((unsigned char*)a.out + z); c.act0 = c.ws + WS_ACT0;
    int ln; asm volatile("v_mbcnt_lo_u32_b32 %0, -1, 0\n\tv_mbcnt_hi_u32_b32 %0, -1, %0" : "=v"(ln)); c.lane = ln; c.wave = wave_id; c.tid = wave_id * 64 + ln;
    c.G = gridDim.x; c.bx = __builtin_amdgcn_readfirstlane(((volatile LAS unsigned*)(ldsb + BST_OFF))[2]); c.gw = c.bx * NWAVES + c.wave; c.ngw = c.G * NWAVES; return c;
}
__device__ __forceinline__ unsigned char* slot_of(const Ctx& c, int l) { return c.ws + WS_SLOT0 + (size_t)(l & 1) * SL_BYTES; }
__device__ __forceinline__ unsigned* ctl_word(const Ctx& c, int w) { return (unsigned*)(c.ws + WS_CTL) + w; }
__device__ __forceinline__ void tail_convert(const Args& a, const Ctx& c, int l, int ph, bool drain, bool early, LAS unsigned char* lds) {
#if MK_ONE_LAUNCH
    const unsigned xcc_ = xb_xcc_id(); const unsigned nloc_ = ((volatile LAS unsigned*)(lds + BST_OFF))[0];
    unsigned* fin = ctl_word(c, CW_FIN + (ph * 8 + (int)(xcc_ & 7u)) * 16);
    if (c.tid == 0) __hip_atomic_fetch_add(fin, 1u, RLX_AGENT);
    if (l + 1 < DEPTH && (drain || early)) convert_queue(a.in, l + 1, slot_of(c, l + 1), lds, ctl_word(c, CW_QHEAD + 64 * (l + 1)), 0, CV_ITEMS, drain ? nullptr : fin, (int)nloc_, c.tid, c.wave, c.lane);
#else
    if (l + 1 < DEPTH && drain) convert_static(a.in, l + 1, slot_of(c, l + 1), lds, 0, CV_ITEMS, c.gw, c.ngw, c.wave, c.lane);
#endif
}
__device__ __forceinline__ void ph_p0(const Args& a, const int wv, LAS unsigned char* lds) { const Ctx c = make_ctx(a, wv, lds);
    convert_static(a.in, 0, c.ws + WS_SLOT0, lds, 0, CV_ITEMS, c.gw, c.ngw, c.wave, c.lane); x_prep(a.in.p[0], (bf16*)(c.ws + WS_XB), (float*)(c.ws + WS_SSQ), c.gw, c.ngw, c.lane); }
constexpr int B1_NGLA = 28, B1_NSGU = 64, B1_NCONV = 32, B1_ITEMS = B1_NGLA + B1_NSGU + B1_NCONV;
__device__ __forceinline__ void b1_item(const Args& a, const Ctx& c, int l, int b, int it, LAS unsigned char* lds) {
    const Inputs& I = a.in; bf16* Zb = (bf16*)(c.act0 + A_Z);
    if (it < B1_NGLA) { const int h = it / 7, g = it % 7;
        gla_b1_item(b + 8 * g + 64 * h, lds, (const bf16*)(c.act0 + A_K), (const bf16*)(c.act0 + A_V), (const float*)(c.act0 + A_LOGA), (float*)(c.act0 + A_CST), (float*)(c.act0 + A_DEC), c.tid, c.wave, c.lane); }
    else if (it < B1_NGLA + B1_NSGU) { const int j = it - B1_NGLA;
        sgu_item(b + 8 * j, lds, Zb + 512, Zb + 512, (const bf16*)(c.act0 + A_SV), (const float*)(c.ws + WS_SVST), I.p[7] + (size_t)l * SGW, I.p[8] + (size_t)l * SGW, (const bf16*)(slot_of(c, l) + SL_SGW), I.p[10] + (size_t)l * 512, c.wave, c.lane); }
    else { const int j = it - B1_NGLA - B1_NSGU; convbr_item((b + 8 * j) * NTHREADS + c.tid, Zb + 1024, Zb + 1024, (const bf16*)(c.act0 + A_CC), (const bf16*)(c.act0 + A_CX), I.p[12] + (size_t)l * 3 * CW); }
}
struct OrderA : pg8::StaticOrder {
    unsigned* cnt;
    __device__ __forceinline__ void done(const Unit& u) const {
        if (cnt && (u.pn >> 2) == 6) { asm volatile("s_waitcnt vmcnt(0)" ::: "memory");
            __hip_atomic_fetch_add(cnt, 1u, RLX_AGENT); } }
};
__device__ __forceinline__ void ph_a(const Args& a, const int wv, int l, int ph, LAS unsigned char* lds) { const Ctx c = make_ctx(a, wv, lds);
    const bool local_ok = ((volatile LAS unsigned*)(lds + BST_OFF))[3] != 0u; const unsigned xcc = xb_xcc_id() & 7u;
    unsigned* ab = ctl_word(c, CW_AB + (l * 8 + (int)xcc) * 32);
    pg8::Gemm g{(const bf16*)(c.ws + WS_XB), (const bf16*)(slot_of(c, l) + SL_WIN), M, NIN, D}; OrderA S; S.init(M, NIN, c.G, c.bx); S.cnt = local_ok ? ab : nullptr;
    const bool tbl = (c.G == 256); if (tbl) rstd_table_fill((const float*)(c.ws + WS_SSQ), c.bx & 7, lds, c.tid);
    EpiA E{c.act0, (const float*)(c.ws + WS_SSQ), (float*)(c.ws + WS_SVST), a.in.p[4] + (size_t)l * GKEY, lds, tbl};
    const int tid = c.tid; TS_BEGIN(61);
    pg8::gemm_phase<EpiA, OrderA, true, true>(lds, g, S, E, wv);
    TS_END(61);
    if (local_ok) {
        const Ctx c2 = make_ctx(a, wv, lds); volatile LAS unsigned* bc = (volatile LAS unsigned*)(lds + RING_BYTES + 768);
        const unsigned want = 512u * ((volatile LAS unsigned*)(lds + BST_OFF))[0];
        TS_BEGIN(62);
        if (c2.tid == 0) { unsigned sp = 0u; while (__hip_atomic_load(ab, RLX_AGENT) < want) { __builtin_amdgcn_s_sleep(2); if (++sp > (1u << 22)) { atomicAdd((unsigned*)(c2.ws + WS_CTL) + CW_BAR + XB_TMO, 1u); break; } }
            __builtin_amdgcn_fence(__ATOMIC_ACQUIRE, "agent"); asm volatile("s_waitcnt vmcnt(0)" ::: "memory"); }
        __syncthreads();
        TS_END(62); TS_BEGIN(63);
        unsigned nxt = 0u; if (c2.tid == 0) nxt = __hip_atomic_fetch_add(ab + 16, 1u, RLX_AGENT);
        for (;;) {
            if (c2.tid == 0) bc[0] = nxt;
            LDS_BARRIER();
            const unsigned it = bc[0];
            LDS_BARRIER();
            if (it >= (unsigned)B1_ITEMS) break;
            if (c2.tid == 0) nxt = __hip_atomic_fetch_add(ab + 16, 1u, RLX_AGENT);
            b1_item(a, c2, l, (int)xcc, (int)it, lds);
        }
        TS_END(63);
    }
}
__device__ __forceinline__ void ph_b1(const Args& a, const int wv, int l, LAS unsigned char* lds) { const Ctx c = make_ctx(a, wv, lds);
    if (((volatile LAS unsigned*)(lds + BST_OFF))[3] != 0u) return;
    for (int q = c.bx; q < 8 * B1_ITEMS; q += c.G) b1_item(a, c, l, q & 7, q >> 3, lds);
}
__device__ __forceinline__ void ph_b2(const Args& a, const int wv, int l, int ph, LAS unsigned char* lds) { const Ctx c = make_ctx(a, wv, lds);
    if (PROBE == 6) for (int it = c.bx; it < 256; it += c.G) gla_b2_unit(it, lds, (const bf16*)(c.act0 + A_Q), (const bf16*)(c.act0 + A_K), (const bf16*)(c.act0 + A_V), (const float*)(c.act0 + A_LOGA), (const float*)(c.act0 + A_CST), (const float*)(c.act0 + A_DEC), (const bf16*)(c.act0 + A_Z), (bf16*)(c.ws + WS_END), c.tid, c.wave, c.lane);
    for (int it = c.bx; it < 256; it += c.G) gla_b2_unit(it, lds, (const bf16*)(c.act0 + A_Q), (const bf16*)(c.act0 + A_K), (const bf16*)(c.act0 + A_V), (const float*)(c.act0 + A_LOGA), (const float*)(c.act0 + A_CST), (const float*)(c.act0 + A_DEC), (const bf16*)(c.act0 + A_Z), (bf16*)(c.act0 + A_Z), c.tid, c.wave, c.lane); }
__device__ __forceinline__ void ph_c(const Args& a, const int wv, int l, LAS unsigned char* lds) { const Ctx c = make_ctx(a, wv, lds);
    pg8::Gemm g{(const bf16*)(c.act0 + A_Z), (const bf16*)(slot_of(c, l) + SL_WBR), M, D, ZPITCH}; pg8::StaticOrder S; S.init(M, D, c.G, c.bx); EpiC E{(const bf16*)(c.act0 + A_G), (bf16*)(c.act0 + A_MERGED)};
    const int tid = c.tid; TS_BEGIN(51);
    for (int rep = 0; rep < 1 + (PROBE == 7); ++rep) pg8::gemm_phase<EpiC, pg8::StaticOrder, true, true>(lds, g, S, E, wv);
    TS_END(51); }
__device__ __forceinline__ void ph_res(const Args& a, const int wv, const bf16* A, const bf16* Bt, int K, int dup, int l, int ph, bool drain, LAS unsigned char* lds) { const Ctx c = make_ctx(a, wv, lds);
    pg8::Gemm g{A, Bt, M, D, K}; pg8::StaticOrder S; S.init(M, D, c.G, c.bx);
    if (dup == 2) { EpiNull<true> EN_{(float*)(c.ws + WS_END)}; pg8::gemm_phase<EpiNull<true>, pg8::StaticOrder, true, true>(lds, g, S, EN_, wv); }
    if (dup == 3) { EpiResT<1> E{(const bf16*)(c.ws + WS_XB), (bf16*)(c.ws + WS_END), (float*)(c.ws + WS_END + 32 * MiB)}; pg8::gemm_phase<EpiResT<1>, pg8::StaticOrder, true, true>(lds, g, S, E, wv); }
    if (dup == 4) { EpiResT<2> E{(const bf16*)(c.ws + WS_XB), (bf16*)(c.ws + WS_END), (float*)(c.ws + WS_END + 32 * MiB)}; pg8::gemm_phase<EpiResT<2>, pg8::StaticOrder, true, true>(lds, g, S, E, wv); }
    if (dup == 1) { EpiRes E{(const bf16*)(c.ws + WS_XB), (bf16*)(c.ws + WS_END), (float*)(c.ws + WS_END + 32 * MiB)}; pg8::gemm_phase<EpiRes, pg8::StaticOrder, true, true>(lds, g, S, E, wv); }
    if (drain) { pg8::Unit u0; for (int i = 0; S.next(i, u0); ++i) ffn_fixup(u0.pm, (const float*)(c.act0 + A_HT), (bf16*)(c.act0 + A_ACT), a.in.p[17] + (size_t)l * 3 * DFF2, a.in.p[18] + (size_t)l * DFF2, c.tid); }
    EpiRes E{(const bf16*)(c.ws + WS_XB), (bf16*)(c.ws + WS_XB), (float*)(c.ws + WS_SSQ)};
    pg8::gemm_phase<EpiRes, pg8::StaticOrder, true, true>(lds, g, S, E, wv);
    if (drain) { const Ctx c2 = make_ctx(a, wv, lds); tail_convert(a, c2, l, ph, true, true, lds); } }
__device__ __forceinline__ void ph_e(const Args& a, const int wv, int l, int ph, LAS unsigned char* lds) { const Ctx c = make_ctx(a, wv, lds);
    pg8::Gemm g{(const bf16*)(c.ws + WS_XB), (const bf16*)(slot_of(c, l) + SL_WUP), M, DFF2, D}; pg8::StaticOrder S; S.init(M, DFF2, c.G, c.bx);
    const bool tbl = (c.G == 256); if (tbl) rstd_table_fill((const float*)(c.ws + WS_SSQ), c.bx & 7, lds, c.tid);
    EpiUpConv E{c.ws, a.in.p[17] + (size_t)l * 3 * DFF2, a.in.p[18] + (size_t)l * DFF2, lds, tbl};
    for (int rep = 0; rep < 1 + (PROBE == 8); ++rep) pg8::gemm_phase<EpiUpConv, pg8::StaticOrder, true, true>(lds, g, S, E, wv);
    { const Ctx c2 = make_ctx(a, wv, lds); tail_convert(a, c2, l, ph, false, ((DFF2 / 256) * 64 - 1) / c2.G * c2.G + c2.bx >= (DFF2 / 256) * 64, lds); } }
__device__ __forceinline__ void ph_e2(const Args& a, const int wv, int l, LAS unsigned char* lds) { const Ctx c = make_ctx(a, wv, lds);
    for (int rep = 0; rep < 1 + (PROBE == 9); ++rep)
    for (int it = c.bx * NTHREADS + c.tid; it < 1024 * 352; it += c.G * NTHREADS) ffn_act_item(it, (const bf16*)(c.act0 + A_HUP), (bf16*)(c.act0 + A_ACT), a.in.p[17] + (size_t)l * 3 * DFF2, a.in.p[18] + (size_t)l * DFF2); }
__device__ __forceinline__ void ph_fin(const Args& a, const int wv, LAS unsigned char* lds) { const Ctx c = make_ctx(a, wv, lds); final_norm((const bf16*)(c.ws + WS_XB), c.X, (const float*)(c.ws + WS_SSQ), a.in.p[20], c.gw, c.ngw, c.lane); }

#ifndef PHMASK
#define PHMASK 0xFFFF
#endif
#define EN(b) ((PHMASK >> (b)) & 1)
__global__ void __launch_bounds__(NTHREADS, 2) mk_fwd(Args args) {
    extern __shared__ __attribute__((aligned(16))) unsigned char lds_raw[];
    LAS unsigned char* lds = (LAS unsigned char*)lds_raw;
    const int wv = __builtin_amdgcn_readfirstlane(threadIdx.x >> 6);
#ifdef TSUB
    if (threadIdx.x == 0) *TS_SLOT = 0ull;
#endif
    const int lo = args.ph_lo, hi = args.ph_hi;
#define IN(k) (lo <= (k) && (k) < hi)
#if MK_ONE_LAUNCH
    volatile LAS unsigned* bst = (volatile LAS unsigned*)(lds + BST_OFF);
    if (threadIdx.x < 4) bst[threadIdx.x] = 0u;
    __syncthreads();
    const XcdBarrier bar = xcd_barrier_post((unsigned*)(args.ws + WS_CTL) + CW_BAR, bst);
    __syncthreads();
    const unsigned my_rank = bst[2];
    __syncthreads();
    if (threadIdx.x == 0) bst[2] = blockIdx.x;
    __syncthreads();
#define SEAM_GLOBAL(k) (((k) % 7) == 0)
#define SEAM_IS_A(k) (((k) % 7) == 1)
#define SEAM(k) do { if (IN(k) && IN((k) + 1)) { \
        if ((k) == 0) { if (args.ph_hi < 0) cg::this_grid().sync();     \
            xcd_barrier(bar); \
            if (threadIdx.x == 0) { unsigned* bw = (unsigned*)(args.ws + WS_CTL) + CW_BAR; unsigned nloc_ = 1u, nx_ = 1u; xcd_barrier_complete(bw, bar.x, nloc_, nx_);     \
                bool u32 = (gridDim.x == 256u) && xb_ld(&bw[XB_TMO]) == 0u; \
                for (unsigned j = 0; j < 16; ++j) { const unsigned c_ = xb_ld(&bw[XB_XCNT(j)]); if (j < 8 ? c_ != 32u : c_ != 0u) u32 = false; } \
                bst[0] = nloc_; bst[1] = nx_; bst[3] = u32 ? 1u : 0u; bst[2] = u32 ? my_rank * 8u + bar.x : blockIdx.x; } \
            __syncthreads(); } \
        else if (SEAM_GLOBAL(k) || bst[3] == 0u) xcd_barrier(bar); else if (!SEAM_IS_A(k)) xcd_barrier_local(bar); } } while (0)
#else
#define SEAM(k) do { } while (0)
#endif
#ifdef TPROBE
    unsigned long long tp_acc = 0ull, tp_prev = __builtin_amdgcn_s_memrealtime();
#define TP_MARK(kind) do { const unsigned long long t_ = __builtin_amdgcn_s_memrealtime(); if ((kind) == TPROBE) tp_acc += t_ - tp_prev; tp_prev = t_; } while (0)
#else
#define TP_MARK(kind) do { } while (0)
#endif
    int ph = 0;
    if (EN(0) && IN(ph)) ph_p0(args, wv, lds);
    SEAM(ph); ++ph; TP_MARK(0);
    for (int l = 0; l < DEPTH; ++l) {
        if (EN(1) && IN(ph)) ph_a(args, wv, l, ph, lds);
        SEAM(ph); ++ph; TP_MARK(1);
        if (EN(2) && IN(ph)) ph_b1(args, wv, l, lds);
        SEAM(ph); ++ph; TP_MARK(2);
        if (EN(3) && IN(ph)) ph_b2(args, wv, l, ph, lds);
        SEAM(ph); ++ph; TP_MARK(3);
        if (EN(4) && IN(ph)) ph_c(args, wv, l, lds);
        SEAM(ph); ++ph; TP_MARK(4);
        if (EN(5) && IN(ph)) { size_t z = 0; LAUNDER_S(z); unsigned char* ws = args.ws + z; ph_res(args, wv, (const bf16*)(ws + WS_ACT0 + A_MERGED), (const bf16*)(ws + WS_SLOT0 + (size_t)(l & 1) * SL_BYTES + SL_WO), D, PROBE == 10 ? 1 : (PROBE == 22 ? 2 : (PROBE == 31 ? 3 : (PROBE == 32 ? 4 : 0))), l, ph, false, lds); }
        SEAM(ph); ++ph; TP_MARK(5);
        if (EN(6) && IN(ph)) ph_e(args, wv, l, ph, lds);
        SEAM(ph); ++ph; TP_MARK(6);
        if (EN(8) && IN(ph)) { size_t z = 0; LAUNDER_S(z); unsigned char* ws = args.ws + z; ph_res(args, wv, (const bf16*)(ws + WS_ACT0 + A_ACT), (const bf16*)(ws + WS_SLOT0 + (size_t)(l & 1) * SL_BYTES + SL_WDN), DFF, PROBE == 11 ? 1 : (PROBE == 23 ? 2 : 0), l, ph, true, lds); }
        SEAM(ph); ++ph; TP_MARK(7);
    }
    if (EN(9) && IN(ph)) ph_fin(args, wv, lds);
#ifdef TSUB
    if (blockIdx.x == 7 && threadIdx.x == 0) { const unsigned long long tt = *TS_SLOT; const unsigned long long t0 = __builtin_amdgcn_s_memrealtime(); while (__builtin_amdgcn_s_memrealtime() - t0 < 10ull * tt) __builtin_amdgcn_s_sleep(8); }
#endif
#ifdef TPROBE
    TP_MARK(8);
    if (blockIdx.x == 0 && wv == 0) { const unsigned long long t0 = __builtin_amdgcn_s_memrealtime(); while (__builtin_amdgcn_s_memrealtime() - t0 < 10ull * tp_acc) __builtin_amdgcn_s_sleep(8); }
#endif
#undef IN
#undef SEAM
}

extern "C" void kernel_launch(void* const* d_in, const int* in_sizes, int n_in, void* d_out, int out_size, void* d_ws, size_t ws_size, hipStream_t stream) {
    static int grid = 0;
    if (grid == 0) {
        if (n_in != 21 || out_size != M * D || ws_size < WS_END + (PROBE ? 64 * MiB : 0)) { fprintf(stderr, "kernel_launch: unexpected shapes / workspace (%zu < %zu)\n", ws_size, (size_t)WS_END); grid = -1; return; }
        int dev = 0, cus = 0, per_cu = 0;
        if (hipGetDevice(&dev) != hipSuccess || hipDeviceGetAttribute(&cus, hipDeviceAttributeMultiprocessorCount, dev) != hipSuccess) { grid = -1; return; }
        if (hipFuncSetAttribute((const void*)mk_fwd, hipFuncAttributeMaxDynamicSharedMemorySize, LDS_BYTES) != hipSuccess) { fprintf(stderr, "kernel_launch: hipFuncSetAttribute failed\n"); grid = -1; return; }
        if (hipOccupancyMaxActiveBlocksPerMultiprocessor(&per_cu, (const void*)mk_fwd, NTHREADS, LDS_BYTES) != hipSuccess || per_cu < 1) { fprintf(stderr, "kernel_launch: occupancy query says %d\n", per_cu); per_cu = 1; }
        (void)hipGetLastError();
        grid = cus * 1;
    }
    if (grid < 0) return;
#if MK_ONE_LAUNCH
    if (hipMemsetAsync((char*)d_ws + WS_CTL, 0, 65536, stream) != hipSuccess) { fprintf(stderr, "kernel_launch: memset failed\n"); return; }
#endif
    Args a{};
    for (int i = 0; i < 21; ++i) a.in.p[i] = (const float*)d_in[i];
    a.out = (float*)d_out; a.ws = (unsigned char*)d_ws;
#if MK_ONE_LAUNCH
    a.ph_lo = 0; a.ph_hi = NPHASE;
    void* kargs[] = {&a};
    hipError_t e = hipLaunchCooperativeKernel((const void*)mk_fwd, dim3(grid), dim3(NTHREADS), kargs, LDS_BYTES, stream);
    if (e != hipSuccess) fprintf(stderr, "kernel_launch: cooperative launch failed: %s (grid %d)\n", hipGetErrorString(e), grid);
#else
    for (int p = 0; p < NPHASE; ++p) { a.ph_lo = p; a.ph_hi = p + 1; hipLaunchKernelGGL(mk_fwd, dim3(grid), dim3(NTHREADS), LDS_BYTES, stream, a); }
#endif
}
```

```cpp
#include <hip/hip_runtime.h>
#include <hip/hip_cooperative_groups.h>
#include <cstdio>
#include <cstdint>
#include <cmath>
namespace cg = cooperative_groups;

#ifndef MK_ONE_LAUNCH
#define MK_ONE_LAUNCH 1
#endif

namespace cfg {
constexpr int D = 1024, BATCH = 8, SEQ = 2048, DEPTH = 4, M = BATCH * SEQ;
constexpr int GH = 4, GDK = 64, GDV = 128, GKEY = 256, GVAL = 512, GRANK = 16;
constexpr int SGW = 512, SGC = 128, CW = 512, DFF = 2816, DFF2 = 5632;
constexpr int INC = 7184, NIN = 7424;
constexpr int O_Q = 0, O_K = 256, O_V = 512, O_G = 1024, O_A = 1536, O_SU = 1552, O_SV = 2064, O_CB = 2576, O_CC = 3088, O_CX = 3600, O_GT = 4112;
constexpr float EPS = 1e-6f;
}
using namespace cfg;

namespace pg8 {
#define PG8_LAS __attribute__((address_space(3)))
typedef unsigned short bf16_t;
typedef short bf16x8 __attribute__((ext_vector_type(8)));
typedef float f32x4 __attribute__((ext_vector_type(4)));
typedef unsigned u32x4 __attribute__((ext_vector_type(4)));
constexpr int BM = 256, BK = 64, HALF = 128, HTB = HALF * BK * 2  , STAGE_BYTES = 8 * HTB, NXCD = 8, WGM = 8;

__host__ __device__ __forceinline__ int lds_byte(int r, int c) { const int st = (r >> 4) * 2 + (c >> 5), rr = r & 15, cc = c & 31, ob = rr * 64 + cc * 2; return st * 1024 + (ob ^ (((ob >> 9) & 1) << 5)); }
__host__ __device__ __forceinline__ void stage_rc(int b, int& R, int& C) { const int st = b / 1024, sb = b % 1024, swz = sb ^ (((sb >> 9) & 1) << 5); R = (st >> 1) * 16 + swz / 64; C = (st & 1) * 32 + (swz % 64) / 2; }
__host__ __device__ __forceinline__ int perm32(int rho) { const int n = rho >> 4, i = rho & 15; return 8 * (i >> 2) + 4 * n + (i & 3); }

struct Unit { int pm, pn; };
struct Gemm { const bf16_t* A; const bf16_t* Bt; int M, N, K; };

struct StaticOrder {
    int nM, nN, nwg, G, c;
    __host__ __device__ void init(int M, int N, int G_, int c_) { nM = M / BM; nN = N / BM; nwg = nM * nN; G = G_; c = c_; }
    __host__ __device__ bool next(int i, Unit& u) const {
        const long L = (long)i * G + c; if (L >= nwg) return false;
        int wgid = (int)L; { const int q = nwg / NXCD, r = nwg % NXCD, xcd = wgid % NXCD, off = wgid / NXCD; wgid = (xcd < r ? xcd * (q + 1) : r * (q + 1) + (xcd - r) * q) + off; }
        const int nig = WGM * nN, gid = wgid / nig, fm = gid * WGM, gsz = (nM - fm) < WGM ? (nM - fm) : WGM;
        u.pm = fm + ((wgid % nig) % gsz); u.pn = (wgid % nig) / gsz; return true;
    }
    __device__ __forceinline__ void a_ready(const Unit&) const {}
    __device__ __forceinline__ void done(const Unit&) const {}
};

__device__ __forceinline__ unsigned cvt_pk_bf16(float lo, float hi) { unsigned r; asm volatile("v_cvt_pk_bf16_f32 %0, %1, %2" : "=v"(r) : "v"(lo), "v"(hi)); return r; }
typedef float f32x2 __attribute__((ext_vector_type(2)));
#ifdef TSUB
#define PG8_TS_BEGIN(k) unsigned long long ts_b_ = 0; if ((k) == TSUB) ts_b_ = __builtin_amdgcn_s_memrealtime()
#define PG8_TS_END(k) do { if ((k) == TSUB && blockIdx.x == 7 && tid == 0) *(PG8_LAS unsigned long long*)(lds + 131072 + 640) += __builtin_amdgcn_s_memrealtime() - ts_b_; } while (0)
#ifdef TSCYC
#define PG8_TK_BEGIN(k) unsigned long long tk_b_ = 0; if ((k) == TSUB) tk_b_ = __builtin_amdgcn_s_memtime()
#define PG8_TK_END(k) do { if ((k) == TSUB && blockIdx.x == 7 && tid == 0) *(PG8_LAS unsigned long long*)(lds + 131072 + 640) += (__builtin_amdgcn_s_memtime() - tk_b_) / 20; } while (0)
#else
#define PG8_TK_BEGIN(k) unsigned long long tk_b_ = 0; if ((k) == TSUB) tk_b_ = __builtin_amdgcn_s_memrealtime()
#define PG8_TK_END(k) do { if ((k) == TSUB && blockIdx.x == 7 && tid == 0) *(PG8_LAS unsigned long long*)(lds + 131072 + 640) += __builtin_amdgcn_s_memrealtime() - tk_b_; } while (0)
#endif
#else
#define PG8_TS_BEGIN(k) do { } while (0)
#define PG8_TS_END(k) do { } while (0)
#define PG8_TK_BEGIN(k) do { } while (0)
#define PG8_TK_END(k) do { } while (0)
#endif
template <class Epi, class Sched, bool ALIGN_EPI = false, bool SP2 = false>
__device__ __forceinline__ void gemm_phase(PG8_LAS unsigned char* lds, const Gemm g, const Sched& S, const Epi& E, const int wave_id) {
    int ln__; asm volatile("v_mbcnt_lo_u32_b32 %0, -1, 0\n\tv_mbcnt_hi_u32_b32 %0, -1, %0" : "=v"(ln__));
    const int tid_ = ln__ + 64 * wave_id;
    const int tid = tid_, wid = __builtin_amdgcn_readfirstlane(tid >> 6), lane = tid & 63, wr = wid >> 2, wc = wid & 3, fr = lane & 15, fq = lane >> 4;
    const int K = g.K, nt = K / BK;
    unsigned voffA[2], voffB[2];
#pragma unroll
    for (int i = 0; i < 2; ++i) { int R, C; stage_rc(tid * 16 + i * 8192, R, C); const int Rb = Epi::PERM ? ((R & ~31) + perm32(R & 31)) : R;
        const int Ra = Epi::APERM ? ((R & ~63) + 4 * (R & 15) + ((R >> 4) & 3)) : R;
        voffA[i] = (unsigned)(Ra * K + C) * 2u; voffB[i] = (unsigned)(Rb * K + C) * 2u; }
    const size_t kstep = (size_t)(BK * 2);
    const size_t hstep = (size_t)HALF * K * 2;
    const size_t tstep = 2 * hstep;
    const unsigned ldsw = (unsigned)wid * 1024u;
    const int aoff = lds_byte(wr * 64 + fr, fq * 8), boff = lds_byte(wc * 32 + fr, fq * 8);
#define PG8_SA(b, h) (((b) * 2 + (h)) * HTB)
#define PG8_SB(b, h) ((4 + (b) * 2 + (h)) * HTB)
#define PG8_STAGE(bufoff, gbase, voff) do { _Pragma("unroll") for (int _i = 0; _i < 2; ++_i) \
        __builtin_amdgcn_global_load_lds((const unsigned*)((const char*)(gbase) + (voff)[_i]), (PG8_LAS unsigned*)(lds + (bufoff) + ldsw + _i * 8192), 16, 0, 0); } while (0)
#define PG8_LDA(dst, b, h) do { _Pragma("unroll") for (int m = 0; m < 4; ++m) _Pragma("unroll") for (int k = 0; k < 2; ++k) dst[m][k] = *(const PG8_LAS bf16x8*)(lds + PG8_SA(b, h) + aoff + m * 2048 + k * 1024); } while (0)
#define PG8_LDB(dst, b, h) do { _Pragma("unroll") for (int n = 0; n < 2; ++n) _Pragma("unroll") for (int k = 0; k < 2; ++k) dst[n][k] = *(const PG8_LAS bf16x8*)(lds + PG8_SB(b, h) + boff + n * 2048 + k * 1024); } while (0)
#define PG8_MMA(ai, bj, At, Bt) do { __builtin_amdgcn_s_setprio(1); _Pragma("unroll") for (int m = 0; m < 4; ++m) _Pragma("unroll") for (int n = 0; n < 2; ++n) _Pragma("unroll") for (int k = 0; k < 2; ++k) \
        acc[ai][bj][m][n] = __builtin_amdgcn_mfma_f32_16x16x32_bf16(Bt[n][k], At[m][k], acc[ai][bj][m][n], 0, 0, 0); __builtin_amdgcn_s_setprio(0); } while (0)
#define PG8_WAIT_V(n) asm volatile("s_waitcnt vmcnt(" #n ")" ::: "memory")
#define PG8_WAIT_L(n) asm volatile("s_waitcnt lgkmcnt(" #n ")" ::: "memory")
#define PG8_BAR __builtin_amdgcn_s_barrier()
#define PG8_SCHED __builtin_amdgcn_sched_barrier(0)
    Unit cur, nxt; int ui = 0;
    if (!S.next(0, cur)) return;
    f32x4 acc[2][2][4][2];
#pragma unroll
    for (int a = 0; a < 2; ++a)
#pragma unroll
        for (int b = 0; b < 2; ++b)
#pragma unroll
            for (int m = 0; m < 4; ++m)
#pragma unroll
                for (int n = 0; n < 2; ++n) acc[a][b][m][n] = (f32x4){0.f, 0.f, 0.f, 0.f};
    bf16x8 At[4][2], B0[2][2], B1[2][2];
    const char* cA = (const char*)g.A + (size_t)cur.pm * tstep; const char* cB = (const char*)g.Bt + (size_t)cur.pn * tstep;
    S.a_ready(cur);
    if constexpr (SP2) {
        PG8_STAGE(PG8_SB(0, 0), cB, voffB); PG8_STAGE(PG8_SB(0, 1), cB + hstep, voffB); PG8_STAGE(PG8_SA(0, 0), cA, voffA); PG8_STAGE(PG8_SA(0, 1), cA + hstep, voffA);
        PG8_STAGE(PG8_SB(1, 0), cB + kstep, voffB); PG8_STAGE(PG8_SA(1, 0), cA + kstep, voffA); PG8_STAGE(PG8_SB(1, 1), cB + hstep + kstep, voffB);
        if (wr == 1) PG8_BAR;
        PG8_WAIT_V(8); PG8_BAR;
        PG8_WAIT_V(6); PG8_BAR;
    } else {
        PG8_STAGE(PG8_SB(0, 0), cB, voffB); PG8_STAGE(PG8_SA(0, 0), cA, voffA); PG8_STAGE(PG8_SB(0, 1), cB + hstep, voffB); PG8_STAGE(PG8_SA(0, 1), cA + hstep, voffA);
        if (wr == 1) PG8_BAR;
        PG8_WAIT_V(4); PG8_BAR;
        PG8_STAGE(PG8_SB(1, 0), cB + kstep, voffB); PG8_STAGE(PG8_SA(1, 0), cA + kstep, voffA); PG8_STAGE(PG8_SB(1, 1), cB + hstep + kstep, voffB);
        PG8_WAIT_V(6); PG8_BAR;
    }
    for (;;) {
        const bool has_next = S.next(ui + 1, nxt);
        const char* nA = has_next ? (const char*)g.A + (size_t)nxt.pm * tstep : cA; const char* nB = has_next ? (const char*)g.Bt + (size_t)nxt.pn * tstep : cB;
        PG8_TK_BEGIN(Epi::TSID + 100);
        for (int t = 0; t < nt; t += 2) {
            const bool last = (t == nt - 2);
            const char* a1 = cA + (size_t)(t + 1) * kstep;
            const char* a2 = last ? nA : cA + (size_t)(t + 2) * kstep; const char* b2 = last ? nB : cB + (size_t)(t + 2) * kstep;
            const char* a3 = a2 + kstep; const char* b3 = b2 + kstep;
            if (last && has_next) S.a_ready(nxt);
            if constexpr (Epi::MIDHOOK) { if (t == Epi::HOOK_T1 || t == Epi::HOOK_T2) E.mid(acc, cur, t, wr, wc); }
            if constexpr (SP2) {
            PG8_LDB(B0, 0, 0); PG8_LDB(B1, 0, 1); PG8_SCHED; PG8_LDA(At, 0, 0); PG8_STAGE(PG8_SA(1, 1), a1 + hstep, voffA);
            PG8_WAIT_V(8); PG8_WAIT_L(0); PG8_BAR; PG8_MMA(0, 0, At, B0); PG8_MMA(0, 1, At, B1); PG8_BAR; PG8_SCHED;
            PG8_LDA(At, 0, 1); PG8_STAGE(PG8_SB(0, 0), b2, voffB); PG8_STAGE(PG8_SB(0, 1), b2 + hstep, voffB); PG8_STAGE(PG8_SA(0, 0), a2, voffA);
            PG8_WAIT_V(8); PG8_WAIT_L(0); PG8_BAR; PG8_MMA(1, 0, At, B0); PG8_MMA(1, 1, At, B1); PG8_BAR; PG8_SCHED;
            PG8_LDB(B0, 1, 0); PG8_LDB(B1, 1, 1); PG8_SCHED; PG8_LDA(At, 1, 0); PG8_STAGE(PG8_SA(0, 1), a2 + hstep, voffA);
            PG8_WAIT_V(8); PG8_WAIT_L(0); PG8_BAR; PG8_MMA(0, 0, At, B0); PG8_MMA(0, 1, At, B1); PG8_BAR; PG8_SCHED;
            PG8_LDA(At, 1, 1); PG8_STAGE(PG8_SB(1, 0), b3, voffB); PG8_STAGE(PG8_SB(1, 1), b3 + hstep, voffB); PG8_STAGE(PG8_SA(1, 0), a3, voffA);
            PG8_WAIT_V(8); PG8_WAIT_L(0); PG8_BAR; PG8_MMA(1, 0, At, B0); PG8_MMA(1, 1, At, B1); PG8_BAR; PG8_SCHED;
            } else {
            PG8_LDB(B0, 0, 0); PG8_SCHED; PG8_LDA(At, 0, 0); PG8_STAGE(PG8_SA(1, 1), a1 + hstep, voffA);
            PG8_WAIT_L(8); PG8_BAR; PG8_WAIT_L(0); PG8_MMA(0, 0, At, B0); PG8_BAR; PG8_SCHED;
            PG8_LDB(B1, 0, 1); PG8_STAGE(PG8_SB(0, 0), b2, voffB);
            PG8_BAR; PG8_WAIT_L(0); PG8_MMA(0, 1, At, B1); PG8_BAR;
            PG8_LDA(At, 0, 1); PG8_STAGE(PG8_SA(0, 0), a2, voffA);
            PG8_BAR; PG8_WAIT_L(0); PG8_MMA(1, 0, At, B0); PG8_BAR; PG8_SCHED;
            PG8_STAGE(PG8_SB(0, 1), b2 + hstep, voffB);
            PG8_WAIT_V(6); PG8_BAR; PG8_MMA(1, 1, At, B1); PG8_BAR;
            PG8_LDB(B0, 1, 0); PG8_SCHED; PG8_LDA(At, 1, 0); PG8_STAGE(PG8_SA(0, 1), a2 + hstep, voffA);
            PG8_WAIT_L(8); PG8_BAR; PG8_WAIT_L(0); PG8_MMA(0, 0, At, B0); PG8_BAR; PG8_SCHED;
            PG8_LDB(B1, 1, 1); PG8_STAGE(PG8_SB(1, 0), b3, voffB);
            PG8_BAR; PG8_WAIT_L(0); PG8_MMA(0, 1, At, B1); PG8_BAR;
            PG8_LDA(At, 1, 1); PG8_STAGE(PG8_SA(1, 0), a3, voffA);
            PG8_BAR; PG8_WAIT_L(0); PG8_MMA(1, 0, At, B0); PG8_BAR; PG8_SCHED;
            PG8_STAGE(PG8_SB(1, 1), b3 + hstep, voffB);
            PG8_WAIT_V(6); PG8_BAR; PG8_MMA(1, 1, At, B1); PG8_BAR;
            }
        }
        PG8_TK_END(Epi::TSID + 100);
        if constexpr (ALIGN_EPI) { if (wr == 0) PG8_BAR; }
        if constexpr (!Epi::AFTER_DRAIN) { PG8_TS_BEGIN(Epi::TSID); E(acc, cur, wr, wc, fr, fq); PG8_TS_END(Epi::TSID); S.done(cur); }
        if (!has_next) break;
#pragma unroll
        for (int a = 0; a < 2; ++a)
#pragma unroll
            for (int b = 0; b < 2; ++b)
#pragma unroll
                for (int m = 0; m < 4; ++m)
#pragma unroll
                    for (int n = 0; n < 2; ++n) acc[a][b][m][n] = (f32x4){0.f, 0.f, 0.f, 0.f};
        cur = nxt; cA = nA; cB = nB; ++ui;
        if constexpr (ALIGN_EPI) { if (wr == 1) PG8_BAR; }
    }
    PG8_WAIT_V(0);
    if constexpr (!ALIGN_EPI) { if (wr == 0) PG8_BAR; }
    PG8_BAR;
    if constexpr (Epi::AFTER_DRAIN) { E.fused(acc, cur, wr, wc, fr, fq, lds, wid, lane); S.done(cur); }
#undef PG8_SA
#undef PG8_SB
#undef PG8_STAGE
#undef PG8_LDA
#undef PG8_LDB
#undef PG8_MMA
#undef PG8_WAIT_V
#undef PG8_WAIT_L
#undef PG8_BAR
#undef PG8_SCHED
}
}

#define GAS __attribute__((address_space(1)))
#define LAS __attribute__((address_space(3)))
typedef unsigned short bf16;
typedef unsigned v4u __attribute__((ext_vector_type(4)));
typedef unsigned v2u __attribute__((ext_vector_type(2)));
typedef float f32x4 __attribute__((ext_vector_type(4)));
typedef float f32x2 __attribute__((ext_vector_type(2)));
typedef short bf16x8 __attribute__((ext_vector_type(8)));
constexpr int NWAVES = 8, NTHREADS = 512;
constexpr int ZPITCH = 1536;
constexpr int RING_BYTES = 131072, LDS_BYTES = 153600;
constexpr int RST_OFF = RING_BYTES + 10240;

constexpr size_t MiB = 1u << 20;
constexpr size_t SL_WIN = 0, SL_WBR = SL_WIN + (size_t)NIN * D * 2, SL_WO = SL_WBR + (size_t)3 * D * 512 * 2, SL_WUP = SL_WO + (size_t)D * D * 2,
                 SL_WDN = SL_WUP + (size_t)DFF2 * D * 2, SL_SGW = SL_WDN + (size_t)D * DFF * 2, SL_END = SL_SGW + (size_t)4 * 128 * 128 * 2, SL_BYTES = 38 * MiB;
static_assert(SL_END <= SL_BYTES, "weight slot");
constexpr size_t WS_CTL = 0, WS_SLOT0 = 1 * MiB, WS_XB = WS_SLOT0 + 2 * SL_BYTES, WS_SSQ = WS_XB + 32 * MiB, WS_SVST = WS_SSQ + 1 * MiB, WS_ACT0 = WS_SVST + 1 * MiB;
constexpr size_t A_Q = 0, A_K = 8 * MiB, A_V = 16 * MiB, A_Z = 32 * MiB, A_SV = 80 * MiB, A_CC = 96 * MiB, A_LOGA = 112 * MiB, A_G = 120 * MiB,
                 A_CST = 168 * MiB, A_DEC = 200 * MiB, A_HT = 201 * MiB, A_ACT = 207 * MiB, A_MERGED = 295 * MiB, A_END = 327 * MiB, A_CX = A_CC;
static_assert(A_ACT + (size_t)M * DFF * 2 <= A_MERGED && A_HT + (size_t)64 * 2 * 2 * DFF2 * 4 <= A_ACT && A_MERGED + (size_t)M * D * 2 <= A_END && A_LOGA + (size_t)M * GKEY * 2 <= A_G && A_G + (size_t)M * 3072 <= A_CST, "activation map");
constexpr size_t WS_END = WS_ACT0 + A_END;
constexpr int CW_BAR = 1024, CW_QHEAD = 6144, CW_FIN = 8192, CW_AB = 12288, CW_QUAD = 13312;

__device__ __forceinline__ float bf2f(unsigned h) { return __uint_as_float(h << 16); }
__device__ __forceinline__ unsigned pk2(float lo, float hi) { return pg8::cvt_pk_bf16(lo, hi); }
__device__ __forceinline__ float fsigmoid(float z) { return __builtin_amdgcn_rcpf(1.f + __expf(-z)); }
__device__ __forceinline__ float fsilu(float z) { return z * fsigmoid(z); }
__device__ __forceinline__ float fgelu(float z) { return z * fsigmoid(1.5957691216057308f * (z + 0.044715f * z * z * z)); }
__device__ __forceinline__ float flogsig(float z) { return fminf(z, 0.f) - __logf(1.f + __expf(-fabsf(z))); }
__device__ __forceinline__ float wave_sum(float v) {
#pragma unroll
    for (int o = 1; o < 64; o <<= 1) v += __shfl_xor(v, o);
    return v;
}
#define LDS_WAIT() asm volatile("s_waitcnt lgkmcnt(0)" ::: "memory")
#define LDS_BARRIER() do { asm volatile("s_waitcnt lgkmcnt(0)" ::: "memory"); __builtin_amdgcn_s_barrier(); asm volatile("" ::: "memory"); } while (0)
__device__ __forceinline__ f32x4 mfma16(bf16x8 a, bf16x8 b, f32x4 c) { return __builtin_amdgcn_mfma_f32_16x16x32_bf16(a, b, c, 0, 0, 0); }

__device__ __forceinline__ void tr_write(bf16* WT, int K, int k0, LAS float* scr, int lane) {
    LDS_WAIT(); asm volatile("" ::: "memory");
    const int c = lane & 7;
#pragma unroll
    for (int j = 0; j < 4; ++j) { const int n = (lane >> 3) + 8 * j; const LAS float* s = scr + (8 * c) * 33 + n;
        v4u o; o.x = pk2(s[0 * 33], s[1 * 33]); o.y = pk2(s[2 * 33], s[3 * 33]); o.z = pk2(s[4 * 33], s[5 * 33]); o.w = pk2(s[6 * 33], s[7 * 33]);
        *(GAS v4u*)(WT + (size_t)n * K + k0 + 8 * c) = o; }
    LDS_WAIT(); asm volatile("" ::: "memory");
}
__device__ __forceinline__ void tr_item(const float* W, int ldw, int col0, const float* ksc, float sc, bf16* WT, int K, int k0, LAS float* scr, int lane) {
    float v[32]; const float* src = W + (size_t)(k0 + (lane >> 5)) * ldw + col0 + (lane & 31);
#pragma unroll
    for (int i = 0; i < 32; ++i) v[i] = src[(size_t)(2 * i) * ldw];
    if (ksc) {
#pragma unroll
        for (int i = 0; i < 32; ++i) v[i] *= ksc[k0 + 2 * i + (lane >> 5)]; }
#pragma unroll
    for (int i = 0; i < 32; ++i) scr[(2 * i + (lane >> 5)) * 33 + (lane & 31)] = v[i] * sc;
    tr_write(WT, K, k0, scr, lane);
}
__device__ __forceinline__ void alpha_item(const float* win, const float* wal, const float* g, bf16* WT, int k0, int j0, LAS float* scr, int lane) {
    const int jj = lane & 31, half = lane >> 5; float wa[16];
#pragma unroll
    for (int r = 0; r < 16; ++r) wa[r] = wal[r * GKEY + j0 + jj];
    for (int i = 0; i < 32; ++i) { const int kk = 2 * i + half, k = k0 + kk; const float* wr = win + (size_t)k * INC + O_A; float s = 0.f;
#pragma unroll
        for (int r = 0; r < 16; ++r) s += wr[r] * wa[r];
        scr[kk * 33 + jj] = s * g[k]; }
    tr_write(WT + (size_t)j0 * D, D, k0, scr, lane);
}
struct Inputs { const float* p[21]; };
constexpr int CV_J0 = 16 * 224, CV_J1 = 16 * 8, CV_J2 = 3 * 8 * 32, CV_J3 = 16 * 32, CV_J4 = 16 * 176, CV_J5 = 44 * 32, CV_J6 = 128, CV_ITEMS = CV_J0 + CV_J1 + CV_J2 + CV_J3 + CV_J4 + CV_J5 + CV_J6;
constexpr int CV_WIN_ITEMS = CV_J0 + CV_J1;
__device__ __forceinline__ void convert_item(const Inputs& I, int l, unsigned char* slot, LAS float* scr, int it, int lane) {
    bf16* WIN = (bf16*)(slot + SL_WIN); bf16* WBR = (bf16*)(slot + SL_WBR); bf16* WO = (bf16*)(slot + SL_WO); bf16* WUP = (bf16*)(slot + SL_WUP); bf16* WDN = (bf16*)(slot + SL_WDN); bf16* SGWS = (bf16*)(slot + SL_SGW);
    const float* win = I.p[2] + (size_t)l * D * INC;
        int r = it;
        if (r < CV_J0) { const int kb = r / 224, nb = r % 224; const int drow = nb < 48 ? 32 * nb : 1792 + 32 * (nb - 48); int scol = nb < 48 ? 32 * nb : O_SU + 32 * (nb - 48);
            if (drow >= 3328 && drow < 4352) { const int j = (drow - 3328) >> 8, rr = (drow - 3328) & 255; scol = rr < 128 ? O_CC + 128 * j + rr : O_CX + 128 * j + (rr - 128); }
            tr_item(win, INC, scol, I.p[1] + (size_t)l * D, drow < 256 ? 0.125f : 1.f, WIN + (size_t)drow * D, D, 64 * kb, scr, lane); return; }
        r -= CV_J0;
        if (r < CV_J1) { const int kb = r / 8, jb = r % 8; alpha_item(win, I.p[3] + (size_t)l * GRANK * GKEY, I.p[1] + (size_t)l * D, WIN + (size_t)1536 * D, 64 * kb, 32 * jb, scr, lane); return; }
        r -= CV_J1;
        if (r < CV_J2) { const int br = r / 256, rr = r % 256, kb = rr / 32, nb = rr % 32;
            const float* W = (br == 0 ? I.p[6] : br == 1 ? I.p[11] : I.p[13]) + (size_t)l * 512 * D;
            tr_item(W, D, 32 * nb, br == 0 ? I.p[5] + (size_t)l * GVAL : nullptr, 1.f, WBR + (size_t)32 * nb * ZPITCH + br * 512, ZPITCH, 64 * kb, scr, lane); return; }
        r -= CV_J2;
        if (r < CV_J3) { const int kb = r / 32, nb = r % 32; tr_item(I.p[14] + (size_t)l * D * D, D, 32 * nb, nullptr, 1.f / 255.f, WO + (size_t)32 * nb * D, D, 64 * kb, scr, lane); return; }
        r -= CV_J3;
        if (r < CV_J4) { const int kb = r / 176, nb = r % 176, pn = nb / 8, jb = nb % 8; const int scol = jb < 4 ? 128 * pn + 32 * jb : DFF + 128 * pn + 32 * (jb - 4);
            tr_item(I.p[16] + (size_t)l * D * DFF2, DFF2, scol, I.p[15] + (size_t)l * D, 1.f, WUP + (size_t)32 * nb * D, D, 64 * kb, scr, lane); return; }
        r -= CV_J4;
        if (r < CV_J5) { const int kb = r / 32, nb = r % 32; tr_item(I.p[19] + (size_t)l * DFF * D, D, 32 * nb, nullptr, 1.f, WDN + (size_t)32 * nb * DFF, DFF, 64 * kb, scr, lane); return; }
        r -= CV_J5;
        { const int e0 = r * 512 + lane * 8, t = (e0 >> 7) & 127, s0 = e0 & 127; const float* src = I.p[9] + (size_t)l * 4 * 128 * 128 + e0;
          const f32x4 a = *(const f32x4*)src, b = *(const f32x4*)(src + 4); float v[8] = {a[0], a[1], a[2], a[3], b[0], b[1], b[2], b[3]};
#pragma unroll
          for (int e = 0; e < 8; ++e) if (s0 + e > t) v[e] = 0.f;
          v4u o; o.x = pk2(v[0], v[1]); o.y = pk2(v[2], v[3]); o.z = pk2(v[4], v[5]); o.w = pk2(v[6], v[7]); *(GAS v4u*)(SGWS + e0) = o; }
}
__device__ __forceinline__ void convert_static(const Inputs& I, int l, unsigned char* slot, LAS unsigned char* lds, int it_lo, int it_hi, int gw, int ngw, int wave, int lane) {
    LAS float* scr = (LAS float*)(lds + wave * 8448);
    for (int it = it_lo + gw; it < it_hi; it += ngw) convert_item(I, l, slot, scr, it, lane);
}
#define RLX_AGENT __ATOMIC_RELAXED, __HIP_MEMORY_SCOPE_AGENT
__device__ __forceinline__ void convert_queue(const Inputs& I, int l, unsigned char* slot, LAS unsigned char* lds, unsigned* head, int it_lo, int it_hi, unsigned* fin, int G, int tid, int wave, int lane) {
    LAS float* scr = (LAS float*)(lds + wave * 8448); volatile LAS unsigned* bc = (volatile LAS unsigned*)(lds + RING_BYTES + 768);
    for (;;) {
        if (tid == 0) { unsigned v = 0xffffffffu; if (!fin || __hip_atomic_load(fin, RLX_AGENT) < (unsigned)G) v = __hip_atomic_fetch_add(head, 8u, RLX_AGENT); bc[0] = v; }
        LDS_BARRIER();
        const unsigned base = bc[0];
        LDS_BARRIER();
        if (base >= (unsigned)(it_hi - it_lo)) break;
        const int it = it_lo + (int)base + wave; if (it < it_hi) convert_item(I, l, slot, scr, it, lane);
    }
}
__device__ __forceinline__ void x_prep(const float* xin, bf16* xb, float* ssq, int gw, int ngw, int lane) {
    for (int row = gw; row < M; row += ngw) {
        const GAS f32x4* xr = (const GAS f32x4*)(xin + (size_t)row * D) + lane; f32x4 v[4]; float s = 0.f;
#pragma unroll
        for (int j = 0; j < 4; ++j) { v[j] = xr[64 * j]; s += (v[j][0] * v[j][0] + v[j][1] * v[j][1]) + (v[j][2] * v[j][2] + v[j][3] * v[j][3]); }
        s = wave_sum(s);
#pragma unroll
        for (int j = 0; j < 4; ++j) { v2u w; w.x = pk2(v[j][0], v[j][1]); w.y = pk2(v[j][2], v[j][3]); ((GAS v2u*)(xb + (size_t)row * D))[lane + 64 * j] = w; }
        if (lane < 16) ssq[(size_t)row * 16 + lane] = lane == 0 ? s : 0.f;
    }
}
__device__ __forceinline__ void final_norm(const bf16* xb, float* out, const float* ssq, const float* g, int gw, int ngw, int lane) {
    for (int row = gw; row < M; row += ngw) {
        const float pv = lane < 16 ? ssq[(size_t)row * 16 + lane] : 0.f; const float rs = rsqrtf(wave_sum(pv) * (1.f / D) + EPS);
        const GAS v2u* xr = (const GAS v2u*)(xb + (size_t)row * D) + lane; GAS f32x4* orow = (GAS f32x4*)(out + (size_t)row * D) + lane;
#pragma unroll
        for (int j = 0; j < 4; ++j) { const v2u w = xr[64 * j]; const f32x4 gv = ((const GAS f32x4*)g)[lane + 64 * j];
            orow[64 * j] = (f32x4){bf2f(w.x & 0xffffu) * rs * gv[0], bf2f(w.x >> 16) * rs * gv[1], bf2f(w.y & 0xffffu) * rs * gv[2], bf2f(w.y >> 16) * rs * gv[3]}; }
    }
}

constexpr int GP = 72;
constexpr int L_QT = 0, L_KT = 9216, L_KENDT = 18432, L_VT = 27648, L_ST = 46080, L_SEG = 64512, L_DECS = 66560, L_RED = 66816, L_GLA_END = 67328;
constexpr int VP = 136;

typedef short s16x4 __attribute__((ext_vector_type(4)));
constexpr int SG_VNP = 288, SG_OUTP = 272, SG_VN = 0, SG_OUT = 128 * SG_VNP, SG_ST = SG_OUT + 128 * SG_OUTP;
__device__ __forceinline__ void sgu_item(int item, LAS unsigned char* lds, const bf16* ZBI, bf16* ZBO, const bf16* SV, const float* SVST, const float* lng, const float* lnb, const bf16* wsb, const float* bs, int wave, int lane) {
    const int b_ = item & 7, h = (item >> 3) & 3, r0 = b_ * SEQ + (item >> 5) * 128;
    const int tid = wave * 64 + lane, fr = lane & 15, fq = lane >> 4, t = 16 * wave + fr, nks = (wave >> 1) + 1;
    const int cc = tid & 15, rg = tid >> 4;
    f32x4 st4[4];
    if (tid < 128) { const f32x4* p = (const f32x4*)(SVST + ((size_t)r0 + tid) * 16); st4[0] = p[0]; st4[1] = p[1]; st4[2] = p[2]; st4[3] = p[3]; }
    v4u svv[4], suv[4];
#pragma unroll
    for (int i = 0; i < 4; ++i) { const size_t row = (size_t)r0 + rg + 32 * i; svv[i] = *(const v4u*)(SV + row * 512 + h * 128 + 8 * cc); suv[i] = *(const v4u*)(ZBI + row * ZPITCH + h * 128 + 8 * cc); }
    const f32x4 g0 = *(const f32x4*)(lng + h * 128 + 8 * cc), g1 = *(const f32x4*)(lng + h * 128 + 8 * cc + 4), b0 = *(const f32x4*)(lnb + h * 128 + 8 * cc), b1 = *(const f32x4*)(lnb + h * 128 + 8 * cc + 4);
    bf16x8 bfr[4];
#pragma unroll
    for (int ks = 0; ks < 4; ++ks) bfr[ks] = (ks < nks) ? *(const bf16x8*)(wsb + ((size_t)h * 128 + t) * 128 + 32 * ks + 8 * fq) : (bf16x8){0, 0, 0, 0, 0, 0, 0, 0};
    const float bias = bs[h * 128 + t];
    if (tid < 128) { const f32x4 a = st4[0], b = st4[1], c = st4[2], d = st4[3];
        const float sm = (a[0] + a[2]) + (b[0] + b[2]) + (c[0] + c[2]) + (d[0] + d[2]), sq = (a[1] + a[3]) + (b[1] + b[3]) + (c[1] + c[3]) + (d[1] + d[3]);
        const float mean = sm * (1.f / 512.f); *(LAS f32x2*)(lds + SG_ST + tid * 8) = (f32x2){mean, rsqrtf(fmaxf(sq * (1.f / 512.f) - mean * mean, 0.f) + EPS)}; }
    LDS_BARRIER();
#pragma unroll
    for (int i = 0; i < 4; ++i) { const int srow = rg + 32 * i; const f32x2 ms = *(const LAS f32x2*)(lds + SG_ST + srow * 8); float v[8];
#pragma unroll
        for (int e = 0; e < 4; ++e) { v[2 * e] = bf2f(svv[i][e] & 0xffffu); v[2 * e + 1] = bf2f(svv[i][e] >> 16); }
#pragma unroll
        for (int e = 0; e < 4; ++e) { v[e] = (v[e] - ms[0]) * ms[1] * g0[e] + b0[e]; v[4 + e] = (v[4 + e] - ms[0]) * ms[1] * g1[e] + b1[e]; }
        v4u o; o.x = pk2(v[0], v[1]); o.y = pk2(v[2], v[3]); o.z = pk2(v[4], v[5]); o.w = pk2(v[6], v[7]); *(LAS v4u*)(lds + SG_VN + srow * SG_VNP + cc * 16) = o; }
    LDS_BARRIER();
    { f32x4 acc[8]; const int gk = lane >> 4, qq = (lane & 15) >> 2, pp = lane & 3;
#pragma unroll
      for (int m = 0; m < 8; ++m) { acc[m] = (f32x4){0.f, 0.f, 0.f, 0.f};
#pragma unroll
          for (int ks = 0; ks < 4; ++ks) if (ks < nks) {
              const s16x4 lo = __builtin_amdgcn_ds_read_tr16_b64_v4i16((LAS s16x4*)(lds + SG_VN + (32 * ks + 8 * gk + qq) * SG_VNP + (16 * m + 4 * pp) * 2));
              const s16x4 hi = __builtin_amdgcn_ds_read_tr16_b64_v4i16((LAS s16x4*)(lds + SG_VN + (32 * ks + 8 * gk + 4 + qq) * SG_VNP + (16 * m + 4 * pp) * 2));
              const bf16x8 a = {lo[0], lo[1], lo[2], lo[3], hi[0], hi[1], hi[2], hi[3]}; acc[m] = mfma16(a, bfr[ks], acc[m]); } }
#pragma unroll
      for (int m = 0; m < 8; ++m) { v2u w; w.x = pk2(acc[m][0] + bias, acc[m][1] + bias); w.y = pk2(acc[m][2] + bias, acc[m][3] + bias); *(LAS v2u*)(lds + SG_OUT + t * SG_OUTP + (16 * m + 4 * fq) * 2) = w; } }
    LDS_BARRIER();
#pragma unroll
    for (int i = 0; i < 4; ++i) { const int srow = rg + 32 * i; const v4u mx = *(const LAS v4u*)(lds + SG_OUT + srow * SG_OUTP + cc * 16); v4u o;
#pragma unroll
        for (int e = 0; e < 4; ++e) o[e] = pk2(bf2f(suv[i][e] & 0xffffu) * bf2f(mx[e] & 0xffffu), bf2f(suv[i][e] >> 16) * bf2f(mx[e] >> 16));
        *(v4u*)(ZBO + ((size_t)r0 + srow) * ZPITCH + h * 128 + 8 * cc) = o; }
    LDS_BARRIER();
}
__device__ __forceinline__ void convbr_item(int idx, const bf16* ZCI, bf16* ZCO, const bf16* CC, const bf16* CX, const float* cw) {
    const int c0 = (idx & 63) * 8, wg_ = idx >> 9, r0 = (wg_ & 7) * SEQ + (wg_ >> 3) * 64 + ((idx >> 6) & 7) * 8;
    const bool first = (r0 & (SEQ - 1)) == 0;
    v4u ca[10], cbv[8];
#pragma unroll
    for (int i = 0; i < 10; ++i) { const int row = r0 - 2 + i; if (i >= 2 || !first) ca[i] = *(const v4u*)(CC + (size_t)row * CW + c0); else ca[i] = (v4u){0u, 0u, 0u, 0u}; }
#pragma unroll
    for (int i = 0; i < 8; ++i) cbv[i] = *(const v4u*)(ZCI + (size_t)(r0 + i) * ZPITCH + c0);
    float w[3][8];
#pragma unroll
    for (int k = 0; k < 3; ++k) { const f32x4 a = *(const f32x4*)(cw + k * CW + c0), b = *(const f32x4*)(cw + k * CW + c0 + 4);
#pragma unroll
        for (int e = 0; e < 4; ++e) { w[k][e] = a[e]; w[k][4 + e] = b[e]; } }
    float u2[8], u1[8];
#define CONV_U(i, u) do { _Pragma("unroll") for (int e = 0; e < 4; ++e) { u[2 * e] = bf2f(ca[i][e] & 0xffffu); u[2 * e + 1] = bf2f(ca[i][e] >> 16); } } while (0)
    CONV_U(0, u2); CONV_U(1, u1);
#pragma unroll
    for (int i = 0; i < 8; ++i) { float u0[8]; CONV_U(i + 2, u0); float z[8];
#pragma unroll
        for (int e = 0; e < 8; ++e) { const float y = w[0][e] * u2[e] + w[1][e] * u1[e] + w[2][e] * u0[e]; const float c = (e & 1) ? bf2f(cbv[i][e >> 1] >> 16) : bf2f(cbv[i][e >> 1] & 0xffffu); z[e] = c * y; u2[e] = u1[e]; u1[e] = u0[e]; }
        v4u o; o.x = pk2(z[0], z[1]); o.y = pk2(z[2], z[3]); o.z = pk2(z[4], z[5]); o.w = pk2(z[6], z[7]); *(v4u*)(ZCO + (size_t)(r0 + i) * ZPITCH + c0) = o; }
#undef CONV_U
}
#ifdef TSUB
#define TS_SLOT ((LAS unsigned long long*)(lds + RING_BYTES + 640))
#define TS_BEGIN(k) unsigned long long ts_b##k = 0; if ((k) == TSUB) ts_b##k = __builtin_amdgcn_s_memrealtime()
#ifdef TSUNIT
constexpr int ts_unit_ = -1;
#define TS_COND (ts_unit_ == TSUNIT)
#else
#define TS_COND (blockIdx.x == 7)
#endif
#define TS_END(k) do { if ((k) == TSUB && TS_COND && tid == 0) *TS_SLOT += __builtin_amdgcn_s_memrealtime() - ts_b##k; } while (0)
#else
#define TS_BEGIN(k) do { } while (0)
#define TS_END(k) do { } while (0)
#endif
__device__ __forceinline__ float wave_scan_incl(float x) {
#define DPP_ADD(ctrl, rmask) x += __builtin_bit_cast(float, __builtin_amdgcn_update_dpp(0, __builtin_bit_cast(int, x), ctrl, rmask, 0xf, true))
    DPP_ADD(0x111, 0xf); DPP_ADD(0x112, 0xf); DPP_ADD(0x114, 0xf); DPP_ADD(0x118, 0xf);
    x += __builtin_bit_cast(float, __builtin_amdgcn_update_dpp(0, __builtin_bit_cast(int, x), 0x142, 0xa, 0xf, false));
    x += __builtin_bit_cast(float, __builtin_amdgcn_update_dpp(0, __builtin_bit_cast(int, x), 0x143, 0xc, 0xf, false));
#undef DPP_ADD
    return x;
}
constexpr int VIP = 144;
struct GlaPre { v4u la; v4u kq, qq, va, vb; };
template <bool FULL> __device__ __forceinline__ GlaPre gla_load(size_t r0, int h, const bf16* Q, const bf16* KK, const bf16* V, const bf16* LOGA, int tid, int wave, int lane) {
    GlaPre p; const size_t row = r0 + lane; const int kc0 = 8 * wave;
    p.la = *(const v4u*)(LOGA + row * GKEY + h * 64 + kc0);
    p.kq = *(const v4u*)(KK + row * GKEY + h * 64 + kc0); if (FULL) p.qq = *(const v4u*)(Q + row * GKEY + h * 64 + kc0); else p.qq = (v4u){0u, 0u, 0u, 0u};
    const int tp = tid & 31, vg = tid >> 5;
    p.va = *(const v4u*)(V + (r0 + 2 * tp) * GVAL + h * 128 + 8 * vg); p.vb = *(const v4u*)(V + (r0 + 2 * tp + 1) * GVAL + h * 128 + 8 * vg);
    return p;
}
template <bool FULL> __device__ __forceinline__ void gla_build(const GlaPre& p, LAS unsigned char* lds, int tid, int wave, int lane, float (&tot)[8]) {
    const int kc0 = 8 * wave; float b[8];
#pragma unroll
    for (int e = 0; e < 4; ++e) { b[2 * e] = bf2f(p.la[e] & 0xffffu); b[2 * e + 1] = bf2f(p.la[e] >> 16); }
#pragma unroll
    for (int j = 0; j < 8; ++j) b[j] = wave_scan_incl(b[j]);
    float kf[8], qf[8];
#pragma unroll
    for (int e = 0; e < 4; ++e) { kf[2 * e] = bf2f(p.kq[e] & 0xffffu); kf[2 * e + 1] = bf2f(p.kq[e] >> 16); qf[2 * e] = bf2f(p.qq[e] & 0xffffu); qf[2 * e + 1] = bf2f(p.qq[e] >> 16); }
    if (FULL) {
        float enb[8], eb[8], et[8], qt[8], kt[8], ke[8];
#pragma unroll
        for (int j = 0; j < 8; ++j) { tot[j] = __builtin_bit_cast(float, __builtin_amdgcn_readlane(__builtin_bit_cast(int, b[j]), 63));
            enb[j] = __builtin_amdgcn_exp2f(b[j] * -1.4426950408889634f); eb[j] = __builtin_amdgcn_rcpf(enb[j]);
            et[j] = __builtin_bit_cast(float, __builtin_amdgcn_readlane(__builtin_bit_cast(int, eb[j]), 63));
            qt[j] = qf[j] * eb[j]; kt[j] = kf[j] * enb[j]; ke[j] = kt[j] * et[j]; }
        v4u o; o.x = pk2(ke[0], ke[1]); o.y = pk2(ke[2], ke[3]); o.z = pk2(ke[4], ke[5]); o.w = pk2(ke[6], ke[7]); *(LAS v4u*)((LAS bf16*)(lds + L_KENDT) + lane * GP + kc0) = o;
        o.x = pk2(qt[0], qt[1]); o.y = pk2(qt[2], qt[3]); o.z = pk2(qt[4], qt[5]); o.w = pk2(qt[6], qt[7]); *(LAS v4u*)((LAS bf16*)(lds + L_QT) + lane * GP + kc0) = o;
        o.x = pk2(kt[0], kt[1]); o.y = pk2(kt[2], kt[3]); o.z = pk2(kt[4], kt[5]); o.w = pk2(kt[6], kt[7]); *(LAS v4u*)((LAS bf16*)(lds + L_KT) + lane * GP + kc0) = o;
        if (lane < 8) { float tl = et[0];
#pragma unroll
            for (int j = 1; j < 8; ++j) tl = (lane == j) ? et[j] : tl;
            ((LAS float*)(lds + L_DECS))[kc0 + lane] = tl; } }
    else { float ke[8];
#pragma unroll
      for (int j = 0; j < 8; ++j) { tot[j] = __builtin_bit_cast(float, __builtin_amdgcn_readlane(__builtin_bit_cast(int, b[j]), 63)); ke[j] = kf[j] * __expf(tot[j] - b[j]); }
      v4u o; o.x = pk2(ke[0], ke[1]); o.y = pk2(ke[2], ke[3]); o.z = pk2(ke[4], ke[5]); o.w = pk2(ke[6], ke[7]); *(LAS v4u*)((LAS bf16*)(lds + L_KENDT) + lane * GP + kc0) = o;
      if (lane < 8) { float tl = tot[0];
#pragma unroll
          for (int j = 1; j < 8; ++j) tl = (lane == j) ? tot[j] : tl;
          ((LAS float*)(lds + L_DECS))[kc0 + lane] = __expf(tl); } }
    { const int tp = tid & 31, vg = tid >> 5; LAS bf16* VI = (LAS bf16*)(lds + L_VT);
      *(LAS v4u*)(VI + (2 * tp) * VIP + 8 * vg) = p.va; *(LAS v4u*)(VI + (2 * tp + 1) * VIP + 8 * vg) = p.vb; }
}
__device__ __forceinline__ bf16x8 tr_frag(const LAS bf16* img, int pitch, int row0, int col0, int lane) {
    const int q = (lane & 15) >> 2, pp = lane & 3;
    const s16x4 lo = __builtin_amdgcn_ds_read_tr16_b64_v4i16((LAS s16x4*)(img + (row0 + q) * pitch + col0 + 4 * pp));
    const s16x4 hi = __builtin_amdgcn_ds_read_tr16_b64_v4i16((LAS s16x4*)(img + (row0 + 4 + q) * pitch + col0 + 4 * pp));
    return (bf16x8){lo[0], lo[1], lo[2], lo[3], hi[0], hi[1], hi[2], hi[3]};
}
__device__ __forceinline__ void gla_state_step(f32x4 (&S)[4], LAS unsigned char* lds, int wave, int fr, int fq) {
    const LAS bf16* VI = (const LAS bf16*)(lds + L_VT); const LAS bf16* KE = (const LAS bf16*)(lds + L_KENDT); const LAS float* DECS = (const LAS float*)(lds + L_DECS);
    const int lane = fr + 16 * fq;
    bf16x8 bv[2];
#pragma unroll
    for (int ks = 0; ks < 2; ++ks) bv[ks] = tr_frag(VI, VIP, 32 * ks + 8 * fq, 16 * wave, lane);
#pragma unroll
    for (int m = 0; m < 4; ++m) { const f32x4 d = *(const LAS f32x4*)(DECS + 16 * m + 4 * fq); S[m] = S[m] * d;
#pragma unroll
        for (int ks = 0; ks < 2; ++ks) S[m] = mfma16(tr_frag(KE, GP, 32 * ks + 8 * fq, 16 * m, lane), bv[ks], S[m]); }
}
__device__ __forceinline__ void gla_b1_item(int item, LAS unsigned char* lds, const bf16* KK, const bf16* V, const bf16* LOGA, float* CST, float* DEC, int tid, int wave, int lane) {
    const int b = item & 7, g = (item >> 3) & 7, h = item >> 6, fr = lane & 15, fq = lane >> 4;
    if (g == 7) return;
    f32x4 S[4]; float lsum[8];
#pragma unroll
    for (int m = 0; m < 4; ++m) S[m] = (f32x4){0.f, 0.f, 0.f, 0.f};
#pragma unroll
    for (int j = 0; j < 8; ++j) lsum[j] = 0.f;
    const size_t rg = (size_t)b * SEQ + (size_t)g * 256;
    GlaPre pre[4];
#pragma unroll
    for (int c = 0; c < 4; ++c) pre[c] = gla_load<false>(rg + (size_t)c * 64, h, nullptr, KK, V, LOGA, tid, wave, lane);
#pragma unroll
    for (int c = 0; c < 4; ++c) {
        float tot[8]; gla_build<false>(pre[c], lds, tid, wave, lane, tot);
#pragma unroll
        for (int j = 0; j < 8; ++j) lsum[j] += tot[j];
        LDS_BARRIER();
        gla_state_step(S, lds, wave, fr, fq);
        LDS_BARRIER();
    }
#pragma unroll
    for (int mp = 0; mp < 2; ++mp) { v4u w; w.x = pk2(S[2 * mp][0], S[2 * mp][1]); w.y = pk2(S[2 * mp][2], S[2 * mp][3]); w.z = pk2(S[2 * mp + 1][0], S[2 * mp + 1][1]); w.w = pk2(S[2 * mp + 1][2], S[2 * mp + 1][3]);
        *(v4u*)((bf16*)CST + (size_t)item * 8192 + (16 * wave + fr) * 64 + 16 * fq + 8 * mp) = w; }
    if (lane < 8) { float tl = lsum[0];
#pragma unroll
        for (int j = 1; j < 8; ++j) tl = (lane == j) ? lsum[j] : tl;
        DEC[(size_t)item * 64 + 8 * wave + lane] = tl; }
}
__device__ __forceinline__ void gla_b2_unit(int unit, LAS unsigned char* lds, const bf16* Q, const bf16* KK, const bf16* V, const bf16* LOGA, const float* CST, const float* DEC, const bf16* ZAI, bf16* ZAO, int tid, int wave, int lane) {
    const int b = unit & 7, g = (unit >> 3) & 7, h = unit >> 6, fr = lane & 15, fq = lane >> 4; const int ts_unit_ = unit; (void)ts_unit_;
    TS_BEGIN(1); TS_BEGIN(2);
    const size_t rg = (size_t)b * SEQ + (size_t)g * 256;
    const int ih = wave & 3, vh = wave >> 2;
    GlaPre pre[4]; v4u gt[4][2];
    f32x4 S[4];
#pragma unroll
    for (int m = 0; m < 4; ++m) S[m] = (f32x4){0.f, 0.f, 0.f, 0.f};
    { const size_t it0 = (size_t)unit - 8 * g;
      float dl = 0.f; if (tid < 64 * g) dl = DEC[(it0 + 8 * (tid >> 6)) * 64 + (tid & 63)];
      v4u cc[7][2];
#pragma unroll
      for (int j = 0; j < 7; ++j) if (j < g) {
#pragma unroll
          for (int mp = 0; mp < 2; ++mp) cc[j][mp] = *(const v4u*)((const bf16*)CST + (it0 + 8 * j) * 8192 + (16 * wave + fr) * 64 + 16 * fq + 8 * mp); }
#pragma unroll
      for (int c = 0; c < 2; ++c) pre[c] = gla_load<true>(rg + (size_t)c * 64, h, Q, KK, V, LOGA, tid, wave, lane);
      LAS float* DT = (LAS float*)(lds + L_QT);
      if (tid < 64 * g) DT[tid] = __expf(dl);
      LDS_BARRIER();
#pragma unroll
      for (int j = 0; j < 7; ++j) if (j < g) {
#pragma unroll
          for (int m = 0; m < 4; ++m) { const f32x4 d = *(const LAS f32x4*)(DT + j * 64 + 16 * m + 4 * fq);
              const unsigned c0 = cc[j][m >> 1][2 * (m & 1)], c1 = cc[j][m >> 1][2 * (m & 1) + 1];
              const f32x4 c = (f32x4){bf2f(c0 & 0xffffu), bf2f(c0 >> 16), bf2f(c1 & 0xffffu), bf2f(c1 >> 16)}; S[m] = d * S[m] + c; } }
      LDS_BARRIER(); }
#define GLA_GT(c_) do { _Pragma("unroll") for (int hv = 0; hv < 2; ++hv) gt[c_][hv] = *(const v4u*)(ZAI + (rg + (size_t)(c_) * 64 + 16 * ih + fr) * ZPITCH + h * 128 + 64 * vh + 16 * fq + 8 * hv); } while (0)
    GLA_GT(0); GLA_GT(1);
    TS_END(2);
    const LAS bf16* QT = (const LAS bf16*)(lds + L_QT); const LAS bf16* KT = (const LAS bf16*)(lds + L_KT);
    const LAS bf16* VT = (const LAS bf16*)(lds + L_VT); LAS bf16* ST = (LAS bf16*)(lds + L_ST); LAS float* RED = (LAS float*)(lds + L_RED);
#pragma unroll
    for (int c = 0; c < 4; ++c) {
        TS_BEGIN(3);
        const size_t r0 = rg + (size_t)c * 64;
#pragma unroll
        for (int m = 0; m < 4; ++m) { v2u w; w.x = pk2(S[m][0], S[m][1]); w.y = pk2(S[m][2], S[m][3]); *(LAS v2u*)(ST + (16 * wave + fr) * GP + 16 * m + 4 * fq) = w; }
        float tot[8]; gla_build<true>(pre[c], lds, tid, wave, lane, tot);
        if (c + 2 < 4) { pre[c + 2] = gla_load<true>(rg + (size_t)(c + 2) * 64, h, Q, KK, V, LOGA, tid, wave, lane); GLA_GT(c + 2); }
        LDS_BARRIER();
        TS_END(3); TS_BEGIN(4);
        bf16x8 bq[2];
#pragma unroll
        for (int ks = 0; ks < 2; ++ks) bq[ks] = *(const LAS bf16x8*)(QT + (16 * ih + fr) * GP + 32 * ks + 8 * fq);
        f32x4 X[4];
#pragma unroll
        for (int jt = 0; jt < 4; ++jt) { X[jt] = (f32x4){0.f, 0.f, 0.f, 0.f};
            if (jt <= ih) {
#pragma unroll
                for (int ks = 0; ks < 2; ++ks) X[jt] = mfma16(*(const LAS bf16x8*)(KT + (16 * jt + fr) * GP + 32 * ks + 8 * fq), bq[ks], X[jt]);
#pragma unroll
                for (int r = 0; r < 4; ++r) if (16 * jt + 4 * fq + r > 16 * ih + fr) X[jt][r] = 0.f; } }
        bf16x8 xb[2];
#pragma unroll
        for (int k2 = 0; k2 < 2; ++k2) { v4u w; w.x = pk2(X[2 * k2][0], X[2 * k2][1]); w.y = pk2(X[2 * k2][2], X[2 * k2][3]); w.z = pk2(X[2 * k2 + 1][0], X[2 * k2 + 1][1]); w.w = pk2(X[2 * k2 + 1][2], X[2 * k2 + 1][3]); xb[k2] = __builtin_bit_cast(bf16x8, w); }
        f32x4 O[4]; float ss = 0.f;
#pragma unroll
        for (int mt = 0; mt < 4; ++mt) { const int v = 64 * vh + 16 * (fr >> 2) + 4 * mt + (fr & 3); f32x4 o = (f32x4){0.f, 0.f, 0.f, 0.f};
#pragma unroll
            for (int k2 = 0; k2 < 2; ++k2) {
                const int q = fr >> 2, pp = fr & 3; const int v0 = 64 * vh + 16 * pp + 4 * mt;
                const s16x4 lo = __builtin_amdgcn_ds_read_tr16_b64_v4i16((LAS s16x4*)(VT + (32 * k2 + 4 * fq + q) * VIP + v0));
                const s16x4 hi = __builtin_amdgcn_ds_read_tr16_b64_v4i16((LAS s16x4*)(VT + (32 * k2 + 16 + 4 * fq + q) * VIP + v0));
                o = mfma16((bf16x8){lo[0], lo[1], lo[2], lo[3], hi[0], hi[1], hi[2], hi[3]}, xb[k2], o); }
#pragma unroll
            for (int ks = 0; ks < 2; ++ks) o = mfma16(*(const LAS bf16x8*)(ST + v * GP + 32 * ks + 8 * fq), bq[ks], o);
            O[mt] = o; ss += (o[0] * o[0] + o[1] * o[1]) + (o[2] * o[2] + o[3] * o[3]); }
        ss += __shfl_xor(ss, 16); ss += __shfl_xor(ss, 32);
        if (fq == 0) RED[(vh * 4 + ih) * 16 + fr] = ss;
        gla_state_step(S, lds, wave, fr, fq);
        LDS_BARRIER();
        TS_END(4); TS_BEGIN(5);
        const float rs = rsqrtf((RED[ih * 16 + fr] + RED[(4 + ih) * 16 + fr]) * (1.f / 128.f) + EPS);
        { const size_t row = r0 + 16 * ih + fr;
#pragma unroll
          for (int hv = 0; hv < 2; ++hv) { const v4u g = gt[c][hv]; v4u o;
              o.x = pk2(O[2 * hv][0] * rs * bf2f(g.x & 0xffffu), O[2 * hv][1] * rs * bf2f(g.x >> 16)); o.y = pk2(O[2 * hv][2] * rs * bf2f(g.y & 0xffffu), O[2 * hv][3] * rs * bf2f(g.y >> 16));
              o.z = pk2(O[2 * hv + 1][0] * rs * bf2f(g.z & 0xffffu), O[2 * hv + 1][1] * rs * bf2f(g.z >> 16)); o.w = pk2(O[2 * hv + 1][2] * rs * bf2f(g.w & 0xffffu), O[2 * hv + 1][3] * rs * bf2f(g.w >> 16));
              *(v4u*)(ZAO + row * ZPITCH + h * 128 + 64 * vh + 16 * fq + 8 * hv) = o; } }
        TS_END(5);
    }
    LDS_BARRIER();
    TS_END(1);
#undef GLA_GT
}
using pg8::Unit;
__device__ __forceinline__ void row_rstd(const float* SSQ, int pm, int wr, int fr, int fq, float (&rsd)[2][4]) {
    const int lane = fr + 16 * fq;
#pragma unroll
    for (int ai = 0; ai < 2; ++ai) { const size_t row = (size_t)pm * 256 + ai * 128 + wr * 64 + lane; const f32x4* p = (const f32x4*)(SSQ + row * 16); const f32x4 a = p[0], b = p[1], c = p[2], d = p[3];
        const float s = ((a[0] + a[1]) + (a[2] + a[3])) + ((b[0] + b[1]) + (b[2] + b[3])) + ((c[0] + c[1]) + (c[2] + c[3])) + ((d[0] + d[1]) + (d[2] + d[3]));
        const float rs = rsqrtf(s * (1.f / D) + EPS);
#pragma unroll
        for (int m = 0; m < 4; ++m) rsd[ai][m] = __shfl(rs, 16 * m + fr); }
}
__device__ __forceinline__ void rstd_table_fill(const float* SSQ, int pm, LAS unsigned char* lds, int tid) {
    LAS float* T = (LAS float*)(lds + RST_OFF) + (pm & 7) * 256;
    if (tid < 256) { const f32x4* p = (const f32x4*)(SSQ + ((size_t)pm * 256 + tid) * 16); const f32x4 a = p[0], b = p[1], c = p[2], d = p[3];
        const float s = ((a[0] + a[1]) + (a[2] + a[3])) + ((b[0] + b[1]) + (b[2] + b[3])) + ((c[0] + c[1]) + (c[2] + c[3])) + ((d[0] + d[1]) + (d[2] + d[3]));
        T[tid] = rsqrtf(s * (1.f / D) + EPS); }
    LDS_BARRIER();
}
__device__ __forceinline__ void row_rstd_tbl(const LAS unsigned char* lds, int pm, int wr, int fr, float (&rsd)[2][4]) {
    const LAS float* T = (const LAS float*)(lds + RST_OFF) + (pm & 7) * 256 + wr * 64 + fr;
#pragma unroll
    for (int ai = 0; ai < 2; ++ai)
#pragma unroll
        for (int m = 0; m < 4; ++m) rsd[ai][m] = T[ai * 128 + m * 16];
}
struct EpiA {
    static constexpr bool PERM = true, AFTER_DRAIN = false, MIDHOOK = false, APERM = false; static constexpr int TSID = 21;
    unsigned char* act0; const float* SSQ; float* SVST; const float* bal; LAS unsigned char* lds; bool tbl;
    template <int mode>
    __device__ __forceinline__ void body(const f32x4 (&acc)[2][2][4][2], const Unit& u, int wr, int wc, int fr, int fq, const float (&rsd)[2][4], size_t boff, int ldc, int colt) const {
        const int pn = u.pn; const int col0 = colt + wc * 32 + 8 * fq;
#pragma unroll
        for (int ai = 0; ai < 2; ++ai)
#pragma unroll
            for (int m = 0; m < 4; ++m) { const size_t row = (size_t)u.pm * 256 + ai * 128 + wr * 64 + m * 16 + fr; const float rs = rsd[ai][m]; float s1 = 0.f, s2 = 0.f; unsigned gq[2] = {0u, 0u}; float uq[8] = {0.f, 0.f, 0.f, 0.f, 0.f, 0.f, 0.f, 0.f};
#pragma unroll
                for (int bj = 0; bj < 2; ++bj) { const f32x4 a0 = acc[ai][bj][m][0] * rs, a1 = acc[ai][bj][m][1] * rs; float v[8] = {a0[0], a0[1], a0[2], a0[3], a1[0], a1[1], a1[2], a1[3]};
                    if (mode == 4) { const f32x4 b0 = *(const f32x4*)(bal + col0 + bj * 128), b1 = *(const f32x4*)(bal + col0 + bj * 128 + 4); f32x4 o0, o1;
#pragma unroll
                        for (int e = 0; e < 4; ++e) { o0[e] = flogsig(v[e] + b0[e]) * 0.0625f; o1[e] = flogsig(v[4 + e] + b1[e]) * 0.0625f; }
                        v4u o; o.x = pk2(o0[0], o0[1]); o.y = pk2(o0[2], o0[3]); o.z = pk2(o1[0], o1[1]); o.w = pk2(o1[2], o1[3]); *(v4u*)((bf16*)(act0 + boff) + row * 256 + col0 + bj * 128) = o; }
                    else {
                        if (mode == 1 || mode == 2 || mode == 3) {
                            constexpr float K1 = -1.5957691216057308f * 1.4426950408889634f, K2 = K1 * 0.044715f;
#pragma unroll
                            for (int hh = 0; hh < 2; ++hh) { const f32x4 z = hh ? a1 : a0; const f32x4 t = mode == 1 ? z * -1.4426950408889634f : z * (z * z * K2 + K1); f32x4 d;
#pragma unroll
                                for (int e = 0; e < 4; ++e) d[e] = __builtin_amdgcn_exp2f(t[e]);
                                d = d + 1.f; f32x4 r;
#pragma unroll
                                for (int e = 0; e < 4; ++e) r[e] = __builtin_amdgcn_rcpf(d[e]);
                                const f32x4 o = z * r;
#pragma unroll
                                for (int e = 0; e < 4; ++e) v[4 * hh + e] = o[e]; } }
                        else if (mode == 7) {
                            if (bj == 0) {
#pragma unroll
                                for (int e = 0; e < 8; ++e) uq[e] = v[e]; }
                            else { v4u o; o.x = pk2(uq[0] * v[0], uq[1] * v[1]); o.y = pk2(uq[2] * v[2], uq[3] * v[3]); o.z = pk2(uq[4] * v[4], uq[5] * v[5]); o.w = pk2(uq[6] * v[6], uq[7] * v[7]);
                                *(v4u*)((bf16*)(act0 + boff) + row * ldc + colt + wc * 32 + 8 * fq) = o; }
                            continue; }
                        else if (mode == 5) {
                            unsigned w0 = 0u, w1 = 0u;
                            const float rsl = rs * -1.4426950408889634f; const f32x4 t0 = acc[ai][bj][m][0] * rsl, t1 = acc[ai][bj][m][1] * rsl;
#pragma unroll
                            for (int e = 0; e < 4; ++e) {
                                const float y0 = __builtin_amdgcn_rcpf(__builtin_amdgcn_fmed3f(__builtin_fmaf(__builtin_amdgcn_exp2f(t0[e]), 1.f / 255.f, 1.f / 255.f), 0.f, 1.f)), y1 = __builtin_amdgcn_rcpf(__builtin_amdgcn_fmed3f(__builtin_fmaf(__builtin_amdgcn_exp2f(t1[e]), 1.f / 255.f, 1.f / 255.f), 0.f, 1.f));
                                w0 = __builtin_amdgcn_cvt_pk_u8_f32(y0, e, w0); w1 = __builtin_amdgcn_cvt_pk_u8_f32(y1, e, w1); }
                            if (bj == 0) { gq[0] = w0; gq[1] = w1; } else *(v4u*)((unsigned char*)(act0 + boff) + row * ldc + colt + wc * 64 + fq * 16) = (v4u){gq[0], gq[1], w0, w1};
                            continue; }
                        if (mode == 3) {
#pragma unroll
                            for (int e = 0; e < 8; ++e) { s1 += v[e]; s2 += v[e] * v[e]; } }
                        v4u o; o.x = pk2(v[0], v[1]); o.y = pk2(v[2], v[3]); o.z = pk2(v[4], v[5]); o.w = pk2(v[6], v[7]);
                        *(v4u*)((bf16*)(act0 + boff) + row * ldc + col0 + bj * 128) = o; } }
                if (mode == 3) { s1 += __shfl_xor(s1, 16); s1 += __shfl_xor(s1, 32); s2 += __shfl_xor(s2, 16); s2 += __shfl_xor(s2, 32);
                    if (fq == 0) *(f32x2*)(SVST + row * 16 + ((pn - 9) * 4 + wc) * 2) = (f32x2){s1, s2}; } }
    }
    __device__ __forceinline__ void operator()(const f32x4 (&acc)[2][2][4][2], const Unit& u, int wr, int wc, int fr_, int fq_) const {
        int ln_; asm volatile("v_mbcnt_lo_u32_b32 %0, -1, 0\n\tv_mbcnt_hi_u32_b32 %0, -1, %0" : "=v"(ln_)); const int fr = ln_ & 15, fq = ln_ >> 4; (void)fr_; (void)fq_;
        float rsd[2][4]; if (tbl) row_rstd_tbl(lds, u.pm, wr, fr, rsd); else row_rstd(SSQ, u.pm, wr, fr, fq, rsd);
        const int pn = u.pn;
        if (pn < 1) body<0>(acc, u, wr, wc, fr, fq, rsd, A_Q, 256, 0); else if (pn < 2) body<0>(acc, u, wr, wc, fr, fq, rsd, A_K, 256, 0); else if (pn < 4) body<0>(acc, u, wr, wc, fr, fq, rsd, A_V, 512, (pn - 2) * 256);
        else if (pn < 6) body<1>(acc, u, wr, wc, fr, fq, rsd, A_Z, ZPITCH, (pn - 4) * 256); else if (pn < 7) body<4>(acc, u, wr, wc, fr, fq, rsd, A_LOGA, 256, 0);
        else if (pn < 9) body<2>(acc, u, wr, wc, fr, fq, rsd, A_Z, ZPITCH, 512 + (pn - 7) * 256); else if (pn < 11) body<3>(acc, u, wr, wc, fr, fq, rsd, A_SV, 512, (pn - 9) * 256);
        else if (pn < 13) body<0>(acc, u, wr, wc, fr, fq, rsd, A_Z, ZPITCH, 1024 + (pn - 11) * 256); else if (pn < 17) body<7>(acc, u, wr, wc, fr, fq, rsd, A_CC, 512, (pn - 13) * 128); else body<5>(acc, u, wr, wc, fr, fq, rsd, A_G, 3072, (pn - 17) * 256);
    }
};
struct EpiC {
    static constexpr bool PERM = true, AFTER_DRAIN = false, MIDHOOK = true, APERM = false; static constexpr int TSID = 23, HOOK_T1 = 8, HOOK_T2 = 16;
    const unsigned char* G; bf16* MG;
    __device__ __forceinline__ void mid(f32x4 (&acc)[2][2][4][2], const Unit& u, int t, int wr, int wc) const {
        int ln_; asm volatile("v_mbcnt_lo_u32_b32 %0, -1, 0\n\tv_mbcnt_hi_u32_b32 %0, -1, %0" : "=v"(ln_)); const int fr = ln_ & 15, fq = ln_ >> 4;
        const int br = t >> 3;
        const int goff = u.pn * 256 + wc * 64 + fq * 16;
        v4u ga[2][4], gb[2][4];
#pragma unroll
        for (int ai = 0; ai < 2; ++ai)
#pragma unroll
            for (int m = 0; m < 4; ++m) { const unsigned char* gp = G + ((size_t)u.pm * 256 + ai * 128 + wr * 64 + m * 16 + fr) * 3072 + (br - 1) * 1024 + goff;
                ga[ai][m] = *(const v4u*)gp; gb[ai][m] = *(const v4u*)(gp + 1024); }
#pragma unroll
        for (int ai = 0; ai < 2; ++ai)
#pragma unroll
            for (int m = 0; m < 4; ++m)
#pragma unroll
                for (int bj = 0; bj < 2; ++bj)
#pragma unroll
                    for (int n = 0; n < 2; ++n) { const unsigned a = ga[ai][m][2 * bj + n], b = gb[ai][m][2 * bj + n];
#pragma unroll
                        for (int e = 0; e < 4; ++e) acc[ai][bj][m][n][e] *= (float)((a >> (8 * e)) & 0xffu) * __builtin_amdgcn_rcpf((float)((b >> (8 * e)) & 0xffu)); }
    }
    __device__ __forceinline__ void operator()(const f32x4 (&acc)[2][2][4][2], const Unit& u, int wr, int wc, int fr_, int fq_) const {
        int ln_; asm volatile("v_mbcnt_lo_u32_b32 %0, -1, 0\n\tv_mbcnt_hi_u32_b32 %0, -1, %0" : "=v"(ln_)); const int fr = ln_ & 15, fq = ln_ >> 4; (void)fr_; (void)fq_;
        const int col0 = u.pn * 256 + wc * 32 + 8 * fq, goff = u.pn * 256 + wc * 64 + fq * 16;
        v4u gt[2][4];
#pragma unroll
        for (int ai = 0; ai < 2; ++ai)
#pragma unroll
            for (int m = 0; m < 4; ++m) gt[ai][m] = *(const v4u*)(G + ((size_t)u.pm * 256 + ai * 128 + wr * 64 + m * 16 + fr) * 3072 + 2048 + goff);
#pragma unroll
        for (int ai = 0; ai < 2; ++ai)
#pragma unroll
            for (int m = 0; m < 4; ++m) { const size_t row = (size_t)u.pm * 256 + ai * 128 + wr * 64 + m * 16 + fr;
#pragma unroll
                for (int bj = 0; bj < 2; ++bj) { const f32x4 a0 = acc[ai][bj][m][0], a1 = acc[ai][bj][m][1]; float v[8] = {a0[0], a0[1], a0[2], a0[3], a1[0], a1[1], a1[2], a1[3]};
#pragma unroll
                    for (int e = 0; e < 4; ++e) { v[e] *= (float)((gt[ai][m][2 * bj] >> (8 * e)) & 0xffu); v[4 + e] *= (float)((gt[ai][m][2 * bj + 1] >> (8 * e)) & 0xffu); }
                    v4u o; o.x = pk2(v[0], v[1]); o.y = pk2(v[2], v[3]); o.z = pk2(v[4], v[5]); o.w = pk2(v[6], v[7]); *(v4u*)(MG + row * 1024 + col0 + bj * 128) = o; } }
    }
};
template <int VAR> struct EpiResT {
    static constexpr bool PERM = true, AFTER_DRAIN = false, MIDHOOK = false, APERM = false; static constexpr int TSID = 24;
    const bf16* XI; bf16* XB; float* SSQ;
    __device__ __forceinline__ void operator()(const f32x4 (&acc)[2][2][4][2], const Unit& u, int wr, int wc, int fr_, int fq_) const {
        int ln_; asm volatile("v_mbcnt_lo_u32_b32 %0, -1, 0\n\tv_mbcnt_hi_u32_b32 %0, -1, %0" : "=v"(ln_)); const int fr = ln_ & 15, fq = ln_ >> 4; (void)fr_; (void)fq_;
        const int col0 = u.pn * 256 + wc * 32 + 8 * fq;
        v4u xo[2][4][2];
#pragma unroll
        for (int ai = 0; ai < 2; ++ai)
#pragma unroll
            for (int m = 0; m < 4; ++m)
#pragma unroll
                for (int bj = 0; bj < 2; ++bj) xo[ai][m][bj] = *(const v4u*)(XI + ((size_t)u.pm * 256 + ai * 128 + wr * 64 + m * 16 + fr) * D + col0 + bj * 128);
#pragma unroll
        for (int ai = 0; ai < 2; ++ai)
#pragma unroll
            for (int m = 0; m < 4; ++m) { const size_t row = (size_t)u.pm * 256 + ai * 128 + wr * 64 + m * 16 + fr; float ss = 0.f;
#pragma unroll
                for (int bj = 0; bj < 2; ++bj) { const size_t off = row * D + col0 + bj * 128; const f32x4 a0 = acc[ai][bj][m][0], a1 = acc[ai][bj][m][1];
                    float v[8] = {a0[0], a0[1], a0[2], a0[3], a1[0], a1[1], a1[2], a1[3]};
#pragma unroll
                    for (int e = 0; e < 4; ++e) { v[2 * e] += bf2f(xo[ai][m][bj][e] & 0xffffu); v[2 * e + 1] += bf2f(xo[ai][m][bj][e] >> 16); }
#pragma unroll
                    for (int e = 0; e < 8; ++e) ss += v[e] * v[e];
                    v4u o; o.x = pk2(v[0], v[1]); o.y = pk2(v[2], v[3]); o.z = pk2(v[4], v[5]); o.w = pk2(v[6], v[7]); if (VAR != 1 || ss == 12345.678f) *(v4u*)(XB + off) = o; }
                if (VAR == 0) { ss += __shfl_xor(ss, 16); ss += __shfl_xor(ss, 32);
                if (fq == 0) SSQ[row * 16 + u.pn * 4 + wc] = ss; } }
    }
};
typedef EpiResT<0> EpiRes;
__device__ __forceinline__ float dpp_f(float old, float src, const int ctrl_sel) {
    const int o = __builtin_bit_cast(int, old), v = __builtin_bit_cast(int, src); int r;
    if (ctrl_sel == 0) r = __builtin_amdgcn_update_dpp(o, v, 0x111, 0xf, 0xf, false);
    else if (ctrl_sel == 1) r = __builtin_amdgcn_update_dpp(o, v, 0x112, 0xf, 0xf, false);
    else if (ctrl_sel == 2) r = __builtin_amdgcn_update_dpp(o, v, 0x121, 0xf, 0xf, false);
    else r = __builtin_amdgcn_update_dpp(o, v, 0x122, 0xf, 0xf, false);
    return __builtin_bit_cast(float, r);
}
constexpr int XL_OFF = RING_BYTES + 1024;
struct EpiUpConv {
    static constexpr bool PERM = true, AFTER_DRAIN = false, MIDHOOK = false, APERM = true; static constexpr int TSID = 22;
    unsigned char* ws; const float* cw; const float* cb; LAS unsigned char* lds; bool tbl;
    __device__ __forceinline__ void operator()(const f32x4 (&acc)[2][2][4][2], const Unit& u, int wr, int wc, int fr_, int fq_) const {
        int ln_; asm volatile("v_mbcnt_lo_u32_b32 %0, -1, 0\n\tv_mbcnt_hi_u32_b32 %0, -1, %0" : "=v"(ln_)); const int fr = ln_ & 15, fq = ln_ >> 4; (void)fr_; (void)fq_;
        bf16* ACT = (bf16*)(ws + WS_ACT0 + A_ACT); const float* SSQ = (const float*)(ws + WS_SSQ); float* HT = (float*)(ws + WS_ACT0 + A_HT);
        float rsd[2][4];
        if (tbl) { const LAS f32x4* T = (const LAS f32x4*)((const LAS float*)(lds + RST_OFF) + (u.pm & 7) * 256 + wr * 64 + 4 * fr);
#pragma unroll
            for (int ai = 0; ai < 2; ++ai) { const f32x4 t = T[ai * 32];
#pragma unroll
                for (int m = 0; m < 4; ++m) rsd[ai][m] = t[m]; } }
        else {
#pragma unroll
            for (int ai = 0; ai < 2; ++ai) { const size_t row = (size_t)u.pm * 256 + ai * 128 + wr * 64 + ln_; const f32x4* p = (const f32x4*)(SSQ + row * 16); const f32x4 a = p[0], b = p[1], c = p[2], d = p[3];
                const float s = ((a[0] + a[1]) + (a[2] + a[3])) + ((b[0] + b[1]) + (b[2] + b[3])) + ((c[0] + c[1]) + (c[2] + c[3])) + ((d[0] + d[1]) + (d[2] + d[3]));
                const float rs = rsqrtf(s * (1.f / D) + EPS);
#pragma unroll
                for (int m = 0; m < 4; ++m) rsd[ai][m] = __shfl(rs, 4 * fr + m); } }
        LAS f32x4* XL = (LAS f32x4*)(lds + XL_OFF);
        const int tcol = u.pn * 256 + wc * 32 + 8 * fq;
        const int ch0 = u.pn * 128 + wc * 32 + 8 * fq; const bool batch_start = (u.pm & 7) == 0;
        f32x4 wgp[3], wvp[3], bgp, bvp;
#pragma unroll
        for (int k = 0; k < 3; ++k) { wgp[k] = *(const f32x4*)(cw + k * DFF2 + ch0); wvp[k] = *(const f32x4*)(cw + k * DFF2 + DFF + ch0); }
        bgp = *(const f32x4*)(cb + ch0); bvp = *(const f32x4*)(cb + DFF + ch0);
#pragma unroll
        for (int ai = 0; ai < 2; ++ai)
#pragma unroll
            for (int bj = 0; bj < 2; ++bj)
#pragma unroll
                for (int n = 0; n < 2; ++n) {
                    if (fr == 15) { const f32x4 h2 = acc[ai][bj][2][n] * rsd[ai][2], h3 = acc[ai][bj][3][n] * rsd[ai][3]; const int xi = ((((ai * 2 + wr) * 4 + wc) * 2 + bj) * 2 + n) * 8 + fq * 2; XL[xi] = h2; XL[xi + 1] = h3;
                        if (ai == 1 && wr == 1) { *(f32x4*)(HT + ((size_t)(u.pm * 2 + 1) * 2 + 0) * DFF2 + tcol + bj * 128 + 4 * n) = h2; *(f32x4*)(HT + ((size_t)(u.pm * 2 + 1) * 2 + 1) * DFF2 + tcol + bj * 128 + 4 * n) = h3; } }
                    if (ai == 0 && wr == 0 && fr == 0) { *(f32x4*)(HT + ((size_t)(u.pm * 2 + 0) * 2 + 0) * DFF2 + tcol + bj * 128 + 4 * n) = acc[0][bj][0][n] * rsd[0][0]; *(f32x4*)(HT + ((size_t)(u.pm * 2 + 0) * 2 + 1) * DFF2 + tcol + bj * 128 + 4 * n) = acc[0][bj][1][n] * rsd[0][1]; } }
        asm volatile("s_waitcnt lgkmcnt(0)" ::: "memory"); __builtin_amdgcn_s_barrier(); asm volatile("" ::: "memory");
        v2u zp[2][4];
#pragma unroll
        for (int n = 0; n < 2; ++n) {
            asm volatile("" ::: "memory");
            f32x4 wg[3], wv[3], bg, bv;
            if (n == 0) {
#pragma unroll
                for (int k = 0; k < 3; ++k) { wg[k] = wgp[k]; wv[k] = wvp[k]; }
                bg = bgp; bv = bvp; }
            else {
#pragma unroll
                for (int k = 0; k < 3; ++k) { wg[k] = *(const f32x4*)(cw + k * DFF2 + ch0 + 4); wv[k] = *(const f32x4*)(cw + k * DFF2 + DFF + ch0 + 4); }
                bg = *(const f32x4*)(cb + ch0 + 4); bv = *(const f32x4*)(cb + DFF + ch0 + 4); }
#pragma unroll
            for (int ai = 0; ai < 2; ++ai) {
                f32x4 pg62 = (f32x4){0.f, 0.f, 0.f, 0.f}, pg63 = pg62, pv62 = pg62, pv63 = pg62;
                if (!(ai == 0 && wr == 0)) { const int pb = ai * 2 + wr - 1; const LAS f32x4* q = XL + ((((pb * 4 + wc) * 2 + 0) * 2 + n) * 8 + fq * 2); const LAS f32x4* qv = XL + ((((pb * 4 + wc) * 2 + 1) * 2 + n) * 8 + fq * 2);
                    pg62 = q[0]; pg63 = q[1]; pv62 = qv[0]; pv63 = qv[1]; }
                f32x4 hg[4], hv[4];
#pragma unroll
                for (int m = 0; m < 4; ++m) { hg[m] = acc[ai][0][m][n] * rsd[ai][m]; hv[m] = acc[ai][1][m][n] * rsd[ai][m]; }
                f32x4 g2p, g3p, v2p, v3p;
#pragma unroll
                for (int e = 0; e < 4; ++e) { g2p[e] = dpp_f(pg62[e], hg[2][e], 0); g3p[e] = dpp_f(pg63[e], hg[3][e], 0); v2p[e] = dpp_f(pv62[e], hv[2][e], 0); v3p[e] = dpp_f(pv63[e], hv[3][e], 0); }
#pragma unroll
                for (int m = 0; m < 4; ++m) { const f32x4 g1 = m >= 1 ? hg[m - (m >= 1)] : g3p, g2 = m >= 2 ? hg[m - 2 * (m >= 2)] : (m == 1 ? g3p : g2p);
                    const f32x4 v1 = m >= 1 ? hv[m - (m >= 1)] : v3p, v2 = m >= 2 ? hv[m - 2 * (m >= 2)] : (m == 1 ? v3p : v2p);
                    f32x4 z;
#pragma unroll
                    for (int eh = 0; eh < 2; ++eh) {
#define P2(v_) ((f32x2){(v_)[2 * eh], (v_)[2 * eh + 1]})
                        f32x2 ga = P2(wg[2]) * P2(hg[m]) + P2(bg), va = P2(wv[2]) * P2(hv[m]) + P2(bv);
                        ga = P2(wg[1]) * P2(g1) + ga; va = P2(wv[1]) * P2(v1) + va; ga = P2(wg[0]) * P2(g2) + ga; va = P2(wv[0]) * P2(v2) + va;
#undef P2
                        const f32x2 tt = ga * -1.4426950408889634f; f32x2 dd = (f32x2){__builtin_amdgcn_exp2f(tt[0]), __builtin_amdgcn_exp2f(tt[1])} + 1.f;
                        const f32x2 rr = (f32x2){__builtin_amdgcn_rcpf(dd[0]), __builtin_amdgcn_rcpf(dd[1])}, zz = (ga * rr) * va;
                        z[2 * eh] = zz[0]; z[2 * eh + 1] = zz[1]; }
                    const size_t row = (size_t)u.pm * 256 + ai * 128 + wr * 64 + 4 * fr + m;
                    const bool skip = (ai == 0 && wr == 0 && m < 2 && fr == 0 && !batch_start);
                    if (n == 0) { zp[ai][m].x = pk2(z[0], z[1]); zp[ai][m].y = pk2(z[2], z[3]); }
                    else if (!skip) { v4u o; o.x = zp[ai][m].x; o.y = zp[ai][m].y; o.z = pk2(z[0], z[1]); o.w = pk2(z[2], z[3]); *(v4u*)(ACT + row * DFF + ch0) = o; } } } }
    }
};
__device__ __forceinline__ void ffn_fixup(int pm, const float* HT, bf16* ACT, const float* cw, const float* cb, int tid) {
    if ((pm & 7) == 0) return;
#pragma unroll
    for (int it_ = 0; it_ < 3; ++it_) { const int it = tid + it_ * NTHREADS; if (it >= 2 * (DFF / 4)) break;
        const int rr = it / (DFF / 4), j = (it % (DFF / 4)) * 4, tc = (j >> 7) * 256 + (j & 127);
        const float* h0 = HT + ((size_t)(pm * 2 + 0) * 2 + rr) * DFF2;
        const float* h1 = rr ? HT + ((size_t)(pm * 2 + 0) * 2 + 0) * DFF2 : HT + ((size_t)((pm - 1) * 2 + 1) * 2 + 1) * DFF2;
        const float* h2 = rr ? HT + ((size_t)((pm - 1) * 2 + 1) * 2 + 1) * DFF2 : HT + ((size_t)((pm - 1) * 2 + 1) * 2 + 0) * DFF2;
        const f32x4 g0 = *(const f32x4*)(h0 + tc), g1 = *(const f32x4*)(h1 + tc), g2 = *(const f32x4*)(h2 + tc), v0 = *(const f32x4*)(h0 + tc + 128), v1 = *(const f32x4*)(h1 + tc + 128), v2 = *(const f32x4*)(h2 + tc + 128);
        const f32x4 ga = *(const f32x4*)(cw + j) * g2 + *(const f32x4*)(cw + DFF2 + j) * g1 + *(const f32x4*)(cw + 2 * DFF2 + j) * g0 + *(const f32x4*)(cb + j);
        const f32x4 va = *(const f32x4*)(cw + DFF + j) * v2 + *(const f32x4*)(cw + DFF2 + DFF + j) * v1 + *(const f32x4*)(cw + 2 * DFF2 + DFF + j) * v0 + *(const f32x4*)(cb + DFF + j);
        v2u o; o.x = pk2(fsilu(ga[0]) * va[0], fsilu(ga[1]) * va[1]); o.y = pk2(fsilu(ga[2]) * va[2], fsilu(ga[3]) * va[3]);
        *(v2u*)(ACT + ((size_t)pm * 256 + rr) * DFF + j) = o; }
    asm volatile("s_waitcnt vmcnt(0)" ::: "memory"); __syncthreads();
}

template <bool P> struct EpiNull {
    static constexpr bool PERM = P, AFTER_DRAIN = false, MIDHOOK = false, APERM = false; static constexpr int TSID = 26; float* sink;
    __device__ __forceinline__ void operator()(const f32x4 (&acc)[2][2][4][2], const Unit& u, int wr, int wc, int fr, int fq) const {
        f32x4 s = (f32x4){0.f, 0.f, 0.f, 0.f};
#pragma unroll
        for (int ai = 0; ai < 2; ++ai)
#pragma unroll
            for (int bj = 0; bj < 2; ++bj)
#pragma unroll
                for (int m = 0; m < 4; ++m)
#pragma unroll
                    for (int n = 0; n < 2; ++n) s += acc[ai][bj][m][n];
        if (s[0] + s[1] + s[2] + s[3] == 12345.678f) sink[u.pm + wr + wc + fr + fq] = s[0];
    }
};
#define XB_TMO      128
#define XB_XCNT(j)  (256  + 64 * (j))
#define XB_XSUB(j)  (1280 + 64 * (j))
#define XB_XGEN(j)  (2304 + 64 * (j))
#define XB_TOP      3328
#define XB_TOPGEN   3392
#define XCD_BAR_WORDS 3456
#define XB_SPIN_CAP (1u << 18)

__device__ __forceinline__ unsigned xb_ld(unsigned* p)              { return __hip_atomic_load(p, __ATOMIC_RELAXED, __HIP_MEMORY_SCOPE_AGENT); }
__device__ __forceinline__ unsigned xb_add(unsigned* p, unsigned v) { return __hip_atomic_fetch_add(p, v, __ATOMIC_RELAXED, __HIP_MEMORY_SCOPE_AGENT); }
__device__ __forceinline__ unsigned xb_xcc_id() { return (unsigned)__builtin_amdgcn_s_getreg((3 << 11) | 20) & 0xFu; }
#define XB_SPIN(cond, bar) do { unsigned _sp = 0; while (cond) { __builtin_amdgcn_s_sleep(1); \
    if ((++_sp & 255u) == 0u) { if (xb_ld(&(bar)[XB_TMO])) break; if (_sp > XB_SPIN_CAP) { atomicAdd(&(bar)[XB_TMO], 1u); break; } } } } while (0)

struct XcdBarrier {
    unsigned* bar; unsigned x;
    volatile LAS unsigned* st;
};

__device__ __forceinline__ XcdBarrier xcd_barrier_post(unsigned* bar, volatile LAS unsigned* st) {
    XcdBarrier b; b.bar = bar; b.x = xb_xcc_id(); b.st = st;
    if (threadIdx.x == 0) st[2] = xb_add(&bar[XB_XCNT(b.x)], 1u);
    return b;
}
__device__ __forceinline__ void xcd_barrier_complete(unsigned* bar, unsigned x, unsigned& nloc, unsigned& nx) {
    const unsigned G = gridDim.x * gridDim.y * gridDim.z;
    unsigned sum, cnt, mine, sp = 0u;
    for (;;) {
        sum = 0u; cnt = 0u; mine = 0u;
#pragma unroll
        for (unsigned j = 0; j < 16; ++j) { const unsigned c = xb_ld(&bar[XB_XCNT(j)]); sum += c; cnt += (c > 0u) ? 1u : 0u; mine = (j == x) ? c : mine; }
        if (sum == G) break;
        __builtin_amdgcn_s_sleep(1);
        if ((++sp & 255u) == 0u) { if (xb_ld(&bar[XB_TMO])) break; if (sp > XB_SPIN_CAP) { atomicAdd(&bar[XB_TMO], 1u); break; } }
    }
    nloc = mine > 0u ? mine : 1u; nx = cnt > 0u ? cnt : 1u;
}

__device__ __forceinline__ void xcd_barrier(const XcdBarrier& b) {
    asm volatile("s_waitcnt vmcnt(0)" ::: "memory");
    __syncthreads();
    if (threadIdx.x == 0) {
        unsigned* bar = b.bar;
        __builtin_amdgcn_s_waitcnt(0);
        unsigned nloc = b.st[0], nx = b.st[1];
        if (nloc == 0u) { xcd_barrier_complete(bar, b.x, nloc, nx); b.st[0] = nloc; b.st[1] = nx; }
        const unsigned old = xb_add(&bar[XB_XSUB(b.x)], 1u);
        const unsigned gen = old / nloc;
        if (old + 1u == (gen + 1u) * nloc) {
            __builtin_amdgcn_fence(__ATOMIC_RELEASE, "agent");
            asm volatile("s_waitcnt vmcnt(0)" ::: "memory");
            const unsigned og = xb_add(&bar[XB_TOP], 1u);
            const unsigned tg = og / nx;
            if (og + 1u == (tg + 1u) * nx) xb_add(&bar[XB_TOPGEN], 1u);
            else XB_SPIN(xb_ld(&bar[XB_TOPGEN]) == tg, bar);
            __builtin_amdgcn_fence(__ATOMIC_ACQUIRE, "agent");
            xb_add(&bar[XB_XGEN(b.x)], 1u);
            asm volatile("s_waitcnt vmcnt(0)" ::: "memory");
        } else {
            XB_SPIN(xb_ld(&bar[XB_XGEN(b.x)]) == gen, bar);
            __builtin_amdgcn_fence(__ATOMIC_ACQUIRE, "agent");
            asm volatile("s_waitcnt vmcnt(0)" ::: "memory");
        }
    }
    __syncthreads();
}

__device__ __forceinline__ void xcd_barrier_local(const XcdBarrier& b) {
    asm volatile("s_waitcnt vmcnt(0)" ::: "memory");
    __syncthreads();
    if (threadIdx.x == 0) {
        unsigned* bar = b.bar;
        __builtin_amdgcn_s_waitcnt(0);
        const unsigned nloc = b.st[0];
        const unsigned old = xb_add(&bar[XB_XSUB(b.x)], 1u);
        const unsigned gen = old / nloc;
        if (old + 1u == (gen + 1u) * nloc) xb_add(&bar[XB_XGEN(b.x)], 1u);
        else XB_SPIN(xb_ld(&bar[XB_XGEN(b.x)]) == gen, bar);
        __builtin_amdgcn_fence(__ATOMIC_ACQUIRE, "agent");
        asm volatile("s_waitcnt vmcnt(0)" ::: "memory");
    }
    __syncthreads();
}

__device__ __forceinline__ void quad_barrier(unsigned* bar, unsigned* quad, unsigned pm, unsigned target, bool with_prev, unsigned* extra = nullptr, unsigned extra_target = 0u) {
    asm volatile("s_waitcnt vmcnt(0)" ::: "memory");
    __syncthreads();
    if (threadIdx.x == 0) {
        __builtin_amdgcn_s_waitcnt(0);
        xb_add(quad + 16u * pm, 1u);
        XB_SPIN(xb_ld(quad + 16u * pm) < target, bar);
        if (with_prev && (pm & 7u) != 0u) XB_SPIN(xb_ld(quad + 16u * (pm - 1u)) < target, bar);
        if (extra) XB_SPIN(xb_ld(extra) < extra_target, bar);
        __builtin_amdgcn_fence(__ATOMIC_ACQUIRE, "agent");
        asm volatile("s_waitcnt vmcnt(0)" ::: "memory");
    }
    __syncthreads();
}

__device__ __forceinline__ void count_wait(unsigned* bar, unsigned* word, unsigned target) {
    asm volatile("s_waitcnt vmcnt(0)" ::: "memory");
    __syncthreads();
    if (threadIdx.x == 0) { XB_SPIN(xb_ld(word) < target, bar); __builtin_amdgcn_fence(__ATOMIC_ACQUIRE, "agent"); asm volatile("s_waitcnt vmcnt(0)" ::: "memory"); }
    __syncthreads();
}

#ifndef PROBE
#define PROBE 0
#endif
struct Args { Inputs in; float* out; unsigned char* ws; int ph_lo, ph_hi; };
constexpr int NPHASE = 2 + 7 * DEPTH;
#define LAUNDER_S(p) asm volatile("" : "+s"(p))
#define LAUNDER_V(p) asm volatile("" : "+v"(p))
struct Ctx { unsigned char* ws; unsigned char* act0; float* X; int tid, lane, wave, G, bx, gw, ngw; };
#define BST_OFF (RING_BYTES + 512)
__device__ __forceinline__ Ctx make_ctx(const Args& a, int wave_id, LAS unsigned char* ldsb) {
    Ctx c; size_t z = 0; LAUNDER_S(z); c.ws = a.ws + z; c.X = (float*)((unsigned char*)a.out + z); c.act0 = c.ws + WS_ACT0;
    int ln; asm volatile("v_mbcnt_lo_u32_b32 %0, -1, 0\n\tv_mbcnt_hi_u32_b32 %0, -1, %0" : "=v"(ln)); c.lane = ln; c.wave = wave_id; c.tid = wave_id * 64 + ln;
    c.G = gridDim.x; c.bx = __builtin_amdgcn_readfirstlane(((volatile LAS unsigned*)(ldsb + BST_OFF))[2]); c.gw = c.bx * NWAVES + c.wave; c.ngw = c.G * NWAVES; return c;
}
__device__ __forceinline__ unsigned char* slot_of(const Ctx& c, int l) { return c.ws + WS_SLOT0 + (size_t)(l & 1) * SL_BYTES; }
__device__ __forceinline__ unsigned* ctl_word(const Ctx& c, int w) { return (unsigned*)(c.ws + WS_CTL) + w; }
__device__ __forceinline__ void tail_convert(const Args& a, const Ctx& c, int l, int ph, bool drain, bool early, LAS unsigned char* lds) {
#if MK_ONE_LAUNCH
    const unsigned xcc_ = xb_xcc_id(); const unsigned nloc_ = ((volatile LAS unsigned*)(lds + BST_OFF))[0];
    unsigned* fin = ctl_word(c, CW_FIN + (ph * 8 + (int)(xcc_ & 7u)) * 16);
    if (c.tid == 0) __hip_atomic_fetch_add(fin, 1u, RLX_AGENT);
    if (l + 1 < DEPTH && (drain || early)) convert_queue(a.in, l + 1, slot_of(c, l + 1), lds, ctl_word(c, CW_QHEAD + 64 * (l + 1)), 0, CV_ITEMS, drain ? nullptr : fin, (int)nloc_, c.tid, c.wave, c.lane);
#else
    if (l + 1 < DEPTH && drain) convert_static(a.in, l + 1, slot_of(c, l + 1), lds, 0, CV_ITEMS, c.gw, c.ngw, c.wave, c.lane);
#endif
}
__device__ __forceinline__ void ph_p0(const Args& a, const int wv, LAS unsigned char* lds) { const Ctx c = make_ctx(a, wv, lds);
    convert_static(a.in, 0, c.ws + WS_SLOT0, lds, 0, CV_ITEMS, c.gw, c.ngw, c.wave, c.lane); x_prep(a.in.p[0], (bf16*)(c.ws + WS_XB), (float*)(c.ws + WS_SSQ), c.gw, c.ngw, c.lane); }
constexpr int B1_NGLA = 28, B1_NSGU = 64, B1_NCONV = 32, B1_ITEMS = B1_NGLA + B1_NSGU + B1_NCONV;
__device__ __forceinline__ void b1_item(const Args& a, const Ctx& c, int l, int b, int it, LAS unsigned char* lds) {
    const Inputs& I = a.in; bf16* Zb = (bf16*)(c.act0 + A_Z);
    if (it < B1_NGLA) { const int h = it / 7, g = it % 7;
        gla_b1_item(b + 8 * g + 64 * h, lds, (const bf16*)(c.act0 + A_K), (const bf16*)(c.act0 + A_V), (const bf16*)(c.act0 + A_LOGA), (float*)(c.act0 + A_CST), (float*)(c.act0 + A_DEC), c.tid, c.wave, c.lane); }
    else if (it < B1_NGLA + B1_NCONV) { const int j = it - B1_NGLA; convbr_item((b + 8 * j) * NTHREADS + c.tid, Zb + 1024, Zb + 1024, (const bf16*)(c.act0 + A_CC), (const bf16*)(c.act0 + A_CX), I.p[12] + (size_t)l * 3 * CW); }
    else { const int j = it - B1_NGLA - B1_NCONV;
        sgu_item(b + 8 * j, lds, Zb + 512, Zb + 512, (const bf16*)(c.act0 + A_SV), (const float*)(c.ws + WS_SVST), I.p[7] + (size_t)l * SGW, I.p[8] + (size_t)l * SGW, (const bf16*)(slot_of(c, l) + SL_SGW), I.p[10] + (size_t)l * 512, c.wave, c.lane); }
}
struct OrderA : pg8::StaticOrder {
    unsigned* cnt;
    __device__ __forceinline__ void done(const Unit& u) const {
        if (cnt && (u.pn >> 2) == 4) { asm volatile("s_waitcnt vmcnt(0)" ::: "memory");
            __hip_atomic_fetch_add(cnt, 1u, RLX_AGENT); } }
};
__device__ __forceinline__ void ph_a(const Args& a, const int wv, int l, int ph, LAS unsigned char* lds) { const Ctx c = make_ctx(a, wv, lds);
    const bool local_ok = ((volatile LAS unsigned*)(lds + BST_OFF))[3] != 0u; const unsigned xcc = xb_xcc_id() & 7u;
    unsigned* ab = ctl_word(c, CW_AB + (l * 8 + (int)xcc) * 32);
    pg8::Gemm g{(const bf16*)(c.ws + WS_XB), (const bf16*)(slot_of(c, l) + SL_WIN), M, NIN, D}; OrderA S; S.init(M, NIN, c.G, c.bx); S.cnt = local_ok ? ab : nullptr;
    const bool tbl = (c.G == 256); if (tbl) { pg8::Unit u0; S.next(0, u0); rstd_table_fill((const float*)(c.ws + WS_SSQ), u0.pm, lds, c.tid); }
    EpiA E{c.act0, (const float*)(c.ws + WS_SSQ), (float*)(c.ws + WS_SVST), a.in.p[4] + (size_t)l * GKEY, lds, tbl};
    const int tid = c.tid; TS_BEGIN(61);
    pg8::gemm_phase<EpiA, OrderA, true, true>(lds, g, S, E, wv);
    TS_END(61);
    if (local_ok) {
        const Ctx c2 = make_ctx(a, wv, lds); volatile LAS unsigned* bc = (volatile LAS unsigned*)(lds + RING_BYTES + 768);
        const unsigned want = 512u * ((volatile LAS unsigned*)(lds + BST_OFF))[0];
        TS_BEGIN(62);
        if (c2.tid == 0) { unsigned sp = 0u; while (__hip_atomic_load(ab, RLX_AGENT) < want) { __builtin_amdgcn_s_sleep(2); if (++sp > (1u << 22)) { atomicAdd((unsigned*)(c2.ws + WS_CTL) + CW_BAR + XB_TMO, 1u); break; } }
            __builtin_amdgcn_fence(__ATOMIC_ACQUIRE, "agent"); asm volatile("s_waitcnt vmcnt(0)" ::: "memory"); }
        __syncthreads();
        TS_END(62); TS_BEGIN(63);
        unsigned nxt = 0u, prev = 0xffffffffu; if (c2.tid == 0) nxt = __hip_atomic_fetch_add(ab + 16, 1u, RLX_AGENT);
        for (;;) {
            if (c2.tid == 0) bc[0] = nxt;
            asm volatile("s_waitcnt vmcnt(0)" ::: "memory");
            LDS_BARRIER();
            if (c2.tid == 0 && prev != 0xffffffffu) { __hip_atomic_fetch_add(ab + 24, 1u, RLX_AGENT); if (prev < (unsigned)B1_NGLA) __hip_atomic_fetch_add(ab + 20, 1u, RLX_AGENT); }
            const unsigned it = bc[0];
            LDS_BARRIER();
            if (it >= (unsigned)B1_ITEMS) break;
            prev = it;
            if (c2.tid == 0) nxt = __hip_atomic_fetch_add(ab + 16, 1u, RLX_AGENT);
            { const Ctx ci = make_ctx(a, wv, lds); b1_item(a, ci, l, (int)xcc, (int)it, lds); }
        }
        TS_END(63);
    }
}
__device__ __forceinline__ void ph_b1(const Args& a, const int wv, int l, LAS unsigned char* lds) { const Ctx c = make_ctx(a, wv, lds);
    if (((volatile LAS unsigned*)(lds + BST_OFF))[3] != 0u) return;
    for (int q = c.bx; q < 8 * B1_ITEMS; q += c.G) { const Ctx ci = make_ctx(a, wv, lds); b1_item(a, ci, l, q & 7, q >> 3, lds); }
}
__device__ __forceinline__ void ph_b2(const Args& a, const int wv, int l, int ph, LAS unsigned char* lds) { const Ctx c = make_ctx(a, wv, lds);
    if (PROBE == 6) for (int it = c.bx; it < 256; it += c.G) gla_b2_unit(it, lds, (const bf16*)(c.act0 + A_Q), (const bf16*)(c.act0 + A_K), (const bf16*)(c.act0 + A_V), (const bf16*)(c.act0 + A_LOGA), (const float*)(c.act0 + A_CST), (const float*)(c.act0 + A_DEC), (const bf16*)(c.act0 + A_Z), (bf16*)(c.ws + WS_END), c.tid, c.wave, c.lane);
    for (int it = c.bx; it < 256; it += c.G) gla_b2_unit(it, lds, (const bf16*)(c.act0 + A_Q), (const bf16*)(c.act0 + A_K), (const bf16*)(c.act0 + A_V), (const bf16*)(c.act0 + A_LOGA), (const float*)(c.act0 + A_CST), (const float*)(c.act0 + A_DEC), (const bf16*)(c.act0 + A_Z), (bf16*)(c.act0 + A_Z), c.tid, c.wave, c.lane); }
__device__ __forceinline__ void ph_c(const Args& a, const int wv, int l, LAS unsigned char* lds) { const Ctx c = make_ctx(a, wv, lds);
    pg8::Gemm g{(const bf16*)(c.act0 + A_Z), (const bf16*)(slot_of(c, l) + SL_WBR), M, D, ZPITCH}; pg8::StaticOrder S; S.init(M, D, c.G, c.bx); EpiC E{(const unsigned char*)(c.act0 + A_G), (bf16*)(c.act0 + A_MERGED)};
    const int tid = c.tid; TS_BEGIN(51);
    for (int rep = 0; rep < 1 + (PROBE == 7); ++rep) pg8::gemm_phase<EpiC, pg8::StaticOrder, true, true>(lds, g, S, E, wv);
    TS_END(51); }
__device__ __forceinline__ void ph_res(const Args& a, const int wv, const bf16* A, const bf16* Bt, int K, int dup, int l, int ph, bool drain, LAS unsigned char* lds) { const Ctx c = make_ctx(a, wv, lds);
    pg8::Gemm g{A, Bt, M, D, K}; pg8::StaticOrder S; S.init(M, D, c.G, c.bx);
    if (dup == 2) { EpiNull<true> EN_{(float*)(c.ws + WS_END)}; pg8::gemm_phase<EpiNull<true>, pg8::StaticOrder, true, true>(lds, g, S, EN_, wv); }
    if (dup == 3) { EpiResT<1> E{(const bf16*)(c.ws + WS_XB), (bf16*)(c.ws + WS_END), (float*)(c.ws + WS_END + 32 * MiB)}; pg8::gemm_phase<EpiResT<1>, pg8::StaticOrder, true, true>(lds, g, S, E, wv); }
    if (dup == 4) { EpiResT<2> E{(const bf16*)(c.ws + WS_XB), (bf16*)(c.ws + WS_END), (float*)(c.ws + WS_END + 32 * MiB)}; pg8::gemm_phase<EpiResT<2>, pg8::StaticOrder, true, true>(lds, g, S, E, wv); }
    if (dup == 1) { EpiRes E{(const bf16*)(c.ws + WS_XB), (bf16*)(c.ws + WS_END), (float*)(c.ws + WS_END + 32 * MiB)}; pg8::gemm_phase<EpiRes, pg8::StaticOrder, true, true>(lds, g, S, E, wv); }
    const int tid = c.tid; TS_BEGIN(71);
    if (drain) { pg8::Unit u0; for (int i = 0; S.next(i, u0); ++i) ffn_fixup(u0.pm, (const float*)(c.act0 + A_HT), (bf16*)(c.act0 + A_ACT), a.in.p[17] + (size_t)l * 3 * DFF2, a.in.p[18] + (size_t)l * DFF2, c.tid); }
    if (drain) TS_END(71);
    TS_BEGIN(72);
    EpiRes E{(const bf16*)(c.ws + WS_XB), (bf16*)(c.ws + WS_XB), (float*)(c.ws + WS_SSQ)};
    pg8::gemm_phase<EpiRes, pg8::StaticOrder, true, true>(lds, g, S, E, wv);
    if (drain) TS_END(72);
    TS_BEGIN(73);
    if (drain) { const Ctx c2 = make_ctx(a, wv, lds); tail_convert(a, c2, l, ph, true, true, lds); }
    if (drain) TS_END(73); }
__device__ __forceinline__ void ph_e(const Args& a, const int wv, int l, int ph, LAS unsigned char* lds) { const Ctx c = make_ctx(a, wv, lds);
    pg8::Gemm g{(const bf16*)(c.ws + WS_XB), (const bf16*)(slot_of(c, l) + SL_WUP), M, DFF2, D}; pg8::StaticOrder S; S.init(M, DFF2, c.G, c.bx);
    const bool tbl = (c.G == 256); if (tbl) { pg8::Unit u0; S.next(0, u0); rstd_table_fill((const float*)(c.ws + WS_SSQ), u0.pm, lds, c.tid); }
    EpiUpConv E{c.ws, a.in.p[17] + (size_t)l * 3 * DFF2, a.in.p[18] + (size_t)l * DFF2, lds, tbl};
    for (int rep = 0; rep < 1 + (PROBE == 8); ++rep) pg8::gemm_phase<EpiUpConv, pg8::StaticOrder, true, true>(lds, g, S, E, wv);
    { const Ctx c2 = make_ctx(a, wv, lds); tail_convert(a, c2, l, ph, false, ((DFF2 / 256) * 64 - 1) / c2.G * c2.G + c2.bx >= (DFF2 / 256) * 64, lds); } }
__device__ __forceinline__ void ph_fin(const Args& a, const int wv, LAS unsigned char* lds) { const Ctx c = make_ctx(a, wv, lds); final_norm((const bf16*)(c.ws + WS_XB), c.X, (const float*)(c.ws + WS_SSQ), a.in.p[20], c.gw, c.ngw, c.lane); }

#ifndef PHMASK
#define PHMASK 0xFFFF
#endif
#define EN(b) ((PHMASK >> (b)) & 1)
__global__ void __launch_bounds__(NTHREADS, 2) mk_fwd(Args args) {
    extern __shared__ __attribute__((aligned(16))) unsigned char lds_raw[];
    LAS unsigned char* lds = (LAS unsigned char*)lds_raw;
    const int wv = __builtin_amdgcn_readfirstlane(threadIdx.x >> 6);
#ifdef TSUB
    if (threadIdx.x == 0) *TS_SLOT = 0ull;
#endif
    const int lo = args.ph_lo, hi = args.ph_hi;
#define IN(k) (lo <= (k) && (k) < hi)
#if MK_ONE_LAUNCH
    volatile LAS unsigned* bst = (volatile LAS unsigned*)(lds + BST_OFF);
    if (threadIdx.x < 4) bst[threadIdx.x] = 0u;
    __syncthreads();
    const XcdBarrier bar = xcd_barrier_post((unsigned*)(args.ws + WS_CTL) + CW_BAR, bst);
    __syncthreads();
    const unsigned my_rank = bst[2];
    __syncthreads();
    if (threadIdx.x == 0) bst[2] = blockIdx.x;
    __syncthreads();
#define SEAM_GLOBAL(k) (((k) % 7) == 0)
#define SEAM_IS_A(k) (((k) % 7) == 1)
#define SEAM(k) do { if (IN(k) && IN((k) + 1)) { \
        if ((k) == 0) { if (args.ph_hi < 0) cg::this_grid().sync();     \
            xcd_barrier(bar); \
            if (threadIdx.x == 0) { unsigned* bw = (unsigned*)(args.ws + WS_CTL) + CW_BAR; unsigned nloc_ = 1u, nx_ = 1u; xcd_barrier_complete(bw, bar.x, nloc_, nx_);     \
                bool u32 = (gridDim.x == 256u) && xb_ld(&bw[XB_TMO]) == 0u; \
                for (unsigned j = 0; j < 16; ++j) { const unsigned c_ = xb_ld(&bw[XB_XCNT(j)]); if (j < 8 ? c_ != 32u : c_ != 0u) u32 = false; } \
                bst[0] = nloc_; bst[1] = nx_; bst[3] = u32 ? 1u : 0u; bst[2] = u32 ? my_rank * 8u + bar.x : blockIdx.x; } \
            __syncthreads(); } \
        else if (SEAM_GLOBAL(k) || bst[3] == 0u) xcd_barrier(bar); \
        else if (((k) % 7) >= 3) { const unsigned lid_ = bst[2], pm_ = ((lid_ & 7u) << 3) | ((lid_ >> 3) & 7u), n_ = 4u * (unsigned)(((k) - 1) / 7) + (unsigned)((k) % 7) - 2u;     \
            unsigned* ab_ = (unsigned*)(args.ws + WS_CTL) + CW_AB + ((unsigned)(((k) - 1) / 7) * 8u + (lid_ & 7u)) * 32u;                                                \
            quad_barrier((unsigned*)(args.ws + WS_CTL) + CW_BAR, (unsigned*)(args.ws + WS_CTL) + CW_QUAD, pm_, 4u * n_, ((k) % 7) == 6, ((k) % 7) == 3 ? ab_ + 24 : nullptr, (unsigned)B1_ITEMS); } \
        else if (!SEAM_IS_A(k)) { const unsigned lid_ = bst[2]; unsigned* ab_ = (unsigned*)(args.ws + WS_CTL) + CW_AB + ((unsigned)(((k) - 1) / 7) * 8u + (lid_ & 7u)) * 32u;     \
            count_wait((unsigned*)(args.ws + WS_CTL) + CW_BAR, ab_ + 20, (unsigned)B1_NGLA); } } } while (0)
#else
#define SEAM(k) do { } while (0)
#endif
#ifdef TPROBE
    unsigned long long tp_acc = 0ull, tp_prev = __builtin_amdgcn_s_memrealtime();
#define TP_MARK(kind) do { const unsigned long long t_ = __builtin_amdgcn_s_memrealtime(); if ((kind) == TPROBE) tp_acc += t_ - tp_prev; tp_prev = t_; } while (0)
#else
#define TP_MARK(kind) do { } while (0)
#endif
    int ph = 0;
    if (EN(0) && IN(ph)) ph_p0(args, wv, lds);
    SEAM(ph); ++ph; TP_MARK(0);
    for (int l = 0; l < DEPTH; ++l) {
        if (EN(1) && IN(ph)) ph_a(args, wv, l, ph, lds);
        SEAM(ph); ++ph; TP_MARK(1);
        if (EN(2) && IN(ph)) ph_b1(args, wv, l, lds);
        SEAM(ph); ++ph; TP_MARK(2);
        if (EN(3) && IN(ph)) ph_b2(args, wv, l, ph, lds);
        SEAM(ph); ++ph; TP_MARK(3);
        if (EN(4) && IN(ph)) ph_c(args, wv, l, lds);
        SEAM(ph); ++ph; TP_MARK(4);
        if (EN(5) && IN(ph)) { size_t z = 0; LAUNDER_S(z); unsigned char* ws = args.ws + z; ph_res(args, wv, (const bf16*)(ws + WS_ACT0 + A_MERGED), (const bf16*)(ws + WS_SLOT0 + (size_t)(l & 1) * SL_BYTES + SL_WO), D, PROBE == 10 ? 1 : (PROBE == 22 ? 2 : (PROBE == 31 ? 3 : (PROBE == 32 ? 4 : 0))), l, ph, false, lds); }
        SEAM(ph); ++ph; TP_MARK(5);
        if (EN(6) && IN(ph)) ph_e(args, wv, l, ph, lds);
        SEAM(ph); ++ph; TP_MARK(6);
        if (EN(8) && IN(ph)) { size_t z = 0; LAUNDER_S(z); unsigned char* ws = args.ws + z; ph_res(args, wv, (const bf16*)(ws + WS_ACT0 + A_ACT), (const bf16*)(ws + WS_SLOT0 + (size_t)(l & 1) * SL_BYTES + SL_WDN), DFF, PROBE == 11 ? 1 : (PROBE == 23 ? 2 : 0), l, ph, true, lds); }
        SEAM(ph); ++ph; TP_MARK(7);
    }
    if (EN(9) && IN(ph)) ph_fin(args, wv, lds);
#ifdef TSUB
    if (threadIdx.x == 0 && *TS_SLOT != 0ull) { const unsigned long long tt = *TS_SLOT; const unsigned long long t0 = __builtin_amdgcn_s_memrealtime(); while (__builtin_amdgcn_s_memrealtime() - t0 < 10ull * tt) __builtin_amdgcn_s_sleep(8); }
#endif
#ifdef TPROBE
    TP_MARK(8);
    if (blockIdx.x == 0 && wv == 0) { const unsigned long long t0 = __builtin_amdgcn_s_memrealtime(); while (__builtin_amdgcn_s_memrealtime() - t0 < 10ull * tp_acc) __builtin_amdgcn_s_sleep(8); }
#endif
#undef IN
#undef SEAM
}

extern "C" void kernel_launch(void* const* d_in, const int* in_sizes, int n_in, void* d_out, int out_size, void* d_ws, size_t ws_size, hipStream_t stream) {
    static int grid = 0;
    if (grid == 0) {
        if (n_in != 21 || out_size != M * D || ws_size < WS_END + (PROBE ? 64 * MiB : 0)) { fprintf(stderr, "kernel_launch: unexpected shapes / workspace (%zu < %zu)\n", ws_size, (size_t)WS_END); grid = -1; return; }
        int dev = 0, cus = 0, per_cu = 0;
        if (hipGetDevice(&dev) != hipSuccess || hipDeviceGetAttribute(&cus, hipDeviceAttributeMultiprocessorCount, dev) != hipSuccess) { grid = -1; return; }
        if (hipFuncSetAttribute((const void*)mk_fwd, hipFuncAttributeMaxDynamicSharedMemorySize, LDS_BYTES) != hipSuccess) { fprintf(stderr, "kernel_launch: hipFuncSetAttribute failed\n"); grid = -1; return; }
        if (hipOccupancyMaxActiveBlocksPerMultiprocessor(&per_cu, (const void*)mk_fwd, NTHREADS, LDS_BYTES) != hipSuccess || per_cu < 1) { fprintf(stderr, "kernel_launch: occupancy query says %d\n", per_cu); per_cu = 1; }
        (void)hipGetLastError();
        grid = cus * 1;
    }
    if (grid < 0) return;
#if MK_ONE_LAUNCH
    if (hipMemsetAsync((char*)d_ws + WS_CTL, 0, 65536, stream) != hipSuccess) { fprintf(stderr, "kernel_launch: memset failed\n"); return; }
#endif
    Args a{};
    for (int i = 0; i < 21; ++i) a.in.p[i] = (const float*)d_in[i];
    a.out = (float*)d_out; a.ws = (unsigned char*)d_ws;
#if MK_ONE_LAUNCH
    a.ph_lo = 0; a.ph_hi = NPHASE;
    void* kargs[] = {&a};
    hipError_t e = hipLaunchCooperativeKernel((const void*)mk_fwd, dim3(grid), dim3(NTHREADS), kargs, LDS_BYTES, stream);
    if (e != hipSuccess) fprintf(stderr, "kernel_launch: cooperative launch failed: %s (grid %d)\n", hipGetErrorString(e), grid);
#else
    for (int p = 0; p < NPHASE; ++p) { a.ph_lo = p; a.ph_hi = p + 1; hipLaunchKernelGGL(mk_fwd, dim3(grid), dim3(NTHREADS), LDS_BYTES, stream, a); }
#endif
}
```
